# Optimizing an MI355X kernel written in HIP

```python
import math
import jax, jax.numpy as jnp
from jax import lax
import numpy as np

D_MODEL = 1024
BATCH = 8
SEQ = 4096
DEPTH = 2

HEAD_DIM = 64
QBLOCK = 128
BRANCH_WIDTH = D_MODEL // 2
DIFF_HEADS = D_MODEL // 256
DIFF_V_DIM = 2 * HEAD_DIM
DIL_HEADS = D_MODEL // 128
DIL_PATTERNS = ((128, 1), (512, 4), (2048, 16))
SB_HEADS = D_MODEL // 128
N_BRANCHES = 3
IN_WIDTH = 9 * BRANCH_WIDTH
D_FF_DENSE = 256 * ((8 * D_MODEL // 3 + 255) // 256)
N_EXPERTS = 8
TOP_K = 2
D_FF_EXPERT = 7 * D_MODEL // 2
N_DENSE = (DEPTH + 1) // 2
N_MOE = DEPTH // 2
NORM_EPS = 1e-6
NEG_INF = -1e30

kernel_name = "hybrid_diff_dilated_stickbreak_moe"


def rmsnorm(x, g):
    xf = x.astype(jnp.float32)
    y = xf * lax.rsqrt(jnp.mean(xf * xf, axis=-1, keepdims=True) + NORM_EPS)
    return (y * g.astype(jnp.float32)).astype(x.dtype)


def alibi_slopes():
    n = DIFF_HEADS + DIL_HEADS
    slopes = (2.0 ** (-8.0 * np.arange(1, n + 1) / n)).astype(np.float32)
    is_diff = (np.arange(n) % 3) == 2
    return slopes[is_diff], slopes[~is_diff]


def diff_attention(q, k, v, lam, slopes):
    S, Dh = q.shape[3], q.shape[4]
    scale = Dh ** -0.5
    outs = []
    for b0 in range(0, S, QBLOCK):
        kl = b0 + QBLOCK
        s = jnp.einsum('bhcqd,bhckd->bhcqk', q[:, :, :, b0:kl], k[:, :, :, :kl]).astype(jnp.float32) * scale
        dist = np.arange(b0, kl)[:, None] - np.arange(kl)[None, :]
        bias = -slopes[:, None, None] * dist.astype(np.float32)[None]
        s = jnp.where(dist >= 0, s + bias[:, None], NEG_INF)
        p = jax.nn.softmax(s, axis=-1)
        a = p[:, :, 0] - lam * p[:, :, 1]
        outs.append(jnp.einsum('bhqk,bhkd->bhqd', a.astype(v.dtype), v[:, :, :kl]))
    return jnp.concatenate(outs, axis=2)


def dilated_attention(q, k, v, slopes):
    B, S, H, Dh = q.shape
    scale = Dh ** -0.5
    outs, maxes, denoms = [], [], []
    for window, dil in DIL_PATTERNS:
        span = window // dil
        n = S // dil
        qb = min(QBLOCK, n)
        nb = -(-n // qb)
        npad = nb * qb

        def to_sub(t):
            return t.reshape(B, n, dil, H, Dh).transpose(0, 2, 3, 1, 4)

        def from_sub(t):
            c = t.shape[-1]
            t = t.reshape(B, dil, H, npad, c)[:, :, :, :n]
            return t.transpose(0, 3, 1, 2, 4).reshape(B, S, H, c)

        qs = jnp.pad(to_sub(q), ((0, 0), (0, 0), (0, 0), (0, npad - n), (0, 0))).reshape(B, dil, H, nb, qb, Dh)
        kv_pad = ((0, 0), (0, 0), (0, 0), (span, npad - n), (0, 0))
        ks = jnp.pad(to_sub(k), kv_pad)
        vs = jnp.pad(to_sub(v), kv_pad)
        kidx = np.arange(nb)[:, None] * qb + np.arange(qb + span)[None, :]
        kg = ks[:, :, :, kidx]
        vg = vs[:, :, :, kidx]
        s = jnp.einsum('brhnqd,brhnkd->brhnqk', qs, kg).astype(jnp.float32) * scale
        qi = np.arange(qb)[:, None]
        kj = np.arange(qb + span)[None, :]
        delta = qi - kj + span
        key_sub = np.arange(nb)[:, None, None] * qb - span + kj[None]
        valid = (delta >= 0) & (delta <= span) & (key_sub >= 0)
        bias = -slopes[:, None, None, None] * (delta * dil).astype(np.float32)[None, None]
        s = jnp.where(valid, s + bias, NEG_INF)
        m = jnp.max(s, axis=-1, keepdims=True)
        p = jnp.exp(s - m)
        l = jnp.sum(p, axis=-1, keepdims=True)
        o = jnp.einsum('brhnqk,brhnkd->brhnqd', p.astype(v.dtype), vg).astype(jnp.float32)
        outs.append(from_sub(o))
        maxes.append(from_sub(m))
        denoms.append(from_sub(l))
    m_all = jnp.maximum(jnp.maximum(maxes[0], maxes[1]), maxes[2])
    num = 0.0
    den = 0.0
    for o, m, l in zip(outs, maxes, denoms):
        w = jnp.exp(m - m_all)
        num = num + w * o
        den = den + w * l
    return (num / den).astype(q.dtype)


def stick_breaking_attention(q, k, v):
    S, Dh = q.shape[2], q.shape[3]
    scale = Dh ** -0.5
    outs = []
    for b0 in range(0, S, QBLOCK):
        kl = b0 + QBLOCK
        z = jnp.einsum('bhqd,bhkd->bhqk', q[:, :, b0:kl], k[:, :, :kl]).astype(jnp.float32) * scale
        causal = (np.arange(b0, kl)[:, None] - np.arange(kl)[None, :]) > 0
        log_beta = jax.nn.log_sigmoid(z)
        log_1m = jnp.where(causal, jax.nn.log_sigmoid(-z), 0.0)
        rem = lax.cumsum(log_1m, axis=3, reverse=True) - log_1m
        a = jnp.where(causal, jnp.exp(log_beta + rem), 0.0)
        outs.append(jnp.einsum('bhqk,bhkd->bhqd', a.astype(v.dtype), v[:, :, :kl]))
    return jnp.concatenate(outs, axis=2)


def swiglu(h, w_g, w_u, w_d):
    return (jax.nn.silu(h @ w_g) * (h @ w_u)) @ w_d


def moe_swiglu(h, w_router, w_g, w_u, w_d):
    logits = (h @ w_router).astype(jnp.float32)
    top_val, top_idx = lax.top_k(logits, TOP_K)
    top_w = jax.nn.softmax(top_val, axis=-1)
    gate = jnp.sum(jax.nn.one_hot(top_idx, N_EXPERTS, dtype=jnp.float32) * top_w[..., None], axis=-2)
    out = jnp.zeros_like(h)
    for e in range(N_EXPERTS):
        out = out + gate[..., e:e + 1].astype(h.dtype) * swiglu(h, w_g[e], w_u[e], w_d[e])
    return out


def setup_inputs(seed: int = 0) -> dict:
    key = jax.random.key(seed)
    ks = jax.random.split(key, 20)
    D, W = D_MODEL, BRANCH_WIDTH
    f32 = jnp.float32

    def nrm(k, shape, fan_in):
        return jax.random.normal(k, shape, f32) * (fan_in ** -0.5)

    return {
        "x": jax.random.normal(ks[0], (BATCH, SEQ, D), f32),
        "norm_mix": 1.0 + 0.05 * jax.random.normal(ks[1], (DEPTH, D), f32),
        "w_in": nrm(ks[2], (DEPTH, D, IN_WIDTH), D),
        "diff_lambda": 0.1 * jax.random.normal(ks[3], (DEPTH, 4, HEAD_DIM), f32),
        "diff_subln": 1.0 + 0.05 * jax.random.normal(ks[4], (DEPTH, DIFF_V_DIM), f32),
        "w_gate": nrm(ks[5], (DEPTH, D, N_BRANCHES * D), D),
        "b_gate": 0.02 * jax.random.normal(ks[6], (DEPTH, N_BRANCHES * D), f32),
        "w_branch": nrm(ks[7], (DEPTH, N_BRANCHES, W, D), W),
        "w_out": nrm(ks[8], (DEPTH, D, D), D),
        "norm_ffn": 1.0 + 0.05 * jax.random.normal(ks[9], (DEPTH, D), f32),
        "w_dense_gate": nrm(ks[10], (N_DENSE, D, D_FF_DENSE), D),
        "w_dense_up": nrm(ks[11], (N_DENSE, D, D_FF_DENSE), D),
        "w_dense_down": nrm(ks[12], (N_DENSE, D_FF_DENSE, D), D_FF_DENSE),
        "w_router": nrm(ks[13], (N_MOE, D, N_EXPERTS), D),
        "w_moe_gate": nrm(ks[14], (N_MOE, N_EXPERTS, D, D_FF_EXPERT), D),
        "w_moe_up": nrm(ks[15], (N_MOE, N_EXPERTS, D, D_FF_EXPERT), D),
        "w_moe_down": nrm(ks[16], (N_MOE, N_EXPERTS, D_FF_EXPERT, D), D_FF_EXPERT),
        "norm_final": 1.0 + 0.05 * jax.random.normal(ks[17], (D,), f32),
    }


def reference(x, norm_mix, w_in, diff_lambda, diff_subln, w_gate, b_gate, w_branch, w_out,
              norm_ffn, w_dense_gate, w_dense_up, w_dense_down,
              w_router, w_moe_gate, w_moe_up, w_moe_down, norm_final):
    B, S, D = x.shape
    W = BRANCH_WIDTH
    slopes_diff, slopes_dil = alibi_slopes()
    for layer in range(DEPTH):
        h = rmsnorm(x, norm_mix[layer])
        proj = h @ w_in[layer]
        qa, ka, va, qb, kb, vb, qc, kc, vc = jnp.split(proj, 9, axis=-1)

        qa = qa.reshape(B, S, DIFF_HEADS, 2, HEAD_DIM).transpose(0, 2, 3, 1, 4)
        ka = ka.reshape(B, S, DIFF_HEADS, 2, HEAD_DIM).transpose(0, 2, 3, 1, 4)
        va = va.reshape(B, S, DIFF_HEADS, DIFF_V_DIM).transpose(0, 2, 1, 3)
        lam_init = 0.8 - 0.6 * math.exp(-0.3 * layer)
        lv = diff_lambda[layer].astype(jnp.float32)
        lam = jnp.exp(jnp.sum(lv[0] * lv[1])) - jnp.exp(jnp.sum(lv[2] * lv[3])) + lam_init
        ya = diff_attention(qa, ka, va, lam, slopes_diff)
        ya = rmsnorm(ya, diff_subln[layer]) * (1.0 - lam_init)
        ya = ya.transpose(0, 2, 1, 3).reshape(B, S, W)

        yb = dilated_attention(qb.reshape(B, S, DIL_HEADS, HEAD_DIM),
                               kb.reshape(B, S, DIL_HEADS, HEAD_DIM),
                               vb.reshape(B, S, DIL_HEADS, HEAD_DIM), slopes_dil).reshape(B, S, W)

        to_heads = lambda t: t.reshape(B, S, SB_HEADS, HEAD_DIM).transpose(0, 2, 1, 3)
        yc = stick_breaking_attention(to_heads(qc), to_heads(kc), to_heads(vc))
        yc = yc.transpose(0, 2, 1, 3).reshape(B, S, W)

        gates = jax.nn.sigmoid(h @ w_gate[layer] + b_gate[layer])
        merged = jnp.zeros_like(x)
        for i, y in enumerate((ya, yb, yc)):
            merged = merged + gates[..., i * D:(i + 1) * D] * (y @ w_branch[layer, i])
        x = x + merged @ w_out[layer]

        h = rmsnorm(x, norm_ffn[layer])
        j = layer // 2
        if layer % 2 == 0:
            f = swiglu(h, w_dense_gate[j], w_dense_up[j], w_dense_down[j])
        else:
            f = moe_swiglu(h, w_router[j], w_moe_gate[j], w_moe_up[j], w_moe_down[j])
        x = x + f
    return rmsnorm(x, norm_final)
```

```cpp
#include <hip/hip_runtime.h>
#include <cstdio>
#include <cstdint>

#ifndef MK_N_LAUNCHES
#define MK_N_LAUNCHES 1
#endif

namespace pg8 {
#define PG8_LAS __attribute__((address_space(3)))
typedef unsigned short bf16_t;
typedef short bf16x8 __attribute__((ext_vector_type(8)));
typedef float f32x4 __attribute__((ext_vector_type(4)));
typedef float f32x2 __attribute__((ext_vector_type(2)));
typedef unsigned u32x4 __attribute__((ext_vector_type(4)));
constexpr int BM = 256, BK = 64, HALF = 128, HTB = HALF * BK * 2  , STAGE_BYTES = 8 * HTB, NXCD = 8, WGM = 8;

__host__ __device__ __forceinline__ int lds_byte(int r, int c) { const int st = (r >> 4) * 2 + (c >> 5), rr = r & 15, cc = c & 31, ob = rr * 64 + cc * 2; return st * 1024 + (ob ^ (((ob >> 9) & 1) << 5)); }
__host__ __device__ __forceinline__ void stage_rc(int b, int& R, int& C) { const int st = b / 1024, sb = b % 1024, swz = sb ^ (((sb >> 9) & 1) << 5); R = (st >> 1) * 16 + swz / 64; C = (st & 1) * 32 + (swz % 64) / 2; }
__host__ __device__ __forceinline__ int perm32(int rho) { const int n = rho >> 4, i = rho & 15; return 8 * (i >> 2) + 4 * n + (i & 3); }

struct Unit { int pm, pn, om, tag; long ao, bo; };
struct Gemm { const bf16_t* A; const bf16_t* Bt; int K; };

__device__ __forceinline__ void tile_of(int wgid, int nwg, int nM, int nN, int& pm, int& pn) {
    { const int q = nwg / NXCD, r = nwg % NXCD, xcd = wgid % NXCD, off = wgid / NXCD; wgid = (xcd < r ? xcd * (q + 1) : r * (q + 1) + (xcd - r) * q) + off; }
    const int nig = WGM * nN, gid = wgid / nig, fm = gid * WGM, gsz = (nM - fm) < WGM ? (nM - fm) : WGM;
    pm = fm + ((wgid % nig) % gsz); pn = (wgid % nig) / gsz;
}
struct StaticOrder {
    int nM, nN, nwg, G, c; long tst;
    __device__ void init(int M, int N, int K, int G_, int c_) { nM = M / BM; nN = N / BM; nwg = nM * nN; G = G_; c = c_; tst = (long)BM * K * 2; }
    __device__ __forceinline__ bool next(int i, Unit& u) const {
        const long L = (long)i * G + c; if (L >= nwg) return false;
        tile_of((int)L, nwg, nM, nN, u.pm, u.pn); u.om = u.pm; u.tag = 0; u.ao = (long)u.pm * tst; u.bo = (long)u.pn * tst; return true;
    }
    __device__ __forceinline__ void a_ready(const Unit&) const {}
    __device__ __forceinline__ void done(const Unit&) const {}
};
struct MergeOrder {
    StaticOrder b; long as, bs;
    __device__ __forceinline__ bool next(int i, Unit& u) const {
        const int ti = i / 3, tg = i - 3 * ti; if (!b.next(ti, u)) return false;
        u.tag = tg; u.ao += (long)tg * as; u.bo += (long)tg * bs; return true;
    }
    __device__ __forceinline__ void a_ready(const Unit&) const {}
    __device__ __forceinline__ void done(const Unit&) const {}
};
struct MoeOrder {
    int t0, nt, nN, nwg, G, c; long tA, tB, eB; int c0, c1, c2, c3, c4, c5, c6; bool a_local, o_local;
    __device__ __forceinline__ bool next(int i, Unit& u) const {
        const long L = (long)i * G + c; if (L >= nwg) return false;
        int pl, pn; tile_of((int)L, nwg, nt, nN, pl, pn);
        const int gt = t0 + pl; const int e = (gt >= c0) + (gt >= c1) + (gt >= c2) + (gt >= c3) + (gt >= c4) + (gt >= c5) + (gt >= c6);
        u.pm = gt; u.pn = pn; u.tag = e; u.om = o_local ? pl : gt; u.ao = (long)(a_local ? pl : gt) * tA; u.bo = (long)e * eB + (long)pn * tB; return true;
    }
    __device__ __forceinline__ void a_ready(const Unit&) const {}
    __device__ __forceinline__ void done(const Unit&) const {}
};

typedef __bf16 bf16x2_t __attribute__((ext_vector_type(2)));
__device__ __forceinline__ unsigned cvt_pk_bf16(float lo, float hi) { f32x2 v = {lo, hi}; bf16x2_t b = __builtin_convertvector(v, bf16x2_t); return __builtin_bit_cast(unsigned, b); }
__device__ __forceinline__ float bf_lo(unsigned w) { return __uint_as_float(w << 16); }
__device__ __forceinline__ float bf_hi(unsigned w) { return __uint_as_float(w & 0xffff0000u); }
__device__ __forceinline__ float sigm(float x) { return __builtin_amdgcn_rcpf(1.0f + __builtin_amdgcn_exp2f(-1.4426950408889634f * x)); }
__device__ __forceinline__ u32x4 pack8(f32x4 v0, f32x4 v1) { u32x4 w; w.x = cvt_pk_bf16(v0[0], v0[1]); w.y = cvt_pk_bf16(v0[2], v0[3]); w.z = cvt_pk_bf16(v1[0], v1[1]); w.w = cvt_pk_bf16(v1[2], v1[3]); return w; }

struct EpiProj {
    static constexpr bool PERM = true, AFTER_DRAIN = false;
    bf16_t* O; size_t split_stride; float qscale;
    __device__ __forceinline__ void operator()(const f32x4 (&acc)[2][2][4][2], const Unit& u, int wr, int wc, int fr, int fq) const {
        const int t = u.pn / 6, lt = u.pn - 6 * t; bf16_t* base = O + (size_t)t * split_stride; const float sc = lt < 2 ? qscale : 1.f;
        const int row0 = u.om * BM + wr * 64 + fr, col0 = lt * BM + wc * 32 + 8 * fq;
#pragma unroll
        for (int ai = 0; ai < 2; ++ai)
#pragma unroll
            for (int m = 0; m < 4; ++m) { bf16_t* rowp = base + (size_t)(row0 + ai * HALF + m * 16) * 1536 + col0;
#pragma unroll
                for (int bj = 0; bj < 2; ++bj) *(u32x4*)(rowp + bj * HALF) = pack8(acc[ai][bj][m][0] * sc, acc[ai][bj][m][1] * sc); }
    }
};
struct EpiGate {
    static constexpr bool PERM = true, AFTER_DRAIN = false;
    bf16_t* O; int ldc; const float* bias;
    __device__ __forceinline__ void operator()(const f32x4 (&acc)[2][2][4][2], const Unit& u, int wr, int wc, int fr, int fq) const {
        const int row0 = u.om * BM + wr * 64 + fr, col0 = u.pn * BM + wc * 32 + 8 * fq;
        f32x4 bv[2][2];
#pragma unroll
        for (int bj = 0; bj < 2; ++bj)
#pragma unroll
            for (int n = 0; n < 2; ++n) bv[bj][n] = *(const f32x4*)(bias + col0 + bj * HALF + 4 * n);
#pragma unroll
        for (int ai = 0; ai < 2; ++ai)
#pragma unroll
            for (int m = 0; m < 4; ++m) { bf16_t* rowp = O + (size_t)(row0 + ai * HALF + m * 16) * ldc + col0;
#pragma unroll
                for (int bj = 0; bj < 2; ++bj) { f32x4 v0 = acc[ai][bj][m][0] + bv[bj][0], v1 = acc[ai][bj][m][1] + bv[bj][1];
#pragma unroll
                    for (int i = 0; i < 4; ++i) { v0[i] = sigm(v0[i]); v1[i] = sigm(v1[i]); }
                    *(u32x4*)(rowp + bj * HALF) = pack8(v0, v1); } }
    }
};
struct EpiMerge {
    static constexpr bool PERM = true, AFTER_DRAIN = false;
    const bf16_t* gates; bf16_t* O;
    __device__ __forceinline__ void operator()(const f32x4 (&acc)[2][2][4][2], const Unit& u, int wr, int wc, int fr, int fq) const {
        const int row0 = u.om * BM + wr * 64 + fr, col0 = u.pn * BM + wc * 32 + 8 * fq; const int tg = u.tag;
#pragma unroll
        for (int ai = 0; ai < 2; ++ai)
#pragma unroll
            for (int m = 0; m < 4; ++m) { const size_t row = (size_t)(row0 + ai * HALF + m * 16);
#pragma unroll
                for (int bj = 0; bj < 2; ++bj) {
                    const u32x4 gw = *(const u32x4*)(gates + row * 3072 + tg * 1024 + col0 + bj * HALF);
                    bf16_t* op = O + row * 1024 + col0 + bj * HALF;
                    f32x4 v0 = acc[ai][bj][m][0], v1 = acc[ai][bj][m][1];
#ifdef ABL_TAG
                    if (tg == ABL_TAG) { v0 = v0 * 0.f; v1 = v1 * 0.f; }
#endif
                    v0[0] *= bf_lo(gw.x); v0[1] *= bf_hi(gw.x); v0[2] *= bf_lo(gw.y); v0[3] *= bf_hi(gw.y);
                    v1[0] *= bf_lo(gw.z); v1[1] *= bf_hi(gw.z); v1[2] *= bf_lo(gw.w); v1[3] *= bf_hi(gw.w);
                    if (tg != 0) { const u32x4 ow = *(const u32x4*)op;
                        v0[0] += bf_lo(ow.x); v0[1] += bf_hi(ow.x); v0[2] += bf_lo(ow.y); v0[3] += bf_hi(ow.y);
                        v1[0] += bf_lo(ow.z); v1[1] += bf_hi(ow.z); v1[2] += bf_lo(ow.w); v1[3] += bf_hi(ow.w); }
                    *(u32x4*)op = pack8(v0, v1); }
                asm volatile("" ::: "memory"); }
    }
};
struct EpiRes {
    static constexpr bool PERM = false, AFTER_DRAIN = false;
    const float* base; float* out;
    __device__ __forceinline__ void operator()(const f32x4 (&acc)[2][2][4][2], const Unit& u, int wr, int wc, int fr, int fq) const {
        const int row0 = u.om * BM + wr * 64 + fr, col0 = u.pn * BM + wc * 32 + 4 * fq;
#pragma unroll
        for (int ai = 0; ai < 2; ++ai)
#pragma unroll
            for (int m = 0; m < 4; ++m) { const size_t off = (size_t)(row0 + ai * HALF + m * 16) * 1024 + col0;
#pragma unroll
                for (int bj = 0; bj < 2; ++bj)
#pragma unroll
                    for (int n = 0; n < 2; ++n) { const f32x4 bs = *(const f32x4*)(base + off + bj * HALF + n * 16); *(f32x4*)(out + off + bj * HALF + n * 16) = bs + acc[ai][bj][m][n]; } }
    }
};
struct EpiSwiglu {
    static constexpr bool PERM = true, AFTER_DRAIN = false;
    bf16_t* O; int ldc;
    __device__ __forceinline__ void operator()(const f32x4 (&acc)[2][2][4][2], const Unit& u, int wr, int wc, int fr, int fq) const {
        const int row0 = u.om * BM + wr * 64 + fr, col0 = u.pn * HALF + wc * 32 + 8 * fq;
#pragma unroll
        for (int ai = 0; ai < 2; ++ai)
#pragma unroll
            for (int m = 0; m < 4; ++m) { f32x4 v0, v1;
#pragma unroll
                for (int i = 0; i < 4; ++i) { const float g0 = acc[ai][0][m][0][i], g1 = acc[ai][0][m][1][i]; v0[i] = g0 * sigm(g0) * acc[ai][1][m][0][i]; v1[i] = g1 * sigm(g1) * acc[ai][1][m][1][i]; }
                *(u32x4*)(O + (size_t)(row0 + ai * HALF + m * 16) * ldc + col0) = pack8(v0, v1); }
    }
};
struct EpiMoeDown {
    static constexpr bool PERM = true, AFTER_DRAIN = false;
    bf16_t* O; const float* w;
    __device__ __forceinline__ void operator()(const f32x4 (&acc)[2][2][4][2], const Unit& u, int wr, int wc, int fr, int fq) const {
        const int row0 = u.om * BM + wr * 64 + fr, col0 = u.pn * BM + wc * 32 + 8 * fq;
#pragma unroll
        for (int ai = 0; ai < 2; ++ai)
#pragma unroll
            for (int m = 0; m < 4; ++m) { const size_t row = (size_t)(row0 + ai * HALF + m * 16); const float sc = w[row];
#pragma unroll
                for (int bj = 0; bj < 2; ++bj) *(u32x4*)(O + row * 1024 + col0 + bj * HALF) = pack8(acc[ai][bj][m][0] * sc, acc[ai][bj][m][1] * sc); }
    }
};
template <class Epi, class Sched, bool ALIGN_EPI = false, bool SP2 = false>
__device__ __forceinline__ void gemm_phase(PG8_LAS unsigned char* lds, const Gemm g, const Sched& S, const Epi& E, const int tid_in) {
    const int tid = tid_in, wid = __builtin_amdgcn_readfirstlane(tid >> 6), lane = tid & 63, wr = wid >> 2, wc = wid & 3, fr = lane & 15, fq = lane >> 4;
    const int K = g.K, nt = K / BK;
    unsigned voffA[2], voffB[2];
#pragma unroll
    for (int i = 0; i < 2; ++i) { int R, C; stage_rc(tid * 16 + i * 8192, R, C); const int Rb = Epi::PERM ? ((R & ~31) + perm32(R & 31)) : R;
        voffA[i] = (unsigned)(R * K + C) * 2u; voffB[i] = (unsigned)(Rb * K + C) * 2u; }
    const size_t kstep = (size_t)(BK * 2);
    const size_t hstep = (size_t)HALF * K * 2;
    const unsigned ldsw = (unsigned)wid * 1024u;
    const int aoff = lds_byte(wr * 64 + fr, fq * 8), boff = lds_byte(wc * 32 + fr, fq * 8);
#define PG8_SA(b, h) (((b) * 2 + (h)) * HTB)
#define PG8_SB(b, h) ((4 + (b) * 2 + (h)) * HTB)
#define PG8_STAGE(bufoff, gbase, voff) do { _Pragma("unroll") for (int _i = 0; _i < 2; ++_i) \
        __builtin_amdgcn_global_load_lds((const unsigned*)((const char*)(gbase) + (voff)[_i]), (PG8_LAS unsigned*)(lds + (bufoff) + ldsw + _i * 8192), 16, 0, 0); } while (0)
#define PG8_LDA(dst, b, h) do { _Pragma("unroll") for (int m = 0; m < 4; ++m) _Pragma("unroll") for (int k = 0; k < 2; ++k) dst[m][k] = *(const PG8_LAS bf16x8*)(lds + PG8_SA(b, h) + aoff + m * 2048 + k * 1024); } while (0)
#define PG8_LDB(dst, b, h) do { _Pragma("unroll") for (int n = 0; n < 2; ++n) _Pragma("unroll") for (int k = 0; k < 2; ++k) dst[n][k] = *(const PG8_LAS bf16x8*)(lds + PG8_SB(b, h) + boff + n * 2048 + k * 1024); } while (0)
#define PG8_MMA(ai, bj, At, Bt) do { __builtin_amdgcn_s_setprio(1); _Pragma("unroll") for (int m = 0; m < 4; ++m) _Pragma("unroll") for (int n = 0; n < 2; ++n) _Pragma("unroll") for (int k = 0; k < 2; ++k) \
        acc[ai][bj][m][n] = __builtin_amdgcn_mfma_f32_16x16x32_bf16(Bt[n][k], At[m][k], acc[ai][bj][m][n], 0, 0, 0); __builtin_amdgcn_s_setprio(0); } while (0)
#define PG8_WAIT_V(n) asm volatile("s_waitcnt vmcnt(" #n ")" ::: "memory")
#define PG8_WAIT_L(n) asm volatile("s_waitcnt lgkmcnt(" #n ")" ::: "memory")
#define PG8_BAR __builtin_amdgcn_s_barrier()
#define PG8_SCHED __builtin_amdgcn_sched_barrier(0)
    Unit cur, nxt; int ui = 0;
    if (!S.next(0, cur)) return;
    f32x4 acc[2][2][4][2];
#pragma unroll
    for (int a = 0; a < 2; ++a)
#pragma unroll
        for (int b = 0; b < 2; ++b)
#pragma unroll
            for (int m = 0; m < 4; ++m)
#pragma unroll
                for (int n = 0; n < 2; ++n) acc[a][b][m][n] = (f32x4){0.f, 0.f, 0.f, 0.f};
    bf16x8 At[4][2], B0[2][2], B1[2][2];
    const char* cA = (const char*)g.A + cur.ao; const char* cB = (const char*)g.Bt + cur.bo;
    S.a_ready(cur);
    if constexpr (SP2) {
        PG8_STAGE(PG8_SB(0, 0), cB, voffB); PG8_STAGE(PG8_SB(0, 1), cB + hstep, voffB); PG8_STAGE(PG8_SA(0, 0), cA, voffA); PG8_STAGE(PG8_SA(0, 1), cA + hstep, voffA);
        if (wr == 1) PG8_BAR;
        PG8_WAIT_V(2); PG8_BAR;
        PG8_STAGE(PG8_SB(1, 0), cB + kstep, voffB); PG8_STAGE(PG8_SA(1, 0), cA + kstep, voffA); PG8_STAGE(PG8_SB(1, 1), cB + hstep + kstep, voffB);
        PG8_WAIT_V(6); PG8_BAR;
    } else {
        PG8_STAGE(PG8_SB(0, 0), cB, voffB); PG8_STAGE(PG8_SA(0, 0), cA, voffA); PG8_STAGE(PG8_SB(0, 1), cB + hstep, voffB); PG8_STAGE(PG8_SA(0, 1), cA + hstep, voffA);
        if (wr == 1) PG8_BAR;
        PG8_WAIT_V(4); PG8_BAR;
        PG8_STAGE(PG8_SB(1, 0), cB + kstep, voffB); PG8_STAGE(PG8_SA(1, 0), cA + kstep, voffA); PG8_STAGE(PG8_SB(1, 1), cB + hstep + kstep, voffB);
        PG8_WAIT_V(6); PG8_BAR;
    }
    for (;;) {
        const bool has_next = S.next(ui + 1, nxt);
        const char* nA = has_next ? (const char*)g.A + nxt.ao : cA; const char* nB = has_next ? (const char*)g.Bt + nxt.bo : cB;
        for (int t = 0; t < nt; t += 2) {
            const bool last = (t == nt - 2);
            const char* a1 = cA + (size_t)(t + 1) * kstep;
            const char* a2 = last ? nA : cA + (size_t)(t + 2) * kstep; const char* b2 = last ? nB : cB + (size_t)(t + 2) * kstep;
            const char* a3 = a2 + kstep; const char* b3 = b2 + kstep;
            if (last && has_next) S.a_ready(nxt);
            if constexpr (SP2) {
            PG8_LDB(B0, 0, 0); PG8_LDB(B1, 0, 1); PG8_SCHED; PG8_LDA(At, 0, 0); PG8_STAGE(PG8_SA(1, 1), a1 + hstep, voffA);
            PG8_WAIT_V(8); PG8_WAIT_L(0); PG8_BAR; PG8_MMA(0, 0, At, B0); PG8_MMA(0, 1, At, B1); PG8_BAR; PG8_SCHED;
            PG8_LDA(At, 0, 1); PG8_STAGE(PG8_SB(0, 0), b2, voffB); PG8_STAGE(PG8_SB(0, 1), b2 + hstep, voffB); PG8_STAGE(PG8_SA(0, 0), a2, voffA);
            PG8_WAIT_V(8); PG8_WAIT_L(0); PG8_BAR; PG8_MMA(1, 0, At, B0); PG8_MMA(1, 1, At, B1); PG8_BAR; PG8_SCHED;
            PG8_LDB(B0, 1, 0); PG8_LDB(B1, 1, 1); PG8_SCHED; PG8_LDA(At, 1, 0); PG8_STAGE(PG8_SA(0, 1), a2 + hstep, voffA);
            PG8_WAIT_V(8); PG8_WAIT_L(0); PG8_BAR; PG8_MMA(0, 0, At, B0); PG8_MMA(0, 1, At, B1); PG8_BAR; PG8_SCHED;
            PG8_LDA(At, 1, 1); PG8_STAGE(PG8_SB(1, 0), b3, voffB); PG8_STAGE(PG8_SB(1, 1), b3 + hstep, voffB); PG8_STAGE(PG8_SA(1, 0), a3, voffA);
            PG8_WAIT_V(8); PG8_WAIT_L(0); PG8_BAR; PG8_MMA(1, 0, At, B0); PG8_MMA(1, 1, At, B1); PG8_BAR; PG8_SCHED;
            } else {
            PG8_LDB(B0, 0, 0); PG8_SCHED; PG8_LDA(At, 0, 0); PG8_STAGE(PG8_SA(1, 1), a1 + hstep, voffA);
            PG8_WAIT_L(8); PG8_BAR; PG8_WAIT_L(0); PG8_MMA(0, 0, At, B0); PG8_BAR; PG8_SCHED;
            PG8_LDB(B1, 0, 1); PG8_STAGE(PG8_SB(0, 0), b2, voffB);
            PG8_BAR; PG8_WAIT_L(0); PG8_MMA(0, 1, At, B1); PG8_BAR;
            PG8_LDA(At, 0, 1); PG8_STAGE(PG8_SA(0, 0), a2, voffA);
            PG8_BAR; PG8_WAIT_L(0); PG8_MMA(1, 0, At, B0); PG8_BAR; PG8_SCHED;
            PG8_STAGE(PG8_SB(0, 1), b2 + hstep, voffB);
            PG8_WAIT_V(6); PG8_BAR; PG8_MMA(1, 1, At, B1); PG8_BAR;
            PG8_LDB(B0, 1, 0); PG8_SCHED; PG8_LDA(At, 1, 0); PG8_STAGE(PG8_SA(0, 1), a2 + hstep, voffA);
            PG8_WAIT_L(8); PG8_BAR; PG8_WAIT_L(0); PG8_MMA(0, 0, At, B0); PG8_BAR; PG8_SCHED;
            PG8_LDB(B1, 1, 1); PG8_STAGE(PG8_SB(1, 0), b3, voffB);
            PG8_BAR; PG8_WAIT_L(0); PG8_MMA(0, 1, At, B1); PG8_BAR;
            PG8_LDA(At, 1, 1); PG8_STAGE(PG8_SA(1, 0), a3, voffA);
            PG8_BAR; PG8_WAIT_L(0); PG8_MMA(1, 0, At, B0); PG8_BAR; PG8_SCHED;
            PG8_STAGE(PG8_SB(1, 1), b3 + hstep, voffB);
            PG8_WAIT_V(6); PG8_BAR; PG8_MMA(1, 1, At, B1); PG8_BAR;
            }
        }
        if constexpr (ALIGN_EPI) { if (wr == 0) PG8_BAR; }
        if constexpr (!Epi::AFTER_DRAIN) { E(acc, cur, wr, wc, fr, fq); S.done(cur); }
        if (!has_next) break;
#pragma unroll
        for (int a = 0; a < 2; ++a)
#pragma unroll
            for (int b = 0; b < 2; ++b)
#pragma unroll
                for (int m = 0; m < 4; ++m)
#pragma unroll
                    for (int n = 0; n < 2; ++n) acc[a][b][m][n] = (f32x4){0.f, 0.f, 0.f, 0.f};
        cur = nxt; cA = nA; cB = nB; ++ui;
        if constexpr (ALIGN_EPI) { if (wr == 1) PG8_BAR; }
    }
    PG8_WAIT_V(0);
    if constexpr (!ALIGN_EPI) { if (wr == 0) PG8_BAR; }
    PG8_BAR;
    if constexpr (Epi::AFTER_DRAIN) { E.fused(acc, cur, wr, wc, fr, fq, lds, wid, lane); S.done(cur); }
#undef PG8_SA
#undef PG8_SB
#undef PG8_STAGE
#undef PG8_LDA
#undef PG8_LDB
#undef PG8_MMA
#undef PG8_WAIT_V
#undef PG8_WAIT_L
#undef PG8_BAR
#undef PG8_SCHED
}
}

namespace att {
#define LAS __attribute__((address_space(3)))
typedef unsigned short bf16;
typedef __attribute__((ext_vector_type(8))) short bf16x8;
typedef __attribute__((ext_vector_type(4))) short s16x4;
typedef __attribute__((ext_vector_type(16))) float f32x16;
typedef __attribute__((ext_vector_type(4))) unsigned u32x4;
typedef float f32x2_t __attribute__((ext_vector_type(2))); typedef __bf16 bf16x2_t __attribute__((ext_vector_type(2)));
typedef short v4i16_t __attribute__((ext_vector_type(4)));
typedef LAS const char* lds_cptr;
constexpr int SEQ = 4096, PP = 1536;
constexpr float LOG2E = 1.4426950408889634f;
constexpr float NEGINF = -INFINITY;
__device__ __forceinline__ int crow(int r, int hi) { return (r & 3) + 8 * (r >> 2) + 4 * hi; }
__device__ __forceinline__ void glds16(const void* gsrc, unsigned lds_dst) { unsigned keep;
    asm volatile("s_mov_b32 %0, m0\n\ts_mov_b32 m0, %2\n\ts_nop 0\n\tglobal_load_lds_dwordx4 %1, off\n\ts_mov_b32 m0, %0" : "=&s"(keep) : "v"(gsrc), "s"(lds_dst) : "memory"); }
__device__ __forceinline__ unsigned cvtpk(float lo, float hi) { f32x2_t v = {lo, hi}; bf16x2_t b = __builtin_convertvector(v, bf16x2_t); return __builtin_bit_cast(unsigned, b); }
__device__ __forceinline__ s16x4 vtr(lds_cptr p) { return __builtin_bit_cast(s16x4, __builtin_amdgcn_ds_read_tr16_b64_v4i16((LAS v4i16_t*)p)); }
__device__ __forceinline__ bf16x8 ldk(lds_cptr p) { return *(const LAS bf16x8*)p; }
__device__ __forceinline__ float xhalf(float v, int hi) {
    auto rr = __builtin_amdgcn_permlane32_swap(__float_as_uint(v), __float_as_uint(v), false, false);
    return hi ? __uint_as_float(rr[0]) : __uint_as_float(rr[1]); }
__device__ __forceinline__ float max16(const f32x16& p) { float a = fmaxf(fmaxf(p[0], p[1]), fmaxf(p[2], p[3]));
#pragma unroll
    for (int r = 4; r < 16; r += 4) a = fmaxf(a, fmaxf(fmaxf(p[r], p[r + 1]), fmaxf(p[r + 2], p[r + 3]))); return a; }
__device__ __forceinline__ float sum16(const f32x16& p) { float a = (p[0] + p[1]) + (p[2] + p[3]);
#pragma unroll
    for (int r = 4; r < 16; r += 4) a += (p[r] + p[r + 1]) + (p[r + 2] + p[r + 3]); return a; }
#define ATT_WAIT_BAR(N) asm volatile("s_waitcnt vmcnt(" #N ") lgkmcnt(0)\n\ts_barrier" ::: "memory")
#define ATT_LDSW() asm volatile("s_waitcnt lgkmcnt(0)" ::: "memory")
#define PACK8(P, B) (u32x4){cvtpk(P[B], P[B + 1]), cvtpk(P[B + 2], P[B + 3]), cvtpk(P[B + 4], P[B + 5]), cvtpk(P[B + 6], P[B + 7])}
#define ASBF(x) __builtin_bit_cast(bf16x8, x)
#define VFRAG(lo, hh) (bf16x8){lo[0], lo[1], lo[2], lo[3], hh[0], hh[1], hh[2], hh[3]}

constexpr int A_SLOT = 32768, A_WSF = 98304, A_XCH = 0, A_STG = 65536;
constexpr float A_THR = 8.f;
__device__ __forceinline__ void diff_unit(int b, int h, int qb, const bf16* __restrict__ PA, bf16* __restrict__ YA, float lam, float oscale, const float* __restrict__ subln, LAS char* shm, const int tid) {
    const int lane = tid & 63, r32 = lane & 31, hi = lane >> 5;
    const int wid = __builtin_amdgcn_readfirstlane(tid >> 6), comp = wid >> 2, g = wid & 3;
    const float slope2 = __builtin_amdgcn_exp2f(-2.f * (float)(h + 1)) * LOG2E;
    const long rowbase = (long)b * SEQ; const int q0 = qb * 128, qw0 = q0 + 32 * g, qi = qw0 + r32;
    const unsigned lds0 = (unsigned)(size_t)shm;
    LAS float* wsf = (LAS float*)(shm + A_WSF) + wid * 128;
    const bf16* kb_ = PA + rowbase * PP + 512 + h * 128; const bf16* vb_ = PA + rowbase * PP + 1024 + h * 128;
    const bf16* ksrc0 = kb_ + (long)lane * PP + wid * 8; const bf16* ksrc1 = ksrc0 + 64;
    const int pa = wid, pb = wid + 8;
    const bf16* vsrca = vb_ + (long)(16 * (pa & 3) + (lane >> 2)) * PP + (pa >> 2) * 32 + (lane & 3) * 8;
    const bf16* vsrcb = vb_ + (long)(16 * (pb & 3) + (lane >> 2)) * PP + (pb >> 2) * 32 + (lane & 3) * 8;
    const int NT = 2 * (qb + 1);
#define A_ISSUE(t_, sl_) do { const long ro_ = (long)(t_) * 64 * PP; const unsigned sb_ = (unsigned)__builtin_amdgcn_readfirstlane(lds0 + (unsigned)(sl_)); \
        glds16(ksrc0 + ro_, sb_ + wid * 1024); glds16(ksrc1 + ro_, sb_ + 8192 + wid * 1024); glds16(vsrca + ro_, sb_ + 16384 + pa * 1024); glds16(vsrcb + ro_, sb_ + 16384 + pb * 1024); } while (0)
    const bf16* qp = PA + (rowbase + qi) * PP + h * 128 + comp * 64 + hi * 8;
    bf16x8 qr[4];
#pragma unroll
    for (int d0 = 0; d0 < 4; ++d0) qr[d0] = *(const bf16x8*)(qp + d0 * 16);
    float lb[16];
#pragma unroll
    for (int r = 0; r < 16; ++r) lb[r] = slope2 * (float)crow(r, hi);
    A_ISSUE(NT - 1, 0); A_ISSUE(NT - 2, A_SLOT);
    float m_ref = NEGINF, l = 0.f; f32x16 o[4];
#pragma unroll
    for (int dq = 0; dq < 4; ++dq) o[dq] = f32x16{};
    int sl = 0, sl2 = 2 * A_SLOT;
    for (int it = 0; it < NT; ++it) {
        if (it + 1 < NT) { ATT_WAIT_BAR(4); } else { ATT_WAIT_BAR(0); }
        if (it + 2 < NT) A_ISSUE(NT - 3 - it, sl2);
        const int kbase = 64 * (NT - 1 - it);
        if (kbase <= qw0) {
            const lds_cptr kp = shm + sl + comp * 8192 + hi * 1024 + r32 * 16;
            const float base = slope2 * (float)(kbase - qi), base1 = base + 32.f * slope2;
            f32x16 p0, p1;
#pragma unroll
            for (int r = 0; r < 16; ++r) { p0[r] = base + lb[r]; p1[r] = base1 + lb[r]; }
#pragma unroll
            for (int d0 = 0; d0 < 4; ++d0) { const bf16x8 k0 = ldk(kp + d0 * 2048), k1 = ldk(kp + d0 * 2048 + 512);
                p0 = __builtin_amdgcn_mfma_f32_32x32x16_bf16(k0, qr[d0], p0, 0, 0, 0); p1 = __builtin_amdgcn_mfma_f32_32x32x16_bf16(k1, qr[d0], p1, 0, 0, 0); }
            if (kbase + 63 > qw0) {
#pragma unroll
                for (int r = 0; r < 16; ++r) { const int kv = kbase + crow(r, hi); if (kv > qi) p0[r] = NEGINF; if (kv + 32 > qi) p1[r] = NEGINF; }
            }
            float rm = fmaxf(max16(p0), max16(p1)); rm = fmaxf(rm, xhalf(rm, hi));
            const float mnew = fmaxf(m_ref, rm);
            if (__any(mnew > m_ref + A_THR)) {
                const float alpha = __builtin_amdgcn_exp2f(m_ref - mnew); l *= alpha; m_ref = mnew;
                if (hi == 0) wsf[r32] = alpha; ATT_LDSW();
#pragma unroll
                for (int r = 0; r < 16; ++r) { const float a = wsf[crow(r, hi)];
#pragma unroll
                    for (int dq = 0; dq < 4; ++dq) o[dq][r] *= a; }
            }
#pragma unroll
            for (int r = 0; r < 16; ++r) { p0[r] = __builtin_amdgcn_exp2f(p0[r] - m_ref); p1[r] = __builtin_amdgcn_exp2f(p1[r] - m_ref); }
            l += sum16(p0) + sum16(p1);
            const u32x4 pw0 = PACK8(p0, 0), pw1 = PACK8(p0, 8), pw2 = PACK8(p1, 0), pw3 = PACK8(p1, 8);
            const lds_cptr vp = shm + sl + 16384 + ((lane >> 4) & 1) * 32 + (lane & 3) * 8 + (4 * hi + ((lane & 15) >> 2)) * 64;
#pragma unroll
            for (int dq = 0; dq < 4; ++dq) {
                const s16x4 l0 = vtr(vp + dq * 4096), h0 = vtr(vp + dq * 4096 + 512), l1 = vtr(vp + dq * 4096 + 1024), h1 = vtr(vp + dq * 4096 + 1536);
                const s16x4 l2 = vtr(vp + dq * 4096 + 2048), h2 = vtr(vp + dq * 4096 + 2560), l3 = vtr(vp + dq * 4096 + 3072), h3 = vtr(vp + dq * 4096 + 3584);
                o[dq] = __builtin_amdgcn_mfma_f32_32x32x16_bf16(ASBF(pw0), VFRAG(l0, h0), o[dq], 0, 0, 0);
                o[dq] = __builtin_amdgcn_mfma_f32_32x32x16_bf16(ASBF(pw1), VFRAG(l1, h1), o[dq], 0, 0, 0);
                o[dq] = __builtin_amdgcn_mfma_f32_32x32x16_bf16(ASBF(pw2), VFRAG(l2, h2), o[dq], 0, 0, 0);
                o[dq] = __builtin_amdgcn_mfma_f32_32x32x16_bf16(ASBF(pw3), VFRAG(l3, h3), o[dq], 0, 0, 0);
            }
        }
        sl2 = sl; sl = (sl == 2 * A_SLOT) ? 0 : sl + A_SLOT;
    }
#undef A_ISSUE
    l += xhalf(l, hi);
    if (hi == 0) wsf[32 + r32] = __builtin_amdgcn_rcpf(l); ATT_LDSW();
#pragma unroll
    for (int r = 0; r < 16; ++r) { const float a = wsf[32 + crow(r, hi)];
#pragma unroll
        for (int dq = 0; dq < 4; ++dq) o[dq][r] *= a; }
    ATT_WAIT_BAR(0);
    LAS float* X = (LAS float*)(shm + A_XCH) + g * 4096;
    if (comp == 1) {
#pragma unroll
        for (int dq = 0; dq < 4; ++dq)
#pragma unroll
            for (int r = 0; r < 16; ++r) X[(dq * 16 + r) * 64 + lane] = o[dq][r];
    }
    ATT_WAIT_BAR(0);
    if (comp == 0) {
        float ss[16];
#pragma unroll
        for (int r = 0; r < 16; ++r) ss[r] = 0.f;
#pragma unroll
        for (int dq = 0; dq < 4; ++dq)
#pragma unroll
            for (int r = 0; r < 16; ++r) { const float d = o[dq][r] - lam * X[(dq * 16 + r) * 64 + lane]; o[dq][r] = d; ss[r] += d * d; }
#pragma unroll
        for (int r = 0; r < 16; ++r) { float s = ss[r];
#pragma unroll
            for (int of = 1; of < 32; of <<= 1) s += __shfl_xor(s, of);
            ss[r] = __builtin_amdgcn_rsqf(s * (1.f / 128.f) + 1e-6f); }
        LAS bf16* stg = (LAS bf16*)(shm + A_STG) + g * 4096;
#pragma unroll
        for (int dq = 0; dq < 4; ++dq) { const float gn = subln[dq * 32 + r32] * oscale;
#pragma unroll
            for (int r = 0; r < 16; ++r) stg[crow(r, hi) * 128 + dq * 32 + r32] = (bf16)(cvtpk(o[dq][r] * ss[r] * gn, 0.f) & 0xffffu); }
        ATT_LDSW();
        bf16* Yw = YA + (rowbase + qw0) * 512 + h * 128;
#pragma unroll
        for (int i = 0; i < 8; ++i) { const int idx = i * 64 + lane, row = idx >> 4, ch = idx & 15; const u32x4 v = *(const LAS u32x4*)(stg + row * 128 + ch * 8); *(u32x4*)(Yw + (long)row * 512 + ch * 8) = v; }
    }
    ATT_WAIT_BAR(0);
}

constexpr int B_V = 49152, B_WSF = 98304, B_STG = 100352;
__device__ __forceinline__ void dil_unit(int b, int h, int dil, int res, int blk, const bf16* __restrict__ PB, bf16* __restrict__ OUT, float* __restrict__ ST, LAS char* shm, const int tid) {
    const int lane = tid & 63, r32 = lane & 31, hi = lane >> 5;
    const int wid = __builtin_amdgcn_readfirstlane(tid >> 6);
    const int hs = h + (h >> 1);
    const float sd = __builtin_amdgcn_exp2f(-(2.f / 3.f) * (float)(hs + 1)) * LOG2E * (float)dil;
    const long rowbase = (long)b * SEQ; const int i0 = 256 * blk, jb = i0 - 128;
    const unsigned lds0 = (unsigned)(size_t)shm;
#pragma unroll
    for (int k = 0; k < 12; ++k) { const int pc = wid * 12 + k;
        const int isv = pc >= 48, q = isv ? pc - 48 : pc, T = q >> 3, c = q & 7;
        int brow, coff; if (!isv) { brow = 64 * T + lane; coff = 512 + h * 64 + c * 8; } else { brow = 64 * T + 16 * (c & 3) + (lane >> 2); coff = 1024 + h * 64 + (c >> 2) * 32 + (lane & 3) * 8; }
        int j = jb + brow; j = j < 0 ? 0 : j;
        const bf16* src = PB + (rowbase + (long)j * dil + res) * PP + coff;
        glds16(src, (unsigned)__builtin_amdgcn_readfirstlane(lds0 + (unsigned)((isv ? B_V : 0) + T * 8192 + c * 1024))); }
    const int iq = i0 + 32 * wid + r32;
    const bf16* qp = PB + (rowbase + (long)iq * dil + res) * PP + h * 64 + hi * 8;
    bf16x8 qr[4];
#pragma unroll
    for (int d0 = 0; d0 < 4; ++d0) qr[d0] = *(const bf16x8*)(qp + d0 * 16);
    ATT_WAIT_BAR(0);
    f32x16 s[5];
#pragma unroll
    for (int g = 0; g < 5; ++g) { const int b0 = 32 * (wid + g), T = b0 >> 6, half = (b0 >> 5) & 1;
        const lds_cptr kp = shm + T * 8192 + hi * 1024 + (half * 32 + r32) * 16;
        const float base = -sd * (float)(128 - 32 * g + r32);
#pragma unroll
        for (int r = 0; r < 16; ++r) s[g][r] = base + sd * (float)crow(r, hi);
#pragma unroll
        for (int d0 = 0; d0 < 4; ++d0) s[g] = __builtin_amdgcn_mfma_f32_32x32x16_bf16(ldk(kp + d0 * 2048), qr[d0], s[g], 0, 0, 0); }
#pragma unroll
    for (int r = 0; r < 16; ++r) { const int cr = crow(r, hi); if (cr < r32) s[0][r] = NEGINF; if (cr > r32) s[4][r] = NEGINF; }
    if (blk == 0) {
#pragma unroll
        for (int g = 0; g < 5; ++g)
#pragma unroll
            for (int r = 0; r < 16; ++r) if (32 * (wid + g) + crow(r, hi) < 128) s[g][r] = NEGINF;
    }
    float m = max16(s[0]);
#pragma unroll
    for (int g = 1; g < 5; ++g) m = fmaxf(m, max16(s[g]));
    m = fmaxf(m, xhalf(m, hi));
    float l = 0.f;
#pragma unroll
    for (int g = 0; g < 5; ++g) {
#pragma unroll
        for (int r = 0; r < 16; ++r) s[g][r] = __builtin_amdgcn_exp2f(s[g][r] - m);
        l += sum16(s[g]); }
    l += xhalf(l, hi);
    f32x16 o[2]; o[0] = f32x16{}; o[1] = f32x16{};
    const lds_cptr vp0 = shm + B_V + ((lane >> 4) & 1) * 32 + (lane & 3) * 8 + (4 * hi + ((lane & 15) >> 2)) * 64;
#pragma unroll
    for (int g = 0; g < 5; ++g) { const u32x4 pwa = PACK8(s[g], 0), pwb = PACK8(s[g], 8);
        const int B16 = 2 * (wid + g), T = B16 >> 2, ks = B16 & 3;
        const lds_cptr vp = vp0 + T * 8192 + ks * 1024;
#pragma unroll
        for (int d0 = 0; d0 < 2; ++d0) {
            const s16x4 la = vtr(vp + d0 * 4096), ha = vtr(vp + d0 * 4096 + 512), lb_ = vtr(vp + d0 * 4096 + 1024), hb = vtr(vp + d0 * 4096 + 1536);
            o[d0] = __builtin_amdgcn_mfma_f32_32x32x16_bf16(ASBF(pwa), VFRAG(la, ha), o[d0], 0, 0, 0);
            o[d0] = __builtin_amdgcn_mfma_f32_32x32x16_bf16(ASBF(pwb), VFRAG(lb_, hb), o[d0], 0, 0, 0); } }
    LAS float* wsf = (LAS float*)(shm + B_WSF) + wid * 64;
    if (hi == 0) wsf[r32] = __builtin_amdgcn_rcpf(l); ATT_LDSW();
    LAS bf16* stg = (LAS bf16*)(shm + B_STG) + wid * 2048;
#pragma unroll
    for (int r = 0; r < 16; ++r) { const float a = wsf[crow(r, hi)];
#pragma unroll
        for (int d0 = 0; d0 < 2; ++d0) stg[crow(r, hi) * 64 + d0 * 32 + r32] = (bf16)(cvtpk(o[d0][r] * a, 0.f) & 0xffffu); }
    ATT_LDSW();
    const long tok = rowbase + (long)iq * dil + res;
    if (hi == 0) { f32x2_t ml = {m, l}; *(f32x2_t*)(ST + (tok * 8 + h) * 2) = ml; }
#pragma unroll
    for (int i = 0; i < 4; ++i) { const int row = i * 8 + (lane >> 3), ch = lane & 7; const u32x4 v = *(const LAS u32x4*)(stg + row * 64 + ch * 8);
        const long trow = rowbase + (long)(i0 + 32 * wid + row) * dil + res; *(u32x4*)(OUT + trow * 512 + h * 64 + ch * 8) = v; }
    ATT_WAIT_BAR(0);
}

constexpr int C_SLOT = 16384, C_FLAGS = 49152, C_STG = 53248;
constexpr float C_EXIT = -150.f;
__device__ __forceinline__ void sb_unit(int b, int h, int qb, const bf16* __restrict__ PC, bf16* __restrict__ YC, LAS char* shm, const int tid) {
    const int lane = tid & 63, r32 = lane & 31, hi = lane >> 5;
    const int wid = __builtin_amdgcn_readfirstlane(tid >> 6);
    const long rowbase = (long)b * SEQ; const int q0 = qb * 256, qw0 = q0 + 32 * wid, qi = qw0 + r32;
    const unsigned lds0 = (unsigned)(size_t)shm;
    volatile LAS int* fl = (volatile LAS int*)(shm + C_FLAGS);
    const bf16* ksrc = PC + (rowbase + lane) * PP + 512 + h * 64 + wid * 8;
    const bf16* vsrc = PC + (rowbase + 16 * (wid & 3) + (lane >> 2)) * PP + 1024 + h * 64 + (wid >> 2) * 32 + (lane & 3) * 8;
    const int NT = 4 * qb + 4;
#define C_ISSUE(t_, sl_) do { const long ro_ = (long)(t_) * 64 * PP; const unsigned sb_ = (unsigned)__builtin_amdgcn_readfirstlane(lds0 + (unsigned)(sl_)); \
        glds16(ksrc + ro_, sb_ + wid * 1024); glds16(vsrc + ro_, sb_ + 8192 + wid * 1024); } while (0)
    const bf16* qp = PC + (rowbase + qi) * PP + h * 64 + hi * 8;
    bf16x8 qr[4];
#pragma unroll
    for (int d0 = 0; d0 < 4; ++d0) qr[d0] = *(const bf16x8*)(qp + d0 * 16);
    C_ISSUE(NT - 1, 0); C_ISSUE(NT - 2, C_SLOT);
    float c = 0.f; bool wdone = false; f32x16 o[2]; o[0] = f32x16{}; o[1] = f32x16{};
    int sl = 0, sl2 = 2 * C_SLOT;
    for (int it = 0; it < NT; ++it) {
        if (it + 1 < NT) { ATT_WAIT_BAR(2); } else { ATT_WAIT_BAR(0); }
        if (it > 0) {
            const volatile LAS int* f = fl + ((it - 1) & 1) * 8;
            const int all = f[0] & f[1] & f[2] & f[3] & f[4] & f[5] & f[6] & f[7];
            if (all) break;
        }
        if (it + 2 < NT) C_ISSUE(NT - 3 - it, sl2);
        const int kbase = 64 * (NT - 1 - it);
        if (!wdone && kbase <= qw0) {
            const lds_cptr kp = shm + sl + hi * 1024 + r32 * 16;
            f32x16 p0 = f32x16{}, p1 = f32x16{};
#pragma unroll
            for (int d0 = 0; d0 < 4; ++d0) { const bf16x8 k0 = ldk(kp + d0 * 2048), k1 = ldk(kp + d0 * 2048 + 512);
                p0 = __builtin_amdgcn_mfma_f32_32x32x16_bf16(k0, qr[d0], p0, 0, 0, 0); p1 = __builtin_amdgcn_mfma_f32_32x32x16_bf16(k1, qr[d0], p1, 0, 0, 0); }
            f32x16 L0, L1;
#pragma unroll
            for (int r = 0; r < 16; ++r) {
                const int kv = kbase + crow(r, hi);
                { const float z = p0[r]; const float t = __builtin_amdgcn_logf(1.f + __builtin_amdgcn_exp2f(-fabsf(z))); L0[r] = (kv < qi) ? (fminf(-z, 0.f) - t) : 0.f; }
                { const float z = p1[r]; const float t = __builtin_amdgcn_logf(1.f + __builtin_amdgcn_exp2f(-fabsf(z))); L1[r] = (kv + 32 < qi) ? (fminf(-z, 0.f) - t) : 0.f; }
            }
            float T[8], U[8];
#pragma unroll
            for (int k = 0; k < 8; ++k) { const f32x16& Lx = (k < 4) ? L0 : L1; const int rb = 4 * (k & 3); T[k] = (Lx[rb] + Lx[rb + 1]) + (Lx[rb + 2] + Lx[rb + 3]); }
#pragma unroll
            for (int k = 0; k < 8; ++k) U[k] = xhalf(T[k], hi);
            float R = c;
#pragma unroll
            for (int k = 7; k >= 0; --k) {
                const float sufk = R + (hi == 0 ? U[k] : 0.f);
                f32x16& Lx = (k < 4) ? L0 : L1; f32x16& Px = (k < 4) ? p0 : p1; const int rb = 4 * (k & 3);
                const float e3 = Lx[rb + 3], e2 = Lx[rb + 2], e1 = Lx[rb + 1];
                const float s3 = sufk, s2 = sufk + e3, s1 = s2 + e2, s0 = s1 + e1;
                const int kv = kbase + 32 * (k >> 2) + 8 * (k & 3) + 4 * hi;
                Px[rb + 3] = (kv + 3 < qi) ? __builtin_amdgcn_exp2f(Lx[rb + 3] + Px[rb + 3] + s3) : 0.f;
                Px[rb + 2] = (kv + 2 < qi) ? __builtin_amdgcn_exp2f(Lx[rb + 2] + Px[rb + 2] + s2) : 0.f;
                Px[rb + 1] = (kv + 1 < qi) ? __builtin_amdgcn_exp2f(Lx[rb + 1] + Px[rb + 1] + s1) : 0.f;
                Px[rb + 0] = (kv + 0 < qi) ? __builtin_amdgcn_exp2f(Lx[rb + 0] + Px[rb + 0] + s0) : 0.f;
                R += T[k] + U[k];
            }
            c = R;
            const u32x4 pw0 = PACK8(p0, 0), pw1 = PACK8(p0, 8), pw2 = PACK8(p1, 0), pw3 = PACK8(p1, 8);
            const lds_cptr vp = shm + sl + 8192 + ((lane >> 4) & 1) * 32 + (lane & 3) * 8 + (4 * hi + ((lane & 15) >> 2)) * 64;
#pragma unroll
            for (int d0 = 0; d0 < 2; ++d0) {
                const s16x4 l0 = vtr(vp + d0 * 4096), h0 = vtr(vp + d0 * 4096 + 512), l1 = vtr(vp + d0 * 4096 + 1024), h1 = vtr(vp + d0 * 4096 + 1536);
                const s16x4 l2 = vtr(vp + d0 * 4096 + 2048), h2 = vtr(vp + d0 * 4096 + 2560), l3 = vtr(vp + d0 * 4096 + 3072), h3 = vtr(vp + d0 * 4096 + 3584);
                o[d0] = __builtin_amdgcn_mfma_f32_32x32x16_bf16(ASBF(pw0), VFRAG(l0, h0), o[d0], 0, 0, 0);
                o[d0] = __builtin_amdgcn_mfma_f32_32x32x16_bf16(ASBF(pw1), VFRAG(l1, h1), o[d0], 0, 0, 0);
                o[d0] = __builtin_amdgcn_mfma_f32_32x32x16_bf16(ASBF(pw2), VFRAG(l2, h2), o[d0], 0, 0, 0);
                o[d0] = __builtin_amdgcn_mfma_f32_32x32x16_bf16(ASBF(pw3), VFRAG(l3, h3), o[d0], 0, 0, 0);
            }
            wdone = __all(c < C_EXIT);
        }
        if (lane == 0) fl[(it & 1) * 8 + wid] = wdone ? 1 : 0;
        sl2 = sl; sl = (sl == 2 * C_SLOT) ? 0 : sl + C_SLOT;
    }
#undef C_ISSUE
    ATT_WAIT_BAR(0);
    LAS bf16* stg = (LAS bf16*)(shm + C_STG) + wid * 2048;
#pragma unroll
    for (int r = 0; r < 16; ++r)
#pragma unroll
        for (int d0 = 0; d0 < 2; ++d0) stg[crow(r, hi) * 64 + d0 * 32 + r32] = (bf16)(cvtpk(o[d0][r], 0.f) & 0xffffu);
    ATT_LDSW();
    bf16* Yw = YC + (rowbase + qw0) * 512 + h * 64;
#pragma unroll
    for (int i = 0; i < 4; ++i) { const int row = i * 8 + (lane >> 3), ch = lane & 7; const u32x4 v = *(const LAS u32x4*)(stg + row * 64 + ch * 8); *(u32x4*)(Yw + (long)row * 512 + ch * 8) = v; }
    ATT_WAIT_BAR(0);
}
#undef LAS
}

#if defined(NAIVE_A) || defined(NAIVE_B) || defined(NAIVE_C)
namespace naive {
typedef unsigned short bf16;
__device__ __forceinline__ float b2f(bf16 v) { return __uint_as_float((unsigned)v << 16); }
__device__ __forceinline__ bf16 f2b(float f) { unsigned u = __float_as_uint(f); return (bf16)((u + 0x7fffu + ((u >> 16) & 1u)) >> 16); }
constexpr int SEQ = 4096, PP = 1536;
__device__ void sb_naive(long idx, const bf16* PC, bf16* YC) {
    const int t = (int)(idx & 4095), h = (int)((idx >> 12) & 7), b = (int)(idx >> 15);
    const bf16* base = PC + (long)b * SEQ * PP;
    float q[64], acc[64];
#pragma unroll
    for (int d = 0; d < 64; ++d) { q[d] = b2f(base[(long)t * PP + h * 64 + d]); acc[d] = 0.f; }
    float c = 0.f;
    for (int s = t - 1; s >= 0; --s) {
        const bf16* kr = base + (long)s * PP + 512 + h * 64; const bf16* vr = base + (long)s * PP + 1024 + h * 64;
        float z = 0.f;
#pragma unroll
        for (int d = 0; d < 64; ++d) z += q[d] * b2f(kr[d]);
        const float tt = log2f(1.f + exp2f(-fabsf(z)));
        const float lb = fminf(z, 0.f) - tt, l1 = fminf(-z, 0.f) - tt;
        const float a = exp2f(lb + c);
#pragma unroll
        for (int d = 0; d < 64; ++d) acc[d] += a * b2f(vr[d]);
        c += l1;
        if (c < -300.f) break;
    }
    bf16* o = YC + ((long)b * SEQ + t) * 512 + h * 64;
#pragma unroll
    for (int d = 0; d < 64; ++d) o[d] = f2b(acc[d]);
}
__device__ void dil_naive(long idx, const bf16* PB, bf16* YB) {
    const int t = (int)(idx & 4095), h = (int)((idx >> 12) & 7), b = (int)(idx >> 15);
    const bf16* base = PB + (long)b * SEQ * PP;
    const int hs = h + (h >> 1); const float slope2 = exp2f(-(2.f / 3.f) * (float)(hs + 1)) * 1.4426950408889634f;
    float q[64], acc[64];
#pragma unroll
    for (int d = 0; d < 64; ++d) { q[d] = b2f(base[(long)t * PP + h * 64 + d]); acc[d] = 0.f; }
    float m = -INFINITY, l = 0.f;
    for (int p = 0; p < 3; ++p) { const int dil = (p == 0) ? 1 : (p == 1) ? 4 : 16; const int i = t / dil;
        for (int dd = 0; dd <= 128; ++dd) { if (i - dd < 0) break; const int s = t - dd * dil;
            const bf16* kr = base + (long)s * PP + 512 + h * 64; const bf16* vr = base + (long)s * PP + 1024 + h * 64;
            float z = 0.f;
#pragma unroll
            for (int d = 0; d < 64; ++d) z += q[d] * b2f(kr[d]);
            z -= slope2 * (float)(dd * dil);
            const float mn = fmaxf(m, z), al = exp2f(m - mn), pw = exp2f(z - mn);
            l = l * al + pw; m = mn;
#pragma unroll
            for (int d = 0; d < 64; ++d) acc[d] = acc[d] * al + pw * b2f(vr[d]);
        } }
    const float inv = 1.f / l;
    bf16* o = YB + ((long)b * SEQ + t) * 512 + h * 64;
#pragma unroll
    for (int d = 0; d < 64; ++d) o[d] = f2b(acc[d] * inv);
}
__device__ void diff_naive(long idx, const bf16* PA, bf16* YA, float lam, float oscale, const float* subln) {
    const int qu = (int)(idx & 3), t = (int)((idx >> 2) & 4095), h = (int)((idx >> 14) & 3), b = (int)(idx >> 16);
    const bf16* base = PA + (long)b * SEQ * PP;
    const float slope2 = exp2f(-2.f * (float)(h + 1)) * 1.4426950408889634f;
    float res[32];
#pragma unroll
    for (int d = 0; d < 32; ++d) res[d] = 0.f;
    for (int c = 0; c < 2; ++c) {
        float q[64], acc[32];
#pragma unroll
        for (int d = 0; d < 64; ++d) q[d] = b2f(base[(long)t * PP + h * 128 + c * 64 + d]);
#pragma unroll
        for (int d = 0; d < 32; ++d) acc[d] = 0.f;
        float m = -INFINITY, l = 0.f;
        for (int s = 0; s <= t; ++s) {
            const bf16* kr = base + (long)s * PP + 512 + h * 128 + c * 64; const bf16* vr = base + (long)s * PP + 1024 + h * 128 + qu * 32;
            float z = 0.f;
#pragma unroll
            for (int d = 0; d < 64; ++d) z += q[d] * b2f(kr[d]);
            z += slope2 * (float)(s - t);
            const float mn = fmaxf(m, z), al = exp2f(m - mn), pw = exp2f(z - mn);
            l = l * al + pw; m = mn;
#pragma unroll
            for (int d = 0; d < 32; ++d) acc[d] = acc[d] * al + pw * b2f(vr[d]);
        }
        const float f = (c == 0 ? 1.f : -lam) / l;
#pragma unroll
        for (int d = 0; d < 32; ++d) res[d] += f * acc[d];
    }
    float ss = 0.f;
#pragma unroll
    for (int d = 0; d < 32; ++d) ss += res[d] * res[d];
    ss += __shfl_xor(ss, 1); ss += __shfl_xor(ss, 2);
    const float rstd = 1.f / sqrtf(ss * (1.f / 128.f) + 1e-6f);
    bf16* o = YA + ((long)b * SEQ + t) * 512 + h * 128 + qu * 32;
#pragma unroll
    for (int d = 0; d < 32; ++d) o[d] = f2b(res[d] * rstd * subln[qu * 32 + d] * oscale);
}
}
#endif

constexpr int NWAVES = 8;
constexpr int BATCH = 8, SEQ = 4096, D = 1024, M = BATCH * SEQ;
constexpr int BW = 512, NPROJ = 9 * BW, NGATE = 3 * D, DFF = 2816, DFX = 3584, NEXP = 8;
constexpr float EPS = 1e-6f, LOG2E_F = 1.4426950408889634f;
constexpr float C2 = 0.125f * LOG2E_F;
constexpr int MOE_CH_TILES = 64, MOE_MAX_TILES = 264, MOE_MAX_CH = 5;

constexpr size_t MiB = 1u << 20, KiB = 1u << 10;
constexpr size_t WS_CTL = 0, CTL_ZERO_BYTES = 1 * MiB;
constexpr size_t WS_WIN = 1 * MiB, WS_WG = 19 * MiB, WS_WB = 31 * MiB, WS_WO = 37 * MiB, WS_WGU = 41 * MiB, WS_WD = 52 * MiB;
constexpr size_t WS_BST = 58 * MiB;
constexpr size_t WS_TOKE = 64 * MiB, WS_TOKW = WS_TOKE + 128 * KiB, WS_SLOT = WS_TOKE + 384 * KiB, WS_SLW = WS_TOKE + 640 * KiB, WS_CNT = WS_TOKE + 960 * KiB, WS_MHDR = WS_TOKE + 992 * KiB;
constexpr size_t WS_H = 66 * MiB;
constexpr size_t WS_PA = 130 * MiB, WS_PB = 226 * MiB, WS_PC = 322 * MiB;
constexpr size_t WS_YA = 418 * MiB, WS_YB = 450 * MiB, WS_YC = 482 * MiB;
constexpr size_t WS_BP = 130 * MiB;
constexpr size_t WS_GATES = 226 * MiB;
constexpr size_t WS_ACT = 130 * MiB;
constexpr size_t WS_MWGU = 130 * MiB, WS_MWD = 242 * MiB;
constexpr size_t WS_HS = 298 * MiB;
constexpr size_t WS_MACT = 430 * MiB;
constexpr size_t WS_END = 542 * MiB;
static_assert(WS_WD + (size_t)D * DFF * 2 <= WS_BST && WS_HS + (size_t)MOE_MAX_TILES * 256 * D * 2 <= WS_MACT && WS_MACT + (size_t)MOE_CH_TILES * 256 * DFX * 2 <= WS_END, "d_ws map");
static_assert(WS_MWGU + (size_t)NEXP * 2 * DFX * D * 2 <= WS_MWD && WS_MWD + (size_t)NEXP * D * DFX * 2 <= WS_HS && WS_ACT + (size_t)M * DFF * 2 <= WS_PC, "d_ws map 2");
constexpr int CW_BAR = 4096;

constexpr int RING_OFF = 0, LDSCTL_OFF = 139264, MISC_OFF = LDSCTL_OFF + 320, LTAB_OFF = LDSCTL_OFF + 1024;
constexpr int LDS_BYTES = 147456;

#define GAS __attribute__((address_space(1)))
#define LAS __attribute__((address_space(3)))
typedef unsigned short bf16;
typedef unsigned v4u __attribute__((ext_vector_type(4)));
typedef unsigned v2u __attribute__((ext_vector_type(2)));
typedef float f32x4 __attribute__((ext_vector_type(4)));
typedef float f32x2 __attribute__((ext_vector_type(2)));
typedef GAS unsigned gu32;
#define RLX_AGENT __ATOMIC_RELAXED, __HIP_MEMORY_SCOPE_AGENT
#define LDS_WAIT() asm volatile("s_waitcnt lgkmcnt(0)" ::: "memory")
#define VM_WAIT() asm volatile("s_waitcnt vmcnt(0)" ::: "memory")
__device__ __forceinline__ unsigned f2bf(float f) { unsigned u = __builtin_bit_cast(unsigned, f); return (u + 0x7fffu + ((u >> 16) & 1u)) >> 16; }
__device__ __forceinline__ unsigned pk2(float lo, float hi) { return f2bf(lo) | (f2bf(hi) << 16); }
__device__ __forceinline__ float bfl(unsigned w) { return __uint_as_float(w << 16); }
__device__ __forceinline__ float bfh(unsigned w) { return __uint_as_float(w & 0xffff0000u); }

#define XB_TMO      128
#define XB_XCNT(j)  (256  + 64 * (j))
#define XB_XSUB(j)  (1280 + 64 * (j))
#define XB_XGEN(j)  (2304 + 64 * (j))
#define XB_TOP      3328
#define XB_TOPGEN   3392
#define XCD_BAR_WORDS 3456
#define XB_SPIN_CAP (1u << 18)

__device__ __forceinline__ unsigned xb_ld(unsigned* p)              { return __hip_atomic_load(p, __ATOMIC_RELAXED, __HIP_MEMORY_SCOPE_AGENT); }
__device__ __forceinline__ unsigned xb_add(unsigned* p, unsigned v) { return __hip_atomic_fetch_add(p, v, __ATOMIC_RELAXED, __HIP_MEMORY_SCOPE_AGENT); }
__device__ __forceinline__ unsigned xb_xcc_id() { return (unsigned)__builtin_amdgcn_s_getreg((3 << 11) | 20) & 0xFu; }
#define XB_SPIN(cond, bar) do { unsigned _sp = 0; while (cond) { __builtin_amdgcn_s_sleep(1); \
    if ((++_sp & 255u) == 0u) { if (xb_ld(&(bar)[XB_TMO])) break; if (_sp > XB_SPIN_CAP) { atomicAdd(&(bar)[XB_TMO], 1u); break; } } } } while (0)

struct XcdBarrier {
    unsigned* bar; unsigned x;
    volatile LAS unsigned* st;
};

__device__ __forceinline__ XcdBarrier xcd_barrier_post(unsigned* bar, volatile LAS unsigned* st) {
    XcdBarrier b; b.bar = bar; b.x = xb_xcc_id(); b.st = st;
    if (threadIdx.x == 0) (void)xb_add(&bar[XB_XCNT(b.x)], 1u);
    return b;
}
__device__ __forceinline__ void xcd_barrier_complete(unsigned* bar, unsigned x, unsigned& nloc, unsigned& nx) {
    const unsigned G = gridDim.x * gridDim.y * gridDim.z;
    unsigned sum, cnt, mine, sp = 0u;
    for (;;) {
        sum = 0u; cnt = 0u; mine = 0u;
#pragma unroll
        for (unsigned j = 0; j < 16; ++j) { const unsigned c = xb_ld(&bar[XB_XCNT(j)]); sum += c; cnt += (c > 0u) ? 1u : 0u; mine = (j == x) ? c : mine; }
        if (sum == G) break;
        __builtin_amdgcn_s_sleep(1);
        if ((++sp & 255u) == 0u) { if (xb_ld(&bar[XB_TMO])) break; if (sp > XB_SPIN_CAP) { atomicAdd(&bar[XB_TMO], 1u); break; } }
    }
    nloc = mine > 0u ? mine : 1u; nx = cnt > 0u ? cnt : 1u;
}

__device__ __forceinline__ void xcd_barrier(const XcdBarrier& b) {
    asm volatile("s_waitcnt vmcnt(0)" ::: "memory");
    __syncthreads();
    if (threadIdx.x == 0) {
        unsigned* bar = b.bar;
        __builtin_amdgcn_s_waitcnt(0);
        unsigned nloc = b.st[0], nx = b.st[1];
        if (nloc == 0u) { xcd_barrier_complete(bar, b.x, nloc, nx); b.st[0] = nloc; b.st[1] = nx; }
        const unsigned old = xb_add(&bar[XB_XSUB(b.x)], 1u);
        const unsigned gen = old / nloc;
        if (old + 1u == (gen + 1u) * nloc) {
            __builtin_amdgcn_fence(__ATOMIC_RELEASE, "agent");
            asm volatile("s_waitcnt vmcnt(0)" ::: "memory");
            const unsigned og = xb_add(&bar[XB_TOP], 1u);
            const unsigned tg = og / nx;
            if (og + 1u == (tg + 1u) * nx) xb_add(&bar[XB_TOPGEN], 1u);
            else XB_SPIN(xb_ld(&bar[XB_TOPGEN]) == tg, bar);
            __builtin_amdgcn_fence(__ATOMIC_ACQUIRE, "agent");
            xb_add(&bar[XB_XGEN(b.x)], 1u);
            asm volatile("s_waitcnt vmcnt(0)" ::: "memory");
        } else {
            XB_SPIN(xb_ld(&bar[XB_XGEN(b.x)]) == gen, bar);
            __builtin_amdgcn_fence(__ATOMIC_ACQUIRE, "agent");
            asm volatile("s_waitcnt vmcnt(0)" ::: "memory");
        }
    }
    __syncthreads();
}


__device__ __forceinline__ float wave_sum(float v) {
#pragma unroll
    for (int o = 1; o < 64; o <<= 1) v += __shfl_xor(v, o);
    return v;
}
__device__ __forceinline__ void transpose_item(const float* W, int K, int N, bf16* WT, int row_off, LAS float* scr, int k0, int n0, int lane) {
#pragma unroll 8
    for (int i = 0; i < 32; ++i) { const int kk = 2 * i + (lane >> 5); scr[kk * 33 + (lane & 31)] = W[(size_t)(k0 + kk) * N + n0 + (lane & 31)]; }
    LDS_WAIT(); asm volatile("" ::: "memory");
    const int c = lane & 7;
#pragma unroll
    for (int j = 0; j < 4; ++j) { const int n = (lane >> 3) + 8 * j; const LAS float* s = scr + (8 * c) * 33 + n;
        v4u o; o.x = pk2(s[0 * 33], s[1 * 33]); o.y = pk2(s[2 * 33], s[3 * 33]); o.z = pk2(s[4 * 33], s[5 * 33]); o.w = pk2(s[6 * 33], s[7 * 33]);
        *(GAS v4u*)(WT + (size_t)(row_off + n0 + n) * K + k0 + 8 * c) = o; }
    LDS_WAIT(); asm volatile("" ::: "memory");
}
__device__ __forceinline__ void conv_matrix(const float* W, int K, int N, bf16* WT, int mode, LAS float* scr, int gw, int ngw, int lane) {
    const int nblk = N / 32, items = (K / 64) * nblk;
    for (int it = gw; it < items; it += ngw) { const int kb = it / nblk, nb = it - kb * nblk, n0 = 32 * nb;
        const int d0 = mode == 0 ? n0 : (256 * (n0 >> 7) + (n0 & 127) + (mode == 2 ? 128 : 0));
        transpose_item(W, K, N, WT, d0 - n0, scr, 64 * kb, n0, lane); }
}
__device__ __forceinline__ void rms_row(const float* xrow, const f32x4 (&g)[4], f32x4 (&v)[4], int lane) {
    const GAS f32x4* xr = (const GAS f32x4*)xrow + lane; float s2 = 0.f;
#pragma unroll
    for (int j = 0; j < 4; ++j) { v[j] = xr[64 * j]; s2 += (v[j].x * v[j].x + v[j].y * v[j].y) + (v[j].z * v[j].z + v[j].w * v[j].w); }
    const float rstd = 1.f / sqrtf(wave_sum(s2) * (1.f / D) + EPS);
#pragma unroll
    for (int j = 0; j < 4; ++j) v[j] = v[j] * rstd * g[j];
}
__device__ __forceinline__ void store_row_bf16(bf16* orow, const f32x4 (&v)[4], int lane) {
    GAS v2u* o8 = (GAS v2u*)orow + lane;
#pragma unroll
    for (int j = 0; j < 4; ++j) { v2u w; w.x = pk2(v[j].x, v[j].y); w.y = pk2(v[j].z, v[j].w); o8[64 * j] = w; }
}


#ifdef SPOT
__device__ __forceinline__ float sp_bf(const bf16* p) { const unsigned w = __hip_atomic_load((const unsigned*)((uintptr_t)p & ~(uintptr_t)3), __ATOMIC_RELAXED, __HIP_MEMORY_SCOPE_AGENT); return ((uintptr_t)p & 2) ? bfh(w) : bfl(w); }
__device__ __forceinline__ float sp_f(const float* p) { return __uint_as_float(__hip_atomic_load((const unsigned*)p, __ATOMIC_RELAXED, __HIP_MEMORY_SCOPE_AGENT)); }
__device__ __forceinline__ float sp_dot(const bf16* a, const bf16* b, int K) { float s = 0.f; for (int k = 0; k < K; ++k) s += sp_bf(a + k) * sp_bf(b + k); return s; }
__device__ __forceinline__ void sp_chk(gu32* ctl, int site, float got, float want) { if (!(fabsf(got - want) <= 0.02f * fabsf(want) + 0.01f)) { __hip_atomic_fetch_or((unsigned*)(ctl + 2048), 1u << site, __ATOMIC_RELAXED, __HIP_MEMORY_SCOPE_AGENT); __hip_atomic_fetch_add((unsigned*)(ctl + 2112 + site), 1u, __ATOMIC_RELAXED, __HIP_MEMORY_SCOPE_AGENT); } }
__device__ __forceinline__ void sp_chk_t(gu32* ctl, int site, float got, float want) { if (!(fabsf(got - want) <= 0.01f * fabsf(want) + 1e-7f)) { __hip_atomic_fetch_or((unsigned*)(ctl + 2048), 1u << site, __ATOMIC_RELAXED, __HIP_MEMORY_SCOPE_AGENT); __hip_atomic_fetch_add((unsigned*)(ctl + 2112 + site), 1u, __ATOMIC_RELAXED, __HIP_MEMORY_SCOPE_AGENT); } }
__device__ __forceinline__ float sp_silu(float g) { return g / (1.f + expf(-g)); }
#define SPOT_BEGIN() VM_WAIT(); __syncthreads(); if (wave == 0) {
#define SPOT_END() }
#endif
enum { PH_PRO = 0, PH_L = 20, NPHASE = 1 + 2 * PH_L };
struct Args { const float* in[18]; float* out; unsigned char* ws; int ph_lo, ph_hi; };
static_assert(sizeof(Args) == 18 * 8 + 8 + 8 + 8, "Args has no padding");

__global__ void __launch_bounds__(NWAVES * 64, 2) mega_fwd(Args args) {
    extern __shared__ __attribute__((aligned(16))) unsigned char lds_raw[];
    LAS unsigned char* const lds = (LAS unsigned char*)lds_raw;
    volatile LAS unsigned* const MISC = (volatile LAS unsigned*)(lds + MISC_OFF);
    const int G = gridDim.x, bx = blockIdx.x; const int vcu = (G % 8 == 0) ? (bx % 8) * (G / 8) + bx / 8 : bx;
    const int NGW = G * NWAVES;
    unsigned char* const ws = args.ws;
    gu32* const ctl = (gu32*)(ws + WS_CTL);
    for (int u = threadIdx.x; u < (LDS_BYTES - LDSCTL_OFF) / 4; u += NWAVES * 64) ((LAS unsigned*)(lds + LDSCTL_OFF))[u] = 0u;
    __syncthreads();
#if MK_N_LAUNCHES == 1
    XcdBarrier bar = xcd_barrier_post((unsigned*)(ctl + CW_BAR), MISC + 8);
#define SEAM() xcd_barrier(bar)
#else
#define SEAM() do { } while (0)
#endif
    const int lo = args.ph_lo, hi = args.ph_hi;
#define IN(k) (lo <= (k) && (k) < hi)
#define PHASE_IDS() int tidp = threadIdx.x; asm volatile("" : "+v"(tidp)); const int tid = tidp, lane = tidp & 63, wave = __builtin_amdgcn_readfirstlane(tidp >> 6); const int gw = vcu * NWAVES + wave; LAS float* const scr = (LAS float*)(lds + RING_OFF + wave * 16384); (void)tid; (void)lane; (void)gw; (void)scr
#define INP(i) ([&]() -> const float* { int i_ = (i); asm volatile("" : "+s"(i_)); return args.in[i_]; }())
#define WSP(T, OFF) ([&]() -> T* { size_t o_ = (size_t)(OFF); asm volatile("" : "+s"(o_)); return (T*)(ws + o_); }())
#define x_in INP(0)
#define norm_mix INP(1)
#define w_in INP(2)
#define diff_lambda INP(3)
#define diff_subln INP(4)
#define w_gate INP(5)
#define b_gate INP(6)
#define w_branch INP(7)
#define w_out INP(8)
#define norm_ffn INP(9)
#define w_dg INP(10)
#define w_du INP(11)
#define w_dd INP(12)
#define w_router INP(13)
#define w_mg INP(14)
#define w_mu INP(15)
#define w_md INP(16)
#define norm_final INP(17)
#define xout (args.out)
#define Win_t WSP(bf16, WS_WIN)
#define Wg_t WSP(bf16, WS_WG)
#define Wb_t WSP(bf16, WS_WB)
#define Wo_t WSP(bf16, WS_WO)
#define Wgu_t WSP(bf16, WS_WGU)
#define Wd_t WSP(bf16, WS_WD)
#define Hb WSP(bf16, WS_H)
#define PA WSP(bf16, WS_PA)
#define PB WSP(bf16, WS_PB)
#define PC WSP(bf16, WS_PC)
#define YA WSP(bf16, WS_YA)
#define YC WSP(bf16, WS_YC)
#define YB WSP(bf16, WS_YB)
#define BP WSP(bf16, WS_BP)
#define BST WSP(float, WS_BST)
#define GATES WSP(bf16, WS_GATES)
#define ACT WSP(bf16, WS_ACT)
#define MWgu WSP(bf16, WS_MWGU)
#define MWd WSP(bf16, WS_MWD)
#define HS WSP(bf16, WS_HS)
#define MACT WSP(bf16, WS_MACT)
#define TOKE WSP(int, WS_TOKE)
#define TOKW WSP(float, WS_TOKW)
#define SLOT WSP(int, WS_SLOT)
#define SLW WSP(float, WS_SLW)
#define CNT WSP(int, WS_CNT)
#define MHDR WSP(int, WS_MHDR)

    if (IN(PH_PRO)) { PHASE_IDS();
        for (int L = 0; L < 2; ++L) {
            conv_matrix(w_in + (size_t)L * D * NPROJ, D, NPROJ, Win_t + (size_t)L * NPROJ * D, 0, scr, gw, NGW, lane);
            conv_matrix(w_gate + (size_t)L * D * NGATE, D, NGATE, Wg_t + (size_t)L * NGATE * D, 0, scr, gw, NGW, lane);
            for (int i = 0; i < 3; ++i) conv_matrix(w_branch + (size_t)(L * 3 + i) * BW * D, BW, D, Wb_t + (size_t)(L * 3 + i) * D * BW, 0, scr, gw, NGW, lane);
            conv_matrix(w_out + (size_t)L * D * D, D, D, Wo_t + (size_t)L * D * D, 0, scr, gw, NGW, lane);
        }
        conv_matrix(w_dg, D, DFF, Wgu_t, 1, scr, gw, NGW, lane);
        conv_matrix(w_du, D, DFF, Wgu_t, 2, scr, gw, NGW, lane);
        conv_matrix(w_dd, DFF, D, Wd_t, 0, scr, gw, NGW, lane);
        SEAM();
    }

    for (int L = 0; L < 2; ++L) {
        const int P = 1 + L * PH_L;
        const float* xres = (L == 0) ? x_in : xout;
        if (IN(P + 0)) { PHASE_IDS();
            f32x4 g[4];
#pragma unroll
            for (int j = 0; j < 4; ++j) g[j] = ((const GAS f32x4*)(norm_mix + L * D) + lane)[64 * j];
            for (int m = gw; m < M; m += NGW) { f32x4 v[4]; rms_row(xres + (size_t)m * D, g, v, lane); store_row_bf16(Hb + (size_t)m * D, v, lane); }
            SEAM();
        }
        if (IN(P + 1)) { PHASE_IDS();
            pg8::Gemm g{Hb, Win_t + (size_t)L * NPROJ * D, D}; pg8::StaticOrder S; S.init(M, NPROJ, D, G, bx);
            pg8::EpiProj E{PA, (size_t)(WS_PB - WS_PA) / 2, C2};

#if !defined(SKIP_G) && (!defined(ONLY_G) || ONLY_G == 1)
 pg8::gemm_phase<pg8::EpiProj, pg8::StaticOrder, true, true>(lds + RING_OFF, g, S, E, tidp);
#endif
#ifdef SPOT
            SPOT_BEGIN()
                pg8::Unit u; if (S.next(0, u)) { const int row = u.om * 256 + ((lane * 5 + 3) & 255), cg = u.pn * 256 + ((lane * 11 + 7) & 255);
                    const float d = sp_dot(Hb + (size_t)row * D, Win_t + (size_t)L * NPROJ * D + (size_t)cg * D, D);
                    const int t = cg / 1536, lc = cg - 1536 * t; const float want = d * (lc < 512 ? C2 : 1.f);
                    sp_chk(ctl, 1, sp_bf(PA + (size_t)t * M * 1536 + (size_t)row * 1536 + lc), want);
                    { const int n = (bx * 64 + lane * 7) % NPROJ, k = (bx * 13 + lane * 29) % D; sp_chk_t(ctl, 12, sp_bf(Win_t + (size_t)L * NPROJ * D + (size_t)n * D + k), w_in[(size_t)L * D * NPROJ + (size_t)k * NPROJ + n]); }
                    { const int n = (bx * 64 + lane * 7) % NGATE, k = (bx * 13 + lane * 29) % D; sp_chk_t(ctl, 13, sp_bf(Wg_t + (size_t)L * NGATE * D + (size_t)n * D + k), w_gate[(size_t)L * D * NGATE + (size_t)k * NGATE + n]); }
                    { const int n = (bx * 64 + lane * 7) % D, k = (bx * 13 + lane * 29) % D; sp_chk_t(ctl, 14, sp_bf(Wo_t + (size_t)L * D * D + (size_t)n * D + k), w_out[(size_t)L * D * D + (size_t)k * D + n]); }
                    { const int i = bx % 3, n = (bx * 64 + lane * 7) % D, k = (bx * 13 + lane * 29) % BW; sp_chk_t(ctl, 15, sp_bf(Wb_t + (size_t)(L * 3 + i) * D * BW + (size_t)n * BW + k), w_branch[(size_t)(L * 3 + i) * BW * D + (size_t)k * D + n]); }
                    { const int j = (bx + lane) % 22, c = (lane * 5) & 127, k = (bx * 13 + lane * 29) % D; sp_chk_t(ctl, 16, sp_bf(Wgu_t + (size_t)(256 * j + c) * D + k), w_dg[(size_t)k * DFF + 128 * j + c]); sp_chk_t(ctl, 16, sp_bf(Wgu_t + (size_t)(256 * j + 128 + c) * D + k), w_du[(size_t)k * DFF + 128 * j + c]); }
                    { const int n = (bx * 64 + lane * 7) % D, k = (bx * 13 + lane * 29) % DFF; sp_chk_t(ctl, 17, sp_bf(Wd_t + (size_t)n * DFF + k), w_dd[(size_t)k * D + n]); }
                }
            SPOT_END()
#endif

            SEAM();
        }
        if (IN(P + 2)) { PHASE_IDS();
            const float lam_init = 0.8f - 0.6f * expf(-0.3f * (float)L);
            float lam;
            { const float* lv = diff_lambda + L * 256; const float s01 = wave_sum(lv[lane] * lv[64 + lane]), s23 = wave_sum(lv[128 + lane] * lv[192 + lane]); lam = expf(s01) - expf(s23) + lam_init; }
#ifdef NAIVE_A
            for (long idx = (long)bx * 512 + tid; idx < (long)M * 4 * 4; idx += (long)G * 512) naive::diff_naive(idx, PA, YA, lam, 1.f - lam_init, diff_subln + L * 128);
#endif
#ifdef NAIVE_C
            for (long idx = (long)bx * 512 + tid; idx < (long)M * 8; idx += (long)G * 512) naive::sb_naive(idx, PC, YC);
#endif
            { const int bh = vcu >> 3, s = vcu & 7;
              for (int i = 0; i < 4; ++i) { const int qb = (i == 0) ? s : (i == 1) ? 15 - s : (i == 2) ? 16 + s : 31 - s;

#if !defined(SKIP_A) && !defined(NAIVE_A)
 att::diff_unit(bh >> 2, bh & 3, qb, PA, YA, lam, 1.f - lam_init, diff_subln + L * 128, (LAS char*)(lds + RING_OFF), tidp);
#endif
 } }
            { const int bh = vcu >> 2, s = vcu & 3;
              for (int i = 0; i < 4; ++i) { const int qb = (i == 0) ? s : (i == 1) ? 7 - s : (i == 2) ? 8 + s : 15 - s;

#if !defined(SKIP_C) && !defined(NAIVE_C)
 att::sb_unit(bh >> 3, bh & 7, qb, PC, YC, (LAS char*)(lds + RING_OFF), tidp);
#endif
 } }
            SEAM();
        }
        if (IN(P + 3)) { PHASE_IDS();
#ifdef NAIVE_B
            for (long idx = (long)bx * 512 + tid; idx < (long)M * 8; idx += (long)G * 512) naive::dil_naive(idx, PB, YB);
#endif
            const int bh = vcu >> 2, sub = vcu & 3;
            for (int i = 0; i < 12; ++i) { const int j = sub * 12 + i; int pat, res, blk, dil;
                if (j < 16) { pat = 0; dil = 1; res = 0; blk = j; } else if (j < 32) { pat = 1; dil = 4; res = (j - 16) >> 2; blk = (j - 16) & 3; } else { pat = 2; dil = 16; res = j - 32; blk = 0; }

#if !defined(SKIP_B) && !defined(NAIVE_B)
 att::dil_unit(bh >> 3, bh & 7, dil, res, blk, PB, BP + (size_t)pat * M * BW, BST + (size_t)pat * M * 16, (LAS char*)(lds + RING_OFF), tidp);
#endif
 }
            SEAM();
        }
        if (IN(P + 4)) { PHASE_IDS();
#ifndef NAIVE_B
            for (int m = gw; m < M; m += NGW) {
                const int hd = lane >> 3; f32x2 st[3]; float mx = -INFINITY;
#pragma unroll
                for (int p = 0; p < 3; ++p) { st[p] = *(const GAS f32x2*)(BST + ((size_t)p * M + m) * 16 + hd * 2); mx = fmaxf(mx, st[p].x); }
                float wgt[3], wsum = 0.f;
#pragma unroll
                for (int p = 0; p < 3; ++p) { wgt[p] = __builtin_amdgcn_exp2f(st[p].x - mx) * st[p].y; wsum += wgt[p]; }
                const float inv = 1.f / wsum; float acc[8];
#pragma unroll
                for (int k = 0; k < 8; ++k) acc[k] = 0.f;
#pragma unroll
                for (int p = 0; p < 3; ++p) { const v4u w = *(const GAS v4u*)(BP + ((size_t)p * M + m) * BW + lane * 8); const float f = wgt[p] * inv;
                    acc[0] += f * bfl(w.x); acc[1] += f * bfh(w.x); acc[2] += f * bfl(w.y); acc[3] += f * bfh(w.y); acc[4] += f * bfl(w.z); acc[5] += f * bfh(w.z); acc[6] += f * bfl(w.w); acc[7] += f * bfh(w.w); }
                v4u o; o.x = pk2(acc[0], acc[1]); o.y = pk2(acc[2], acc[3]); o.z = pk2(acc[4], acc[5]); o.w = pk2(acc[6], acc[7]);
                *(GAS v4u*)(YB + (size_t)m * BW + lane * 8) = o;
            }
#endif
            VM_WAIT(); __syncthreads();
            pg8::Gemm g{Hb, Wg_t + (size_t)L * NGATE * D, D}; pg8::StaticOrder S; S.init(M, NGATE, D, G, bx);
            pg8::EpiGate E{GATES, NGATE, b_gate + L * NGATE};

#if !defined(SKIP_G) && (!defined(ONLY_G) || ONLY_G == 2)
 pg8::gemm_phase<pg8::EpiGate, pg8::StaticOrder, true, true>(lds + RING_OFF, g, S, E, tidp);
#endif
#ifdef SPOT
            SPOT_BEGIN()
                pg8::Unit u; if (S.next(0, u)) { const int row = u.om * 256 + ((lane * 5 + 3) & 255), cg = u.pn * 256 + ((lane * 11 + 7) & 255);
                    const float d = sp_dot(Hb + (size_t)row * D, Wg_t + (size_t)L * NGATE * D + (size_t)cg * D, D) + b_gate[L * NGATE + cg];
                    sp_chk(ctl, 2, sp_bf(GATES + (size_t)row * NGATE + cg), 1.f / (1.f + expf(-d))); }
            SPOT_END()
#endif

            SEAM();
        }
        if (IN(P + 5)) { PHASE_IDS();
            pg8::Gemm g{YA, Wb_t + (size_t)L * 3 * D * BW, BW}; pg8::MergeOrder S; S.b.init(M, D, BW, G, bx);
            S.as = (long)(WS_YB - WS_YA); S.bs = (long)D * BW * 2;
            pg8::EpiMerge E{GATES, Hb};

#if !defined(SKIP_G) && (!defined(ONLY_G) || ONLY_G == 3)
 pg8::gemm_phase<pg8::EpiMerge, pg8::MergeOrder, true, true>(lds + RING_OFF, g, S, E, tidp);
#endif
#ifdef SPOT
            SPOT_BEGIN()
                pg8::Unit u; if (S.b.next(0, u)) { const int row = u.om * 256 + ((lane * 5 + 3) & 255), cg = u.pn * 256 + ((lane * 11 + 7) & 255);
                    float want = 0.f;
                    for (int i = 0; i < 3; ++i) { const bf16* Y = (i == 0) ? YA : (i == 1) ? YB : YC;
                        want += sp_bf(GATES + (size_t)row * NGATE + i * D + cg) * sp_dot(Y + (size_t)row * BW, Wb_t + (size_t)(L * 3 + i) * D * BW + (size_t)cg * BW, BW); }
                    sp_chk(ctl, 3, sp_bf(Hb + (size_t)row * D + cg), want); }
            SPOT_END()
#endif

            SEAM();
        }
        if (IN(P + 6)) { PHASE_IDS();
            pg8::Gemm g{Hb, Wo_t + (size_t)L * D * D, D}; pg8::StaticOrder S; S.init(M, D, D, G, bx);
            pg8::EpiRes E{xres, xout};

#if !defined(SKIP_G) && (!defined(ONLY_G) || ONLY_G == 4)
 pg8::gemm_phase<pg8::EpiRes, pg8::StaticOrder, true, true>(lds + RING_OFF, g, S, E, tidp);
#endif
#ifdef SPOT
            SPOT_BEGIN()
                pg8::Unit u; if (L == 0 && S.next(0, u)) { const int row = u.om * 256 + ((lane * 5 + 3) & 255), cg = u.pn * 256 + ((lane * 11 + 7) & 255);
                    const float want = x_in[(size_t)row * D + cg] + sp_dot(Hb + (size_t)row * D, Wo_t + (size_t)L * D * D + (size_t)cg * D, D);
                    sp_chk(ctl, 4, sp_f(xout + (size_t)row * D + cg), want); }
            SPOT_END()
#endif

            SEAM();
        }
        if (L == 0) {
            if (IN(P + 7)) { PHASE_IDS();
                f32x4 g[4];
#pragma unroll
                for (int j = 0; j < 4; ++j) g[j] = ((const GAS f32x4*)(norm_ffn + L * D) + lane)[64 * j];
                for (int m = gw; m < M; m += NGW) { f32x4 v[4]; rms_row(xout + (size_t)m * D, g, v, lane); store_row_bf16(Hb + (size_t)m * D, v, lane); }
                SEAM();
            }
#ifndef ABL_DENSE
            if (IN(P + 8)) { PHASE_IDS();
                pg8::Gemm g{Hb, Wgu_t, D}; pg8::StaticOrder S; S.init(M, 2 * DFF, D, G, bx);
                pg8::EpiSwiglu E{ACT, DFF};

#if !defined(SKIP_G) && (!defined(ONLY_G) || ONLY_G == 5)
 pg8::gemm_phase<pg8::EpiSwiglu, pg8::StaticOrder, true, true>(lds + RING_OFF, g, S, E, tidp);
#endif
#ifdef SPOT
            SPOT_BEGIN()
                pg8::Unit u; if (S.next(0, u)) { const int row = u.om * 256 + ((lane * 5 + 3) & 255), c = (lane * 7 + 1) & 127;
                    const float gv = sp_dot(Hb + (size_t)row * D, Wgu_t + (size_t)(u.pn * 256 + c) * D, D), uv = sp_dot(Hb + (size_t)row * D, Wgu_t + (size_t)(u.pn * 256 + 128 + c) * D, D);
                    sp_chk(ctl, 5, sp_bf(ACT + (size_t)row * DFF + u.pn * 128 + c), sp_silu(gv) * uv); }
            SPOT_END()
#endif

                SEAM();
            }
            if (IN(P + 9)) { PHASE_IDS();
                pg8::Gemm g{ACT, Wd_t, DFF}; pg8::StaticOrder S; S.init(M, D, DFF, G, bx);
                pg8::EpiRes E{xout, xout};

#if !defined(SKIP_G) && (!defined(ONLY_G) || ONLY_G == 6)
 pg8::gemm_phase<pg8::EpiRes, pg8::StaticOrder, true, true>(lds + RING_OFF, g, S, E, tidp);
#endif

                SEAM();
            }
#endif
        } else {
            if (IN(P + 7)) { PHASE_IDS();
                LAS float* wr = (LAS float*)(lds + RING_OFF);
                LAS int* cl = (LAS int*)(lds + RING_OFF + 32768);
                for (int u = tid; u < D * NEXP / 4; u += NWAVES * 64) ((LAS f32x4*)wr)[u] = ((const GAS f32x4*)w_router)[u];
                if (tid < NEXP) cl[tid] = 0;
                __syncthreads();
                f32x4 g[4];
#pragma unroll
                for (int j = 0; j < 4; ++j) g[j] = ((const GAS f32x4*)(norm_ffn + L * D) + lane)[64 * j];
                for (int k = 0; k < 16; ++k) { const int m = bx * 128 + wave + 8 * k;
                    f32x4 v[4]; rms_row(xout + (size_t)m * D, g, v, lane); store_row_bf16(Hb + (size_t)m * D, v, lane);
                    float lg[NEXP];
#pragma unroll
                    for (int e = 0; e < NEXP; ++e) lg[e] = 0.f;
#pragma unroll
                    for (int j = 0; j < 4; ++j)
#pragma unroll
                        for (int i = 0; i < 4; ++i) { const LAS f32x4* wp = (const LAS f32x4*)(wr + (size_t)(4 * lane + 256 * j + i) * NEXP); const f32x4 wa = wp[0], wb = wp[1]; const float xv = v[j][i];
                            lg[0] += xv * wa.x; lg[1] += xv * wa.y; lg[2] += xv * wa.z; lg[3] += xv * wa.w; lg[4] += xv * wb.x; lg[5] += xv * wb.y; lg[6] += xv * wb.z; lg[7] += xv * wb.w; }
#pragma unroll
                    for (int e = 0; e < NEXP; ++e) lg[e] = wave_sum(lg[e]);
                    int e1 = 0; float v1 = lg[0];
#pragma unroll
                    for (int e = 1; e < NEXP; ++e) if (lg[e] > v1) { v1 = lg[e]; e1 = e; }
                    int e2 = -1; float v2 = -INFINITY;
#pragma unroll
                    for (int e = 0; e < NEXP; ++e) if (e != e1 && lg[e] > v2) { v2 = lg[e]; e2 = e; }
                    const float w1 = 1.f / (1.f + expf(v2 - v1));
                    if (lane == 0) { TOKE[m] = e1 | (e2 << 8); TOKW[2 * m] = w1; TOKW[2 * m + 1] = 1.f - w1; __hip_atomic_fetch_add(cl + e1, 1, __ATOMIC_RELAXED, __HIP_MEMORY_SCOPE_WORKGROUP); __hip_atomic_fetch_add(cl + e2, 1, __ATOMIC_RELAXED, __HIP_MEMORY_SCOPE_WORKGROUP); }
                }
                __syncthreads();
                if (tid < NEXP) CNT[bx * NEXP + tid] = cl[tid];
                __syncthreads();
                for (int e = 0; e < NEXP; ++e) {
                    conv_matrix(w_mg + (size_t)e * D * DFX, D, DFX, MWgu + (size_t)e * 2 * DFX * D, 1, scr, gw, NGW, lane);
                    conv_matrix(w_mu + (size_t)e * D * DFX, D, DFX, MWgu + (size_t)e * 2 * DFX * D, 2, scr, gw, NGW, lane);
                    conv_matrix(w_md + (size_t)e * DFX * D, DFX, D, MWd + (size_t)e * D * DFX, 0, scr, gw, NGW, lane);
                }
                SEAM();
            }
            if (IN(P + 8)) { PHASE_IDS();
                LAS int* C = (LAS int*)(lds + RING_OFF);
                LAS int* TB = (LAS int*)(lds + RING_OFF + 8192);
                LAS int* SL = (LAS int*)(lds + RING_OFF + 8192 + 256);
                for (int u = tid; u < 256 * NEXP; u += NWAVES * 64) C[u] = CNT[u];
                __syncthreads();
                { const int e = wave; int tot = 0, pre = 0;
#pragma unroll
                  for (int q = 0; q < 4; ++q) { const int i = 4 * lane + q; const int cv = C[i * NEXP + e]; tot += cv; pre += (i < bx) ? cv : 0; }
#pragma unroll
                  for (int o = 1; o < 64; o <<= 1) { tot += __shfl_xor(tot, o); pre += __shfl_xor(pre, o); }
                  if (lane == 0) { TB[e] = pre; TB[8 + e] = tot; } }
                __syncthreads();
                if (tid == 0) { int base = 0, cum = 0;
                    for (int e = 0; e < NEXP; ++e) { TB[16 + e] = base; const int nt = (TB[8 + e] + 255) >> 8; base += nt * 256; cum += nt; if (bx == 0) MHDR[1 + e] = cum; }
                    if (bx == 0) MHDR[0] = cum; }
                __syncthreads();
                if (wave == 0) {
                    const int t0 = bx * 128 + 2 * lane; const int ea = TOKE[t0], eb = TOKE[t0 + 1];
                    int pe[4] = {ea & 255, ea >> 8, eb & 255, eb >> 8}; int slot[4] = {0, 0, 0, 0};
#pragma unroll
                    for (int e = 0; e < NEXP; ++e) { int mine = 0;
#pragma unroll
                        for (int q = 0; q < 4; ++q) mine += (pe[q] == e) ? 1 : 0;
                        int inc = mine;
#pragma unroll
                        for (int o = 1; o < 64; o <<= 1) { const int t = __shfl_up(inc, o); if (lane >= o) inc += t; }
                        int run = TB[16 + e] + TB[e] + inc - mine;
#pragma unroll
                        for (int q = 0; q < 4; ++q) if (pe[q] == e) { slot[q] = run; ++run; } }
                    const f32x4 wv = *(const GAS f32x4*)(TOKW + 2 * t0);
                    SL[4 * lane + 0] = slot[0]; SL[4 * lane + 1] = slot[1]; SL[4 * lane + 2] = slot[2]; SL[4 * lane + 3] = slot[3];
                    { v4u sv; sv.x = (unsigned)slot[0]; sv.y = (unsigned)slot[1]; sv.z = (unsigned)slot[2]; sv.w = (unsigned)slot[3]; *(GAS v4u*)(SLOT + 2 * t0) = sv; }
                    SLW[slot[0]] = wv.x; SLW[slot[1]] = wv.y; SLW[slot[2]] = wv.z; SLW[slot[3]] = wv.w;
                }
                __syncthreads();
                for (int k = 0; k < 16; ++k) { const int tl = wave + 8 * k; const int m = bx * 128 + tl; const int s0 = SL[2 * tl], s1 = SL[2 * tl + 1];
                    const GAS v4u* src = (const GAS v4u*)(Hb + (size_t)m * D) + lane; const v4u a = src[0], b = src[64];
                    GAS v4u* d0 = (GAS v4u*)(HS + (size_t)s0 * D) + lane; GAS v4u* d1 = (GAS v4u*)(HS + (size_t)s1 * D) + lane;
                    d0[0] = a; d0[64] = b; d1[0] = a; d1[64] = b; }
                SEAM();
            }
            {
                int nt_all = 0, c0 = 0, c1 = 0, c2 = 0, c3 = 0, c4 = 0, c5 = 0, c6 = 0;
                if (hi > P + 9 && lo < P + 19) { const int* hd = MHDR;
                    nt_all = __builtin_amdgcn_readfirstlane(hd[0]); c0 = __builtin_amdgcn_readfirstlane(hd[1]); c1 = __builtin_amdgcn_readfirstlane(hd[2]); c2 = __builtin_amdgcn_readfirstlane(hd[3]);
                    c3 = __builtin_amdgcn_readfirstlane(hd[4]); c4 = __builtin_amdgcn_readfirstlane(hd[5]); c5 = __builtin_amdgcn_readfirstlane(hd[6]); c6 = __builtin_amdgcn_readfirstlane(hd[7]); }
                if (nt_all > MOE_MAX_TILES) nt_all = MOE_MAX_TILES;
                for (int ch = 0; ch < MOE_MAX_CH; ++ch) {
                    const int t0 = ch * MOE_CH_TILES; int nt = nt_all - t0; if (nt > MOE_CH_TILES) nt = MOE_CH_TILES;
                    if (nt <= 0) break;
                    if (IN(P + 9 + 2 * ch)) { PHASE_IDS();
                        pg8::Gemm g{HS, MWgu, D}; pg8::MoeOrder S{t0, nt, 2 * DFX / 256, nt * (2 * DFX / 256), G, bx, (long)256 * D * 2, (long)256 * D * 2, (long)2 * DFX * D * 2, c0, c1, c2, c3, c4, c5, c6, false, true};
                        pg8::EpiSwiglu E{MACT, DFX};

#if !defined(SKIP_G) && (!defined(ONLY_G) || ONLY_G == 7)
 pg8::gemm_phase<pg8::EpiSwiglu, pg8::MoeOrder, true, true>(lds + RING_OFF, g, S, E, tidp);
#endif
#ifdef SPOT_MOE
            SPOT_BEGIN()
                pg8::Unit u; if (S.next(0, u)) { const int c = (lane * 7 + 1) & 127; const bf16* hrow = HS + (size_t)u.pm * 256 * D; const bf16* wb = MWgu + (size_t)u.tag * 2 * DFX * D;
                    const float gv = sp_dot(hrow, wb + (size_t)(u.pn * 256 + c) * D, D), uv = sp_dot(hrow, wb + (size_t)(u.pn * 256 + 128 + c) * D, D);
                    sp_chk(ctl, 7, sp_bf(MACT + (size_t)u.om * 256 * DFX + u.pn * 128 + c), sp_silu(gv) * uv);
                    { const int e = u.tag, j = (bx + lane) % 28, cc = (lane * 5) & 127, k = (bx * 13 + lane * 29) % D; sp_chk(ctl, 9, sp_bf(wb + (size_t)(256 * j + cc) * D + k), w_mg[(size_t)e * D * DFX + (size_t)k * DFX + 128 * j + cc]); sp_chk(ctl, 9, sp_bf(wb + (size_t)(256 * j + 128 + cc) * D + k), w_mu[(size_t)e * D * DFX + (size_t)k * DFX + 128 * j + cc]); }
                }
            SPOT_END()
#endif

                        SEAM();
                    }
                    if (IN(P + 10 + 2 * ch)) { PHASE_IDS();
                        pg8::Gemm g{MACT, MWd, DFX}; pg8::MoeOrder S{t0, nt, D / 256, nt * (D / 256), G, bx, (long)256 * DFX * 2, (long)256 * DFX * 2, (long)D * DFX * 2, c0, c1, c2, c3, c4, c5, c6, true, false};
                        pg8::EpiMoeDown E{HS, SLW};

#if !defined(SKIP_G) && (!defined(ONLY_G) || ONLY_G == 8)
 pg8::gemm_phase<pg8::EpiMoeDown, pg8::MoeOrder, true, true>(lds + RING_OFF, g, S, E, tidp);
#endif
#ifdef SPOT_MOE
            SPOT_BEGIN()
                pg8::Unit u; if (S.next(0, u)) { const int cg = u.pn * 256 + ((lane * 11 + 7) & 255); const bf16* wb = MWd + (size_t)u.tag * D * DFX;
                    const float want = SLW[(size_t)u.pm * 256] * sp_dot(MACT + (size_t)(u.pm - t0) * 256 * DFX, wb + (size_t)cg * DFX, DFX);
                    sp_chk(ctl, 8, sp_bf(HS + (size_t)u.pm * 256 * D + cg), want);
                    { const int e = u.tag, n = (bx * 64 + lane * 7) % D, k = (bx * 13 + lane * 29) % DFX; sp_chk(ctl, 10, sp_bf(wb + (size_t)n * DFX + k), w_md[(size_t)e * DFX * D + (size_t)k * D + n]); }
                }
            SPOT_END()
#endif

                        SEAM();
                    }
                }
            }
            if (IN(P + 19)) { PHASE_IDS();
                f32x4 g[4];
#pragma unroll
                for (int j = 0; j < 4; ++j) g[j] = ((const GAS f32x4*)norm_final + lane)[64 * j];
                unsigned bad = 0u;
#ifdef SPOT
                float osc = 1.f; { unsigned fl = __builtin_amdgcn_readfirstlane(__hip_atomic_load(ctl + 2048, RLX_AGENT));
#ifdef SPOT_MASK
 fl &= SPOT_MASK;
#endif
 if (fl) osc = 1.f + 0.25f * (float)(__builtin_ctz(fl) + 1);
#ifdef SPOT_FRAC
                  const unsigned fc = __builtin_amdgcn_readfirstlane(__hip_atomic_load(ctl + 2112 + SPOT_FRAC, RLX_AGENT)); osc = 1.f + 4.f * (float)fc / 32768.f;
#endif
 }
#endif
#if MK_N_LAUNCHES == 1
                bad = __hip_atomic_load(ctl + CW_BAR + XB_TMO, RLX_AGENT);
#endif
                for (int m = gw; m < M; m += NGW) {
                    const int s0 = SLOT[2 * m], s1 = SLOT[2 * m + 1];
                    const GAS f32x4* xr = (const GAS f32x4*)(xout + (size_t)m * D) + lane; const GAS v2u* y0 = (const GAS v2u*)(HS + (size_t)s0 * D) + lane; const GAS v2u* y1 = (const GAS v2u*)(HS + (size_t)s1 * D) + lane;
                    f32x4 v[4]; float s2 = 0.f;
#pragma unroll
                    for (int j = 0; j < 4; ++j) { const v2u a = y0[64 * j], b = y1[64 * j]; f32x4 t = xr[64 * j];

#ifndef ABL_MOE
t.x += bfl(a.x) + bfl(b.x); t.y += bfh(a.x) + bfh(b.x); t.z += bfl(a.y) + bfl(b.y); t.w += bfh(a.y) + bfh(b.y);
#endif
 v[j] = t;
                        s2 += (t.x * t.x + t.y * t.y) + (t.z * t.z + t.w * t.w); }
                    const float rstd = 1.f / sqrtf(wave_sum(s2) * (1.f / D) + EPS);
                    GAS f32x4* orow = (GAS f32x4*)(xout + (size_t)m * D) + lane;
#pragma unroll
                    for (int j = 0; j < 4; ++j) { f32x4 o = v[j] * rstd * g[j];
#ifdef SPOT
                        o = o * osc;
#endif
#ifdef ZERO_ROWS
                        if (ZERO_ROWS) o = o * 0.f;
#endif
#ifdef ZERO_COLS
                        { const int col = 4 * lane + 256 * j; if (ZERO_COLS) o = o * 0.f; }
#endif
                        if (bad) { const float q = __builtin_nanf(""); o = (f32x4){q, q, q, q}; } orow[64 * j] = o; }
                }
            }
        }
    }
#undef IN
#undef SEAM
}

extern "C" void kernel_launch(void* const* d_in, const int* in_sizes, int n_in, void* d_out, int out_size, void* d_ws, size_t ws_size, hipStream_t stream) {
    static int grid = 0;
    if (grid == 0) {
        if (n_in != 18 || in_sizes[0] != M * D || out_size != M * D || ws_size < WS_END) { fprintf(stderr, "kernel_launch: unexpected shapes (n_in %d, in0 %d, out %d, ws %zu < %zu); nothing launched\n", n_in, n_in > 0 ? in_sizes[0] : -1, out_size, ws_size, (size_t)WS_END); grid = -1; return; }
        int dev = 0, cus = 0, per_cu = 0;
        if (hipGetDevice(&dev) != hipSuccess || hipDeviceGetAttribute(&cus, hipDeviceAttributeMultiprocessorCount, dev) != hipSuccess) { grid = -1; return; }
        if (hipFuncSetAttribute((const void*)mega_fwd, hipFuncAttributeMaxDynamicSharedMemorySize, LDS_BYTES) != hipSuccess) { fprintf(stderr, "kernel_launch: hipFuncSetAttribute failed\n"); grid = -1; return; }
        if (hipOccupancyMaxActiveBlocksPerMultiprocessor(&per_cu, (const void*)mega_fwd, NWAVES * 64, LDS_BYTES) != hipSuccess || per_cu < 1) fprintf(stderr, "kernel_launch: occupancy query reports %d workgroups per CU\n", per_cu);
        (void)hipGetLastError();
        grid = cus;
        if (grid != 256) { fprintf(stderr, "kernel_launch: built for 256 CUs, device has %d; nothing launched\n", cus); grid = -1; return; }
    }
    if (grid < 0) return;
    if (hipMemsetAsync((char*)d_ws + WS_CTL, 0, CTL_ZERO_BYTES, stream) != hipSuccess) return;
    Args a{};
    for (int i = 0; i < 18; ++i) a.in[i] = (const float*)d_in[i];
    a.out = (float*)d_out; a.ws = (unsigned char*)d_ws;
#if MK_N_LAUNCHES == 1
    a.ph_lo = 0; a.ph_hi = NPHASE;
    hipLaunchKernelGGL(mega_fwd, dim3(grid), dim3(NWAVES * 64), LDS_BYTES, stream, a);
#else
    for (int p = 0; p < NPHASE; ++p) {
        const int r = (p - 1) % PH_L, L = (p - 1) / PH_L;
        if (p > 0 && L == 0 && r >= 10) continue;
        a.ph_lo = p; a.ph_hi = p + 1;
        hipLaunchKernelGGL(mega_fwd, dim3(grid), dim3(NWAVES * 64), LDS_BYTES, stream, a);
    }
#endif
}
```

```cpp
#include <hip/hip_runtime.h>
#include <cstdio>
#include <cstdint>

#ifndef MK_N_LAUNCHES
#define MK_N_LAUNCHES 1
#endif

namespace pg8 {
#define PG8_LAS __attribute__((address_space(3)))
typedef unsigned short bf16_t;
typedef short bf16x8 __attribute__((ext_vector_type(8)));
typedef float f32x4 __attribute__((ext_vector_type(4)));
typedef float f32x2 __attribute__((ext_vector_type(2)));
typedef unsigned u32x4 __attribute__((ext_vector_type(4)));
typedef int v8i32 __attribute__((ext_vector_type(8)));
typedef unsigned u32x2 __attribute__((ext_vector_type(2)));
constexpr int F8_WSHIFT = 6;
constexpr float F8_WINV = 1.f / (float)(1 << F8_WSHIFT);
constexpr int BM = 256, BK = 64, HALF = 128, HTB = HALF * BK * 2  , STAGE_BYTES = 8 * HTB, NXCD = 8, WGM = 8;

__host__ __device__ __forceinline__ int lds_byte(int r, int c) { const int st = (r >> 4) * 2 + (c >> 5), rr = r & 15, cc = c & 31, ob = rr * 64 + cc * 2; return st * 1024 + (ob ^ (((ob >> 9) & 1) << 5)); }
__host__ __device__ __forceinline__ void stage_rc(int b, int& R, int& C) { const int st = b / 1024, sb = b % 1024, swz = sb ^ (((sb >> 9) & 1) << 5); R = (st >> 1) * 16 + swz / 64; C = (st & 1) * 32 + (swz % 64) / 2; }
__host__ __device__ __forceinline__ int perm32(int rho) { const int n = rho >> 4, i = rho & 15; return 8 * (i >> 2) + 4 * n + (i & 3); }

struct Unit { int pm, pn, om, tag; long ao, bo; };
struct Gemm { const bf16_t* A; const bf16_t* Bt; int K; };

__device__ __forceinline__ void tile_of(int wgid, int nwg, int nM, int nN, int& pm, int& pn) {
    { const int q = nwg / NXCD, r = nwg % NXCD, xcd = wgid % NXCD, off = wgid / NXCD; wgid = (xcd < r ? xcd * (q + 1) : r * (q + 1) + (xcd - r) * q) + off; }
    const int nig = WGM * nN, gid = wgid / nig, fm = gid * WGM, gsz = (nM - fm) < WGM ? (nM - fm) : WGM;
    pm = fm + ((wgid % nig) % gsz); pn = (wgid % nig) / gsz;
}
struct StaticOrder {
    int nM, nN, nwg, G, c; long tst;
    __device__ void init(int M, int N, int K, int G_, int c_) { nM = M / BM; nN = N / BM; nwg = nM * nN; G = G_; c = c_; tst = (long)BM * K * 2; }
    __device__ __forceinline__ bool next(int i, Unit& u) const {
        const long L = (long)i * G + c; if (L >= nwg) return false;
        tile_of((int)L, nwg, nM, nN, u.pm, u.pn); u.om = u.pm; u.tag = 0; u.ao = (long)u.pm * tst; u.bo = (long)u.pn * tst; return true;
    }
    __device__ __forceinline__ void a_ready(const Unit&) const {}
    __device__ __forceinline__ void done(const Unit&) const {}
};
struct MergeOrder {
    StaticOrder b; long as, bs;
    __device__ __forceinline__ bool next(int i, Unit& u) const {
        const int ti = i / 3, tg = i - 3 * ti; if (!b.next(ti, u)) return false;
        u.tag = tg; u.ao += (long)tg * as; u.bo += (long)tg * bs; return true;
    }
    __device__ __forceinline__ void a_ready(const Unit&) const {}
    __device__ __forceinline__ void done(const Unit&) const {}
};
struct MoeOrder {
    int t0, nt, nN, nwg, G, c; long tA, tB, eB; int c0, c1, c2, c3, c4, c5, c6; bool a_local, o_local;
    __device__ __forceinline__ bool next(int i, Unit& u) const {
        const long L = (long)i * G + c; if (L >= nwg) return false;
        int pl, pn; tile_of((int)L, nwg, nt, nN, pl, pn);
        const int gt = t0 + pl; const int e = (gt >= c0) + (gt >= c1) + (gt >= c2) + (gt >= c3) + (gt >= c4) + (gt >= c5) + (gt >= c6);
        u.pm = gt; u.pn = pn; u.tag = e; u.om = o_local ? pl : gt; u.ao = (long)(a_local ? pl : gt) * tA; u.bo = (long)e * eB + (long)pn * tB; return true;
    }
    __device__ __forceinline__ void a_ready(const Unit&) const {}
    __device__ __forceinline__ void done(const Unit&) const {}
};

typedef __bf16 bf16x2_t __attribute__((ext_vector_type(2)));
__device__ __forceinline__ unsigned cvt_pk_bf16(float lo, float hi) { f32x2 v = {lo, hi}; bf16x2_t b = __builtin_convertvector(v, bf16x2_t); return __builtin_bit_cast(unsigned, b); }
__device__ __forceinline__ float bf_lo(unsigned w) { return __uint_as_float(w << 16); }
__device__ __forceinline__ float bf_hi(unsigned w) { return __uint_as_float(w & 0xffff0000u); }
__device__ __forceinline__ float sigm(float x) { return __builtin_amdgcn_rcpf(1.0f + __builtin_amdgcn_exp2f(-1.4426950408889634f * x)); }
__device__ __forceinline__ u32x4 pack8(f32x4 v0, f32x4 v1) { u32x4 w; w.x = cvt_pk_bf16(v0[0], v0[1]); w.y = cvt_pk_bf16(v0[2], v0[3]); w.z = cvt_pk_bf16(v1[0], v1[1]); w.w = cvt_pk_bf16(v1[2], v1[3]); return w; }

struct EpiProj {
    static constexpr bool PERM = true, AFTER_DRAIN = false;
    bf16_t* O; size_t split_stride; float qscale;
    __device__ __forceinline__ void operator()(const f32x4 (&acc)[2][2][4][2], const Unit& u, int wr, int wc, int fr, int fq) const {
        const int t = u.pn / 6, lt = u.pn - 6 * t; bf16_t* base = O + (size_t)t * split_stride; const float sc = lt < 2 ? qscale : 1.f;
        const int row0 = u.om * BM + wr * 64 + fr, col0 = lt * BM + wc * 32 + 8 * fq;
#pragma unroll
        for (int ai = 0; ai < 2; ++ai)
#pragma unroll
            for (int m = 0; m < 4; ++m) { bf16_t* rowp = base + (size_t)(row0 + ai * HALF + m * 16) * 1536 + col0;
#pragma unroll
                for (int bj = 0; bj < 2; ++bj) *(u32x4*)(rowp + bj * HALF) = pack8(acc[ai][bj][m][0] * sc, acc[ai][bj][m][1] * sc); }
    }
};
struct EpiGate {
    static constexpr bool PERM = true, AFTER_DRAIN = false;
    bf16_t* O; int ldc; const float* bias;
    __device__ __forceinline__ void operator()(const f32x4 (&acc)[2][2][4][2], const Unit& u, int wr, int wc, int fr, int fq) const {
        const int row0 = u.om * BM + wr * 64 + fr, col0 = u.pn * BM + wc * 32 + 8 * fq;
        f32x4 bv[2][2];
#pragma unroll
        for (int bj = 0; bj < 2; ++bj)
#pragma unroll
            for (int n = 0; n < 2; ++n) bv[bj][n] = *(const f32x4*)(bias + col0 + bj * HALF + 4 * n);
#pragma unroll
        for (int ai = 0; ai < 2; ++ai)
#pragma unroll
            for (int m = 0; m < 4; ++m) { bf16_t* rowp = O + (size_t)(row0 + ai * HALF + m * 16) * ldc + col0;
#pragma unroll
                for (int bj = 0; bj < 2; ++bj) { f32x4 v0 = acc[ai][bj][m][0] + bv[bj][0], v1 = acc[ai][bj][m][1] + bv[bj][1];
#pragma unroll
                    for (int i = 0; i < 4; ++i) { v0[i] = sigm(v0[i]); v1[i] = sigm(v1[i]); }
                    *(u32x4*)(rowp + bj * HALF) = pack8(v0, v1); } }
    }
};
struct EpiMerge {
    static constexpr bool PERM = true, AFTER_DRAIN = false;
    const bf16_t* gates; bf16_t* O;
    __device__ __forceinline__ void operator()(const f32x4 (&acc)[2][2][4][2], const Unit& u, int wr, int wc, int fr, int fq) const {
        const int row0 = u.om * BM + wr * 64 + fr, col0 = u.pn * BM + wc * 32 + 8 * fq; const int tg = u.tag;
#pragma unroll
        for (int ai = 0; ai < 2; ++ai)
#pragma unroll
            for (int m = 0; m < 4; ++m) { const size_t row = (size_t)(row0 + ai * HALF + m * 16);
#pragma unroll
                for (int bj = 0; bj < 2; ++bj) {
                    const u32x4 gw = *(const u32x4*)(gates + row * 3072 + tg * 1024 + col0 + bj * HALF);
                    bf16_t* op = O + row * 1024 + col0 + bj * HALF;
                    f32x4 v0 = acc[ai][bj][m][0], v1 = acc[ai][bj][m][1];
#ifdef ABL_TAG
                    if (tg == ABL_TAG) { v0 = v0 * 0.f; v1 = v1 * 0.f; }
#endif
                    v0[0] *= bf_lo(gw.x); v0[1] *= bf_hi(gw.x); v0[2] *= bf_lo(gw.y); v0[3] *= bf_hi(gw.y);
                    v1[0] *= bf_lo(gw.z); v1[1] *= bf_hi(gw.z); v1[2] *= bf_lo(gw.w); v1[3] *= bf_hi(gw.w);
                    if (tg != 0) { const u32x4 ow = *(const u32x4*)op;
                        v0[0] += bf_lo(ow.x); v0[1] += bf_hi(ow.x); v0[2] += bf_lo(ow.y); v0[3] += bf_hi(ow.y);
                        v1[0] += bf_lo(ow.z); v1[1] += bf_hi(ow.z); v1[2] += bf_lo(ow.w); v1[3] += bf_hi(ow.w); }
                    *(u32x4*)op = pack8(v0, v1); }
                asm volatile("" ::: "memory"); }
    }
};
struct EpiRes {
    static constexpr bool PERM = false, AFTER_DRAIN = false;
    const float* base; float* out; float sc;
    __device__ __forceinline__ void operator()(const f32x4 (&acc)[2][2][4][2], const Unit& u, int wr, int wc, int fr, int fq) const {
        const int row0 = u.om * BM + wr * 64 + fr, col0 = u.pn * BM + wc * 32 + 4 * fq;
#pragma unroll
        for (int ai = 0; ai < 2; ++ai)
#pragma unroll
            for (int m = 0; m < 4; ++m) { const size_t off = (size_t)(row0 + ai * HALF + m * 16) * 1024 + col0;
#pragma unroll
                for (int bj = 0; bj < 2; ++bj)
#pragma unroll
                    for (int n = 0; n < 2; ++n) { const f32x4 bs = *(const f32x4*)(base + off + bj * HALF + n * 16); *(f32x4*)(out + off + bj * HALF + n * 16) = bs + acc[ai][bj][m][n] * sc; } }
    }
};
struct EpiSwiglu {
    static constexpr bool PERM = true, AFTER_DRAIN = false;
    bf16_t* O; int ldc;
    __device__ __forceinline__ void operator()(const f32x4 (&acc)[2][2][4][2], const Unit& u, int wr, int wc, int fr, int fq) const {
        const int row0 = u.om * BM + wr * 64 + fr, col0 = u.pn * HALF + wc * 32 + 8 * fq;
#pragma unroll
        for (int ai = 0; ai < 2; ++ai)
#pragma unroll
            for (int m = 0; m < 4; ++m) { f32x4 v0, v1;
#pragma unroll
                for (int i = 0; i < 4; ++i) { const float g0 = acc[ai][0][m][0][i], g1 = acc[ai][0][m][1][i]; v0[i] = g0 * sigm(g0) * acc[ai][1][m][0][i]; v1[i] = g1 * sigm(g1) * acc[ai][1][m][1][i]; }
                *(u32x4*)(O + (size_t)(row0 + ai * HALF + m * 16) * ldc + col0) = pack8(v0, v1); }
    }
};
__device__ __forceinline__ unsigned pk4_fp8(float a, float b, float c, float d) {
    a = __builtin_fminf(__builtin_fmaxf(a, -448.f), 448.f); b = __builtin_fminf(__builtin_fmaxf(b, -448.f), 448.f); c = __builtin_fminf(__builtin_fmaxf(c, -448.f), 448.f); d = __builtin_fminf(__builtin_fmaxf(d, -448.f), 448.f);
    int w = __builtin_amdgcn_cvt_pk_fp8_f32(a, b, 0, false); w = __builtin_amdgcn_cvt_pk_fp8_f32(c, d, w, true); return (unsigned)w; }
struct EpiSwigluF8 {
    static constexpr bool PERM = true, AFTER_DRAIN = false;
    unsigned char* O; int ldc;
    __device__ __forceinline__ void operator()(const f32x4 (&acc)[2][2][4][2], const Unit& u, int wr, int wc, int fr, int fq) const {
        const int row0 = u.om * BM + wr * 64 + fr, col0 = u.pn * HALF + wc * 32 + 8 * fq;
#pragma unroll
        for (int ai = 0; ai < 2; ++ai)
#pragma unroll
            for (int m = 0; m < 4; ++m) { f32x4 v0, v1;
#pragma unroll
                for (int i = 0; i < 4; ++i) { const float g0 = acc[ai][0][m][0][i] * F8_WINV, g1 = acc[ai][0][m][1][i] * F8_WINV; v0[i] = g0 * sigm(g0) * (acc[ai][1][m][0][i] * F8_WINV); v1[i] = g1 * sigm(g1) * (acc[ai][1][m][1][i] * F8_WINV); }
                u32x2 w; w.x = pk4_fp8(v0[0], v0[1], v0[2], v0[3]); w.y = pk4_fp8(v1[0], v1[1], v1[2], v1[3]);
                *(u32x2*)(O + (size_t)(row0 + ai * HALF + m * 16) * ldc + col0) = w; }
    }
};
struct EpiMoeDown {
    static constexpr bool PERM = true, AFTER_DRAIN = false;
    bf16_t* O; const float* w; float scale;
    __device__ __forceinline__ void operator()(const f32x4 (&acc)[2][2][4][2], const Unit& u, int wr, int wc, int fr, int fq) const {
        const int row0 = u.om * BM + wr * 64 + fr, col0 = u.pn * BM + wc * 32 + 8 * fq;
#pragma unroll
        for (int ai = 0; ai < 2; ++ai)
#pragma unroll
            for (int m = 0; m < 4; ++m) { const size_t row = (size_t)(row0 + ai * HALF + m * 16); const float sc = w[row] * scale;
#pragma unroll
                for (int bj = 0; bj < 2; ++bj) *(u32x4*)(O + row * 1024 + col0 + bj * HALF) = pack8(acc[ai][bj][m][0] * sc, acc[ai][bj][m][1] * sc); }
    }
};
template <class Epi, class Sched, bool ALIGN_EPI = false, bool SP2 = false, bool F8 = false>
__device__ __forceinline__ void gemm_phase(PG8_LAS unsigned char* lds, const Gemm g, const Sched& S, const Epi& E, const int tid_in) {
    const int tid = tid_in, wid = __builtin_amdgcn_readfirstlane(tid >> 6), lane = tid & 63, wr = wid >> 2, wc = wid & 3, fr = lane & 15, fq = lane >> 4;
    const int K = g.K, nt = K / BK;
    unsigned voffA[2], voffB[2];
#pragma unroll
    for (int i = 0; i < 2; ++i) { int R, C; stage_rc(tid * 16 + i * 8192, R, C); const int Rb = Epi::PERM ? ((R & ~31) + perm32(R & 31)) : R;
        voffA[i] = (unsigned)(R * K + C) * 2u; voffB[i] = (unsigned)(Rb * K + C) * 2u; }
    const size_t kstep = (size_t)(BK * 2);
    const size_t hstep = (size_t)HALF * K * 2;
    const unsigned ldsw = (unsigned)wid * 1024u;
    const int aoff = lds_byte(wr * 64 + fr, fq * 8), boff = lds_byte(wc * 32 + fr, fq * 8);
#define PG8_SA(b, h) (((b) * 2 + (h)) * HTB)
#define PG8_SB(b, h) ((4 + (b) * 2 + (h)) * HTB)
#define PG8_STAGE(bufoff, gbase, voff) do { _Pragma("unroll") for (int _i = 0; _i < 2; ++_i) \
        __builtin_amdgcn_global_load_lds((const unsigned*)((const char*)(gbase) + (voff)[_i]), (PG8_LAS unsigned*)(lds + (bufoff) + ldsw + _i * 8192), 16, 0, 0); } while (0)
#define PG8_LDA(dst, b, h) do { _Pragma("unroll") for (int m = 0; m < 4; ++m) _Pragma("unroll") for (int k = 0; k < 2; ++k) dst[m][k] = *(const PG8_LAS bf16x8*)(lds + PG8_SA(b, h) + aoff + m * 2048 + k * 1024); } while (0)
#define PG8_LDB(dst, b, h) do { _Pragma("unroll") for (int n = 0; n < 2; ++n) _Pragma("unroll") for (int k = 0; k < 2; ++k) dst[n][k] = *(const PG8_LAS bf16x8*)(lds + PG8_SB(b, h) + boff + n * 2048 + k * 1024); } while (0)
#define PG8_CAT8(x) __builtin_bit_cast(v8i32, __builtin_shufflevector((x)[0], (x)[1], 0, 1, 2, 3, 4, 5, 6, 7, 8, 9, 10, 11, 12, 13, 14, 15))
#define PG8_MMA(ai, bj, At, Bt) do { __builtin_amdgcn_s_setprio(1); if constexpr (F8) { _Pragma("unroll") for (int m = 0; m < 4; ++m) _Pragma("unroll") for (int n = 0; n < 2; ++n) \
        asm volatile("v_mfma_f32_16x16x128_f8f6f4 %0, %1, %2, %0" : "+v"(acc[ai][bj][m][n]) : "v"(PG8_CAT8(Bt[n])), "v"(PG8_CAT8(At[m]))); } else { \
        _Pragma("unroll") for (int m = 0; m < 4; ++m) _Pragma("unroll") for (int n = 0; n < 2; ++n) _Pragma("unroll") for (int k = 0; k < 2; ++k) \
        acc[ai][bj][m][n] = __builtin_amdgcn_mfma_f32_16x16x32_bf16(Bt[n][k], At[m][k], acc[ai][bj][m][n], 0, 0, 0); } __builtin_amdgcn_s_setprio(0); } while (0)
#define PG8_WAIT_V(n) asm volatile("s_waitcnt vmcnt(" #n ")" ::: "memory")
#define PG8_WAIT_L(n) asm volatile("s_waitcnt lgkmcnt(" #n ")" ::: "memory")
#define PG8_BAR __builtin_amdgcn_s_barrier()
#define PG8_SCHED __builtin_amdgcn_sched_barrier(0)
    Unit cur, nxt; int ui = 0;
    if (!S.next(0, cur)) return;
    f32x4 acc[2][2][4][2];
#pragma unroll
    for (int a = 0; a < 2; ++a)
#pragma unroll
        for (int b = 0; b < 2; ++b)
#pragma unroll
            for (int m = 0; m < 4; ++m)
#pragma unroll
                for (int n = 0; n < 2; ++n) { acc[a][b][m][n] = (f32x4){0.f, 0.f, 0.f, 0.f}; if constexpr (F8) asm volatile("" : "+v"(acc[a][b][m][n])); }
    bf16x8 At[4][2], B0[2][2], B1[2][2];
    const char* cA = (const char*)g.A + cur.ao; const char* cB = (const char*)g.Bt + cur.bo;
    S.a_ready(cur);
    if constexpr (SP2) {
        PG8_STAGE(PG8_SB(0, 0), cB, voffB); PG8_STAGE(PG8_SB(0, 1), cB + hstep, voffB); PG8_STAGE(PG8_SA(0, 0), cA, voffA); PG8_STAGE(PG8_SA(0, 1), cA + hstep, voffA);
        if (wr == 1) PG8_BAR;
        PG8_WAIT_V(2); PG8_BAR;
        PG8_STAGE(PG8_SB(1, 0), cB + kstep, voffB); PG8_STAGE(PG8_SA(1, 0), cA + kstep, voffA); PG8_STAGE(PG8_SB(1, 1), cB + hstep + kstep, voffB);
        PG8_WAIT_V(6); PG8_BAR;
    } else {
        PG8_STAGE(PG8_SB(0, 0), cB, voffB); PG8_STAGE(PG8_SA(0, 0), cA, voffA); PG8_STAGE(PG8_SB(0, 1), cB + hstep, voffB); PG8_STAGE(PG8_SA(0, 1), cA + hstep, voffA);
        if (wr == 1) PG8_BAR;
        PG8_WAIT_V(4); PG8_BAR;
        PG8_STAGE(PG8_SB(1, 0), cB + kstep, voffB); PG8_STAGE(PG8_SA(1, 0), cA + kstep, voffA); PG8_STAGE(PG8_SB(1, 1), cB + hstep + kstep, voffB);
        PG8_WAIT_V(6); PG8_BAR;
    }
    for (;;) {
        const bool has_next = S.next(ui + 1, nxt);
        const char* nA = has_next ? (const char*)g.A + nxt.ao : cA; const char* nB = has_next ? (const char*)g.Bt + nxt.bo : cB;
#pragma nounroll
        for (int t = 0; t < nt; t += 2) {
            const bool last = (t == nt - 2);
            const char* a1 = cA + (size_t)(t + 1) * kstep;
            const char* a2 = last ? nA : cA + (size_t)(t + 2) * kstep; const char* b2 = last ? nB : cB + (size_t)(t + 2) * kstep;
            const char* a3 = a2 + kstep; const char* b3 = b2 + kstep;
            if (last && has_next) S.a_ready(nxt);
            if constexpr (SP2) {
            PG8_LDB(B0, 0, 0); PG8_LDB(B1, 0, 1); PG8_SCHED; PG8_LDA(At, 0, 0); PG8_STAGE(PG8_SA(1, 1), a1 + hstep, voffA);
            PG8_WAIT_V(8); PG8_WAIT_L(0); PG8_BAR; PG8_MMA(0, 0, At, B0); PG8_MMA(0, 1, At, B1); PG8_BAR; PG8_SCHED;
            PG8_LDA(At, 0, 1); PG8_STAGE(PG8_SB(0, 0), b2, voffB); PG8_STAGE(PG8_SB(0, 1), b2 + hstep, voffB); PG8_STAGE(PG8_SA(0, 0), a2, voffA);
            PG8_WAIT_V(8); PG8_WAIT_L(0); PG8_BAR; PG8_MMA(1, 0, At, B0); PG8_MMA(1, 1, At, B1); PG8_BAR; PG8_SCHED;
            PG8_LDB(B0, 1, 0); PG8_LDB(B1, 1, 1); PG8_SCHED; PG8_LDA(At, 1, 0); PG8_STAGE(PG8_SA(0, 1), a2 + hstep, voffA);
            PG8_WAIT_V(8); PG8_WAIT_L(0); PG8_BAR; PG8_MMA(0, 0, At, B0); PG8_MMA(0, 1, At, B1); PG8_BAR; PG8_SCHED;
            PG8_LDA(At, 1, 1); PG8_STAGE(PG8_SB(1, 0), b3, voffB); PG8_STAGE(PG8_SB(1, 1), b3 + hstep, voffB); PG8_STAGE(PG8_SA(1, 0), a3, voffA);
            PG8_WAIT_V(8); PG8_WAIT_L(0); PG8_BAR; PG8_MMA(1, 0, At, B0); PG8_MMA(1, 1, At, B1); PG8_BAR; PG8_SCHED;
            } else {
            PG8_LDB(B0, 0, 0); PG8_SCHED; PG8_LDA(At, 0, 0); PG8_STAGE(PG8_SA(1, 1), a1 + hstep, voffA);
            PG8_WAIT_L(8); PG8_BAR; PG8_WAIT_L(0); PG8_MMA(0, 0, At, B0); PG8_BAR; PG8_SCHED;
            PG8_LDB(B1, 0, 1); PG8_STAGE(PG8_SB(0, 0), b2, voffB);
            PG8_BAR; PG8_WAIT_L(0); PG8_MMA(0, 1, At, B1); PG8_BAR;
            PG8_LDA(At, 0, 1); PG8_STAGE(PG8_SA(0, 0), a2, voffA);
            PG8_BAR; PG8_WAIT_L(0); PG8_MMA(1, 0, At, B0); PG8_BAR; PG8_SCHED;
            PG8_STAGE(PG8_SB(0, 1), b2 + hstep, voffB);
            PG8_WAIT_V(6); PG8_BAR; PG8_MMA(1, 1, At, B1); PG8_BAR;
            PG8_LDB(B0, 1, 0); PG8_SCHED; PG8_LDA(At, 1, 0); PG8_STAGE(PG8_SA(0, 1), a2 + hstep, voffA);
            PG8_WAIT_L(8); PG8_BAR; PG8_WAIT_L(0); PG8_MMA(0, 0, At, B0); PG8_BAR; PG8_SCHED;
            PG8_LDB(B1, 1, 1); PG8_STAGE(PG8_SB(1, 0), b3, voffB);
            PG8_BAR; PG8_WAIT_L(0); PG8_MMA(0, 1, At, B1); PG8_BAR;
            PG8_LDA(At, 1, 1); PG8_STAGE(PG8_SA(1, 0), a3, voffA);
            PG8_BAR; PG8_WAIT_L(0); PG8_MMA(1, 0, At, B0); PG8_BAR; PG8_SCHED;
            PG8_STAGE(PG8_SB(1, 1), b3 + hstep, voffB);
            PG8_WAIT_V(6); PG8_BAR; PG8_MMA(1, 1, At, B1); PG8_BAR;
            }
        }
        if constexpr (ALIGN_EPI) { if (wr == 0) PG8_BAR; }
        if constexpr (F8) asm volatile("s_nop 15\n\ts_nop 15" ::: "memory");
        if constexpr (!Epi::AFTER_DRAIN) { E(acc, cur, wr, wc, fr, fq); S.done(cur); }
        if (!has_next) break;
#pragma unroll
        for (int a = 0; a < 2; ++a)
#pragma unroll
            for (int b = 0; b < 2; ++b)
#pragma unroll
                for (int m = 0; m < 4; ++m)
#pragma unroll
                    for (int n = 0; n < 2; ++n) { acc[a][b][m][n] = (f32x4){0.f, 0.f, 0.f, 0.f}; if constexpr (F8) asm volatile("" : "+v"(acc[a][b][m][n])); }
        cur = nxt; cA = nA; cB = nB; ++ui;
        if constexpr (ALIGN_EPI) { if (wr == 1) PG8_BAR; }
    }
    PG8_WAIT_V(0);
    if constexpr (!ALIGN_EPI) { if (wr == 0) PG8_BAR; }
    PG8_BAR;
    if constexpr (Epi::AFTER_DRAIN) { E.fused(acc, cur, wr, wc, fr, fq, lds, wid, lane); S.done(cur); }
#undef PG8_SA
#undef PG8_SB
#undef PG8_STAGE
#undef PG8_LDA
#undef PG8_LDB
#undef PG8_MMA
#undef PG8_CAT8
#undef PG8_WAIT_V
#undef PG8_WAIT_L
#undef PG8_BAR
#undef PG8_SCHED
}
}

namespace att {
#define LAS __attribute__((address_space(3)))
typedef unsigned short bf16;
typedef __attribute__((ext_vector_type(8))) short bf16x8;
typedef __attribute__((ext_vector_type(4))) short s16x4;
typedef __attribute__((ext_vector_type(16))) float f32x16;
typedef __attribute__((ext_vector_type(4))) unsigned u32x4;
typedef float f32x2_t __attribute__((ext_vector_type(2))); typedef __bf16 bf16x2_t __attribute__((ext_vector_type(2)));
typedef short v4i16_t __attribute__((ext_vector_type(4)));
typedef LAS const char* lds_cptr;
constexpr int SEQ = 4096, PP = 1536;
constexpr float LOG2E = 1.4426950408889634f;
constexpr float NEGINF = -INFINITY;
__device__ __forceinline__ int crow(int r, int hi) { return (r & 3) + 8 * (r >> 2) + 4 * hi; }
__device__ __forceinline__ void glds16(const void* gsrc, unsigned lds_dst) { unsigned keep;
    asm volatile("s_mov_b32 %0, m0\n\ts_mov_b32 m0, %2\n\ts_nop 0\n\tglobal_load_lds_dwordx4 %1, off\n\ts_mov_b32 m0, %0" : "=&s"(keep) : "v"(gsrc), "s"(lds_dst) : "memory"); }
__device__ __forceinline__ unsigned cvtpk(float lo, float hi) { f32x2_t v = {lo, hi}; bf16x2_t b = __builtin_convertvector(v, bf16x2_t); return __builtin_bit_cast(unsigned, b); }
__device__ __forceinline__ s16x4 vtr(lds_cptr p) { return __builtin_bit_cast(s16x4, __builtin_amdgcn_ds_read_tr16_b64_v4i16((LAS v4i16_t*)p)); }
__device__ __forceinline__ bf16x8 ldk(lds_cptr p) { return *(const LAS bf16x8*)p; }
__device__ __forceinline__ float xhalf(float v, int hi) {
    auto rr = __builtin_amdgcn_permlane32_swap(__float_as_uint(v), __float_as_uint(v), false, false);
    return hi ? __uint_as_float(rr[0]) : __uint_as_float(rr[1]); }
__device__ __forceinline__ float max16(const f32x16& p) { float a = fmaxf(fmaxf(p[0], p[1]), fmaxf(p[2], p[3]));
#pragma unroll
    for (int r = 4; r < 16; r += 4) a = fmaxf(a, fmaxf(fmaxf(p[r], p[r + 1]), fmaxf(p[r + 2], p[r + 3]))); return a; }
__device__ __forceinline__ float sum16(const f32x16& p) { float a = (p[0] + p[1]) + (p[2] + p[3]);
#pragma unroll
    for (int r = 4; r < 16; r += 4) a += (p[r] + p[r + 1]) + (p[r + 2] + p[r + 3]); return a; }
#define ATT_WAIT_BAR(N) asm volatile("s_waitcnt vmcnt(" #N ") lgkmcnt(0)\n\ts_barrier" ::: "memory")
#define ATT_LDSW() asm volatile("s_waitcnt lgkmcnt(0)" ::: "memory")
#define PACK8(P, B) (u32x4){cvtpk(P[B], P[B + 1]), cvtpk(P[B + 2], P[B + 3]), cvtpk(P[B + 4], P[B + 5]), cvtpk(P[B + 6], P[B + 7])}
#define ASBF(x) __builtin_bit_cast(bf16x8, x)
#define VFRAG(lo, hh) (bf16x8){lo[0], lo[1], lo[2], lo[3], hh[0], hh[1], hh[2], hh[3]}

constexpr int A_SLOT = 32768, A_WSF = 98304, A_XCH = 0, A_STG = 65536;
constexpr float A_THR = 8.f;
__device__ __forceinline__ void diff_unit(int b, int h, int qb, const bf16* __restrict__ PA, bf16* __restrict__ YA, float lam, float oscale, const float* __restrict__ subln, LAS char* shm, const int tid) {
    const int lane = tid & 63, r32 = lane & 31, hi = lane >> 5;
    const int wid = __builtin_amdgcn_readfirstlane(tid >> 6), comp = wid >> 2, g = wid & 3;
    const float slope2 = __builtin_amdgcn_exp2f(-2.f * (float)(h + 1)) * LOG2E;
    const long rowbase = (long)b * SEQ; const int q0 = qb * 128, qw0 = q0 + 32 * g, qi = qw0 + r32;
    const unsigned lds0 = (unsigned)(size_t)shm;
    LAS float* wsf = (LAS float*)(shm + A_WSF) + wid * 128;
    const bf16* kb_ = PA + rowbase * PP + 512 + h * 128; const bf16* vb_ = PA + rowbase * PP + 1024 + h * 128;
    const bf16* ksrc0 = kb_ + (long)lane * PP + wid * 8; const bf16* ksrc1 = ksrc0 + 64;
    const int pa = wid, pb = wid + 8;
    const bf16* vsrca = vb_ + (long)(16 * (pa & 3) + (lane >> 2)) * PP + (pa >> 2) * 32 + (lane & 3) * 8;
    const bf16* vsrcb = vb_ + (long)(16 * (pb & 3) + (lane >> 2)) * PP + (pb >> 2) * 32 + (lane & 3) * 8;
    const int NT = 2 * (qb + 1);
#define A_ISSUE(t_, sl_) do { const long ro_ = (long)(t_) * 64 * PP; const unsigned sb_ = (unsigned)__builtin_amdgcn_readfirstlane(lds0 + (unsigned)(sl_)); \
        glds16(ksrc0 + ro_, sb_ + wid * 1024); glds16(ksrc1 + ro_, sb_ + 8192 + wid * 1024); glds16(vsrca + ro_, sb_ + 16384 + pa * 1024); glds16(vsrcb + ro_, sb_ + 16384 + pb * 1024); } while (0)
    const bf16* qp = PA + (rowbase + qi) * PP + h * 128 + comp * 64 + hi * 8;
    bf16x8 qr[4];
#pragma unroll
    for (int d0 = 0; d0 < 4; ++d0) qr[d0] = *(const bf16x8*)(qp + d0 * 16);
    float lb[16];
#pragma unroll
    for (int r = 0; r < 16; ++r) lb[r] = slope2 * (float)crow(r, hi);
    A_ISSUE(NT - 1, 0); A_ISSUE(NT - 2, A_SLOT);
    float m_ref = NEGINF, l = 0.f; f32x16 o[4];
#pragma unroll
    for (int dq = 0; dq < 4; ++dq) o[dq] = f32x16{};
    int sl = 0, sl2 = 2 * A_SLOT;
    for (int it = 0; it < NT; ++it) {
        if (it + 1 < NT) { ATT_WAIT_BAR(4); } else { ATT_WAIT_BAR(0); }
        if (it + 2 < NT) A_ISSUE(NT - 3 - it, sl2);
        const int kbase = 64 * (NT - 1 - it);
        if (kbase <= qw0) {
            const lds_cptr kp = shm + sl + comp * 8192 + hi * 1024 + r32 * 16;
            const float base = slope2 * (float)(kbase - qi), base1 = base + 32.f * slope2;
            f32x16 p0, p1;
#pragma unroll
            for (int r = 0; r < 16; ++r) { p0[r] = base + lb[r]; p1[r] = base1 + lb[r]; }
#pragma unroll
            for (int d0 = 0; d0 < 4; ++d0) { const bf16x8 k0 = ldk(kp + d0 * 2048), k1 = ldk(kp + d0 * 2048 + 512);
                p0 = __builtin_amdgcn_mfma_f32_32x32x16_bf16(k0, qr[d0], p0, 0, 0, 0); p1 = __builtin_amdgcn_mfma_f32_32x32x16_bf16(k1, qr[d0], p1, 0, 0, 0); }
            if (kbase + 63 > qw0) {
#pragma unroll
                for (int r = 0; r < 16; ++r) { const int kv = kbase + crow(r, hi); if (kv > qi) p0[r] = NEGINF; if (kv + 32 > qi) p1[r] = NEGINF; }
            }
            float rm = fmaxf(max16(p0), max16(p1)); rm = fmaxf(rm, xhalf(rm, hi));
            const float mnew = fmaxf(m_ref, rm);
            if (__any(mnew > m_ref + A_THR)) {
                const float alpha = __builtin_amdgcn_exp2f(m_ref - mnew); l *= alpha; m_ref = mnew;
                if (hi == 0) wsf[r32] = alpha; ATT_LDSW();
#pragma unroll
                for (int r = 0; r < 16; ++r) { const float a = wsf[crow(r, hi)];
#pragma unroll
                    for (int dq = 0; dq < 4; ++dq) o[dq][r] *= a; }
            }
#pragma unroll
            for (int r = 0; r < 16; ++r) { p0[r] = __builtin_amdgcn_exp2f(p0[r] - m_ref); p1[r] = __builtin_amdgcn_exp2f(p1[r] - m_ref); }
            l += sum16(p0) + sum16(p1);
            const u32x4 pw0 = PACK8(p0, 0), pw1 = PACK8(p0, 8), pw2 = PACK8(p1, 0), pw3 = PACK8(p1, 8);
            const lds_cptr vp = shm + sl + 16384 + ((lane >> 4) & 1) * 32 + (lane & 3) * 8 + (4 * hi + ((lane & 15) >> 2)) * 64;
#pragma unroll
            for (int dq = 0; dq < 4; ++dq) {
                const s16x4 l0 = vtr(vp + dq * 4096), h0 = vtr(vp + dq * 4096 + 512), l1 = vtr(vp + dq * 4096 + 1024), h1 = vtr(vp + dq * 4096 + 1536);
                const s16x4 l2 = vtr(vp + dq * 4096 + 2048), h2 = vtr(vp + dq * 4096 + 2560), l3 = vtr(vp + dq * 4096 + 3072), h3 = vtr(vp + dq * 4096 + 3584);
                o[dq] = __builtin_amdgcn_mfma_f32_32x32x16_bf16(ASBF(pw0), VFRAG(l0, h0), o[dq], 0, 0, 0);
                o[dq] = __builtin_amdgcn_mfma_f32_32x32x16_bf16(ASBF(pw1), VFRAG(l1, h1), o[dq], 0, 0, 0);
                o[dq] = __builtin_amdgcn_mfma_f32_32x32x16_bf16(ASBF(pw2), VFRAG(l2, h2), o[dq], 0, 0, 0);
                o[dq] = __builtin_amdgcn_mfma_f32_32x32x16_bf16(ASBF(pw3), VFRAG(l3, h3), o[dq], 0, 0, 0);
            }
        }
        sl2 = sl; sl = (sl == 2 * A_SLOT) ? 0 : sl + A_SLOT;
    }
#undef A_ISSUE
    l += xhalf(l, hi);
    if (hi == 0) wsf[32 + r32] = __builtin_amdgcn_rcpf(l); ATT_LDSW();
#pragma unroll
    for (int r = 0; r < 16; ++r) { const float a = wsf[32 + crow(r, hi)];
#pragma unroll
        for (int dq = 0; dq < 4; ++dq) o[dq][r] *= a; }
    ATT_WAIT_BAR(0);
    LAS float* X = (LAS float*)(shm + A_XCH) + g * 4096;
    if (comp == 1) {
#pragma unroll
        for (int dq = 0; dq < 4; ++dq)
#pragma unroll
            for (int r = 0; r < 16; ++r) X[(dq * 16 + r) * 64 + lane] = o[dq][r];
    }
    ATT_WAIT_BAR(0);
    if (comp == 0) {
        float ss[16];
#pragma unroll
        for (int r = 0; r < 16; ++r) ss[r] = 0.f;
#pragma unroll
        for (int dq = 0; dq < 4; ++dq)
#pragma unroll
            for (int r = 0; r < 16; ++r) { const float d = o[dq][r] - lam * X[(dq * 16 + r) * 64 + lane]; o[dq][r] = d; ss[r] += d * d; }
#pragma unroll
        for (int r = 0; r < 16; ++r) { float s = ss[r];
#pragma unroll
            for (int of = 1; of < 32; of <<= 1) s += __shfl_xor(s, of);
            ss[r] = __builtin_amdgcn_rsqf(s * (1.f / 128.f) + 1e-6f); }
        LAS bf16* stg = (LAS bf16*)(shm + A_STG) + g * 4096;
#pragma unroll
        for (int dq = 0; dq < 4; ++dq) { const float gn = subln[dq * 32 + r32] * oscale;
#pragma unroll
            for (int r = 0; r < 16; ++r) stg[crow(r, hi) * 128 + dq * 32 + r32] = (bf16)(cvtpk(o[dq][r] * ss[r] * gn, 0.f) & 0xffffu); }
        ATT_LDSW();
        bf16* Yw = YA + (rowbase + qw0) * 512 + h * 128;
#pragma unroll
        for (int i = 0; i < 8; ++i) { const int idx = i * 64 + lane, row = idx >> 4, ch = idx & 15; const u32x4 v = *(const LAS u32x4*)(stg + row * 128 + ch * 8); *(u32x4*)(Yw + (long)row * 512 + ch * 8) = v; }
    }
    ATT_WAIT_BAR(0);
}

constexpr int B_V = 49152, B_WSF = 98304, B_STG = 100352;
__device__ __forceinline__ void dil_unit(int b, int h, int dil, int res, int blk, const bf16* __restrict__ PB, bf16* __restrict__ OUT, float* __restrict__ ST, LAS char* shm, const int tid) {
    const int lane = tid & 63, r32 = lane & 31, hi = lane >> 5;
    const int wid = __builtin_amdgcn_readfirstlane(tid >> 6);
    const int hs = h + (h >> 1);
    const float sd = __builtin_amdgcn_exp2f(-(2.f / 3.f) * (float)(hs + 1)) * LOG2E * (float)dil;
    const long rowbase = (long)b * SEQ; const int i0 = 256 * blk, jb = i0 - 128;
    const unsigned lds0 = (unsigned)(size_t)shm;
#pragma unroll
    for (int k = 0; k < 12; ++k) { const int pc = wid * 12 + k;
        const int isv = pc >= 48, q = isv ? pc - 48 : pc, T = q >> 3, c = q & 7;
        int brow, coff; if (!isv) { brow = 64 * T + lane; coff = 512 + h * 64 + c * 8; } else { brow = 64 * T + 16 * (c & 3) + (lane >> 2); coff = 1024 + h * 64 + (c >> 2) * 32 + (lane & 3) * 8; }
        int j = jb + brow; j = j < 0 ? 0 : j;
        const bf16* src = PB + (rowbase + (long)j * dil + res) * PP + coff;
        glds16(src, (unsigned)__builtin_amdgcn_readfirstlane(lds0 + (unsigned)((isv ? B_V : 0) + T * 8192 + c * 1024))); }
    const int iq = i0 + 32 * wid + r32;
    const bf16* qp = PB + (rowbase + (long)iq * dil + res) * PP + h * 64 + hi * 8;
    bf16x8 qr[4];
#pragma unroll
    for (int d0 = 0; d0 < 4; ++d0) qr[d0] = *(const bf16x8*)(qp + d0 * 16);
    ATT_WAIT_BAR(0);
    f32x16 s[5];
#pragma unroll
    for (int g = 0; g < 5; ++g) { const int b0 = 32 * (wid + g), T = b0 >> 6, half = (b0 >> 5) & 1;
        const lds_cptr kp = shm + T * 8192 + hi * 1024 + (half * 32 + r32) * 16;
        const float base = -sd * (float)(128 - 32 * g + r32);
#pragma unroll
        for (int r = 0; r < 16; ++r) s[g][r] = base + sd * (float)crow(r, hi);
#pragma unroll
        for (int d0 = 0; d0 < 4; ++d0) s[g] = __builtin_amdgcn_mfma_f32_32x32x16_bf16(ldk(kp + d0 * 2048), qr[d0], s[g], 0, 0, 0); }
#pragma unroll
    for (int r = 0; r < 16; ++r) { const int cr = crow(r, hi); if (cr < r32) s[0][r] = NEGINF; if (cr > r32) s[4][r] = NEGINF; }
    if (blk == 0) {
#pragma unroll
        for (int g = 0; g < 5; ++g)
#pragma unroll
            for (int r = 0; r < 16; ++r) if (32 * (wid + g) + crow(r, hi) < 128) s[g][r] = NEGINF;
    }
    float m = max16(s[0]);
#pragma unroll
    for (int g = 1; g < 5; ++g) m = fmaxf(m, max16(s[g]));
    m = fmaxf(m, xhalf(m, hi));
    float l = 0.f;
#pragma unroll
    for (int g = 0; g < 5; ++g) {
#pragma unroll
        for (int r = 0; r < 16; ++r) s[g][r] = __builtin_amdgcn_exp2f(s[g][r] - m);
        l += sum16(s[g]); }
    l += xhalf(l, hi);
    f32x16 o[2]; o[0] = f32x16{}; o[1] = f32x16{};
    const lds_cptr vp0 = shm + B_V + ((lane >> 4) & 1) * 32 + (lane & 3) * 8 + (4 * hi + ((lane & 15) >> 2)) * 64;
#pragma unroll
    for (int g = 0; g < 5; ++g) { const u32x4 pwa = PACK8(s[g], 0), pwb = PACK8(s[g], 8);
        const int B16 = 2 * (wid + g), T = B16 >> 2, ks = B16 & 3;
        const lds_cptr vp = vp0 + T * 8192 + ks * 1024;
#pragma unroll
        for (int d0 = 0; d0 < 2; ++d0) {
            const s16x4 la = vtr(vp + d0 * 4096), ha = vtr(vp + d0 * 4096 + 512), lb_ = vtr(vp + d0 * 4096 + 1024), hb = vtr(vp + d0 * 4096 + 1536);
            o[d0] = __builtin_amdgcn_mfma_f32_32x32x16_bf16(ASBF(pwa), VFRAG(la, ha), o[d0], 0, 0, 0);
            o[d0] = __builtin_amdgcn_mfma_f32_32x32x16_bf16(ASBF(pwb), VFRAG(lb_, hb), o[d0], 0, 0, 0); } }
    LAS float* wsf = (LAS float*)(shm + B_WSF) + wid * 64;
    if (hi == 0) wsf[r32] = __builtin_amdgcn_rcpf(l); ATT_LDSW();
    LAS bf16* stg = (LAS bf16*)(shm + B_STG) + wid * 2048;
#pragma unroll
    for (int r = 0; r < 16; ++r) { const float a = wsf[crow(r, hi)];
#pragma unroll
        for (int d0 = 0; d0 < 2; ++d0) stg[crow(r, hi) * 64 + d0 * 32 + r32] = (bf16)(cvtpk(o[d0][r] * a, 0.f) & 0xffffu); }
    ATT_LDSW();
    const long tok = rowbase + (long)iq * dil + res;
    if (hi == 0) { f32x2_t ml = {m, l}; *(f32x2_t*)(ST + (tok * 8 + h) * 2) = ml; }
#pragma unroll
    for (int i = 0; i < 4; ++i) { const int row = i * 8 + (lane >> 3), ch = lane & 7; const u32x4 v = *(const LAS u32x4*)(stg + row * 64 + ch * 8);
        const long trow = rowbase + (long)(i0 + 32 * wid + row) * dil + res; *(u32x4*)(OUT + trow * 512 + h * 64 + ch * 8) = v; }
    ATT_WAIT_BAR(0);
}

constexpr int C_SLOT = 16384, C_FLAGS = 49152, C_STG = 53248;
constexpr float C_EXIT = -150.f;
__device__ __forceinline__ void sb_unit(int b, int h, int qb, const bf16* __restrict__ PC, bf16* __restrict__ YC, LAS char* shm, const int tid) {
    const int lane = tid & 63, r32 = lane & 31, hi = lane >> 5;
    const int wid = __builtin_amdgcn_readfirstlane(tid >> 6);
    const long rowbase = (long)b * SEQ; const int q0 = qb * 256, qw0 = q0 + 32 * wid, qi = qw0 + r32;
    const unsigned lds0 = (unsigned)(size_t)shm;
    volatile LAS int* fl = (volatile LAS int*)(shm + C_FLAGS);
    const bf16* ksrc = PC + (rowbase + lane) * PP + 512 + h * 64 + wid * 8;
    const bf16* vsrc = PC + (rowbase + 16 * (wid & 3) + (lane >> 2)) * PP + 1024 + h * 64 + (wid >> 2) * 32 + (lane & 3) * 8;
    const int NT = 4 * qb + 4;
#define C_ISSUE(t_, sl_) do { const long ro_ = (long)(t_) * 64 * PP; const unsigned sb_ = (unsigned)__builtin_amdgcn_readfirstlane(lds0 + (unsigned)(sl_)); \
        glds16(ksrc + ro_, sb_ + wid * 1024); glds16(vsrc + ro_, sb_ + 8192 + wid * 1024); } while (0)
    const bf16* qp = PC + (rowbase + qi) * PP + h * 64 + hi * 8;
    bf16x8 qr[4];
#pragma unroll
    for (int d0 = 0; d0 < 4; ++d0) qr[d0] = *(const bf16x8*)(qp + d0 * 16);
    C_ISSUE(NT - 1, 0); C_ISSUE(NT - 2, C_SLOT);
    float c = 0.f; bool wdone = false; f32x16 o[2]; o[0] = f32x16{}; o[1] = f32x16{};
    int sl = 0, sl2 = 2 * C_SLOT;
    for (int it = 0; it < NT; ++it) {
        if (it + 1 < NT) { ATT_WAIT_BAR(2); } else { ATT_WAIT_BAR(0); }
        if (it > 0) {
            const volatile LAS int* f = fl + ((it - 1) & 1) * 8;
            const int all = f[0] & f[1] & f[2] & f[3] & f[4] & f[5] & f[6] & f[7];
            if (all) break;
        }
        if (it + 2 < NT) C_ISSUE(NT - 3 - it, sl2);
        const int kbase = 64 * (NT - 1 - it);
        if (!wdone && kbase <= qw0) {
            const lds_cptr kp = shm + sl + hi * 1024 + r32 * 16;
            f32x16 p0 = f32x16{}, p1 = f32x16{};
#pragma unroll
            for (int d0 = 0; d0 < 4; ++d0) { const bf16x8 k0 = ldk(kp + d0 * 2048), k1 = ldk(kp + d0 * 2048 + 512);
                p0 = __builtin_amdgcn_mfma_f32_32x32x16_bf16(k0, qr[d0], p0, 0, 0, 0); p1 = __builtin_amdgcn_mfma_f32_32x32x16_bf16(k1, qr[d0], p1, 0, 0, 0); }
            f32x16 L0, L1;
#pragma unroll
            for (int r = 0; r < 16; ++r) {
                const int kv = kbase + crow(r, hi);
                { const float z = p0[r]; const float t = __builtin_amdgcn_logf(1.f + __builtin_amdgcn_exp2f(-fabsf(z))); L0[r] = (kv < qi) ? (fminf(-z, 0.f) - t) : 0.f; }
                { const float z = p1[r]; const float t = __builtin_amdgcn_logf(1.f + __builtin_amdgcn_exp2f(-fabsf(z))); L1[r] = (kv + 32 < qi) ? (fminf(-z, 0.f) - t) : 0.f; }
            }
            float T[8], U[8];
#pragma unroll
            for (int k = 0; k < 8; ++k) { const f32x16& Lx = (k < 4) ? L0 : L1; const int rb = 4 * (k & 3); T[k] = (Lx[rb] + Lx[rb + 1]) + (Lx[rb + 2] + Lx[rb + 3]); }
#pragma unroll
            for (int k = 0; k < 8; ++k) U[k] = xhalf(T[k], hi);
            float R = c;
#pragma unroll
            for (int k = 7; k >= 0; --k) {
                const float sufk = R + (hi == 0 ? U[k] : 0.f);
                f32x16& Lx = (k < 4) ? L0 : L1; f32x16& Px = (k < 4) ? p0 : p1; const int rb = 4 * (k & 3);
                const float e3 = Lx[rb + 3], e2 = Lx[rb + 2], e1 = Lx[rb + 1];
                const float s3 = sufk, s2 = sufk + e3, s1 = s2 + e2, s0 = s1 + e1;
                const int kv = kbase + 32 * (k >> 2) + 8 * (k & 3) + 4 * hi;
                Px[rb + 3] = (kv + 3 < qi) ? __builtin_amdgcn_exp2f(Lx[rb + 3] + Px[rb + 3] + s3) : 0.f;
                Px[rb + 2] = (kv + 2 < qi) ? __builtin_amdgcn_exp2f(Lx[rb + 2] + Px[rb + 2] + s2) : 0.f;
                Px[rb + 1] = (kv + 1 < qi) ? __builtin_amdgcn_exp2f(Lx[rb + 1] + Px[rb + 1] + s1) : 0.f;
                Px[rb + 0] = (kv + 0 < qi) ? __builtin_amdgcn_exp2f(Lx[rb + 0] + Px[rb + 0] + s0) : 0.f;
                R += T[k] + U[k];
            }
            c = R;
            const u32x4 pw0 = PACK8(p0, 0), pw1 = PACK8(p0, 8), pw2 = PACK8(p1, 0), pw3 = PACK8(p1, 8);
            const lds_cptr vp = shm + sl + 8192 + ((lane >> 4) & 1) * 32 + (lane & 3) * 8 + (4 * hi + ((lane & 15) >> 2)) * 64;
#pragma unroll
            for (int d0 = 0; d0 < 2; ++d0) {
                const s16x4 l0 = vtr(vp + d0 * 4096), h0 = vtr(vp + d0 * 4096 + 512), l1 = vtr(vp + d0 * 4096 + 1024), h1 = vtr(vp + d0 * 4096 + 1536);
                const s16x4 l2 = vtr(vp + d0 * 4096 + 2048), h2 = vtr(vp + d0 * 4096 + 2560), l3 = vtr(vp + d0 * 4096 + 3072), h3 = vtr(vp + d0 * 4096 + 3584);
                o[d0] = __builtin_amdgcn_mfma_f32_32x32x16_bf16(ASBF(pw0), VFRAG(l0, h0), o[d0], 0, 0, 0);
                o[d0] = __builtin_amdgcn_mfma_f32_32x32x16_bf16(ASBF(pw1), VFRAG(l1, h1), o[d0], 0, 0, 0);
                o[d0] = __builtin_amdgcn_mfma_f32_32x32x16_bf16(ASBF(pw2), VFRAG(l2, h2), o[d0], 0, 0, 0);
                o[d0] = __builtin_amdgcn_mfma_f32_32x32x16_bf16(ASBF(pw3), VFRAG(l3, h3), o[d0], 0, 0, 0);
            }
            wdone = __all(c < C_EXIT);
        }
        if (lane == 0) fl[(it & 1) * 8 + wid] = wdone ? 1 : 0;
        sl2 = sl; sl = (sl == 2 * C_SLOT) ? 0 : sl + C_SLOT;
    }
#undef C_ISSUE
    ATT_WAIT_BAR(0);
    LAS bf16* stg = (LAS bf16*)(shm + C_STG) + wid * 2048;
#pragma unroll
    for (int r = 0; r < 16; ++r)
#pragma unroll
        for (int d0 = 0; d0 < 2; ++d0) stg[crow(r, hi) * 64 + d0 * 32 + r32] = (bf16)(cvtpk(o[d0][r], 0.f) & 0xffffu);
    ATT_LDSW();
    bf16* Yw = YC + (rowbase + qw0) * 512 + h * 64;
#pragma unroll
    for (int i = 0; i < 4; ++i) { const int row = i * 8 + (lane >> 3), ch = lane & 7; const u32x4 v = *(const LAS u32x4*)(stg + row * 64 + ch * 8); *(u32x4*)(Yw + (long)row * 512 + ch * 8) = v; }
    ATT_WAIT_BAR(0);
}
#undef LAS
}

constexpr int NWAVES = 8;
constexpr int BATCH = 8, SEQ = 4096, D = 1024, M = BATCH * SEQ;
constexpr int BW = 512, NPROJ = 9 * BW, NGATE = 3 * D, DFF = 2816, DFX = 3584, NEXP = 8;
constexpr float EPS = 1e-6f, LOG2E_F = 1.4426950408889634f;
constexpr float C2 = 0.125f * LOG2E_F;
#ifndef DENSE_FP8
#define DENSE_FP8 0
#endif
#ifndef FFN_FP8
#define FFN_FP8 1
#endif
constexpr int MOE_CH_TILES = 64, MOE_MAX_TILES = 264, MOE_MAX_CH = 5;

constexpr size_t MiB = 1u << 20, KiB = 1u << 10;
constexpr size_t WS_CTL = 0, CTL_ZERO_BYTES = 1 * MiB;
constexpr size_t WS_WIN = 1 * MiB, WS_WG = 19 * MiB, WS_WB = 31 * MiB, WS_WO = 37 * MiB, WS_WGU = 41 * MiB, WS_WD = 52 * MiB;
constexpr size_t WS_BST = 58 * MiB;
constexpr size_t WS_TOKE = 64 * MiB, WS_TOKW = WS_TOKE + 128 * KiB, WS_SLOT = WS_TOKE + 384 * KiB, WS_SLW = WS_TOKE + 640 * KiB, WS_CNT = WS_TOKE + 960 * KiB, WS_MHDR = WS_TOKE + 992 * KiB;
constexpr size_t WS_H = 66 * MiB;
constexpr size_t WS_PA = 130 * MiB, WS_PB = 226 * MiB, WS_PC = 322 * MiB;
constexpr size_t WS_YA = 418 * MiB, WS_YB = 450 * MiB, WS_YC = 482 * MiB;
constexpr size_t WS_BP = 130 * MiB;
constexpr size_t WS_GATES = 226 * MiB;
constexpr size_t WS_ACT = 130 * MiB;
constexpr size_t WS_MWGU = 130 * MiB, WS_MWD = 242 * MiB;
constexpr size_t WS_HS = 298 * MiB;
constexpr size_t WS_MACT = 430 * MiB;
constexpr size_t WS_END = 542 * MiB;
constexpr size_t WS8_MWGU = 130 * MiB, WS8_MWD = 186 * MiB, WS8_HS = 214 * MiB, WS8_YS = 280 * MiB, WS8_MACT = 412 * MiB;
static_assert(WS8_MWGU + (size_t)NEXP * 2 * DFX * D <= WS8_MWD && WS8_MWD + (size_t)NEXP * D * DFX <= WS8_HS && WS8_HS + (size_t)MOE_MAX_TILES * 256 * D <= WS8_YS && WS8_YS + (size_t)MOE_MAX_TILES * 256 * D * 2 <= WS8_MACT && WS8_MACT + (size_t)MOE_CH_TILES * 256 * DFX <= WS_END, "d_ws map fp8");
static_assert(WS_WD + (size_t)D * DFF * 2 <= WS_BST && WS_HS + (size_t)MOE_MAX_TILES * 256 * D * 2 <= WS_MACT && WS_MACT + (size_t)MOE_CH_TILES * 256 * DFX * 2 <= WS_END, "d_ws map");
static_assert(WS_MWGU + (size_t)NEXP * 2 * DFX * D * 2 <= WS_MWD && WS_MWD + (size_t)NEXP * D * DFX * 2 <= WS_HS && WS_ACT + (size_t)M * DFF * 2 <= WS_PC, "d_ws map 2");
constexpr int CW_BAR = 4096;

constexpr int RING_OFF = 0, LDSCTL_OFF = 139264, MISC_OFF = LDSCTL_OFF + 320, LTAB_OFF = LDSCTL_OFF + 1024;
constexpr int LDS_BYTES = 147456;

#define GAS __attribute__((address_space(1)))
#define LAS __attribute__((address_space(3)))
typedef unsigned short bf16;
typedef unsigned v4u __attribute__((ext_vector_type(4)));
typedef unsigned v2u __attribute__((ext_vector_type(2)));
typedef float f32x4 __attribute__((ext_vector_type(4)));
typedef float f32x2 __attribute__((ext_vector_type(2)));
typedef GAS unsigned gu32;
#define RLX_AGENT __ATOMIC_RELAXED, __HIP_MEMORY_SCOPE_AGENT
#define LDS_WAIT() asm volatile("s_waitcnt lgkmcnt(0)" ::: "memory")
#define VM_WAIT() asm volatile("s_waitcnt vmcnt(0)" ::: "memory")
__device__ __forceinline__ unsigned f2bf(float f) { unsigned u = __builtin_bit_cast(unsigned, f); return (u + 0x7fffu + ((u >> 16) & 1u)) >> 16; }
__device__ __forceinline__ unsigned pk2(float lo, float hi) { return f2bf(lo) | (f2bf(hi) << 16); }
__device__ __forceinline__ float bfl(unsigned w) { return __uint_as_float(w << 16); }
__device__ __forceinline__ float bfh(unsigned w) { return __uint_as_float(w & 0xffff0000u); }

#define XB_TMO      128
#define XB_XCNT(j)  (256  + 64 * (j))
#define XB_XSUB(j)  (1280 + 64 * (j))
#define XB_XGEN(j)  (2304 + 64 * (j))
#define XB_TOP      3328
#define XB_TOPGEN   3392
#define XCD_BAR_WORDS 3456
#define XB_SPIN_CAP (1u << 18)

__device__ __forceinline__ unsigned xb_ld(unsigned* p)              { return __hip_atomic_load(p, __ATOMIC_RELAXED, __HIP_MEMORY_SCOPE_AGENT); }
__device__ __forceinline__ unsigned xb_add(unsigned* p, unsigned v) { return __hip_atomic_fetch_add(p, v, __ATOMIC_RELAXED, __HIP_MEMORY_SCOPE_AGENT); }
__device__ __forceinline__ unsigned xb_xcc_id() { return (unsigned)__builtin_amdgcn_s_getreg((3 << 11) | 20) & 0xFu; }
#define XB_SPIN(cond, bar) do { unsigned _sp = 0; while (cond) { __builtin_amdgcn_s_sleep(1); \
    if ((++_sp & 255u) == 0u) { if (xb_ld(&(bar)[XB_TMO])) break; if (_sp > XB_SPIN_CAP) { atomicAdd(&(bar)[XB_TMO], 1u); break; } } } } while (0)

struct XcdBarrier {
    unsigned* bar; unsigned x;
    volatile LAS unsigned* st;
};

__device__ __forceinline__ XcdBarrier xcd_barrier_post(unsigned* bar, volatile LAS unsigned* st) {
    XcdBarrier b; b.bar = bar; b.x = xb_xcc_id(); b.st = st;
    if (threadIdx.x == 0) (void)xb_add(&bar[XB_XCNT(b.x)], 1u);
    return b;
}
__device__ __forceinline__ void xcd_barrier_complete(unsigned* bar, unsigned x, unsigned& nloc, unsigned& nx) {
    const unsigned G = gridDim.x * gridDim.y * gridDim.z;
    unsigned sum, cnt, mine, sp = 0u;
    for (;;) {
        sum = 0u; cnt = 0u; mine = 0u;
#pragma unroll
        for (unsigned j = 0; j < 16; ++j) { const unsigned c = xb_ld(&bar[XB_XCNT(j)]); sum += c; cnt += (c > 0u) ? 1u : 0u; mine = (j == x) ? c : mine; }
        if (sum == G) break;
        __builtin_amdgcn_s_sleep(1);
        if ((++sp & 255u) == 0u) { if (xb_ld(&bar[XB_TMO])) break; if (sp > XB_SPIN_CAP) { atomicAdd(&bar[XB_TMO], 1u); break; } }
    }
    nloc = mine > 0u ? mine : 1u; nx = cnt > 0u ? cnt : 1u;
}

__device__ __forceinline__ void xcd_barrier(const XcdBarrier& b) {
    asm volatile("s_waitcnt vmcnt(0)" ::: "memory");
    __syncthreads();
    if (threadIdx.x == 0) {
        unsigned* bar = b.bar;
        __builtin_amdgcn_s_waitcnt(0);
        unsigned nloc = b.st[0], nx = b.st[1];
        if (nloc == 0u) { xcd_barrier_complete(bar, b.x, nloc, nx); b.st[0] = nloc; b.st[1] = nx; }
        const unsigned old = xb_add(&bar[XB_XSUB(b.x)], 1u);
        const unsigned gen = old / nloc;
        if (old + 1u == (gen + 1u) * nloc) {
            __builtin_amdgcn_fence(__ATOMIC_RELEASE, "agent");
            asm volatile("s_waitcnt vmcnt(0)" ::: "memory");
            const unsigned og = xb_add(&bar[XB_TOP], 1u);
            const unsigned tg = og / nx;
            if (og + 1u == (tg + 1u) * nx) xb_add(&bar[XB_TOPGEN], 1u);
            else XB_SPIN(xb_ld(&bar[XB_TOPGEN]) == tg, bar);
            __builtin_amdgcn_fence(__ATOMIC_ACQUIRE, "agent");
            xb_add(&bar[XB_XGEN(b.x)], 1u);
            asm volatile("s_waitcnt vmcnt(0)" ::: "memory");
        } else {
            XB_SPIN(xb_ld(&bar[XB_XGEN(b.x)]) == gen, bar);
            __builtin_amdgcn_fence(__ATOMIC_ACQUIRE, "agent");
            asm volatile("s_waitcnt vmcnt(0)" ::: "memory");
        }
    }
    __syncthreads();
}


__device__ __forceinline__ float wave_sum(float v) {
#pragma unroll
    for (int o = 1; o < 64; o <<= 1) v += __shfl_xor(v, o);
    return v;
}
__device__ __forceinline__ void transpose_item(const float* W, int K, int N, bf16* WT, int row_off, LAS float* scr, int k0, int n0, int lane) {
#pragma unroll 8
    for (int i = 0; i < 32; ++i) { const int kk = 2 * i + (lane >> 5); scr[kk * 33 + (lane & 31)] = W[(size_t)(k0 + kk) * N + n0 + (lane & 31)]; }
    LDS_WAIT(); asm volatile("" ::: "memory");
    const int c = lane & 7;
#pragma unroll
    for (int j = 0; j < 4; ++j) { const int n = (lane >> 3) + 8 * j; const LAS float* s = scr + (8 * c) * 33 + n;
        v4u o; o.x = pk2(s[0 * 33], s[1 * 33]); o.y = pk2(s[2 * 33], s[3 * 33]); o.z = pk2(s[4 * 33], s[5 * 33]); o.w = pk2(s[6 * 33], s[7 * 33]);
        *(GAS v4u*)(WT + (size_t)(row_off + n0 + n) * K + k0 + 8 * c) = o; }
    LDS_WAIT(); asm volatile("" ::: "memory");
}
__device__ __forceinline__ void conv_matrix(const float* W, int K, int N, bf16* WT, int mode, LAS float* scr, int gw, int ngw, int lane) {
    const int nblk = N / 32, items = (K / 64) * nblk;
    for (int it = gw; it < items; it += ngw) { const int kb = it / nblk, nb = it - kb * nblk, n0 = 32 * nb;
        const int d0 = mode == 0 ? n0 : (256 * (n0 >> 7) + (n0 & 127) + (mode == 2 ? 128 : 0));
        transpose_item(W, K, N, WT, d0 - n0, scr, 64 * kb, n0, lane); }
}
__device__ __forceinline__ void transpose_item8(const float* W, int K, int N, unsigned char* WT, int row_off, LAS float* scr, int k0, int n0, int lane) {
#pragma unroll 8
    for (int i = 0; i < 32; ++i) { const int kk = 2 * i + (lane >> 5); scr[kk * 33 + (lane & 31)] = W[(size_t)(k0 + kk) * N + n0 + (lane & 31)]; }
    LDS_WAIT(); asm volatile("" ::: "memory");
    const int c = lane & 7; const float sc = (float)(1 << pg8::F8_WSHIFT);
#pragma unroll
    for (int j = 0; j < 4; ++j) { const int n = (lane >> 3) + 8 * j; const LAS float* s = scr + (8 * c) * 33 + n;
        v2u o; o.x = pg8::pk4_fp8(s[0 * 33] * sc, s[1 * 33] * sc, s[2 * 33] * sc, s[3 * 33] * sc); o.y = pg8::pk4_fp8(s[4 * 33] * sc, s[5 * 33] * sc, s[6 * 33] * sc, s[7 * 33] * sc);
        *(GAS v2u*)(WT + (size_t)(row_off + n0 + n) * K + k0 + 8 * c) = o; }
    LDS_WAIT(); asm volatile("" ::: "memory");
}
__device__ __forceinline__ void conv_matrix8(const float* W, int K, int N, unsigned char* WT, int mode, LAS float* scr, int gw, int ngw, int lane) {
    const int nblk = N / 32, items = (K / 64) * nblk;
    for (int it = gw; it < items; it += ngw) { const int kb = it / nblk, nb = it - kb * nblk, n0 = 32 * nb;
        const int d0 = mode == 0 ? n0 : (256 * (n0 >> 7) + (n0 & 127) + (mode == 2 ? 128 : 0));
        transpose_item8(W, K, N, WT, d0 - n0, scr, 64 * kb, n0, lane); }
}
__device__ __forceinline__ void store_row_fp8(unsigned char* orow, const f32x4 (&v)[4], int lane) {
    GAS unsigned* o4 = (GAS unsigned*)orow + lane;
#pragma unroll
    for (int j = 0; j < 4; ++j) o4[64 * j] = pg8::pk4_fp8(v[j].x, v[j].y, v[j].z, v[j].w);
}
__device__ __forceinline__ void rms_row(const float* xrow, const f32x4 (&g)[4], f32x4 (&v)[4], int lane) {
    const GAS f32x4* xr = (const GAS f32x4*)xrow + lane; float s2 = 0.f;
#pragma unroll
    for (int j = 0; j < 4; ++j) { v[j] = xr[64 * j]; s2 += (v[j].x * v[j].x + v[j].y * v[j].y) + (v[j].z * v[j].z + v[j].w * v[j].w); }
    const float rstd = 1.f / sqrtf(wave_sum(s2) * (1.f / D) + EPS);
#pragma unroll
    for (int j = 0; j < 4; ++j) v[j] = v[j] * rstd * g[j];
}
__device__ __forceinline__ void store_row_bf16(bf16* orow, const f32x4 (&v)[4], int lane) {
    GAS v2u* o8 = (GAS v2u*)orow + lane;
#pragma unroll
    for (int j = 0; j < 4; ++j) { v2u w; w.x = pk2(v[j].x, v[j].y); w.y = pk2(v[j].z, v[j].w); o8[64 * j] = w; }
}


enum { PH_PRO = 0, PH_L = 20, NPHASE = 1 + 2 * PH_L };
struct Args { const float* in[18]; float* out; unsigned char* ws; int ph_lo, ph_hi; };
static_assert(sizeof(Args) == 18 * 8 + 8 + 8 + 8, "Args has no padding");

__global__ void __launch_bounds__(NWAVES * 64, 2) mega_fwd(Args args) {
    extern __shared__ __attribute__((aligned(16))) unsigned char lds_raw[];
    LAS unsigned char* const lds = (LAS unsigned char*)lds_raw;
    volatile LAS unsigned* const MISC = (volatile LAS unsigned*)(lds + MISC_OFF);
    const int wave_k = __builtin_amdgcn_readfirstlane((int)threadIdx.x >> 6);
    const int G = gridDim.x, bx = blockIdx.x; const int vcu = (G % 8 == 0) ? (bx % 8) * (G / 8) + bx / 8 : bx;
    const int NGW = G * NWAVES;
    unsigned char* const ws = args.ws;
    gu32* const ctl = (gu32*)(ws + WS_CTL);
    for (int u = threadIdx.x; u < (LDS_BYTES - LDSCTL_OFF) / 4; u += NWAVES * 64) ((LAS unsigned*)(lds + LDSCTL_OFF))[u] = 0u;
    __syncthreads();
#if MK_N_LAUNCHES == 1
    XcdBarrier bar = xcd_barrier_post((unsigned*)(ctl + CW_BAR), MISC + 8);
#define SEAM() xcd_barrier(bar)
#else
#define SEAM() do { } while (0)
#endif
    const int lo = args.ph_lo, hi = args.ph_hi;
#define IN(k) (lo <= (k) && (k) < hi)
#ifndef REPG
#define REPG 1
#endif
#ifndef REPA
#define REPA 1
#endif
#ifndef REPA_A
#define REPA_A REPA
#endif
#ifndef REPA_C
#define REPA_C REPA
#endif
#ifndef REPA_B
#define REPA_B REPA
#endif
#ifndef REPT
#define REPT 1
#endif
#define PHASE_IDS() int tidp = wave_k * 64 + (int)__builtin_amdgcn_mbcnt_hi(~0u, __builtin_amdgcn_mbcnt_lo(~0u, 0u)); asm volatile("" : "+v"(tidp)); const int tid = tidp, lane = tidp & 63, wave = __builtin_amdgcn_readfirstlane(tidp >> 6); const int gw = vcu * NWAVES + wave; LAS float* const scr = (LAS float*)(lds + RING_OFF + wave * 16384); (void)tid; (void)lane; (void)gw; (void)scr
#define INP(i) ([&]() -> const float* { int i_ = (i); asm volatile("" : "+s"(i_)); return args.in[i_]; }())
#define WSP(T, OFF) ([&]() -> T* { size_t o_ = (size_t)(OFF); asm volatile("" : "+s"(o_)); return (T*)(ws + o_); }())
#define x_in INP(0)
#define norm_mix INP(1)
#define w_in INP(2)
#define diff_lambda INP(3)
#define diff_subln INP(4)
#define w_gate INP(5)
#define b_gate INP(6)
#define w_branch INP(7)
#define w_out INP(8)
#define norm_ffn INP(9)
#define w_dg INP(10)
#define w_du INP(11)
#define w_dd INP(12)
#define w_router INP(13)
#define w_mg INP(14)
#define w_mu INP(15)
#define w_md INP(16)
#define norm_final INP(17)
#define xout (args.out)
#define Win_t WSP(bf16, WS_WIN)
#define Wg_t WSP(bf16, WS_WG)
#define Wb_t WSP(bf16, WS_WB)
#define Wo_t WSP(bf16, WS_WO)
#define Wgu_t WSP(bf16, WS_WGU)
#define Wd_t WSP(bf16, WS_WD)
#define Hb WSP(bf16, WS_H)
#define PA WSP(bf16, WS_PA)
#define PB WSP(bf16, WS_PB)
#define PC WSP(bf16, WS_PC)
#define YA WSP(bf16, WS_YA)
#define YC WSP(bf16, WS_YC)
#define YB WSP(bf16, WS_YB)
#define BP WSP(bf16, WS_BP)
#define BST WSP(float, WS_BST)
#define GATES WSP(bf16, WS_GATES)
#define ACT WSP(bf16, WS_ACT)
#define MWgu WSP(bf16, WS_MWGU)
#define MWd WSP(bf16, WS_MWD)
#define HS WSP(bf16, WS_HS)
#define MACT WSP(bf16, WS_MACT)
#define TOKE WSP(int, WS_TOKE)
#define TOKW WSP(float, WS_TOKW)
#define SLOT WSP(int, WS_SLOT)
#define SLW WSP(float, WS_SLW)
#define CNT WSP(int, WS_CNT)
#define MHDR WSP(int, WS_MHDR)
#define Hb8 WSP(unsigned char, WS_H)
#define Wgu8 WSP(unsigned char, WS_WGU)
#define Wd8 WSP(unsigned char, WS_WD)
#define ACT8 WSP(unsigned char, WS_ACT)
#define MWgu8 WSP(unsigned char, WS8_MWGU)
#define MWd8 WSP(unsigned char, WS8_MWD)
#define HS8 WSP(unsigned char, WS8_HS)
#define YS8 WSP(bf16, WS8_YS)
#define MACT8 WSP(unsigned char, WS8_MACT)

    if (IN(PH_PRO)) { PHASE_IDS();
        for (int L = 0; L < 2; ++L) {
            conv_matrix(w_in + (size_t)L * D * NPROJ, D, NPROJ, Win_t + (size_t)L * NPROJ * D, 0, scr, gw, NGW, lane);
            conv_matrix(w_gate + (size_t)L * D * NGATE, D, NGATE, Wg_t + (size_t)L * NGATE * D, 0, scr, gw, NGW, lane);
            for (int i = 0; i < 3; ++i) conv_matrix(w_branch + (size_t)(L * 3 + i) * BW * D, BW, D, Wb_t + (size_t)(L * 3 + i) * D * BW, 0, scr, gw, NGW, lane);
            conv_matrix(w_out + (size_t)L * D * D, D, D, Wo_t + (size_t)L * D * D, 0, scr, gw, NGW, lane);
        }
#if DENSE_FP8
        conv_matrix8(w_dg, D, DFF, Wgu8, 1, scr, gw, NGW, lane);
        conv_matrix8(w_du, D, DFF, Wgu8, 2, scr, gw, NGW, lane);
        conv_matrix8(w_dd, DFF, D, Wd8, 0, scr, gw, NGW, lane);
#else
        conv_matrix(w_dg, D, DFF, Wgu_t, 1, scr, gw, NGW, lane);
        conv_matrix(w_du, D, DFF, Wgu_t, 2, scr, gw, NGW, lane);
        conv_matrix(w_dd, DFF, D, Wd_t, 0, scr, gw, NGW, lane);
#endif
        SEAM();
    }

    for (int L = 0; L < 2; ++L) {
        const int P = 1 + L * PH_L;
        const float* xres = (L == 0) ? x_in : xout;
        if (IN(P + 0)) { PHASE_IDS();
            f32x4 g[4];
#pragma unroll
            for (int j = 0; j < 4; ++j) g[j] = ((const GAS f32x4*)(norm_mix + L * D) + lane)[64 * j];
            for (int m = gw; m < M; m += NGW) { f32x4 v[4]; rms_row(xres + (size_t)m * D, g, v, lane); store_row_bf16(Hb + (size_t)m * D, v, lane); }
            SEAM();
        }
        if (IN(P + 1)) { PHASE_IDS();
            pg8::Gemm g{Hb, Win_t + (size_t)L * NPROJ * D, D}; pg8::StaticOrder S; S.init(M, NPROJ, D, G, bx);
            pg8::EpiProj E{PA, (size_t)(WS_PB - WS_PA) / 2, C2};

 for (int rep_ = 0; rep_ < ((true) ? REPG : 1); ++rep_) { int tq_ = tidp; asm volatile("" : "+v"(tq_));  pg8::gemm_phase<pg8::EpiProj, pg8::StaticOrder, true, true>(lds + RING_OFF, g, S, E, tq_); }

            SEAM();
        }
        if (IN(P + 2)) { PHASE_IDS();
            const float lam_init = 0.8f - 0.6f * expf(-0.3f * (float)L);
            float lam;
            { const float* lv = diff_lambda + L * 256; const float s01 = wave_sum(lv[lane] * lv[64 + lane]), s23 = wave_sum(lv[128 + lane] * lv[192 + lane]); lam = expf(s01) - expf(s23) + lam_init; }
            for (int rep_ = 0; rep_ < (REPA_A > REPA_C ? REPA_A : REPA_C); ++rep_) {
            if (rep_ < REPA_A) { const int bh = vcu >> 3, s = vcu & 7;
              for (int i = 0; i < 4; ++i) { const int qb = (i == 0) ? s : (i == 1) ? 15 - s : (i == 2) ? 16 + s : 31 - s;

 att::diff_unit(bh >> 2, bh & 3, qb, PA, YA, lam, 1.f - lam_init, diff_subln + L * 128, (LAS char*)(lds + RING_OFF), tidp);
 } }
            if (rep_ < REPA_C) { const int bh = vcu >> 2, s = vcu & 3;
              for (int i = 0; i < 4; ++i) { const int qb = (i == 0) ? s : (i == 1) ? 7 - s : (i == 2) ? 8 + s : 15 - s;

 att::sb_unit(bh >> 3, bh & 7, qb, PC, YC, (LAS char*)(lds + RING_OFF), tidp);
 } }
            }
            SEAM();
        }
        if (IN(P + 3)) { PHASE_IDS();
            for (int rep_ = 0; rep_ < REPA_B; ++rep_) {
            const int bh = vcu >> 2, sub = vcu & 3;
            for (int i = 0; i < 12; ++i) { const int j = sub * 12 + i; int pat, res, blk, dil;
                if (j < 16) { pat = 0; dil = 1; res = 0; blk = j; } else if (j < 32) { pat = 1; dil = 4; res = (j - 16) >> 2; blk = (j - 16) & 3; } else { pat = 2; dil = 16; res = j - 32; blk = 0; }

 att::dil_unit(bh >> 3, bh & 7, dil, res, blk, PB, BP + (size_t)pat * M * BW, BST + (size_t)pat * M * 16, (LAS char*)(lds + RING_OFF), tidp);
 }
            }
            SEAM();
        }
        if (IN(P + 4)) { PHASE_IDS();
            for (int m = gw; m < M; m += NGW) {
                const int hd = lane >> 3; f32x2 st[3]; float mx = -INFINITY;
#pragma unroll
                for (int p = 0; p < 3; ++p) { st[p] = *(const GAS f32x2*)(BST + ((size_t)p * M + m) * 16 + hd * 2); mx = fmaxf(mx, st[p].x); }
                float wgt[3], wsum = 0.f;
#pragma unroll
                for (int p = 0; p < 3; ++p) { wgt[p] = __builtin_amdgcn_exp2f(st[p].x - mx) * st[p].y; wsum += wgt[p]; }
                const float inv = 1.f / wsum; float acc[8];
#pragma unroll
                for (int k = 0; k < 8; ++k) acc[k] = 0.f;
#pragma unroll
                for (int p = 0; p < 3; ++p) { const v4u w = *(const GAS v4u*)(BP + ((size_t)p * M + m) * BW + lane * 8); const float f = wgt[p] * inv;
                    acc[0] += f * bfl(w.x); acc[1] += f * bfh(w.x); acc[2] += f * bfl(w.y); acc[3] += f * bfh(w.y); acc[4] += f * bfl(w.z); acc[5] += f * bfh(w.z); acc[6] += f * bfl(w.w); acc[7] += f * bfh(w.w); }
                v4u o; o.x = pk2(acc[0], acc[1]); o.y = pk2(acc[2], acc[3]); o.z = pk2(acc[4], acc[5]); o.w = pk2(acc[6], acc[7]);
                *(GAS v4u*)(YB + (size_t)m * BW + lane * 8) = o;
            }
            VM_WAIT(); __syncthreads();
            pg8::Gemm g{Hb, Wg_t + (size_t)L * NGATE * D, D}; pg8::StaticOrder S; S.init(M, NGATE, D, G, bx);
            pg8::EpiGate E{GATES, NGATE, b_gate + L * NGATE};

 for (int rep_ = 0; rep_ < ((true) ? REPG : 1); ++rep_) { int tq_ = tidp; asm volatile("" : "+v"(tq_));  pg8::gemm_phase<pg8::EpiGate, pg8::StaticOrder, true, true>(lds + RING_OFF, g, S, E, tq_); }

            SEAM();
        }
        if (IN(P + 5)) { PHASE_IDS();
            pg8::Gemm g{YA, Wb_t + (size_t)L * 3 * D * BW, BW}; pg8::MergeOrder S; S.b.init(M, D, BW, G, bx);
            S.as = (long)(WS_YB - WS_YA); S.bs = (long)D * BW * 2;
            pg8::EpiMerge E{GATES, Hb};

 for (int rep_ = 0; rep_ < ((true) ? REPG : 1); ++rep_) { int tq_ = tidp; asm volatile("" : "+v"(tq_));  pg8::gemm_phase<pg8::EpiMerge, pg8::MergeOrder, true, true>(lds + RING_OFF, g, S, E, tq_); }

            SEAM();
        }
        if (IN(P + 6)) { PHASE_IDS();
            pg8::Gemm g{Hb, Wo_t + (size_t)L * D * D, D}; pg8::StaticOrder S; S.init(M, D, D, G, bx);
            pg8::EpiRes E{xres, xout, 1.f};

 for (int rep_ = 0; rep_ < ((L == 0) ? REPG : 1); ++rep_) { int tq_ = tidp; asm volatile("" : "+v"(tq_));  pg8::gemm_phase<pg8::EpiRes, pg8::StaticOrder, true, true>(lds + RING_OFF, g, S, E, tq_); }

            SEAM();
        }
        if (L == 0) {
            if (IN(P + 7)) { PHASE_IDS();
                f32x4 g[4];
#pragma unroll
                for (int j = 0; j < 4; ++j) g[j] = ((const GAS f32x4*)(norm_ffn + L * D) + lane)[64 * j];
#if DENSE_FP8
                for (int m = gw; m < M; m += NGW) { f32x4 v[4]; rms_row(xout + (size_t)m * D, g, v, lane); store_row_fp8(Hb8 + (size_t)m * D, v, lane); }
#else
                for (int m = gw; m < M; m += NGW) { f32x4 v[4]; rms_row(xout + (size_t)m * D, g, v, lane); store_row_bf16(Hb + (size_t)m * D, v, lane); }
#endif
                SEAM();
            }
            if (IN(P + 8)) { PHASE_IDS();
#if DENSE_FP8
                pg8::Gemm g{(const bf16*)Hb8, (const bf16*)Wgu8, D / 2}; pg8::StaticOrder S; S.init(M, 2 * DFF, D / 2, G, bx);
                pg8::EpiSwigluF8 E{ACT8, DFF};
                for (int rep_ = 0; rep_ < REPG; ++rep_) { int tq_ = tidp; asm volatile("" : "+v"(tq_)); pg8::gemm_phase<pg8::EpiSwigluF8, pg8::StaticOrder, true, true, true>(lds + RING_OFF, g, S, E, tq_); }
#else
                pg8::Gemm g{Hb, Wgu_t, D}; pg8::StaticOrder S; S.init(M, 2 * DFF, D, G, bx);
                pg8::EpiSwiglu E{ACT, DFF};
                for (int rep_ = 0; rep_ < REPG; ++rep_) { int tq_ = tidp; asm volatile("" : "+v"(tq_)); pg8::gemm_phase<pg8::EpiSwiglu, pg8::StaticOrder, true, true>(lds + RING_OFF, g, S, E, tq_); }
#endif

                SEAM();
            }
            if (IN(P + 9)) { PHASE_IDS();
#if DENSE_FP8
                pg8::EpiRes E{xout, xout, pg8::F8_WINV};
                pg8::Gemm g{(const bf16*)ACT8, (const bf16*)Wd8, DFF / 2}; pg8::StaticOrder S; S.init(M, D, DFF / 2, G, bx);
                pg8::gemm_phase<pg8::EpiRes, pg8::StaticOrder, true, true, true>(lds + RING_OFF, g, S, E, tidp);
#else
                pg8::EpiRes E{xout, xout, 1.f};
                pg8::Gemm g{ACT, Wd_t, DFF}; pg8::StaticOrder S; S.init(M, D, DFF, G, bx);
                pg8::gemm_phase<pg8::EpiRes, pg8::StaticOrder, true, true>(lds + RING_OFF, g, S, E, tidp);
#endif

                SEAM();
            }
        } else {
            if (IN(P + 7)) { PHASE_IDS();
                LAS float* wr = (LAS float*)(lds + RING_OFF);
                LAS int* cl = (LAS int*)(lds + RING_OFF + 32768);
                for (int u = tid; u < D * NEXP / 4; u += NWAVES * 64) ((LAS f32x4*)wr)[u] = ((const GAS f32x4*)w_router)[u];
                if (tid < NEXP) cl[tid] = 0;
                __syncthreads();
                f32x4 g[4];
#pragma unroll
                for (int j = 0; j < 4; ++j) g[j] = ((const GAS f32x4*)(norm_ffn + L * D) + lane)[64 * j];
                for (int k = 0; k < 16; ++k) { const int m = bx * 128 + wave + 8 * k;
                    f32x4 v[4]; rms_row(xout + (size_t)m * D, g, v, lane);
#if FFN_FP8
                    store_row_fp8(Hb8 + (size_t)m * D, v, lane);
#else
                    store_row_bf16(Hb + (size_t)m * D, v, lane);
#endif
                    float lg[NEXP];
#pragma unroll
                    for (int e = 0; e < NEXP; ++e) lg[e] = 0.f;
#pragma unroll
                    for (int j = 0; j < 4; ++j)
#pragma unroll
                        for (int i = 0; i < 4; ++i) { const LAS f32x4* wp = (const LAS f32x4*)(wr + (size_t)(4 * lane + 256 * j + i) * NEXP); const f32x4 wa = wp[0], wb = wp[1]; const float xv = v[j][i];
                            lg[0] += xv * wa.x; lg[1] += xv * wa.y; lg[2] += xv * wa.z; lg[3] += xv * wa.w; lg[4] += xv * wb.x; lg[5] += xv * wb.y; lg[6] += xv * wb.z; lg[7] += xv * wb.w; }
#pragma unroll
                    for (int e = 0; e < NEXP; ++e) lg[e] = wave_sum(lg[e]);
                    int e1 = 0; float v1 = lg[0];
#pragma unroll
                    for (int e = 1; e < NEXP; ++e) if (lg[e] > v1) { v1 = lg[e]; e1 = e; }
                    int e2 = -1; float v2 = -INFINITY;
#pragma unroll
                    for (int e = 0; e < NEXP; ++e) if (e != e1 && lg[e] > v2) { v2 = lg[e]; e2 = e; }
                    const float w1 = 1.f / (1.f + expf(v2 - v1));
                    if (lane == 0) { TOKE[m] = e1 | (e2 << 8); TOKW[2 * m] = w1; TOKW[2 * m + 1] = 1.f - w1; __hip_atomic_fetch_add(cl + e1, 1, __ATOMIC_RELAXED, __HIP_MEMORY_SCOPE_WORKGROUP); __hip_atomic_fetch_add(cl + e2, 1, __ATOMIC_RELAXED, __HIP_MEMORY_SCOPE_WORKGROUP); }
                }
                __syncthreads();
                if (tid < NEXP) CNT[bx * NEXP + tid] = cl[tid];
                __syncthreads();
                for (int e = 0; e < NEXP; ++e) {
#if FFN_FP8
                    conv_matrix8(w_mg + (size_t)e * D * DFX, D, DFX, MWgu8 + (size_t)e * 2 * DFX * D, 1, scr, gw, NGW, lane);
                    conv_matrix8(w_mu + (size_t)e * D * DFX, D, DFX, MWgu8 + (size_t)e * 2 * DFX * D, 2, scr, gw, NGW, lane);
                    conv_matrix8(w_md + (size_t)e * DFX * D, DFX, D, MWd8 + (size_t)e * D * DFX, 0, scr, gw, NGW, lane);
#else
                    conv_matrix(w_mg + (size_t)e * D * DFX, D, DFX, MWgu + (size_t)e * 2 * DFX * D, 1, scr, gw, NGW, lane);
                    conv_matrix(w_mu + (size_t)e * D * DFX, D, DFX, MWgu + (size_t)e * 2 * DFX * D, 2, scr, gw, NGW, lane);
                    conv_matrix(w_md + (size_t)e * DFX * D, DFX, D, MWd + (size_t)e * D * DFX, 0, scr, gw, NGW, lane);
#endif
                }
                SEAM();
            }
            if (IN(P + 8)) { PHASE_IDS();
                LAS int* C = (LAS int*)(lds + RING_OFF);
                LAS int* TB = (LAS int*)(lds + RING_OFF + 8192);
                LAS int* SL = (LAS int*)(lds + RING_OFF + 8192 + 256);
                for (int u = tid; u < 256 * NEXP; u += NWAVES * 64) C[u] = CNT[u];
                __syncthreads();
                { const int e = wave; int tot = 0, pre = 0;
#pragma unroll
                  for (int q = 0; q < 4; ++q) { const int i = 4 * lane + q; const int cv = C[i * NEXP + e]; tot += cv; pre += (i < bx) ? cv : 0; }
#pragma unroll
                  for (int o = 1; o < 64; o <<= 1) { tot += __shfl_xor(tot, o); pre += __shfl_xor(pre, o); }
                  if (lane == 0) { TB[e] = pre; TB[8 + e] = tot; } }
                __syncthreads();
                if (tid == 0) { int base = 0, cum = 0;
                    for (int e = 0; e < NEXP; ++e) { TB[16 + e] = base; const int nt = (TB[8 + e] + 255) >> 8; base += nt * 256; cum += nt; if (bx == 0) MHDR[1 + e] = cum; }
                    if (bx == 0) MHDR[0] = cum; }
                __syncthreads();
                if (wave == 0) {
                    const int t0 = bx * 128 + 2 * lane; const int ea = TOKE[t0], eb = TOKE[t0 + 1];
                    int pe[4] = {ea & 255, ea >> 8, eb & 255, eb >> 8}; int slot[4] = {0, 0, 0, 0};
#pragma unroll
                    for (int e = 0; e < NEXP; ++e) { int mine = 0;
#pragma unroll
                        for (int q = 0; q < 4; ++q) mine += (pe[q] == e) ? 1 : 0;
                        int inc = mine;
#pragma unroll
                        for (int o = 1; o < 64; o <<= 1) { const int t = __shfl_up(inc, o); if (lane >= o) inc += t; }
                        int run = TB[16 + e] + TB[e] + inc - mine;
#pragma unroll
                        for (int q = 0; q < 4; ++q) if (pe[q] == e) { slot[q] = run; ++run; } }
                    const f32x4 wv = *(const GAS f32x4*)(TOKW + 2 * t0);
                    SL[4 * lane + 0] = slot[0]; SL[4 * lane + 1] = slot[1]; SL[4 * lane + 2] = slot[2]; SL[4 * lane + 3] = slot[3];
                    { v4u sv; sv.x = (unsigned)slot[0]; sv.y = (unsigned)slot[1]; sv.z = (unsigned)slot[2]; sv.w = (unsigned)slot[3]; *(GAS v4u*)(SLOT + 2 * t0) = sv; }
                    SLW[slot[0]] = wv.x; SLW[slot[1]] = wv.y; SLW[slot[2]] = wv.z; SLW[slot[3]] = wv.w;
                }
                __syncthreads();
                for (int k = 0; k < 16; ++k) { const int tl = wave + 8 * k; const int m = bx * 128 + tl; const int s0 = SL[2 * tl], s1 = SL[2 * tl + 1];
#if FFN_FP8
                    const v4u a = ((const GAS v4u*)(Hb8 + (size_t)m * D))[lane];
                    ((GAS v4u*)(HS8 + (size_t)s0 * D))[lane] = a; ((GAS v4u*)(HS8 + (size_t)s1 * D))[lane] = a; }
#else
                    const GAS v4u* src = (const GAS v4u*)(Hb + (size_t)m * D) + lane; const v4u a = src[0], b = src[64];
                    GAS v4u* d0 = (GAS v4u*)(HS + (size_t)s0 * D) + lane; GAS v4u* d1 = (GAS v4u*)(HS + (size_t)s1 * D) + lane;
                    d0[0] = a; d0[64] = b; d1[0] = a; d1[64] = b; }
#endif
                SEAM();
            }
            {
                int nt_all = 0, c0 = 0, c1 = 0, c2 = 0, c3 = 0, c4 = 0, c5 = 0, c6 = 0;
                if (hi > P + 9 && lo < P + 19) { const int* hd = MHDR;
                    nt_all = __builtin_amdgcn_readfirstlane(hd[0]); c0 = __builtin_amdgcn_readfirstlane(hd[1]); c1 = __builtin_amdgcn_readfirstlane(hd[2]); c2 = __builtin_amdgcn_readfirstlane(hd[3]);
                    c3 = __builtin_amdgcn_readfirstlane(hd[4]); c4 = __builtin_amdgcn_readfirstlane(hd[5]); c5 = __builtin_amdgcn_readfirstlane(hd[6]); c6 = __builtin_amdgcn_readfirstlane(hd[7]); }
                if (nt_all > MOE_MAX_TILES) nt_all = MOE_MAX_TILES;
                for (int ch = 0; ch < MOE_MAX_CH; ++ch) {
                    const int t0 = ch * MOE_CH_TILES; int nt = nt_all - t0; if (nt > MOE_CH_TILES) nt = MOE_CH_TILES;
                    if (nt <= 0) break;
                    if (IN(P + 9 + 2 * ch)) { PHASE_IDS();
#if FFN_FP8
                        pg8::Gemm g{(const bf16*)HS8, (const bf16*)MWgu8, D / 2}; pg8::MoeOrder S{t0, nt, 2 * DFX / 256, nt * (2 * DFX / 256), G, bx, (long)256 * D, (long)256 * D, (long)2 * DFX * D, c0, c1, c2, c3, c4, c5, c6, false, true};
                        pg8::EpiSwigluF8 E{MACT8, DFX};
                        pg8::gemm_phase<pg8::EpiSwigluF8, pg8::MoeOrder, true, true, true>(lds + RING_OFF, g, S, E, tidp);
#else
                        pg8::Gemm g{HS, MWgu, D}; pg8::MoeOrder S{t0, nt, 2 * DFX / 256, nt * (2 * DFX / 256), G, bx, (long)256 * D * 2, (long)256 * D * 2, (long)2 * DFX * D * 2, c0, c1, c2, c3, c4, c5, c6, false, true};
                        pg8::EpiSwiglu E{MACT, DFX};
                        pg8::gemm_phase<pg8::EpiSwiglu, pg8::MoeOrder, true, true>(lds + RING_OFF, g, S, E, tidp);
#endif

                        SEAM();
                    }
                    if (IN(P + 10 + 2 * ch)) { PHASE_IDS();
#if FFN_FP8
                        pg8::Gemm g{(const bf16*)MACT8, (const bf16*)MWd8, DFX / 2}; pg8::MoeOrder S{t0, nt, D / 256, nt * (D / 256), G, bx, (long)256 * DFX, (long)256 * DFX, (long)D * DFX, c0, c1, c2, c3, c4, c5, c6, true, false};
                        pg8::EpiMoeDown E{YS8, SLW, pg8::F8_WINV};
                        pg8::gemm_phase<pg8::EpiMoeDown, pg8::MoeOrder, true, true, true>(lds + RING_OFF, g, S, E, tidp);
#else
                        pg8::Gemm g{MACT, MWd, DFX}; pg8::MoeOrder S{t0, nt, D / 256, nt * (D / 256), G, bx, (long)256 * DFX * 2, (long)256 * DFX * 2, (long)D * DFX * 2, c0, c1, c2, c3, c4, c5, c6, true, false};
                        pg8::EpiMoeDown E{HS, SLW, 1.f};
                        pg8::gemm_phase<pg8::EpiMoeDown, pg8::MoeOrder, true, true>(lds + RING_OFF, g, S, E, tidp);
#endif

                        SEAM();
                    }
                }
            }
            if (IN(P + 19)) { PHASE_IDS();
                f32x4 g[4];
#pragma unroll
                for (int j = 0; j < 4; ++j) g[j] = ((const GAS f32x4*)norm_final + lane)[64 * j];
                unsigned bad = 0u;
#if MK_N_LAUNCHES == 1
                bad = __hip_atomic_load(ctl + CW_BAR + XB_TMO, RLX_AGENT);
#endif
                for (int m = gw; m < M; m += NGW) {
                    const int s0 = SLOT[2 * m], s1 = SLOT[2 * m + 1];
                    const GAS f32x4* xr = (const GAS f32x4*)(xout + (size_t)m * D) + lane;
#if FFN_FP8
                    const GAS v2u* y0 = (const GAS v2u*)(YS8 + (size_t)s0 * D) + lane; const GAS v2u* y1 = (const GAS v2u*)(YS8 + (size_t)s1 * D) + lane;
#else
                    const GAS v2u* y0 = (const GAS v2u*)(HS + (size_t)s0 * D) + lane; const GAS v2u* y1 = (const GAS v2u*)(HS + (size_t)s1 * D) + lane;
#endif

                    f32x4 v[4]; float s2 = 0.f;
#pragma unroll
                    for (int j = 0; j < 4; ++j) { const v2u a = y0[64 * j], b = y1[64 * j]; f32x4 t = xr[64 * j];

t.x += bfl(a.x) + bfl(b.x); t.y += bfh(a.x) + bfh(b.x); t.z += bfl(a.y) + bfl(b.y); t.w += bfh(a.y) + bfh(b.y);
 v[j] = t;
                        s2 += (t.x * t.x + t.y * t.y) + (t.z * t.z + t.w * t.w); }
                    const float rstd = 1.f / sqrtf(wave_sum(s2) * (1.f / D) + EPS);
                    GAS f32x4* orow = (GAS f32x4*)(xout + (size_t)m * D) + lane;
#pragma unroll
                    for (int j = 0; j < 4; ++j) { f32x4 o = v[j] * rstd * g[j];
                        if (bad) { const float q = __builtin_nanf(""); o = (f32x4){q, q, q, q}; } orow[64 * j] = o; }
                }
            }
        }
    }
#undef IN
#undef SEAM
}

extern "C" void kernel_launch(void* const* d_in, const int* in_sizes, int n_in, void* d_out, int out_size, void* d_ws, size_t ws_size, hipStream_t stream) {
    static int grid = 0;
    if (grid == 0) {
        if (n_in != 18 || in_sizes[0] != M * D || out_size != M * D || ws_size < WS_END) { fprintf(stderr, "kernel_launch: unexpected shapes (n_in %d, in0 %d, out %d, ws %zu < %zu); nothing launched\n", n_in, n_in > 0 ? in_sizes[0] : -1, out_size, ws_size, (size_t)WS_END); grid = -1; return; }
        int dev = 0, cus = 0, per_cu = 0;
        if (hipGetDevice(&dev) != hipSuccess || hipDeviceGetAttribute(&cus, hipDeviceAttributeMultiprocessorCount, dev) != hipSuccess) { grid = -1; return; }
        if (hipFuncSetAttribute((const void*)mega_fwd, hipFuncAttributeMaxDynamicSharedMemorySize, LDS_BYTES) != hipSuccess) { fprintf(stderr, "kernel_launch: hipFuncSetAttribute failed\n"); grid = -1; return; }
        if (hipOccupancyMaxActiveBlocksPerMultiprocessor(&per_cu, (const void*)mega_fwd, NWAVES * 64, LDS_BYTES) != hipSuccess || per_cu < 1) fprintf(stderr, "kernel_launch: occupancy query reports %d workgroups per CU\n", per_cu);
        (void)hipGetLastError();
        grid = cus;
        if (grid != 256) { fprintf(stderr, "kernel_launch: built for 256 CUs, device has %d; nothing launched\n", cus); grid = -1; return; }
    }
    if (grid < 0) return;
    if (hipMemsetAsync((char*)d_ws + WS_CTL, 0, CTL_ZERO_BYTES, stream) != hipSuccess) return;
    Args a{};
    for (int i = 0; i < 18; ++i) a.in[i] = (const float*)d_in[i];
    a.out = (float*)d_out; a.ws = (unsigned char*)d_ws;
#if MK_N_LAUNCHES == 1
    a.ph_lo = 0; a.ph_hi = NPHASE;
    hipLaunchKernelGGL(mega_fwd, dim3(grid), dim3(NWAVES * 64), LDS_BYTES, stream, a);
#else
    for (int p = 0; p < NPHASE; ++p) {
        const int r = (p - 1) % PH_L, L = (p - 1) / PH_L;
        if (p > 0 && L == 0 && r >= 10) continue;
        a.ph_lo = p; a.ph_hi = p + 1;
        hipLaunchKernelGGL(mega_fwd, dim3(grid), dim3(NWAVES * 64), LDS_BYTES, stream, a);
    }
#endif
}
```

```cpp
#include <hip/hip_runtime.h>
#include <cstdio>
#include <cstdint>

#ifndef MK_N_LAUNCHES
#define MK_N_LAUNCHES 1
#endif

namespace pg8 {
#define PG8_LAS __attribute__((address_space(3)))
typedef unsigned short bf16_t;
typedef short bf16x8 __attribute__((ext_vector_type(8)));
typedef float f32x4 __attribute__((ext_vector_type(4)));
typedef float f32x2 __attribute__((ext_vector_type(2)));
typedef unsigned u32x4 __attribute__((ext_vector_type(4)));
typedef int v8i32 __attribute__((ext_vector_type(8)));
typedef unsigned u32x2 __attribute__((ext_vector_type(2)));
constexpr int F8_WSHIFT = 6;
constexpr float F8_WINV = 1.f / (float)(1 << F8_WSHIFT);
constexpr int BM = 256, BK = 64, HALF = 128, HTB = HALF * BK * 2  , STAGE_BYTES = 8 * HTB, NXCD = 8, WGM = 8;

__host__ __device__ __forceinline__ int lds_byte(int r, int c) { const int st = (r >> 4) * 2 + (c >> 5), rr = r & 15, cc = c & 31, ob = rr * 64 + cc * 2; return st * 1024 + (ob ^ (((ob >> 9) & 1) << 5)); }
__host__ __device__ __forceinline__ void stage_rc(int b, int& R, int& C) { const int st = b / 1024, sb = b % 1024, swz = sb ^ (((sb >> 9) & 1) << 5); R = (st >> 1) * 16 + swz / 64; C = (st & 1) * 32 + (swz % 64) / 2; }
__host__ __device__ __forceinline__ int perm32(int rho) { const int n = rho >> 4, i = rho & 15; return 8 * (i >> 2) + 4 * n + (i & 3); }

struct Unit { int pm, pn, om, tag; long ao, bo; };
struct Gemm { const bf16_t* A; const bf16_t* Bt; int K; };

__device__ __forceinline__ void tile_of(int wgid, int nwg, int nM, int nN, int& pm, int& pn) {
    { const int q = nwg / NXCD, r = nwg % NXCD, xcd = wgid % NXCD, off = wgid / NXCD; wgid = (xcd < r ? xcd * (q + 1) : r * (q + 1) + (xcd - r) * q) + off; }
    const int nig = WGM * nN, gid = wgid / nig, fm = gid * WGM, gsz = (nM - fm) < WGM ? (nM - fm) : WGM;
    pm = fm + ((wgid % nig) % gsz); pn = (wgid % nig) / gsz;
}
struct StaticOrder {
    int nM, nN, nwg, G, c; long tst;
    __device__ void init(int M, int N, int K, int G_, int c_) { nM = M / BM; nN = N / BM; nwg = nM * nN; G = G_; c = c_; tst = (long)BM * K * 2; }
    __device__ __forceinline__ bool next(int i, Unit& u) const {
        const long L = (long)i * G + c; if (L >= nwg) return false;
        tile_of((int)L, nwg, nM, nN, u.pm, u.pn); u.om = u.pm; u.tag = 0; u.ao = (long)u.pm * tst; u.bo = (long)u.pn * tst; return true;
    }
    __device__ __forceinline__ void a_ready(const Unit&) const {}
    __device__ __forceinline__ void done(const Unit&) const {}
};
struct MergeOrder {
    StaticOrder b; long as, bs;
    __device__ __forceinline__ bool next(int i, Unit& u) const {
        const int ti = i / 3, tg = i - 3 * ti; if (!b.next(ti, u)) return false;
        u.tag = tg; u.ao += (long)tg * as; u.bo += (long)tg * bs; return true;
    }
    __device__ __forceinline__ void a_ready(const Unit&) const {}
    __device__ __forceinline__ void done(const Unit&) const {}
};
struct MoeOrder {
    int t0, nt, nN, nwg, G, c; long tA, tB, eB; int c0, c1, c2, c3, c4, c5, c6; bool a_local, o_local;
    __device__ __forceinline__ bool next(int i, Unit& u) const {
        const long L = (long)i * G + c; if (L >= nwg) return false;
        int pl, pn; tile_of((int)L, nwg, nt, nN, pl, pn);
        const int gt = t0 + pl; const int e = (gt >= c0) + (gt >= c1) + (gt >= c2) + (gt >= c3) + (gt >= c4) + (gt >= c5) + (gt >= c6);
        u.pm = gt; u.pn = pn; u.tag = e; u.om = o_local ? pl : gt; u.ao = (long)(a_local ? pl : gt) * tA; u.bo = (long)e * eB + (long)pn * tB; return true;
    }
    __device__ __forceinline__ void a_ready(const Unit&) const {}
    __device__ __forceinline__ void done(const Unit&) const {}
};

typedef __bf16 bf16x2_t __attribute__((ext_vector_type(2)));
__device__ __forceinline__ unsigned cvt_pk_bf16(float lo, float hi) { f32x2 v = {lo, hi}; bf16x2_t b = __builtin_convertvector(v, bf16x2_t); return __builtin_bit_cast(unsigned, b); }
__device__ __forceinline__ float bf_lo(unsigned w) { return __uint_as_float(w << 16); }
__device__ __forceinline__ float bf_hi(unsigned w) { return __uint_as_float(w & 0xffff0000u); }
__device__ __forceinline__ float sigm(float x) { return __builtin_amdgcn_rcpf(1.0f + __builtin_amdgcn_exp2f(-1.4426950408889634f * x)); }
__device__ __forceinline__ u32x4 pack8(f32x4 v0, f32x4 v1) { u32x4 w; w.x = cvt_pk_bf16(v0[0], v0[1]); w.y = cvt_pk_bf16(v0[2], v0[3]); w.z = cvt_pk_bf16(v1[0], v1[1]); w.w = cvt_pk_bf16(v1[2], v1[3]); return w; }

struct EpiProj {
    static constexpr bool PERM = true, AFTER_DRAIN = false;
    bf16_t* O; size_t split_stride; float qscale, wscale;
    __device__ __forceinline__ void operator()(const f32x4 (&acc)[2][2][4][2], const Unit& u, int wr, int wc, int fr, int fq) const {
        const int t = u.pn / 6, lt = u.pn - 6 * t; bf16_t* base = O + (size_t)t * split_stride; const float sc = (lt < 2 ? qscale : 1.f) * wscale;
        const int row0 = u.om * BM + wr * 64 + fr, col0 = lt * BM + wc * 32 + 8 * fq;
#pragma unroll
        for (int ai = 0; ai < 2; ++ai)
#pragma unroll
            for (int m = 0; m < 4; ++m) { bf16_t* rowp = base + (size_t)(row0 + ai * HALF + m * 16) * 1536 + col0;
#pragma unroll
                for (int bj = 0; bj < 2; ++bj) *(u32x4*)(rowp + bj * HALF) = pack8(acc[ai][bj][m][0] * sc, acc[ai][bj][m][1] * sc); }
    }
};
struct EpiGate {
    static constexpr bool PERM = true, AFTER_DRAIN = false;
    bf16_t* O; int ldc; const float* bias; float wscale;
    __device__ __forceinline__ void operator()(const f32x4 (&acc)[2][2][4][2], const Unit& u, int wr, int wc, int fr, int fq) const {
        const int row0 = u.om * BM + wr * 64 + fr, col0 = u.pn * BM + wc * 32 + 8 * fq;
        f32x4 bv[2][2];
#pragma unroll
        for (int bj = 0; bj < 2; ++bj)
#pragma unroll
            for (int n = 0; n < 2; ++n) bv[bj][n] = *(const f32x4*)(bias + col0 + bj * HALF + 4 * n);
#pragma unroll
        for (int ai = 0; ai < 2; ++ai)
#pragma unroll
            for (int m = 0; m < 4; ++m) { bf16_t* rowp = O + (size_t)(row0 + ai * HALF + m * 16) * ldc + col0;
#pragma unroll
                for (int bj = 0; bj < 2; ++bj) { f32x4 v0 = acc[ai][bj][m][0] * wscale + bv[bj][0], v1 = acc[ai][bj][m][1] * wscale + bv[bj][1];
#pragma unroll
                    for (int i = 0; i < 4; ++i) { v0[i] = sigm(v0[i]); v1[i] = sigm(v1[i]); }
                    *(u32x4*)(rowp + bj * HALF) = pack8(v0, v1); } }
    }
};
struct EpiMerge {
    static constexpr bool PERM = true, AFTER_DRAIN = false;
    const bf16_t* gates; bf16_t* O;
    __device__ __forceinline__ void operator()(const f32x4 (&acc)[2][2][4][2], const Unit& u, int wr, int wc, int fr, int fq) const {
        const int row0 = u.om * BM + wr * 64 + fr, col0 = u.pn * BM + wc * 32 + 8 * fq; const int tg = u.tag;
#pragma unroll
        for (int ai = 0; ai < 2; ++ai)
#pragma unroll
            for (int m = 0; m < 4; ++m) { const size_t row = (size_t)(row0 + ai * HALF + m * 16);
#pragma unroll
                for (int bj = 0; bj < 2; ++bj) {
                    const u32x4 gw = *(const u32x4*)(gates + row * 3072 + tg * 1024 + col0 + bj * HALF);
                    bf16_t* op = O + row * 1024 + col0 + bj * HALF;
                    f32x4 v0 = acc[ai][bj][m][0], v1 = acc[ai][bj][m][1];
#ifdef ABL_TAG
                    if (tg == ABL_TAG) { v0 = v0 * 0.f; v1 = v1 * 0.f; }
#endif
                    v0[0] *= bf_lo(gw.x); v0[1] *= bf_hi(gw.x); v0[2] *= bf_lo(gw.y); v0[3] *= bf_hi(gw.y);
                    v1[0] *= bf_lo(gw.z); v1[1] *= bf_hi(gw.z); v1[2] *= bf_lo(gw.w); v1[3] *= bf_hi(gw.w);
                    if (tg != 0) { const u32x4 ow = *(const u32x4*)op;
                        v0[0] += bf_lo(ow.x); v0[1] += bf_hi(ow.x); v0[2] += bf_lo(ow.y); v0[3] += bf_hi(ow.y);
                        v1[0] += bf_lo(ow.z); v1[1] += bf_hi(ow.z); v1[2] += bf_lo(ow.w); v1[3] += bf_hi(ow.w); }
                    *(u32x4*)op = pack8(v0, v1); }
                asm volatile("" ::: "memory"); }
    }
};
struct EpiRes {
    static constexpr bool PERM = false, AFTER_DRAIN = false;
    const float* base; float* out; float sc;
    __device__ __forceinline__ void operator()(const f32x4 (&acc)[2][2][4][2], const Unit& u, int wr, int wc, int fr, int fq) const {
        const int row0 = u.om * BM + wr * 64 + fr, col0 = u.pn * BM + wc * 32 + 4 * fq;
#pragma unroll
        for (int ai = 0; ai < 2; ++ai)
#pragma unroll
            for (int m = 0; m < 4; ++m) { const size_t off = (size_t)(row0 + ai * HALF + m * 16) * 1024 + col0;
#pragma unroll
                for (int bj = 0; bj < 2; ++bj)
#pragma unroll
                    for (int n = 0; n < 2; ++n) { const f32x4 bs = *(const f32x4*)(base + off + bj * HALF + n * 16); *(f32x4*)(out + off + bj * HALF + n * 16) = bs + acc[ai][bj][m][n] * sc; } }
    }
};
struct EpiSwiglu {
    static constexpr bool PERM = true, AFTER_DRAIN = false;
    bf16_t* O; int ldc;
    __device__ __forceinline__ void operator()(const f32x4 (&acc)[2][2][4][2], const Unit& u, int wr, int wc, int fr, int fq) const {
        const int row0 = u.om * BM + wr * 64 + fr, col0 = u.pn * HALF + wc * 32 + 8 * fq;
#pragma unroll
        for (int ai = 0; ai < 2; ++ai)
#pragma unroll
            for (int m = 0; m < 4; ++m) { f32x4 v0, v1;
#pragma unroll
                for (int i = 0; i < 4; ++i) { const float g0 = acc[ai][0][m][0][i], g1 = acc[ai][0][m][1][i]; v0[i] = g0 * sigm(g0) * acc[ai][1][m][0][i]; v1[i] = g1 * sigm(g1) * acc[ai][1][m][1][i]; }
                *(u32x4*)(O + (size_t)(row0 + ai * HALF + m * 16) * ldc + col0) = pack8(v0, v1); }
    }
};
__device__ __forceinline__ unsigned pk4_fp8(float a, float b, float c, float d) {
    a = __builtin_fminf(__builtin_fmaxf(a, -448.f), 448.f); b = __builtin_fminf(__builtin_fmaxf(b, -448.f), 448.f); c = __builtin_fminf(__builtin_fmaxf(c, -448.f), 448.f); d = __builtin_fminf(__builtin_fmaxf(d, -448.f), 448.f);
    int w = __builtin_amdgcn_cvt_pk_fp8_f32(a, b, 0, false); w = __builtin_amdgcn_cvt_pk_fp8_f32(c, d, w, true); return (unsigned)w; }
struct EpiSwigluF8 {
    static constexpr bool PERM = true, AFTER_DRAIN = false;
    unsigned char* O; int ldc;
    __device__ __forceinline__ void operator()(const f32x4 (&acc)[2][2][4][2], const Unit& u, int wr, int wc, int fr, int fq) const {
        const int row0 = u.om * BM + wr * 64 + fr, col0 = u.pn * HALF + wc * 32 + 8 * fq;
#pragma unroll
        for (int ai = 0; ai < 2; ++ai)
#pragma unroll
            for (int m = 0; m < 4; ++m) { f32x4 v0, v1;
#pragma unroll
                for (int i = 0; i < 4; ++i) { const float g0 = acc[ai][0][m][0][i] * F8_WINV, g1 = acc[ai][0][m][1][i] * F8_WINV; v0[i] = g0 * sigm(g0) * (acc[ai][1][m][0][i] * F8_WINV); v1[i] = g1 * sigm(g1) * (acc[ai][1][m][1][i] * F8_WINV); }
                u32x2 w; w.x = pk4_fp8(v0[0], v0[1], v0[2], v0[3]); w.y = pk4_fp8(v1[0], v1[1], v1[2], v1[3]);
                *(u32x2*)(O + (size_t)(row0 + ai * HALF + m * 16) * ldc + col0) = w; }
    }
};
struct EpiMoeDown {
    static constexpr bool PERM = true, AFTER_DRAIN = false;
    bf16_t* O; const float* w; float scale;
    __device__ __forceinline__ void operator()(const f32x4 (&acc)[2][2][4][2], const Unit& u, int wr, int wc, int fr, int fq) const {
        const int row0 = u.om * BM + wr * 64 + fr, col0 = u.pn * BM + wc * 32 + 8 * fq;
#pragma unroll
        for (int ai = 0; ai < 2; ++ai)
#pragma unroll
            for (int m = 0; m < 4; ++m) { const size_t row = (size_t)(row0 + ai * HALF + m * 16); const float sc = w[row] * scale;
#pragma unroll
                for (int bj = 0; bj < 2; ++bj) *(u32x4*)(O + row * 1024 + col0 + bj * HALF) = pack8(acc[ai][bj][m][0] * sc, acc[ai][bj][m][1] * sc); }
    }
};
template <class Epi, class Sched, bool ALIGN_EPI = false, bool SP2 = false, bool F8 = false>
__device__ __forceinline__ void gemm_phase(PG8_LAS unsigned char* lds, const Gemm g, const Sched& S, const Epi& E, const int tid_in) {
    const int tid = tid_in, wid = __builtin_amdgcn_readfirstlane(tid >> 6), lane = tid & 63, wr = wid >> 2, wc = wid & 3, fr = lane & 15, fq = lane >> 4;
    const int K = g.K, nt = K / BK;
    unsigned voffA[2], voffB[2];
#pragma unroll
    for (int i = 0; i < 2; ++i) { int R, C; stage_rc(tid * 16 + i * 8192, R, C); const int Rb = Epi::PERM ? ((R & ~31) + perm32(R & 31)) : R;
        voffA[i] = (unsigned)(R * K + C) * 2u; voffB[i] = (unsigned)(Rb * K + C) * 2u; }
    const size_t kstep = (size_t)(BK * 2);
    const size_t hstep = (size_t)HALF * K * 2;
    const unsigned ldsw = (unsigned)wid * 1024u;
    const int aoff = lds_byte(wr * 64 + fr, fq * 8), boff = lds_byte(wc * 32 + fr, fq * 8);
#define PG8_SA(b, h) (((b) * 2 + (h)) * HTB)
#define PG8_SB(b, h) ((4 + (b) * 2 + (h)) * HTB)
#define PG8_STAGE(bufoff, gbase, voff) do { _Pragma("unroll") for (int _i = 0; _i < 2; ++_i) \
        __builtin_amdgcn_global_load_lds((const unsigned*)((const char*)(gbase) + (voff)[_i]), (PG8_LAS unsigned*)(lds + (bufoff) + ldsw + _i * 8192), 16, 0, 0); } while (0)
#define PG8_LDA(dst, b, h) do { _Pragma("unroll") for (int m = 0; m < 4; ++m) _Pragma("unroll") for (int k = 0; k < 2; ++k) dst[m][k] = *(const PG8_LAS bf16x8*)(lds + PG8_SA(b, h) + aoff + m * 2048 + k * 1024); } while (0)
#define PG8_LDB(dst, b, h) do { _Pragma("unroll") for (int n = 0; n < 2; ++n) _Pragma("unroll") for (int k = 0; k < 2; ++k) dst[n][k] = *(const PG8_LAS bf16x8*)(lds + PG8_SB(b, h) + boff + n * 2048 + k * 1024); } while (0)
#define PG8_CAT8(x) __builtin_bit_cast(v8i32, __builtin_shufflevector((x)[0], (x)[1], 0, 1, 2, 3, 4, 5, 6, 7, 8, 9, 10, 11, 12, 13, 14, 15))
#define PG8_MMA(ai, bj, At, Bt) do { __builtin_amdgcn_s_setprio(1); if constexpr (F8) { _Pragma("unroll") for (int m = 0; m < 4; ++m) _Pragma("unroll") for (int n = 0; n < 2; ++n) \
        asm volatile("v_mfma_f32_16x16x128_f8f6f4 %0, %1, %2, %0" : "+v"(acc[ai][bj][m][n]) : "v"(PG8_CAT8(Bt[n])), "v"(PG8_CAT8(At[m]))); } else { \
        _Pragma("unroll") for (int m = 0; m < 4; ++m) _Pragma("unroll") for (int n = 0; n < 2; ++n) _Pragma("unroll") for (int k = 0; k < 2; ++k) \
        acc[ai][bj][m][n] = __builtin_amdgcn_mfma_f32_16x16x32_bf16(Bt[n][k], At[m][k], acc[ai][bj][m][n], 0, 0, 0); } __builtin_amdgcn_s_setprio(0); } while (0)
#define PG8_WAIT_V(n) asm volatile("s_waitcnt vmcnt(" #n ")" ::: "memory")
#define PG8_WAIT_L(n) asm volatile("s_waitcnt lgkmcnt(" #n ")" ::: "memory")
#define PG8_BAR __builtin_amdgcn_s_barrier()
#define PG8_SCHED __builtin_amdgcn_sched_barrier(0)
    Unit cur, nxt; int ui = 0;
    if (!S.next(0, cur)) return;
    f32x4 acc[2][2][4][2];
#pragma unroll
    for (int a = 0; a < 2; ++a)
#pragma unroll
        for (int b = 0; b < 2; ++b)
#pragma unroll
            for (int m = 0; m < 4; ++m)
#pragma unroll
                for (int n = 0; n < 2; ++n) { acc[a][b][m][n] = (f32x4){0.f, 0.f, 0.f, 0.f}; if constexpr (F8) asm volatile("" : "+v"(acc[a][b][m][n])); }
    bf16x8 At[4][2], B0[2][2], B1[2][2];
    const char* cA = (const char*)g.A + cur.ao; const char* cB = (const char*)g.Bt + cur.bo;
    S.a_ready(cur);
    if constexpr (SP2) {
        PG8_STAGE(PG8_SB(0, 0), cB, voffB); PG8_STAGE(PG8_SB(0, 1), cB + hstep, voffB); PG8_STAGE(PG8_SA(0, 0), cA, voffA); PG8_STAGE(PG8_SA(0, 1), cA + hstep, voffA);
        if (wr == 1) PG8_BAR;
        PG8_WAIT_V(2); PG8_BAR;
        PG8_STAGE(PG8_SB(1, 0), cB + kstep, voffB); PG8_STAGE(PG8_SA(1, 0), cA + kstep, voffA); PG8_STAGE(PG8_SB(1, 1), cB + hstep + kstep, voffB);
        PG8_WAIT_V(6); PG8_BAR;
    } else {
        PG8_STAGE(PG8_SB(0, 0), cB, voffB); PG8_STAGE(PG8_SA(0, 0), cA, voffA); PG8_STAGE(PG8_SB(0, 1), cB + hstep, voffB); PG8_STAGE(PG8_SA(0, 1), cA + hstep, voffA);
        if (wr == 1) PG8_BAR;
        PG8_WAIT_V(4); PG8_BAR;
        PG8_STAGE(PG8_SB(1, 0), cB + kstep, voffB); PG8_STAGE(PG8_SA(1, 0), cA + kstep, voffA); PG8_STAGE(PG8_SB(1, 1), cB + hstep + kstep, voffB);
        PG8_WAIT_V(6); PG8_BAR;
    }
    for (;;) {
        const bool has_next = S.next(ui + 1, nxt);
        const char* nA = has_next ? (const char*)g.A + nxt.ao : cA; const char* nB = has_next ? (const char*)g.Bt + nxt.bo : cB;
#pragma nounroll
        for (int t = 0; t < nt; t += 2) {
            const bool last = (t == nt - 2);
            const char* a1 = cA + (size_t)(t + 1) * kstep;
            const char* a2 = last ? nA : cA + (size_t)(t + 2) * kstep; const char* b2 = last ? nB : cB + (size_t)(t + 2) * kstep;
            const char* a3 = a2 + kstep; const char* b3 = b2 + kstep;
            if (last && has_next) S.a_ready(nxt);
            if constexpr (SP2) {
            PG8_LDB(B0, 0, 0); PG8_LDB(B1, 0, 1); PG8_SCHED; PG8_LDA(At, 0, 0); PG8_STAGE(PG8_SA(1, 1), a1 + hstep, voffA);
            PG8_WAIT_V(8); PG8_WAIT_L(0); PG8_BAR; PG8_MMA(0, 0, At, B0); PG8_MMA(0, 1, At, B1); PG8_BAR; PG8_SCHED;
            PG8_LDA(At, 0, 1); PG8_STAGE(PG8_SB(0, 0), b2, voffB); PG8_STAGE(PG8_SB(0, 1), b2 + hstep, voffB); PG8_STAGE(PG8_SA(0, 0), a2, voffA);
            PG8_WAIT_V(8); PG8_WAIT_L(0); PG8_BAR; PG8_MMA(1, 0, At, B0); PG8_MMA(1, 1, At, B1); PG8_BAR; PG8_SCHED;
            PG8_LDB(B0, 1, 0); PG8_LDB(B1, 1, 1); PG8_SCHED; PG8_LDA(At, 1, 0); PG8_STAGE(PG8_SA(0, 1), a2 + hstep, voffA);
            PG8_WAIT_V(8); PG8_WAIT_L(0); PG8_BAR; PG8_MMA(0, 0, At, B0); PG8_MMA(0, 1, At, B1); PG8_BAR; PG8_SCHED;
            PG8_LDA(At, 1, 1); PG8_STAGE(PG8_SB(1, 0), b3, voffB); PG8_STAGE(PG8_SB(1, 1), b3 + hstep, voffB); PG8_STAGE(PG8_SA(1, 0), a3, voffA);
            PG8_WAIT_V(8); PG8_WAIT_L(0); PG8_BAR; PG8_MMA(1, 0, At, B0); PG8_MMA(1, 1, At, B1); PG8_BAR; PG8_SCHED;
            } else {
            PG8_LDB(B0, 0, 0); PG8_SCHED; PG8_LDA(At, 0, 0); PG8_STAGE(PG8_SA(1, 1), a1 + hstep, voffA);
            PG8_WAIT_L(8); PG8_BAR; PG8_WAIT_L(0); PG8_MMA(0, 0, At, B0); PG8_BAR; PG8_SCHED;
            PG8_LDB(B1, 0, 1); PG8_STAGE(PG8_SB(0, 0), b2, voffB);
            PG8_BAR; PG8_WAIT_L(0); PG8_MMA(0, 1, At, B1); PG8_BAR;
            PG8_LDA(At, 0, 1); PG8_STAGE(PG8_SA(0, 0), a2, voffA);
            PG8_BAR; PG8_WAIT_L(0); PG8_MMA(1, 0, At, B0); PG8_BAR; PG8_SCHED;
            PG8_STAGE(PG8_SB(0, 1), b2 + hstep, voffB);
            PG8_WAIT_V(6); PG8_BAR; PG8_MMA(1, 1, At, B1); PG8_BAR;
            PG8_LDB(B0, 1, 0); PG8_SCHED; PG8_LDA(At, 1, 0); PG8_STAGE(PG8_SA(0, 1), a2 + hstep, voffA);
            PG8_WAIT_L(8); PG8_BAR; PG8_WAIT_L(0); PG8_MMA(0, 0, At, B0); PG8_BAR; PG8_SCHED;
            PG8_LDB(B1, 1, 1); PG8_STAGE(PG8_SB(1, 0), b3, voffB);
            PG8_BAR; PG8_WAIT_L(0); PG8_MMA(0, 1, At, B1); PG8_BAR;
            PG8_LDA(At, 1, 1); PG8_STAGE(PG8_SA(1, 0), a3, voffA);
            PG8_BAR; PG8_WAIT_L(0); PG8_MMA(1, 0, At, B0); PG8_BAR; PG8_SCHED;
            PG8_STAGE(PG8_SB(1, 1), b3 + hstep, voffB);
            PG8_WAIT_V(6); PG8_BAR; PG8_MMA(1, 1, At, B1); PG8_BAR;
            }
        }
        if constexpr (ALIGN_EPI) { if (wr == 0) PG8_BAR; }
        if constexpr (F8) asm volatile("s_nop 15\n\ts_nop 15" ::: "memory");
        if constexpr (!Epi::AFTER_DRAIN) { E(acc, cur, wr, wc, fr, fq); S.done(cur); }
        if (!has_next) break;
#pragma unroll
        for (int a = 0; a < 2; ++a)
#pragma unroll
            for (int b = 0; b < 2; ++b)
#pragma unroll
                for (int m = 0; m < 4; ++m)
#pragma unroll
                    for (int n = 0; n < 2; ++n) { acc[a][b][m][n] = (f32x4){0.f, 0.f, 0.f, 0.f}; if constexpr (F8) asm volatile("" : "+v"(acc[a][b][m][n])); }
        cur = nxt; cA = nA; cB = nB; ++ui;
        if constexpr (ALIGN_EPI) { if (wr == 1) PG8_BAR; }
    }
    PG8_WAIT_V(0);
    if constexpr (!ALIGN_EPI) { if (wr == 0) PG8_BAR; }
    PG8_BAR;
    if constexpr (Epi::AFTER_DRAIN) { E.fused(acc, cur, wr, wc, fr, fq, lds, wid, lane); S.done(cur); }
#undef PG8_SA
#undef PG8_SB
#undef PG8_STAGE
#undef PG8_LDA
#undef PG8_LDB
#undef PG8_MMA
#undef PG8_CAT8
#undef PG8_WAIT_V
#undef PG8_WAIT_L
#undef PG8_BAR
#undef PG8_SCHED
}
}

namespace att {
#define LAS __attribute__((address_space(3)))
typedef unsigned short bf16;
typedef __attribute__((ext_vector_type(8))) short bf16x8;
typedef __attribute__((ext_vector_type(4))) short s16x4;
typedef __attribute__((ext_vector_type(16))) float f32x16;
typedef __attribute__((ext_vector_type(4))) unsigned u32x4;
typedef float f32x2_t __attribute__((ext_vector_type(2))); typedef __bf16 bf16x2_t __attribute__((ext_vector_type(2)));
typedef short v4i16_t __attribute__((ext_vector_type(4)));
typedef LAS const char* lds_cptr;
constexpr int SEQ = 4096, PP = 1536;
constexpr float LOG2E = 1.4426950408889634f;
constexpr float NEGINF = -INFINITY;
__device__ __forceinline__ int crow(int r, int hi) { return (r & 3) + 8 * (r >> 2) + 4 * hi; }
__device__ __forceinline__ void glds16(const void* gsrc, unsigned lds_dst) { unsigned keep;
    asm volatile("s_mov_b32 %0, m0\n\ts_mov_b32 m0, %2\n\ts_nop 0\n\tglobal_load_lds_dwordx4 %1, off\n\ts_mov_b32 m0, %0" : "=&s"(keep) : "v"(gsrc), "s"(lds_dst) : "memory"); }
__device__ __forceinline__ unsigned cvtpk(float lo, float hi) { f32x2_t v = {lo, hi}; bf16x2_t b = __builtin_convertvector(v, bf16x2_t); return __builtin_bit_cast(unsigned, b); }
__device__ __forceinline__ s16x4 vtr(lds_cptr p) { return __builtin_bit_cast(s16x4, __builtin_amdgcn_ds_read_tr16_b64_v4i16((LAS v4i16_t*)p)); }
__device__ __forceinline__ bf16x8 ldk(lds_cptr p) { return *(const LAS bf16x8*)p; }
__device__ __forceinline__ float xhalf(float v, int hi) {
    auto rr = __builtin_amdgcn_permlane32_swap(__float_as_uint(v), __float_as_uint(v), false, false);
    return hi ? __uint_as_float(rr[0]) : __uint_as_float(rr[1]); }
template <int OF> __device__ __forceinline__ float swz_xor(float v) { return __int_as_float(__builtin_amdgcn_ds_swizzle(__float_as_int(v), (OF << 10) | 0x1f)); }
__device__ __forceinline__ float max16(const f32x16& p) { float a = fmaxf(fmaxf(p[0], p[1]), fmaxf(p[2], p[3]));
#pragma unroll
    for (int r = 4; r < 16; r += 4) a = fmaxf(a, fmaxf(fmaxf(p[r], p[r + 1]), fmaxf(p[r + 2], p[r + 3]))); return a; }
__device__ __forceinline__ float sum16(const f32x16& p) { float a = (p[0] + p[1]) + (p[2] + p[3]);
#pragma unroll
    for (int r = 4; r < 16; r += 4) a += (p[r] + p[r + 1]) + (p[r + 2] + p[r + 3]); return a; }
#define ATT_WAIT_BAR(N) asm volatile("s_waitcnt vmcnt(" #N ") lgkmcnt(0)\n\ts_barrier" ::: "memory")
#define ATT_LDSW() asm volatile("s_waitcnt lgkmcnt(0)" ::: "memory")
#define PACK8(P, B) (u32x4){cvtpk(P[B], P[B + 1]), cvtpk(P[B + 2], P[B + 3]), cvtpk(P[B + 4], P[B + 5]), cvtpk(P[B + 6], P[B + 7])}
#define ASBF(x) __builtin_bit_cast(bf16x8, x)
#define VFRAG(lo, hh) (bf16x8){lo[0], lo[1], lo[2], lo[3], hh[0], hh[1], hh[2], hh[3]}

constexpr int A_SLOT = 32768, A_NSLOT = 4, A_WSF = 131072, A_FLAGS = 135168, A_XCH = 0, A_STG = 65536;
constexpr float A_THR = 8.f, A_DEAD = -150.f;
__device__ __forceinline__ void diff_unit(int b, int h, int qb, const bf16* __restrict__ PA, bf16* __restrict__ YA, float lam, float oscale, const float* __restrict__ subln, float knmax0, float knmax1, LAS char* shm, const int tid) {
    const int lane = tid & 63, r32 = lane & 31, hi = lane >> 5;
    const int wid = __builtin_amdgcn_readfirstlane(tid >> 6), comp = wid >> 2, g = wid & 3;
    const float slope2 = __builtin_amdgcn_exp2f(-2.f * (float)(h + 1)) * LOG2E;
    const long rowbase = (long)b * SEQ; const int q0 = qb * 128, qw0 = q0 + 32 * g, qi = qw0 + r32;
    const unsigned lds0 = (unsigned)(size_t)shm;
    LAS float* wsf = (LAS float*)(shm + A_WSF) + wid * 128;
    const bf16* kb_ = PA + rowbase * PP + 512 + h * 128; const bf16* vb_ = PA + rowbase * PP + 1024 + h * 128;
    const bf16* ksrc0 = kb_ + (long)lane * PP + wid * 8; const bf16* ksrc1 = ksrc0 + 64;
    const int pa = wid, pb = wid + 8;
    const bf16* vsrca = vb_ + (long)(16 * (pa & 3) + (lane >> 2)) * PP + (pa >> 2) * 32 + (lane & 3) * 8;
    const bf16* vsrcb = vb_ + (long)(16 * (pb & 3) + (lane >> 2)) * PP + (pb >> 2) * 32 + (lane & 3) * 8;
    const int NT = 2 * (qb + 1);
#define A_ISSUE(it_) do { const long ro_ = (long)(NT - 1 - (it_)) * 64 * PP; const unsigned sb_ = (unsigned)__builtin_amdgcn_readfirstlane(lds0 + (unsigned)(((it_) & 3) * A_SLOT)); \
        glds16(ksrc0 + ro_, sb_ + wid * 1024); glds16(ksrc1 + ro_, sb_ + 8192 + wid * 1024); glds16(vsrca + ro_, sb_ + 16384 + pa * 1024); glds16(vsrcb + ro_, sb_ + 16384 + pb * 1024); } while (0)
    const bf16* qp = PA + (rowbase + qi) * PP + h * 128 + comp * 64 + hi * 8;
    bf16x8 qr[4];
#pragma unroll
    for (int d0 = 0; d0 < 4; ++d0) qr[d0] = *(const bf16x8*)(qp + d0 * 16);
    const float sl4 = slope2 * 4.f * (float)hi;
    float qkb;
    { float ss = 0.f;
#pragma unroll
      for (int d0 = 0; d0 < 4; ++d0)
#pragma unroll
          for (int e = 0; e < 8; ++e) { const float v = __uint_as_float((unsigned)(unsigned short)qr[d0][e] << 16); ss += v * v; }
      ss += xhalf(ss, hi); qkb = sqrtf(ss) * (comp ? knmax1 : knmax0) * 1.001f + 1.0f; }
    volatile LAS int* fl = (volatile LAS int*)(shm + A_FLAGS);
    A_ISSUE(0); A_ISSUE(1); if (NT > 2) A_ISSUE(2);
    float m_ref = NEGINF, l = 0.f; f32x16 o[4];
#pragma unroll
    for (int dq = 0; dq < 4; ++dq) o[dq] = f32x16{};
#define A_QKH(P, it_, hf_) do { const int kh_ = 64 * (NT - 1 - (it_)) + 32 * (hf_); if (kh_ <= qw0) { \
        const lds_cptr kp_ = shm + ((it_) & 3) * A_SLOT + comp * 8192 + hi * 1024 + r32 * 16 + (hf_) * 512; \
        float s2_ = slope2; asm volatile("" : "+v"(s2_));     \
        const float bs_ = s2_ * (float)(kh_ - qi) + sl4; \
        _Pragma("unroll") for (int r = 0; r < 16; ++r) P[r] = __builtin_fmaf(s2_, (float)((r & 3) + 8 * (r >> 2)), bs_); \
        _Pragma("unroll") for (int d0 = 0; d0 < 4; ++d0) P = __builtin_amdgcn_mfma_f32_32x32x16_bf16(ldk(kp_ + d0 * 2048), qr[d0], P, 0, 0, 0); } } while (0)
#define A_SVH(P, it_, hf_) do { const int kh_ = 64 * (NT - 1 - (it_)) + 32 * (hf_); if (kh_ <= qw0) { \
        if (kh_ == qw0) { _Pragma("unroll") for (int r = 0; r < 16; ++r) if (crow(r, hi) > r32) P[r] = NEGINF; } \
        float rm_ = max16(P); rm_ = fmaxf(rm_, xhalf(rm_, hi)); \
        if (!__all(rm_ < m_ref + A_DEAD)) { \
            const float mnew_ = fmaxf(m_ref, rm_); \
            if (__any(mnew_ > m_ref + A_THR)) { const float alpha_ = __builtin_amdgcn_exp2f(m_ref - mnew_); l *= alpha_; m_ref = mnew_; \
                if (hi == 0) wsf[r32] = alpha_; ATT_LDSW(); \
                _Pragma("unroll") for (int r = 0; r < 16; ++r) { const float a_ = wsf[crow(r, hi)]; _Pragma("unroll") for (int dq = 0; dq < 4; ++dq) o[dq][r] *= a_; } } \
            _Pragma("unroll") for (int r = 0; r < 16; ++r) P[r] = __builtin_amdgcn_exp2f(P[r] - m_ref); \
            l += sum16(P); \
            const u32x4 pw0_ = PACK8(P, 0), pw1_ = PACK8(P, 8); \
            const lds_cptr vp_ = shm + ((it_) & 3) * A_SLOT + 16384 + (hf_) * 2048 + ((lane >> 4) & 1) * 32 + (lane & 3) * 8 + (4 * hi + ((lane & 15) >> 2)) * 64; \
            _Pragma("unroll") for (int dq = 0; dq < 4; ++dq) { \
                const s16x4 l0_ = vtr(vp_ + dq * 4096), h0_ = vtr(vp_ + dq * 4096 + 512), l1_ = vtr(vp_ + dq * 4096 + 1024), h1_ = vtr(vp_ + dq * 4096 + 1536); \
                o[dq] = __builtin_amdgcn_mfma_f32_32x32x16_bf16(ASBF(pw0_), VFRAG(l0_, h0_), o[dq], 0, 0, 0); \
                o[dq] = __builtin_amdgcn_mfma_f32_32x32x16_bf16(ASBF(pw1_), VFRAG(l1_, h1_), o[dq], 0, 0, 0); } } } } while (0)
    f32x16 PH, PL;
    if (NT > 2) { ATT_WAIT_BAR(8); } else { ATT_WAIT_BAR(4); }
    A_QKH(PH, 0, 1);
    for (int it = 0; it < NT; ++it) {
        A_QKH(PL, it, 0);
        A_SVH(PH, it, 1);
        if (it + 1 < NT) {
            if (it + 2 < NT) { ATT_WAIT_BAR(4); } else { ATT_WAIT_BAR(0); }
            if (it > 0) { const volatile LAS int* f = fl + ((it - 1) & 1) * 8;
                if (f[0] & f[1] & f[2] & f[3] & f[4] & f[5] & f[6] & f[7]) break; }
            if (it + 3 < NT) A_ISSUE(it + 3);
            A_QKH(PH, it + 1, 1);
        }
        A_SVH(PL, it, 0);
        { const float bmax = slope2 * (float)(64 * (NT - 2 - it) + 63 - qi);
          const int dead = __all(qkb + bmax < m_ref + A_DEAD) ? 1 : 0;
          if (lane == 0) fl[(it & 1) * 8 + wid] = dead; }
    }
#undef A_ISSUE
#undef A_QKH
#undef A_SVH
    l += xhalf(l, hi);
    if (hi == 0) wsf[32 + r32] = __builtin_amdgcn_rcpf(l); ATT_LDSW();
#pragma unroll
    for (int r = 0; r < 16; ++r) { const float a = wsf[32 + crow(r, hi)];
#pragma unroll
        for (int dq = 0; dq < 4; ++dq) o[dq][r] *= a; }
    ATT_WAIT_BAR(0);
    LAS float* X = (LAS float*)(shm + A_XCH) + g * 4096;
    if (comp == 1) {
#pragma unroll
        for (int dq = 0; dq < 4; ++dq)
#pragma unroll
            for (int r = 0; r < 16; ++r) X[(dq * 16 + r) * 64 + lane] = o[dq][r];
    }
    ATT_WAIT_BAR(0);
    if (comp == 0) {
        float ss[16];
#pragma unroll
        for (int r = 0; r < 16; ++r) ss[r] = 0.f;
#pragma unroll
        for (int dq = 0; dq < 4; ++dq)
#pragma unroll
            for (int r = 0; r < 16; ++r) { const float d = o[dq][r] - lam * X[(dq * 16 + r) * 64 + lane]; o[dq][r] = d; ss[r] += d * d; }
#pragma unroll
        for (int r = 0; r < 16; ++r) { float s = ss[r];
            s += swz_xor<1>(s); s += swz_xor<2>(s); s += swz_xor<4>(s); s += swz_xor<8>(s); s += swz_xor<16>(s);
            ss[r] = __builtin_amdgcn_rsqf(s * (1.f / 128.f) + 1e-6f); }
        LAS bf16* stg = (LAS bf16*)(shm + A_STG) + g * 4096;
#pragma unroll
        for (int dq = 0; dq < 4; ++dq) { const float gn = subln[dq * 32 + r32] * oscale;
#pragma unroll
            for (int r = 0; r < 16; ++r) stg[crow(r, hi) * 128 + dq * 32 + r32] = (bf16)(cvtpk(o[dq][r] * ss[r] * gn, 0.f) & 0xffffu); }
        ATT_LDSW();
        bf16* Yw = YA + (rowbase + qw0) * 512 + h * 128;
#pragma unroll
        for (int i = 0; i < 8; ++i) { const int idx = i * 64 + lane, row = idx >> 4, ch = idx & 15; const u32x4 v = *(const LAS u32x4*)(stg + row * 128 + ch * 8); *(u32x4*)(Yw + (long)row * 512 + ch * 8) = v; }
    }
    ATT_WAIT_BAR(0);
}

constexpr int B_V = 49152, B_WSF = 98304, B_STG = 100352;
__device__ __forceinline__ void dil_unit(int b, int h, int dil, int res, int blk, const bf16* __restrict__ PB, bf16* __restrict__ OUT, float* __restrict__ ST, LAS char* shm, const int tid) {
    const int lane = tid & 63, r32 = lane & 31, hi = lane >> 5;
    const int wid = __builtin_amdgcn_readfirstlane(tid >> 6);
    const int hs = h + (h >> 1);
    const float sd = __builtin_amdgcn_exp2f(-(2.f / 3.f) * (float)(hs + 1)) * LOG2E * (float)dil;
    const long rowbase = (long)b * SEQ; const int i0 = 256 * blk, jb = i0 - 128;
    const unsigned lds0 = (unsigned)(size_t)shm;
#pragma unroll
    for (int k = 0; k < 12; ++k) { const int pc = wid * 12 + k;
        const int isv = pc >= 48, q = isv ? pc - 48 : pc, T = q >> 3, c = q & 7;
        int brow, coff; if (!isv) { brow = 64 * T + lane; coff = 512 + h * 64 + c * 8; } else { brow = 64 * T + 16 * (c & 3) + (lane >> 2); coff = 1024 + h * 64 + (c >> 2) * 32 + (lane & 3) * 8; }
        int j = jb + brow; j = j < 0 ? 0 : j;
        const bf16* src = PB + (rowbase + (long)j * dil + res) * PP + coff;
        glds16(src, (unsigned)__builtin_amdgcn_readfirstlane(lds0 + (unsigned)((isv ? B_V : 0) + T * 8192 + c * 1024))); }
    const int iq = i0 + 32 * wid + r32;
    const bf16* qp = PB + (rowbase + (long)iq * dil + res) * PP + h * 64 + hi * 8;
    bf16x8 qr[4];
#pragma unroll
    for (int d0 = 0; d0 < 4; ++d0) qr[d0] = *(const bf16x8*)(qp + d0 * 16);
    ATT_WAIT_BAR(0);
    f32x16 s[5];
#pragma unroll
    for (int g = 0; g < 5; ++g) { const int b0 = 32 * (wid + g), T = b0 >> 6, half = (b0 >> 5) & 1;
        const lds_cptr kp = shm + T * 8192 + hi * 1024 + (half * 32 + r32) * 16;
        const float base = -sd * (float)(128 - 32 * g + r32);
#pragma unroll
        for (int r = 0; r < 16; ++r) s[g][r] = base + sd * (float)crow(r, hi);
#pragma unroll
        for (int d0 = 0; d0 < 4; ++d0) s[g] = __builtin_amdgcn_mfma_f32_32x32x16_bf16(ldk(kp + d0 * 2048), qr[d0], s[g], 0, 0, 0); }
#pragma unroll
    for (int r = 0; r < 16; ++r) { const int cr = crow(r, hi); if (cr < r32) s[0][r] = NEGINF; if (cr > r32) s[4][r] = NEGINF; }
    if (blk == 0) {
#pragma unroll
        for (int g = 0; g < 5; ++g)
#pragma unroll
            for (int r = 0; r < 16; ++r) if (32 * (wid + g) + crow(r, hi) < 128) s[g][r] = NEGINF;
    }
    float m = max16(s[0]);
#pragma unroll
    for (int g = 1; g < 5; ++g) m = fmaxf(m, max16(s[g]));
    m = fmaxf(m, xhalf(m, hi));
    float l = 0.f;
#pragma unroll
    for (int g = 0; g < 5; ++g) {
#pragma unroll
        for (int r = 0; r < 16; ++r) s[g][r] = __builtin_amdgcn_exp2f(s[g][r] - m);
        l += sum16(s[g]); }
    l += xhalf(l, hi);
    f32x16 o[2]; o[0] = f32x16{}; o[1] = f32x16{};
    const lds_cptr vp0 = shm + B_V + ((lane >> 4) & 1) * 32 + (lane & 3) * 8 + (4 * hi + ((lane & 15) >> 2)) * 64;
#pragma unroll
    for (int g = 0; g < 5; ++g) { const u32x4 pwa = PACK8(s[g], 0), pwb = PACK8(s[g], 8);
        const int B16 = 2 * (wid + g), T = B16 >> 2, ks = B16 & 3;
        const lds_cptr vp = vp0 + T * 8192 + ks * 1024;
#pragma unroll
        for (int d0 = 0; d0 < 2; ++d0) {
            const s16x4 la = vtr(vp + d0 * 4096), ha = vtr(vp + d0 * 4096 + 512), lb_ = vtr(vp + d0 * 4096 + 1024), hb = vtr(vp + d0 * 4096 + 1536);
            o[d0] = __builtin_amdgcn_mfma_f32_32x32x16_bf16(ASBF(pwa), VFRAG(la, ha), o[d0], 0, 0, 0);
            o[d0] = __builtin_amdgcn_mfma_f32_32x32x16_bf16(ASBF(pwb), VFRAG(lb_, hb), o[d0], 0, 0, 0); } }
    LAS float* wsf = (LAS float*)(shm + B_WSF) + wid * 64;
    if (hi == 0) wsf[r32] = __builtin_amdgcn_rcpf(l); ATT_LDSW();
    LAS bf16* stg = (LAS bf16*)(shm + B_STG) + wid * 2048;
#pragma unroll
    for (int r = 0; r < 16; ++r) { const float a = wsf[crow(r, hi)];
#pragma unroll
        for (int d0 = 0; d0 < 2; ++d0) stg[crow(r, hi) * 64 + d0 * 32 + r32] = (bf16)(cvtpk(o[d0][r] * a, 0.f) & 0xffffu); }
    ATT_LDSW();
    const long tok = rowbase + (long)iq * dil + res;
    if (hi == 0) { f32x2_t ml = {m, l}; *(f32x2_t*)(ST + (tok * 8 + h) * 2) = ml; }
#pragma unroll
    for (int i = 0; i < 4; ++i) { const int row = i * 8 + (lane >> 3), ch = lane & 7; const u32x4 v = *(const LAS u32x4*)(stg + row * 64 + ch * 8);
        const long trow = rowbase + (long)(i0 + 32 * wid + row) * dil + res; *(u32x4*)(OUT + trow * 512 + h * 64 + ch * 8) = v; }
    ATT_WAIT_BAR(0);
}

constexpr int C_SLOT = 16384, C_FLAGS = 49152, C_STG = 53248;
constexpr float C_EXIT = -150.f;
__device__ __forceinline__ void sb_unit(int b, int h, int qb, const bf16* __restrict__ PC, bf16* __restrict__ YC, LAS char* shm, const int tid) {
    const int lane = tid & 63, r32 = lane & 31, hi = lane >> 5;
    const int wid = __builtin_amdgcn_readfirstlane(tid >> 6);
    const long rowbase = (long)b * SEQ; const int q0 = qb * 256, qw0 = q0 + 32 * wid, qi = qw0 + r32;
    const unsigned lds0 = (unsigned)(size_t)shm;
    volatile LAS int* fl = (volatile LAS int*)(shm + C_FLAGS);
    const bf16* ksrc = PC + (rowbase + lane) * PP + 512 + h * 64 + wid * 8;
    const bf16* vsrc = PC + (rowbase + 16 * (wid & 3) + (lane >> 2)) * PP + 1024 + h * 64 + (wid >> 2) * 32 + (lane & 3) * 8;
    const int NT = 4 * qb + 4;
#define C_ISSUE(t_, sl_) do { const long ro_ = (long)(t_) * 64 * PP; const unsigned sb_ = (unsigned)__builtin_amdgcn_readfirstlane(lds0 + (unsigned)(sl_)); \
        glds16(ksrc + ro_, sb_ + wid * 1024); glds16(vsrc + ro_, sb_ + 8192 + wid * 1024); } while (0)
    const bf16* qp = PC + (rowbase + qi) * PP + h * 64 + hi * 8;
    bf16x8 qr[4];
#pragma unroll
    for (int d0 = 0; d0 < 4; ++d0) qr[d0] = *(const bf16x8*)(qp + d0 * 16);
    C_ISSUE(NT - 1, 0); C_ISSUE(NT - 2, C_SLOT);
    float c = 0.f; bool wdone = false; f32x16 o[2]; o[0] = f32x16{}; o[1] = f32x16{};
    int sl = 0, sl2 = 2 * C_SLOT;
    for (int it = 0; it < NT; ++it) {
        if (it + 1 < NT) { ATT_WAIT_BAR(2); } else { ATT_WAIT_BAR(0); }
        if (it > 0) {
            const volatile LAS int* f = fl + ((it - 1) & 1) * 8;
            const int all = f[0] & f[1] & f[2] & f[3] & f[4] & f[5] & f[6] & f[7];
            if (all) break;
        }
        if (it + 2 < NT) C_ISSUE(NT - 3 - it, sl2);
        const int kbase = 64 * (NT - 1 - it);
        if (!wdone && kbase <= qw0) {
            const lds_cptr kp = shm + sl + hi * 1024 + r32 * 16;
            f32x16 p0 = f32x16{}, p1 = f32x16{};
#pragma unroll
            for (int d0 = 0; d0 < 4; ++d0) { const bf16x8 k0 = ldk(kp + d0 * 2048), k1 = ldk(kp + d0 * 2048 + 512);
                p0 = __builtin_amdgcn_mfma_f32_32x32x16_bf16(k0, qr[d0], p0, 0, 0, 0); p1 = __builtin_amdgcn_mfma_f32_32x32x16_bf16(k1, qr[d0], p1, 0, 0, 0); }
            f32x16 L0, L1;
#pragma unroll
            for (int r = 0; r < 16; ++r) {
                const int kv = kbase + crow(r, hi);
                { const float z = p0[r]; const float t = __builtin_amdgcn_logf(1.f + __builtin_amdgcn_exp2f(-fabsf(z))); L0[r] = (kv < qi) ? (fminf(-z, 0.f) - t) : 0.f; }
                { const float z = p1[r]; const float t = __builtin_amdgcn_logf(1.f + __builtin_amdgcn_exp2f(-fabsf(z))); L1[r] = (kv + 32 < qi) ? (fminf(-z, 0.f) - t) : 0.f; }
            }
            float T[8], U[8];
#pragma unroll
            for (int k = 0; k < 8; ++k) { const f32x16& Lx = (k < 4) ? L0 : L1; const int rb = 4 * (k & 3); T[k] = (Lx[rb] + Lx[rb + 1]) + (Lx[rb + 2] + Lx[rb + 3]); }
#pragma unroll
            for (int k = 0; k < 8; ++k) U[k] = xhalf(T[k], hi);
            float R = c;
#pragma unroll
            for (int k = 7; k >= 0; --k) {
                const float sufk = R + (hi == 0 ? U[k] : 0.f);
                f32x16& Lx = (k < 4) ? L0 : L1; f32x16& Px = (k < 4) ? p0 : p1; const int rb = 4 * (k & 3);
                const float e3 = Lx[rb + 3], e2 = Lx[rb + 2], e1 = Lx[rb + 1];
                const float s3 = sufk, s2 = sufk + e3, s1 = s2 + e2, s0 = s1 + e1;
                const int kv = kbase + 32 * (k >> 2) + 8 * (k & 3) + 4 * hi;
                Px[rb + 3] = (kv + 3 < qi) ? __builtin_amdgcn_exp2f(Lx[rb + 3] + Px[rb + 3] + s3) : 0.f;
                Px[rb + 2] = (kv + 2 < qi) ? __builtin_amdgcn_exp2f(Lx[rb + 2] + Px[rb + 2] + s2) : 0.f;
                Px[rb + 1] = (kv + 1 < qi) ? __builtin_amdgcn_exp2f(Lx[rb + 1] + Px[rb + 1] + s1) : 0.f;
                Px[rb + 0] = (kv + 0 < qi) ? __builtin_amdgcn_exp2f(Lx[rb + 0] + Px[rb + 0] + s0) : 0.f;
                R += T[k] + U[k];
            }
            c = R;
            const u32x4 pw0 = PACK8(p0, 0), pw1 = PACK8(p0, 8), pw2 = PACK8(p1, 0), pw3 = PACK8(p1, 8);
            const lds_cptr vp = shm + sl + 8192 + ((lane >> 4) & 1) * 32 + (lane & 3) * 8 + (4 * hi + ((lane & 15) >> 2)) * 64;
#pragma unroll
            for (int d0 = 0; d0 < 2; ++d0) {
                const s16x4 l0 = vtr(vp + d0 * 4096), h0 = vtr(vp + d0 * 4096 + 512), l1 = vtr(vp + d0 * 4096 + 1024), h1 = vtr(vp + d0 * 4096 + 1536);
                const s16x4 l2 = vtr(vp + d0 * 4096 + 2048), h2 = vtr(vp + d0 * 4096 + 2560), l3 = vtr(vp + d0 * 4096 + 3072), h3 = vtr(vp + d0 * 4096 + 3584);
                o[d0] = __builtin_amdgcn_mfma_f32_32x32x16_bf16(ASBF(pw0), VFRAG(l0, h0), o[d0], 0, 0, 0);
                o[d0] = __builtin_amdgcn_mfma_f32_32x32x16_bf16(ASBF(pw1), VFRAG(l1, h1), o[d0], 0, 0, 0);
                o[d0] = __builtin_amdgcn_mfma_f32_32x32x16_bf16(ASBF(pw2), VFRAG(l2, h2), o[d0], 0, 0, 0);
                o[d0] = __builtin_amdgcn_mfma_f32_32x32x16_bf16(ASBF(pw3), VFRAG(l3, h3), o[d0], 0, 0, 0);
            }
            wdone = __all(c < C_EXIT);
        }
        if (lane == 0) fl[(it & 1) * 8 + wid] = wdone ? 1 : 0;
        sl2 = sl; sl = (sl == 2 * C_SLOT) ? 0 : sl + C_SLOT;
    }
#undef C_ISSUE
    ATT_WAIT_BAR(0);
    LAS bf16* stg = (LAS bf16*)(shm + C_STG) + wid * 2048;
#pragma unroll
    for (int r = 0; r < 16; ++r)
#pragma unroll
        for (int d0 = 0; d0 < 2; ++d0) stg[crow(r, hi) * 64 + d0 * 32 + r32] = (bf16)(cvtpk(o[d0][r], 0.f) & 0xffffu);
    ATT_LDSW();
    bf16* Yw = YC + (rowbase + qw0) * 512 + h * 64;
#pragma unroll
    for (int i = 0; i < 4; ++i) { const int row = i * 8 + (lane >> 3), ch = lane & 7; const u32x4 v = *(const LAS u32x4*)(stg + row * 64 + ch * 8); *(u32x4*)(Yw + (long)row * 512 + ch * 8) = v; }
    ATT_WAIT_BAR(0);
}
#undef LAS
}

constexpr int NWAVES = 8;
constexpr int BATCH = 8, SEQ = 4096, D = 1024, M = BATCH * SEQ;
constexpr int BW = 512, NPROJ = 9 * BW, NGATE = 3 * D, DFF = 2816, DFX = 3584, NEXP = 8;
constexpr float EPS = 1e-6f, LOG2E_F = 1.4426950408889634f;
constexpr float C2 = 0.125f * LOG2E_F;
#ifndef MIX_FP8
#define MIX_FP8 1
#endif
#ifndef DENSE_FP8
#define DENSE_FP8 0
#endif
#ifndef FFN_FP8
#define FFN_FP8 1
#endif
constexpr int MOE_CH_TILES = 64, MOE_MAX_TILES = 264, MOE_MAX_CH = 5;

constexpr size_t MiB = 1u << 20, KiB = 1u << 10;
constexpr size_t WS_CTL = 0, CTL_ZERO_BYTES = 1 * MiB;
constexpr size_t WS_WIN = 1 * MiB, WS_WG = 19 * MiB, WS_WB = 31 * MiB, WS_WO = 37 * MiB, WS_WGU = 41 * MiB, WS_WD = 52 * MiB;
constexpr size_t WS_BST = 58 * MiB;
constexpr size_t WS_TOKE = 64 * MiB, WS_TOKW = WS_TOKE + 128 * KiB, WS_SLOT = WS_TOKE + 384 * KiB, WS_SLW = WS_TOKE + 640 * KiB, WS_CNT = WS_TOKE + 960 * KiB, WS_MHDR = WS_TOKE + 992 * KiB;
constexpr size_t WS_H = 66 * MiB;
constexpr size_t WS_PA = 130 * MiB, WS_PB = 226 * MiB, WS_PC = 322 * MiB;
constexpr size_t WS_YA = 418 * MiB, WS_YB = 450 * MiB, WS_YC = 482 * MiB;
constexpr size_t WS_BP = 130 * MiB;
constexpr size_t WS_GATES = 226 * MiB;
constexpr size_t WS_ACT = 130 * MiB;
constexpr size_t WS_MWGU = 130 * MiB, WS_MWD = 242 * MiB;
constexpr size_t WS_HS = 298 * MiB;
constexpr size_t WS_MACT = 430 * MiB;
constexpr size_t WS_H8 = 514 * MiB;
constexpr size_t WS_END = 546 * MiB;
constexpr size_t WS8_MWGU = 130 * MiB, WS8_MWD = 186 * MiB, WS8_HS = 214 * MiB, WS8_YS = 280 * MiB, WS8_MACT = 412 * MiB;
static_assert(WS8_MWGU + (size_t)NEXP * 2 * DFX * D <= WS8_MWD && WS8_MWD + (size_t)NEXP * D * DFX <= WS8_HS && WS8_HS + (size_t)MOE_MAX_TILES * 256 * D <= WS8_YS && WS8_YS + (size_t)MOE_MAX_TILES * 256 * D * 2 <= WS8_MACT && WS8_MACT + (size_t)MOE_CH_TILES * 256 * DFX <= WS_END, "d_ws map fp8");
static_assert(WS_WD + (size_t)D * DFF * 2 <= WS_BST && WS_HS + (size_t)MOE_MAX_TILES * 256 * D * 2 <= WS_MACT && WS_MACT + (size_t)MOE_CH_TILES * 256 * DFX * 2 <= WS_END, "d_ws map");
static_assert(WS_MWGU + (size_t)NEXP * 2 * DFX * D * 2 <= WS_MWD && WS_MWD + (size_t)NEXP * D * DFX * 2 <= WS_HS && WS_ACT + (size_t)M * DFF * 2 <= WS_PC, "d_ws map 2");
constexpr int CW_BAR = 4096, CW_Q = 16384, CW_KM = 49152, CW_KC = 53248;

constexpr int RING_OFF = 0, LDSCTL_OFF = 139264, MISC_OFF = LDSCTL_OFF + 320, LTAB_OFF = LDSCTL_OFF + 1024;
constexpr int LDS_BYTES = 147456;

#define GAS __attribute__((address_space(1)))
#define LAS __attribute__((address_space(3)))
typedef unsigned short bf16;
typedef unsigned v4u __attribute__((ext_vector_type(4)));
typedef unsigned v2u __attribute__((ext_vector_type(2)));
typedef float f32x4 __attribute__((ext_vector_type(4)));
typedef float f32x2 __attribute__((ext_vector_type(2)));
typedef GAS unsigned gu32;
#define RLX_AGENT __ATOMIC_RELAXED, __HIP_MEMORY_SCOPE_AGENT
#define LDS_WAIT() asm volatile("s_waitcnt lgkmcnt(0)" ::: "memory")
#define VM_WAIT() asm volatile("s_waitcnt vmcnt(0)" ::: "memory")
__device__ __forceinline__ unsigned f2bf(float f) { unsigned u = __builtin_bit_cast(unsigned, f); return (u + 0x7fffu + ((u >> 16) & 1u)) >> 16; }
__device__ __forceinline__ unsigned pk2(float lo, float hi) { return f2bf(lo) | (f2bf(hi) << 16); }
__device__ __forceinline__ float bfl(unsigned w) { return __uint_as_float(w << 16); }
__device__ __forceinline__ float bfh(unsigned w) { return __uint_as_float(w & 0xffff0000u); }

#define XB_TMO      128
#define XB_XCNT(j)  (256  + 64 * (j))
#define XB_XSUB(j)  (1280 + 64 * (j))
#define XB_XGEN(j)  (2304 + 64 * (j))
#define XB_TOP      3328
#define XB_TOPGEN   3392
#define XCD_BAR_WORDS 3456
#define XB_SPIN_CAP (1u << 18)

__device__ __forceinline__ unsigned xb_ld(unsigned* p)              { return __hip_atomic_load(p, __ATOMIC_RELAXED, __HIP_MEMORY_SCOPE_AGENT); }
__device__ __forceinline__ unsigned xb_add(unsigned* p, unsigned v) { return __hip_atomic_fetch_add(p, v, __ATOMIC_RELAXED, __HIP_MEMORY_SCOPE_AGENT); }
__device__ __forceinline__ unsigned xb_xcc_id() { return (unsigned)__builtin_amdgcn_s_getreg((3 << 11) | 20) & 0xFu; }
#define XB_SPIN(cond, bar) do { unsigned _sp = 0; while (cond) { __builtin_amdgcn_s_sleep(1); \
    if ((++_sp & 255u) == 0u) { if (xb_ld(&(bar)[XB_TMO])) break; if (_sp > XB_SPIN_CAP) { atomicAdd(&(bar)[XB_TMO], 1u); break; } } } } while (0)

struct XcdBarrier {
    unsigned* bar; unsigned x;
    volatile LAS unsigned* st;
};

__device__ __forceinline__ XcdBarrier xcd_barrier_post(unsigned* bar, volatile LAS unsigned* st) {
    XcdBarrier b; b.bar = bar; b.x = xb_xcc_id(); b.st = st;
    if (threadIdx.x == 0) (void)xb_add(&bar[XB_XCNT(b.x)], 1u);
    return b;
}
__device__ __forceinline__ void xcd_barrier_complete(unsigned* bar, unsigned x, unsigned& nloc, unsigned& nx) {
    const unsigned G = gridDim.x * gridDim.y * gridDim.z;
    unsigned sum, cnt, mine, sp = 0u;
    for (;;) {
        sum = 0u; cnt = 0u; mine = 0u;
#pragma unroll
        for (unsigned j = 0; j < 16; ++j) { const unsigned c = xb_ld(&bar[XB_XCNT(j)]); sum += c; cnt += (c > 0u) ? 1u : 0u; mine = (j == x) ? c : mine; }
        if (sum == G) break;
        __builtin_amdgcn_s_sleep(1);
        if ((++sp & 255u) == 0u) { if (xb_ld(&bar[XB_TMO])) break; if (sp > XB_SPIN_CAP) { atomicAdd(&bar[XB_TMO], 1u); break; } }
    }
    nloc = mine > 0u ? mine : 1u; nx = cnt > 0u ? cnt : 1u;
}

__device__ __forceinline__ void xcd_barrier(const XcdBarrier& b) {
    asm volatile("s_waitcnt vmcnt(0)" ::: "memory");
    __syncthreads();
    if (threadIdx.x == 0) {
        unsigned* bar = b.bar;
        __builtin_amdgcn_s_waitcnt(0);
        unsigned nloc = b.st[0], nx = b.st[1];
        if (nloc == 0u) { xcd_barrier_complete(bar, b.x, nloc, nx); b.st[0] = nloc; b.st[1] = nx; }
        const unsigned old = xb_add(&bar[XB_XSUB(b.x)], 1u);
        const unsigned gen = old / nloc;
        if (old + 1u == (gen + 1u) * nloc) {
            __builtin_amdgcn_fence(__ATOMIC_RELEASE, "agent");
            asm volatile("s_waitcnt vmcnt(0)" ::: "memory");
            const unsigned og = xb_add(&bar[XB_TOP], 1u);
            const unsigned tg = og / nx;
            if (og + 1u == (tg + 1u) * nx) xb_add(&bar[XB_TOPGEN], 1u);
            else XB_SPIN(xb_ld(&bar[XB_TOPGEN]) == tg, bar);
            __builtin_amdgcn_fence(__ATOMIC_ACQUIRE, "agent");
            xb_add(&bar[XB_XGEN(b.x)], 1u);
            asm volatile("s_waitcnt vmcnt(0)" ::: "memory");
        } else {
            XB_SPIN(xb_ld(&bar[XB_XGEN(b.x)]) == gen, bar);
            __builtin_amdgcn_fence(__ATOMIC_ACQUIRE, "agent");
            asm volatile("s_waitcnt vmcnt(0)" ::: "memory");
        }
    }
    __syncthreads();
}


__device__ __forceinline__ float wave_sum(float v) {
#pragma unroll
    for (int o = 1; o < 64; o <<= 1) v += __shfl_xor(v, o);
    return v;
}
__device__ __forceinline__ void transpose_item(const float* W, int K, int N, bf16* WT, int row_off, LAS float* scr, int k0, int n0, int lane) {
#pragma unroll 8
    for (int i = 0; i < 32; ++i) { const int kk = 2 * i + (lane >> 5); scr[kk * 33 + (lane & 31)] = W[(size_t)(k0 + kk) * N + n0 + (lane & 31)]; }
    LDS_WAIT(); asm volatile("" ::: "memory");
    const int c = lane & 7;
#pragma unroll
    for (int j = 0; j < 4; ++j) { const int n = (lane >> 3) + 8 * j; const LAS float* s = scr + (8 * c) * 33 + n;
        v4u o; o.x = pk2(s[0 * 33], s[1 * 33]); o.y = pk2(s[2 * 33], s[3 * 33]); o.z = pk2(s[4 * 33], s[5 * 33]); o.w = pk2(s[6 * 33], s[7 * 33]);
        *(GAS v4u*)(WT + (size_t)(row_off + n0 + n) * K + k0 + 8 * c) = o; }
    LDS_WAIT(); asm volatile("" ::: "memory");
}
__device__ __forceinline__ void conv_matrix(const float* W, int K, int N, bf16* WT, int mode, LAS float* scr, int gw, int ngw, int lane) {
    const int nblk = N / 32, items = (K / 64) * nblk;
    for (int it = gw; it < items; it += ngw) { const int kb = it / nblk, nb = it - kb * nblk, n0 = 32 * nb;
        const int d0 = mode == 0 ? n0 : (256 * (n0 >> 7) + (n0 & 127) + (mode == 2 ? 128 : 0));
        transpose_item(W, K, N, WT, d0 - n0, scr, 64 * kb, n0, lane); }
}
__device__ __forceinline__ void transpose_item8(const float* W, int K, int N, unsigned char* WT, int row_off, LAS float* scr, int k0, int n0, int lane) {
#pragma unroll 8
    for (int i = 0; i < 32; ++i) { const int kk = 2 * i + (lane >> 5); scr[kk * 33 + (lane & 31)] = W[(size_t)(k0 + kk) * N + n0 + (lane & 31)]; }
    LDS_WAIT(); asm volatile("" ::: "memory");
    const int c = lane & 7; const float sc = (float)(1 << pg8::F8_WSHIFT);
#pragma unroll
    for (int j = 0; j < 4; ++j) { const int n = (lane >> 3) + 8 * j; const LAS float* s = scr + (8 * c) * 33 + n;
        v2u o; o.x = pg8::pk4_fp8(s[0 * 33] * sc, s[1 * 33] * sc, s[2 * 33] * sc, s[3 * 33] * sc); o.y = pg8::pk4_fp8(s[4 * 33] * sc, s[5 * 33] * sc, s[6 * 33] * sc, s[7 * 33] * sc);
        *(GAS v2u*)(WT + (size_t)(row_off + n0 + n) * K + k0 + 8 * c) = o; }
    LDS_WAIT(); asm volatile("" ::: "memory");
}
__device__ __forceinline__ void conv_matrix8(const float* W, int K, int N, unsigned char* WT, int mode, LAS float* scr, int gw, int ngw, int lane) {
    const int nblk = N / 32, items = (K / 64) * nblk;
    for (int it = gw; it < items; it += ngw) { const int kb = it / nblk, nb = it - kb * nblk, n0 = 32 * nb;
        const int d0 = mode == 0 ? n0 : (256 * (n0 >> 7) + (n0 & 127) + (mode == 2 ? 128 : 0));
        transpose_item8(W, K, N, WT, d0 - n0, scr, 64 * kb, n0, lane); }
}
__device__ __forceinline__ void store_row_fp8(unsigned char* orow, const f32x4 (&v)[4], int lane) {
    GAS unsigned* o4 = (GAS unsigned*)orow + lane;
#pragma unroll
    for (int j = 0; j < 4; ++j) o4[64 * j] = pg8::pk4_fp8(v[j].x, v[j].y, v[j].z, v[j].w);
}
__device__ __forceinline__ void rms_row(const float* xrow, const f32x4 (&g)[4], f32x4 (&v)[4], int lane) {
    const GAS f32x4* xr = (const GAS f32x4*)xrow + lane; float s2 = 0.f;
#pragma unroll
    for (int j = 0; j < 4; ++j) { v[j] = xr[64 * j]; s2 += (v[j].x * v[j].x + v[j].y * v[j].y) + (v[j].z * v[j].z + v[j].w * v[j].w); }
    const float rstd = 1.f / sqrtf(wave_sum(s2) * (1.f / D) + EPS);
#pragma unroll
    for (int j = 0; j < 4; ++j) v[j] = v[j] * rstd * g[j];
}
__device__ __forceinline__ void store_row_bf16(bf16* orow, const f32x4 (&v)[4], int lane) {
    GAS v2u* o8 = (GAS v2u*)orow + lane;
#pragma unroll
    for (int j = 0; j < 4; ++j) { v2u w; w.x = pk2(v[j].x, v[j].y); w.y = pk2(v[j].z, v[j].w); o8[64 * j] = w; }
}


enum { PH_PRO = 0, PH_L = 20, NPHASE = 1 + 2 * PH_L };
struct Args { const float* in[18]; float* out; unsigned char* ws; int ph_lo, ph_hi; };
static_assert(sizeof(Args) == 18 * 8 + 8 + 8 + 8, "Args has no padding");

__global__ void __launch_bounds__(NWAVES * 64, 2) mega_fwd(Args args) {
    extern __shared__ __attribute__((aligned(16))) unsigned char lds_raw[];
    LAS unsigned char* const lds = (LAS unsigned char*)lds_raw;
    volatile LAS unsigned* const MISC = (volatile LAS unsigned*)(lds + MISC_OFF);
    const int wave_k = __builtin_amdgcn_readfirstlane((int)threadIdx.x >> 6);
    const int G = gridDim.x, bx = blockIdx.x; const int vcu = (G % 8 == 0) ? (bx % 8) * (G / 8) + bx / 8 : bx;
    const int NGW = G * NWAVES;
    unsigned char* const ws = args.ws;
    gu32* const ctl = (gu32*)(ws + WS_CTL);
    for (int u = threadIdx.x; u < (LDS_BYTES - LDSCTL_OFF) / 4; u += NWAVES * 64) ((LAS unsigned*)(lds + LDSCTL_OFF))[u] = 0u;
    __syncthreads();
#if MK_N_LAUNCHES == 1
    XcdBarrier bar = xcd_barrier_post((unsigned*)(ctl + CW_BAR), MISC + 8);
#define SEAM() xcd_barrier(bar)
#else
#define SEAM() do { } while (0)
#endif
    const int lo = args.ph_lo, hi = args.ph_hi;
#define IN(k) (lo <= (k) && (k) < hi)
#ifndef REPG
#define REPG 1
#endif
#ifndef REPA
#define REPA 1
#endif
#ifndef REPA_A
#define REPA_A REPA
#endif
#ifndef REPA_C
#define REPA_C REPA
#endif
#ifndef REPA_B
#define REPA_B REPA
#endif
#ifndef REPT
#define REPT 1
#endif
#define PHASE_IDS() unsigned z0_ = 0u; asm volatile("" : "+s"(z0_)); int tidp = wave_k * 64 + (int)__builtin_amdgcn_mbcnt_hi(~0u, __builtin_amdgcn_mbcnt_lo(~0u, z0_)); asm volatile("" : "+v"(tidp)); const int tid = tidp, lane = tidp & 63, wave = __builtin_amdgcn_readfirstlane(tidp >> 6); const int gw = vcu * NWAVES + wave; LAS float* const scr = (LAS float*)(lds + RING_OFF + wave * 16384); (void)tid; (void)lane; (void)gw; (void)scr
#define INP(i) ([&]() -> const float* { int i_ = (i); asm volatile("" : "+s"(i_)); return args.in[i_]; }())
#define WSP(T, OFF) ([&]() -> T* { size_t o_ = (size_t)(OFF); asm volatile("" : "+s"(o_)); return (T*)(ws + o_); }())
#define x_in INP(0)
#define norm_mix INP(1)
#define w_in INP(2)
#define diff_lambda INP(3)
#define diff_subln INP(4)
#define w_gate INP(5)
#define b_gate INP(6)
#define w_branch INP(7)
#define w_out INP(8)
#define norm_ffn INP(9)
#define w_dg INP(10)
#define w_du INP(11)
#define w_dd INP(12)
#define w_router INP(13)
#define w_mg INP(14)
#define w_mu INP(15)
#define w_md INP(16)
#define norm_final INP(17)
#define xout (args.out)
#define Win_t WSP(bf16, WS_WIN)
#define Wg_t WSP(bf16, WS_WG)
#define Wb_t WSP(bf16, WS_WB)
#define Wo_t WSP(bf16, WS_WO)
#define Wgu_t WSP(bf16, WS_WGU)
#define Wd_t WSP(bf16, WS_WD)
#define Hb WSP(bf16, WS_H)
#define PA WSP(bf16, WS_PA)
#define PB WSP(bf16, WS_PB)
#define PC WSP(bf16, WS_PC)
#define YA WSP(bf16, WS_YA)
#define YC WSP(bf16, WS_YC)
#define YB WSP(bf16, WS_YB)
#define BP WSP(bf16, WS_BP)
#define BST WSP(float, WS_BST)
#define GATES WSP(bf16, WS_GATES)
#define ACT WSP(bf16, WS_ACT)
#define MWgu WSP(bf16, WS_MWGU)
#define MWd WSP(bf16, WS_MWD)
#define HS WSP(bf16, WS_HS)
#define MACT WSP(bf16, WS_MACT)
#define TOKE WSP(int, WS_TOKE)
#define TOKW WSP(float, WS_TOKW)
#define SLOT WSP(int, WS_SLOT)
#define SLW WSP(float, WS_SLW)
#define CNT WSP(int, WS_CNT)
#define MHDR WSP(int, WS_MHDR)
#define Hb8 WSP(unsigned char, WS_H)
#define H8 WSP(unsigned char, WS_H8)
#define Win8 WSP(unsigned char, WS_WIN)
#define Wg8 WSP(unsigned char, WS_WG)
#define Wgu8 WSP(unsigned char, WS_WGU)
#define Wd8 WSP(unsigned char, WS_WD)
#define ACT8 WSP(unsigned char, WS_ACT)
#define MWgu8 WSP(unsigned char, WS8_MWGU)
#define MWd8 WSP(unsigned char, WS8_MWD)
#define HS8 WSP(unsigned char, WS8_HS)
#define YS8 WSP(bf16, WS8_YS)
#define MACT8 WSP(unsigned char, WS8_MACT)

    if (IN(PH_PRO)) { PHASE_IDS();
        for (int L = 0; L < 2; ++L) {
#if MIX_FP8 >= 2
            conv_matrix8(w_in + (size_t)L * D * NPROJ, D, NPROJ, Win8 + (size_t)L * NPROJ * D, 0, scr, gw, NGW, lane);
#else
            conv_matrix(w_in + (size_t)L * D * NPROJ, D, NPROJ, Win_t + (size_t)L * NPROJ * D, 0, scr, gw, NGW, lane);
#endif
            if (MIX_FP8 >= 1 && L == 1) conv_matrix8(w_gate + (size_t)L * D * NGATE, D, NGATE, Wg8 + (size_t)L * NGATE * D * 2, 0, scr, gw, NGW, lane);
            else conv_matrix(w_gate + (size_t)L * D * NGATE, D, NGATE, Wg_t + (size_t)L * NGATE * D, 0, scr, gw, NGW, lane);
            for (int i = 0; i < 3; ++i) conv_matrix(w_branch + (size_t)(L * 3 + i) * BW * D, BW, D, Wb_t + (size_t)(L * 3 + i) * D * BW, 0, scr, gw, NGW, lane);
            conv_matrix(w_out + (size_t)L * D * D, D, D, Wo_t + (size_t)L * D * D, 0, scr, gw, NGW, lane);
        }
#if DENSE_FP8
        conv_matrix8(w_dg, D, DFF, Wgu8, 1, scr, gw, NGW, lane);
        conv_matrix8(w_du, D, DFF, Wgu8, 2, scr, gw, NGW, lane);
        conv_matrix8(w_dd, DFF, D, Wd8, 0, scr, gw, NGW, lane);
#else
        conv_matrix(w_dg, D, DFF, Wgu_t, 1, scr, gw, NGW, lane);
        conv_matrix(w_du, D, DFF, Wgu_t, 2, scr, gw, NGW, lane);
        conv_matrix(w_dd, DFF, D, Wd_t, 0, scr, gw, NGW, lane);
#endif
        {

            f32x4 g[4];
#pragma unroll
            for (int j = 0; j < 4; ++j) g[j] = ((const GAS f32x4*)(norm_mix) + lane)[64 * j];
            for (int m = gw; m < M; m += NGW) { f32x4 v[4]; rms_row(x_in + (size_t)m * D, g, v, lane);
#if MIX_FP8 < 2
                store_row_bf16(Hb + (size_t)m * D, v, lane);
#endif
                if (false) store_row_fp8(H8 + (size_t)m * D, v, lane);
            }
        }
        SEAM();
    }

    for (int L = 0; L < 2; ++L) {
        const int P = 1 + L * PH_L;
        const float* xres = (L == 0) ? x_in : xout;
        if (L == 1 && IN(P + 0)) { PHASE_IDS();
            f32x4 g[4];
#pragma unroll
            for (int j = 0; j < 4; ++j) g[j] = ((const GAS f32x4*)(norm_mix + L * D) + lane)[64 * j];
            for (int m = gw; m < M; m += NGW) { f32x4 v[4]; rms_row(xres + (size_t)m * D, g, v, lane);
#if MIX_FP8 < 2
                store_row_bf16(Hb + (size_t)m * D, v, lane);
#endif
                if (MIX_FP8 >= 1 && L == 1) store_row_fp8(H8 + (size_t)m * D, v, lane);
            }
            SEAM();
        }
        if (IN(P + 1)) { PHASE_IDS();
#if MIX_FP8 >= 2
            pg8::Gemm g{(const bf16*)H8, (const bf16*)(Win8 + (size_t)L * NPROJ * D), D / 2}; pg8::StaticOrder S; S.init(M, NPROJ, D / 2, G, bx);
            pg8::EpiProj E{PA, (size_t)(WS_PB - WS_PA) / 2, C2, pg8::F8_WINV};
            pg8::gemm_phase<pg8::EpiProj, pg8::StaticOrder, true, true, true>(lds + RING_OFF, g, S, E, tidp);
#else
            pg8::Gemm g{Hb, Win_t + (size_t)L * NPROJ * D, D}; pg8::StaticOrder S; S.init(M, NPROJ, D, G, bx);
            pg8::EpiProj E{PA, (size_t)(WS_PB - WS_PA) / 2, C2, 1.f};
            for (int rep_ = 0; rep_ < REPG; ++rep_) { int tq_ = tidp; asm volatile("" : "+v"(tq_)); pg8::gemm_phase<pg8::EpiProj, pg8::StaticOrder, true, true>(lds + RING_OFF, g, S, E, tq_); }
#endif

            SEAM();
        }
        if (IN(P + 2)) { PHASE_IDS();
            const float lam_init = 0.8f - 0.6f * expf(-0.3f * (float)L);
            float lam;
            { const float* lv = diff_lambda + L * 256; float s01 = lv[lane] * lv[64 + lane], s23 = lv[128 + lane] * lv[192 + lane];
              s01 += att::swz_xor<1>(s01); s01 += att::swz_xor<2>(s01); s01 += att::swz_xor<4>(s01); s01 += att::swz_xor<8>(s01); s01 += att::swz_xor<16>(s01); s01 += att::xhalf(s01, lane >> 5);
              s23 += att::swz_xor<1>(s23); s23 += att::swz_xor<2>(s23); s23 += att::swz_xor<4>(s23); s23 += att::swz_xor<8>(s23); s23 += att::swz_xor<16>(s23); s23 += att::xhalf(s23, lane >> 5);
              lam = expf(s01) - expf(s23) + lam_init; }
            { LAS int* qs = (LAS int*)(lds + LDSCTL_OFF + 512); const int grp = bx & 7;
              gu32* km = ctl + CW_KM + (L * 8 + grp) * 64; gu32* kc = ctl + CW_KC + (L * 8 + grp) * 64;
              { const int r0 = grp * SEQ + (bx >> 3) * 128 + wave * 16; float mx = 0.f;
                for (int r = 0; r < 16; ++r) { const v4u w = *(const GAS v4u*)(PA + (size_t)(r0 + r) * 1536 + 512 + lane * 8);
                    float ss = bfl(w.x) * bfl(w.x) + bfh(w.x) * bfh(w.x) + bfl(w.y) * bfl(w.y) + bfh(w.y) * bfh(w.y) + bfl(w.z) * bfl(w.z) + bfh(w.z) * bfh(w.z) + bfl(w.w) * bfl(w.w) + bfh(w.w) * bfh(w.w);
                    ss += att::swz_xor<1>(ss); ss += att::swz_xor<2>(ss); ss += att::swz_xor<4>(ss); mx = fmaxf(mx, ss); }
                if ((lane & 7) == 0) __hip_atomic_fetch_max(km + (lane >> 3), __float_as_uint(mx), RLX_AGENT);
                VM_WAIT(); __syncthreads();
                if (tid == 0) { __hip_atomic_fetch_add(kc, 1u, RLX_AGENT); unsigned sp = 0; while (__hip_atomic_load(kc, RLX_AGENT) < 32u && ++sp < (1u << 22)) __builtin_amdgcn_s_sleep(2);
                    qs[2] = (sp < (1u << 22)) ? 1 : 0; }
                __syncthreads(); }
              const bool kok = qs[2] != 0;
              gu32* ctrA = ctl + CW_Q + ((L * 2 + 0) * 8 + grp) * 64; gu32* ctrC = ctl + CW_Q + ((L * 2 + 1) * 8 + grp) * 64;
              for (int rep_ = 0; rep_ < REPA_A; ++rep_)
              for (;;) {
                  if (tid == 0) qs[0] = (int)__hip_atomic_fetch_add(ctrA + rep_ * 8192, 1u, RLX_AGENT);
                  __syncthreads();
                  const int u = __builtin_amdgcn_readfirstlane(qs[0]); if (u >= 128) break;
                  float kn0 = INFINITY, kn1 = INFINITY;
                  if (kok) { kn0 = sqrtf(__uint_as_float(__hip_atomic_load(km + 2 * (u & 3), RLX_AGENT))); kn1 = sqrtf(__uint_as_float(__hip_atomic_load(km + 2 * (u & 3) + 1, RLX_AGENT))); }
                  att::diff_unit(grp, u & 3, 31 - (u >> 2), PA, YA, lam, 1.f - lam_init, diff_subln + L * 128, kn0, kn1, (LAS char*)(lds + RING_OFF), tidp);
              }
              __syncthreads();
              for (int rep_ = 0; rep_ < REPA_C; ++rep_)
              for (;;) {
                  if (tid == 0) qs[1] = (int)__hip_atomic_fetch_add(ctrC + rep_ * 8192, 1u, RLX_AGENT);
                  __syncthreads();
                  const int u = __builtin_amdgcn_readfirstlane(qs[1]); if (u >= 128) break;
                  att::sb_unit(grp, u & 7, 15 - (u >> 3), PC, YC, (LAS char*)(lds + RING_OFF), tidp);
              }
            }
            SEAM();
        }
        if (IN(P + 3)) { PHASE_IDS();
            for (int rep_ = 0; rep_ < REPA_B; ++rep_) {
            const int bh = vcu >> 2, sub = vcu & 3;
            for (int i = 0; i < 12; ++i) { const int j = sub * 12 + i; int pat, res, blk, dil;
                if (j < 16) { pat = 0; dil = 1; res = 0; blk = j; } else if (j < 32) { pat = 1; dil = 4; res = (j - 16) >> 2; blk = (j - 16) & 3; } else { pat = 2; dil = 16; res = j - 32; blk = 0; }

 att::dil_unit(bh >> 3, bh & 7, dil, res, blk, PB, BP + (size_t)pat * M * BW, BST + (size_t)pat * M * 16, (LAS char*)(lds + RING_OFF), tidp);
 }
            }
            SEAM();
        }
        if (IN(P + 4)) { PHASE_IDS();
            for (int m = gw; m < M; m += NGW) {
                const int hd = lane >> 3; f32x2 st[3]; float mx = -INFINITY;
#pragma unroll
                for (int p = 0; p < 3; ++p) { st[p] = *(const GAS f32x2*)(BST + ((size_t)p * M + m) * 16 + hd * 2); mx = fmaxf(mx, st[p].x); }
                float wgt[3], wsum = 0.f;
#pragma unroll
                for (int p = 0; p < 3; ++p) { wgt[p] = __builtin_amdgcn_exp2f(st[p].x - mx) * st[p].y; wsum += wgt[p]; }
                const float inv = 1.f / wsum; float acc[8];
#pragma unroll
                for (int k = 0; k < 8; ++k) acc[k] = 0.f;
#pragma unroll
                for (int p = 0; p < 3; ++p) { const v4u w = *(const GAS v4u*)(BP + ((size_t)p * M + m) * BW + lane * 8); const float f = wgt[p] * inv;
                    acc[0] += f * bfl(w.x); acc[1] += f * bfh(w.x); acc[2] += f * bfl(w.y); acc[3] += f * bfh(w.y); acc[4] += f * bfl(w.z); acc[5] += f * bfh(w.z); acc[6] += f * bfl(w.w); acc[7] += f * bfh(w.w); }
                v4u o; o.x = pk2(acc[0], acc[1]); o.y = pk2(acc[2], acc[3]); o.z = pk2(acc[4], acc[5]); o.w = pk2(acc[6], acc[7]);
                *(GAS v4u*)(YB + (size_t)m * BW + lane * 8) = o;
            }
            VM_WAIT(); __syncthreads();
            if (MIX_FP8 >= 1 && L == 1) {
                pg8::Gemm g{(const bf16*)H8, (const bf16*)(Wg8 + (size_t)L * NGATE * D * 2), D / 2}; pg8::StaticOrder S; S.init(M, NGATE, D / 2, G, bx);
                pg8::EpiGate E{GATES, NGATE, b_gate + L * NGATE, pg8::F8_WINV};
                pg8::gemm_phase<pg8::EpiGate, pg8::StaticOrder, true, true, true>(lds + RING_OFF, g, S, E, tidp);
            } else {
                pg8::Gemm g{Hb, Wg_t + (size_t)L * NGATE * D, D}; pg8::StaticOrder S; S.init(M, NGATE, D, G, bx);
                pg8::EpiGate E{GATES, NGATE, b_gate + L * NGATE, 1.f};
                for (int rep_ = 0; rep_ < REPG; ++rep_) { int tq_ = tidp; asm volatile("" : "+v"(tq_)); pg8::gemm_phase<pg8::EpiGate, pg8::StaticOrder, true, true>(lds + RING_OFF, g, S, E, tq_); }
            }

            SEAM();
        }
        if (IN(P + 5)) { PHASE_IDS();
            pg8::Gemm g{YA, Wb_t + (size_t)L * 3 * D * BW, BW}; pg8::MergeOrder S; S.b.init(M, D, BW, G, bx);
            S.as = (long)(WS_YB - WS_YA); S.bs = (long)D * BW * 2;
            pg8::EpiMerge E{GATES, Hb};

 for (int rep_ = 0; rep_ < ((true) ? REPG : 1); ++rep_) { int tq_ = tidp; asm volatile("" : "+v"(tq_));  pg8::gemm_phase<pg8::EpiMerge, pg8::MergeOrder, true, true>(lds + RING_OFF, g, S, E, tq_); }

            SEAM();
        }
        if (IN(P + 6)) { PHASE_IDS();
            pg8::Gemm g{Hb, Wo_t + (size_t)L * D * D, D}; pg8::StaticOrder S; S.init(M, D, D, G, bx);
            pg8::EpiRes E{xres, xout, 1.f};

 for (int rep_ = 0; rep_ < ((L == 0) ? REPG : 1); ++rep_) { int tq_ = tidp; asm volatile("" : "+v"(tq_));  pg8::gemm_phase<pg8::EpiRes, pg8::StaticOrder, true, true>(lds + RING_OFF, g, S, E, tq_); }

            SEAM();
        }
        if (L == 0) {
            if (IN(P + 7)) { PHASE_IDS();
                f32x4 g[4];
#pragma unroll
                for (int j = 0; j < 4; ++j) g[j] = ((const GAS f32x4*)(norm_ffn + L * D) + lane)[64 * j];
#if DENSE_FP8
                for (int m = gw; m < M; m += NGW) { f32x4 v[4]; rms_row(xout + (size_t)m * D, g, v, lane); store_row_fp8(Hb8 + (size_t)m * D, v, lane); }
#else
                for (int m = gw; m < M; m += NGW) { f32x4 v[4]; rms_row(xout + (size_t)m * D, g, v, lane); store_row_bf16(Hb + (size_t)m * D, v, lane); }
#endif
                SEAM();
            }
            if (IN(P + 8)) { PHASE_IDS();
#if DENSE_FP8
                pg8::Gemm g{(const bf16*)Hb8, (const bf16*)Wgu8, D / 2}; pg8::StaticOrder S; S.init(M, 2 * DFF, D / 2, G, bx);
                pg8::EpiSwigluF8 E{ACT8, DFF};
                for (int rep_ = 0; rep_ < REPG; ++rep_) { int tq_ = tidp; asm volatile("" : "+v"(tq_)); pg8::gemm_phase<pg8::EpiSwigluF8, pg8::StaticOrder, true, true, true>(lds + RING_OFF, g, S, E, tq_); }
#else
                pg8::Gemm g{Hb, Wgu_t, D}; pg8::StaticOrder S; S.init(M, 2 * DFF, D, G, bx);
                pg8::EpiSwiglu E{ACT, DFF};
                for (int rep_ = 0; rep_ < REPG; ++rep_) { int tq_ = tidp; asm volatile("" : "+v"(tq_)); pg8::gemm_phase<pg8::EpiSwiglu, pg8::StaticOrder, true, true>(lds + RING_OFF, g, S, E, tq_); }
#endif

                SEAM();
            }
            if (IN(P + 9)) { PHASE_IDS();
#if DENSE_FP8
                pg8::EpiRes E{xout, xout, pg8::F8_WINV};
                pg8::Gemm g{(const bf16*)ACT8, (const bf16*)Wd8, DFF / 2}; pg8::StaticOrder S; S.init(M, D, DFF / 2, G, bx);
                pg8::gemm_phase<pg8::EpiRes, pg8::StaticOrder, true, true, true>(lds + RING_OFF, g, S, E, tidp);
#else
                pg8::EpiRes E{xout, xout, 1.f};
                pg8::Gemm g{ACT, Wd_t, DFF}; pg8::StaticOrder S; S.init(M, D, DFF, G, bx);
                pg8::gemm_phase<pg8::EpiRes, pg8::StaticOrder, true, true>(lds + RING_OFF, g, S, E, tidp);
#endif

                SEAM();
            }
        } else {
            if (IN(P + 7)) { PHASE_IDS();
                LAS float* wr = (LAS float*)(lds + RING_OFF);
                LAS int* cl = (LAS int*)(lds + RING_OFF + 32768);
                for (int u = tid; u < D * NEXP / 4; u += NWAVES * 64) ((LAS f32x4*)wr)[u] = ((const GAS f32x4*)w_router)[u];
                if (tid < NEXP) cl[tid] = 0;
                __syncthreads();
                f32x4 g[4];
#pragma unroll
                for (int j = 0; j < 4; ++j) g[j] = ((const GAS f32x4*)(norm_ffn + L * D) + lane)[64 * j];
                for (int k = 0; k < 16; ++k) { const int m = bx * 128 + wave + 8 * k;
                    f32x4 v[4]; rms_row(xout + (size_t)m * D, g, v, lane);
#if FFN_FP8
                    store_row_fp8(Hb8 + (size_t)m * D, v, lane);
#else
                    store_row_bf16(Hb + (size_t)m * D, v, lane);
#endif
                    float lg[NEXP];
#pragma unroll
                    for (int e = 0; e < NEXP; ++e) lg[e] = 0.f;
#pragma unroll
                    for (int j = 0; j < 4; ++j)
#pragma unroll
                        for (int i = 0; i < 4; ++i) { const LAS f32x4* wp = (const LAS f32x4*)(wr + (size_t)(4 * lane + 256 * j + i) * NEXP); const f32x4 wa = wp[0], wb = wp[1]; const float xv = v[j][i];
                            lg[0] += xv * wa.x; lg[1] += xv * wa.y; lg[2] += xv * wa.z; lg[3] += xv * wa.w; lg[4] += xv * wb.x; lg[5] += xv * wb.y; lg[6] += xv * wb.z; lg[7] += xv * wb.w; }
#pragma unroll
                    for (int e = 0; e < NEXP; ++e) lg[e] = wave_sum(lg[e]);
                    int e1 = 0; float v1 = lg[0];
#pragma unroll
                    for (int e = 1; e < NEXP; ++e) if (lg[e] > v1) { v1 = lg[e]; e1 = e; }
                    int e2 = -1; float v2 = -INFINITY;
#pragma unroll
                    for (int e = 0; e < NEXP; ++e) if (e != e1 && lg[e] > v2) { v2 = lg[e]; e2 = e; }
                    const float w1 = 1.f / (1.f + expf(v2 - v1));
                    if (lane == 0) { TOKE[m] = e1 | (e2 << 8); TOKW[2 * m] = w1; TOKW[2 * m + 1] = 1.f - w1; __hip_atomic_fetch_add(cl + e1, 1, __ATOMIC_RELAXED, __HIP_MEMORY_SCOPE_WORKGROUP); __hip_atomic_fetch_add(cl + e2, 1, __ATOMIC_RELAXED, __HIP_MEMORY_SCOPE_WORKGROUP); }
                }
                __syncthreads();
                if (tid < NEXP) CNT[bx * NEXP + tid] = cl[tid];
                __syncthreads();
                for (int e = 0; e < NEXP; ++e) {
#if FFN_FP8
                    conv_matrix8(w_mg + (size_t)e * D * DFX, D, DFX, MWgu8 + (size_t)e * 2 * DFX * D, 1, scr, gw, NGW, lane);
                    conv_matrix8(w_mu + (size_t)e * D * DFX, D, DFX, MWgu8 + (size_t)e * 2 * DFX * D, 2, scr, gw, NGW, lane);
                    conv_matrix8(w_md + (size_t)e * DFX * D, DFX, D, MWd8 + (size_t)e * D * DFX, 0, scr, gw, NGW, lane);
#else
                    conv_matrix(w_mg + (size_t)e * D * DFX, D, DFX, MWgu + (size_t)e * 2 * DFX * D, 1, scr, gw, NGW, lane);
                    conv_matrix(w_mu + (size_t)e * D * DFX, D, DFX, MWgu + (size_t)e * 2 * DFX * D, 2, scr, gw, NGW, lane);
                    conv_matrix(w_md + (size_t)e * DFX * D, DFX, D, MWd + (size_t)e * D * DFX, 0, scr, gw, NGW, lane);
#endif
                }
                SEAM();
            }
            if (IN(P + 8)) { PHASE_IDS();
                LAS int* C = (LAS int*)(lds + RING_OFF);
                LAS int* TB = (LAS int*)(lds + RING_OFF + 8192);
                LAS int* SL = (LAS int*)(lds + RING_OFF + 8192 + 256);
                for (int u = tid; u < 256 * NEXP; u += NWAVES * 64) C[u] = CNT[u];
                __syncthreads();
                { const int e = wave; int tot = 0, pre = 0;
#pragma unroll
                  for (int q = 0; q < 4; ++q) { const int i = 4 * lane + q; const int cv = C[i * NEXP + e]; tot += cv; pre += (i < bx) ? cv : 0; }
#pragma unroll
                  for (int o = 1; o < 64; o <<= 1) { tot += __shfl_xor(tot, o); pre += __shfl_xor(pre, o); }
                  if (lane == 0) { TB[e] = pre; TB[8 + e] = tot; } }
                __syncthreads();
                if (tid == 0) { int base = 0, cum = 0;
                    for (int e = 0; e < NEXP; ++e) { TB[16 + e] = base; const int nt = (TB[8 + e] + 255) >> 8; base += nt * 256; cum += nt; if (bx == 0) MHDR[1 + e] = cum; }
                    if (bx == 0) MHDR[0] = cum; }
                __syncthreads();
                if (wave == 0) {
                    const int t0 = bx * 128 + 2 * lane; const int ea = TOKE[t0], eb = TOKE[t0 + 1];
                    int pe[4] = {ea & 255, ea >> 8, eb & 255, eb >> 8}; int slot[4] = {0, 0, 0, 0};
#pragma unroll
                    for (int e = 0; e < NEXP; ++e) { int mine = 0;
#pragma unroll
                        for (int q = 0; q < 4; ++q) mine += (pe[q] == e) ? 1 : 0;
                        int inc = mine;
#pragma unroll
                        for (int o = 1; o < 64; o <<= 1) { const int t = __shfl_up(inc, o); if (lane >= o) inc += t; }
                        int run = TB[16 + e] + TB[e] + inc - mine;
#pragma unroll
                        for (int q = 0; q < 4; ++q) if (pe[q] == e) { slot[q] = run; ++run; } }
                    const f32x4 wv = *(const GAS f32x4*)(TOKW + 2 * t0);
                    SL[4 * lane + 0] = slot[0]; SL[4 * lane + 1] = slot[1]; SL[4 * lane + 2] = slot[2]; SL[4 * lane + 3] = slot[3];
                    { v4u sv; sv.x = (unsigned)slot[0]; sv.y = (unsigned)slot[1]; sv.z = (unsigned)slot[2]; sv.w = (unsigned)slot[3]; *(GAS v4u*)(SLOT + 2 * t0) = sv; }
                    SLW[slot[0]] = wv.x; SLW[slot[1]] = wv.y; SLW[slot[2]] = wv.z; SLW[slot[3]] = wv.w;
                }
                __syncthreads();
                for (int k = 0; k < 16; ++k) { const int tl = wave + 8 * k; const int m = bx * 128 + tl; const int s0 = SL[2 * tl], s1 = SL[2 * tl + 1];
#if FFN_FP8
                    const v4u a = ((const GAS v4u*)(Hb8 + (size_t)m * D))[lane];
                    ((GAS v4u*)(HS8 + (size_t)s0 * D))[lane] = a; ((GAS v4u*)(HS8 + (size_t)s1 * D))[lane] = a; }
#else
                    const GAS v4u* src = (const GAS v4u*)(Hb + (size_t)m * D) + lane; const v4u a = src[0], b = src[64];
                    GAS v4u* d0 = (GAS v4u*)(HS + (size_t)s0 * D) + lane; GAS v4u* d1 = (GAS v4u*)(HS + (size_t)s1 * D) + lane;
                    d0[0] = a; d0[64] = b; d1[0] = a; d1[64] = b; }
#endif
                SEAM();
            }
            {
                int nt_all = 0, c0 = 0, c1 = 0, c2 = 0, c3 = 0, c4 = 0, c5 = 0, c6 = 0;
                if (hi > P + 9 && lo < P + 19) { const int* hd = MHDR;
                    nt_all = __builtin_amdgcn_readfirstlane(hd[0]); c0 = __builtin_amdgcn_readfirstlane(hd[1]); c1 = __builtin_amdgcn_readfirstlane(hd[2]); c2 = __builtin_amdgcn_readfirstlane(hd[3]);
                    c3 = __builtin_amdgcn_readfirstlane(hd[4]); c4 = __builtin_amdgcn_readfirstlane(hd[5]); c5 = __builtin_amdgcn_readfirstlane(hd[6]); c6 = __builtin_amdgcn_readfirstlane(hd[7]); }
                if (nt_all > MOE_MAX_TILES) nt_all = MOE_MAX_TILES;
                for (int ch = 0; ch < MOE_MAX_CH; ++ch) {
                    const int t0 = ch * MOE_CH_TILES; int nt = nt_all - t0; if (nt > MOE_CH_TILES) nt = MOE_CH_TILES;
                    if (nt <= 0) break;
                    if (IN(P + 9 + 2 * ch)) { PHASE_IDS();
#if FFN_FP8
                        pg8::Gemm g{(const bf16*)HS8, (const bf16*)MWgu8, D / 2}; pg8::MoeOrder S{t0, nt, 2 * DFX / 256, nt * (2 * DFX / 256), G, bx, (long)256 * D, (long)256 * D, (long)2 * DFX * D, c0, c1, c2, c3, c4, c5, c6, false, true};
                        pg8::EpiSwigluF8 E{MACT8, DFX};
                        pg8::gemm_phase<pg8::EpiSwigluF8, pg8::MoeOrder, true, true, true>(lds + RING_OFF, g, S, E, tidp);
#else
                        pg8::Gemm g{HS, MWgu, D}; pg8::MoeOrder S{t0, nt, 2 * DFX / 256, nt * (2 * DFX / 256), G, bx, (long)256 * D * 2, (long)256 * D * 2, (long)2 * DFX * D * 2, c0, c1, c2, c3, c4, c5, c6, false, true};
                        pg8::EpiSwiglu E{MACT, DFX};
                        pg8::gemm_phase<pg8::EpiSwiglu, pg8::MoeOrder, true, true>(lds + RING_OFF, g, S, E, tidp);
#endif

                        SEAM();
                    }
                    if (IN(P + 10 + 2 * ch)) { PHASE_IDS();
#if FFN_FP8
                        pg8::Gemm g{(const bf16*)MACT8, (const bf16*)MWd8, DFX / 2}; pg8::MoeOrder S{t0, nt, D / 256, nt * (D / 256), G, bx, (long)256 * DFX, (long)256 * DFX, (long)D * DFX, c0, c1, c2, c3, c4, c5, c6, true, false};
                        pg8::EpiMoeDown E{YS8, SLW, pg8::F8_WINV};
                        pg8::gemm_phase<pg8::EpiMoeDown, pg8::MoeOrder, true, true, true>(lds + RING_OFF, g, S, E, tidp);
#else
                        pg8::Gemm g{MACT, MWd, DFX}; pg8::MoeOrder S{t0, nt, D / 256, nt * (D / 256), G, bx, (long)256 * DFX * 2, (long)256 * DFX * 2, (long)D * DFX * 2, c0, c1, c2, c3, c4, c5, c6, true, false};
                        pg8::EpiMoeDown E{HS, SLW, 1.f};
                        pg8::gemm_phase<pg8::EpiMoeDown, pg8::MoeOrder, true, true>(lds + RING_OFF, g, S, E, tidp);
#endif

                        SEAM();
                    }
                }
            }
            if (IN(P + 19)) { PHASE_IDS();
                f32x4 g[4];
#pragma unroll
                for (int j = 0; j < 4; ++j) g[j] = ((const GAS f32x4*)norm_final + lane)[64 * j];
                unsigned bad = 0u;
#if MK_N_LAUNCHES == 1
                bad = __hip_atomic_load(ctl + CW_BAR + XB_TMO, RLX_AGENT);
#endif
                for (int m = gw; m < M; m += NGW) {
                    const int s0 = SLOT[2 * m], s1 = SLOT[2 * m + 1];
                    const GAS f32x4* xr = (const GAS f32x4*)(xout + (size_t)m * D) + lane;
#if FFN_FP8
                    const GAS v2u* y0 = (const GAS v2u*)(YS8 + (size_t)s0 * D) + lane; const GAS v2u* y1 = (const GAS v2u*)(YS8 + (size_t)s1 * D) + lane;
#else
                    const GAS v2u* y0 = (const GAS v2u*)(HS + (size_t)s0 * D) + lane; const GAS v2u* y1 = (const GAS v2u*)(HS + (size_t)s1 * D) + lane;
#endif

                    f32x4 v[4]; float s2 = 0.f;
#pragma unroll
                    for (int j = 0; j < 4; ++j) { const v2u a = y0[64 * j], b = y1[64 * j]; f32x4 t = xr[64 * j];

t.x += bfl(a.x) + bfl(b.x); t.y += bfh(a.x) + bfh(b.x); t.z += bfl(a.y) + bfl(b.y); t.w += bfh(a.y) + bfh(b.y);
 v[j] = t;
                        s2 += (t.x * t.x + t.y * t.y) + (t.z * t.z + t.w * t.w); }
                    const float rstd = 1.f / sqrtf(wave_sum(s2) * (1.f / D) + EPS);
                    GAS f32x4* orow = (GAS f32x4*)(xout + (size_t)m * D) + lane;
#pragma unroll
                    for (int j = 0; j < 4; ++j) { f32x4 o = v[j] * rstd * g[j];
                        if (bad) { const float q = __builtin_nanf(""); o = (f32x4){q, q, q, q}; } orow[64 * j] = o; }
                }
            }
        }
    }
#undef IN
#undef SEAM
}

extern "C" void kernel_launch(void* const* d_in, const int* in_sizes, int n_in, void* d_out, int out_size, void* d_ws, size_t ws_size, hipStream_t stream) {
    static int grid = 0;
    if (grid == 0) {
        if (n_in != 18 || in_sizes[0] != M * D || out_size != M * D || ws_size < WS_END) { fprintf(stderr, "kernel_launch: unexpected shapes (n_in %d, in0 %d, out %d, ws %zu < %zu); nothing launched\n", n_in, n_in > 0 ? in_sizes[0] : -1, out_size, ws_size, (size_t)WS_END); grid = -1; return; }
        int dev = 0, cus = 0, per_cu = 0;
        if (hipGetDevice(&dev) != hipSuccess || hipDeviceGetAttribute(&cus, hipDeviceAttributeMultiprocessorCount, dev) != hipSuccess) { grid = -1; return; }
        if (hipFuncSetAttribute((const void*)mega_fwd, hipFuncAttributeMaxDynamicSharedMemorySize, LDS_BYTES) != hipSuccess) { fprintf(stderr, "kernel_launch: hipFuncSetAttribute failed\n"); grid = -1; return; }
        if (hipOccupancyMaxActiveBlocksPerMultiprocessor(&per_cu, (const void*)mega_fwd, NWAVES * 64, LDS_BYTES) != hipSuccess || per_cu < 1) fprintf(stderr, "kernel_launch: occupancy query reports %d workgroups per CU\n", per_cu);
        (void)hipGetLastError();
        grid = cus;
        if (grid != 256) { fprintf(stderr, "kernel_launch: built for 256 CUs, device has %d; nothing launched\n", cus); grid = -1; return; }
    }
    if (grid < 0) return;
    if (hipMemsetAsync((char*)d_ws + WS_CTL, 0, CTL_ZERO_BYTES, stream) != hipSuccess) return;
    Args a{};
    for (int i = 0; i < 18; ++i) a.in[i] = (const float*)d_in[i];
    a.out = (float*)d_out; a.ws = (unsigned char*)d_ws;
#if MK_N_LAUNCHES == 1
    a.ph_lo = 0; a.ph_hi = NPHASE;
    hipLaunchKernelGGL(mega_fwd, dim3(grid), dim3(NWAVES * 64), LDS_BYTES, stream, a);
#else
    for (int p = 0; p < NPHASE; ++p) {
        const int r = (p - 1) % PH_L, L = (p - 1) / PH_L;
        if (p > 0 && L == 0 && r >= 10) continue;
        a.ph_lo = p; a.ph_hi = p + 1;
        hipLaunchKernelGGL(mega_fwd, dim3(grid), dim3(NWAVES * 64), LDS_BYTES, stream, a);
    }
#endif
}
```

```cpp
#include <hip/hip_runtime.h>
#include <cstdio>
#include <cstdint>

#ifndef MK_N_LAUNCHES
#define MK_N_LAUNCHES 1
#endif

namespace pg8 {
#define PG8_LAS __attribute__((address_space(3)))
typedef unsigned short bf16_t;
typedef short bf16x8 __attribute__((ext_vector_type(8)));
typedef float f32x4 __attribute__((ext_vector_type(4)));
typedef float f32x2 __attribute__((ext_vector_type(2)));
typedef unsigned u32x4 __attribute__((ext_vector_type(4)));
typedef int v8i32 __attribute__((ext_vector_type(8)));
typedef unsigned u32x2 __attribute__((ext_vector_type(2)));
constexpr int F8_WSHIFT = 6;
constexpr float F8_WINV = 1.f / (float)(1 << F8_WSHIFT);
constexpr int BM = 256, BK = 64, HALF = 128, HTB = HALF * BK * 2  , STAGE_BYTES = 8 * HTB, NXCD = 8, WGM = 8;

__host__ __device__ __forceinline__ int lds_byte(int r, int c) { const int st = (r >> 4) * 2 + (c >> 5), rr = r & 15, cc = c & 31, ob = rr * 64 + cc * 2; return st * 1024 + (ob ^ (((ob >> 9) & 1) << 5)); }
__host__ __device__ __forceinline__ void stage_rc(int b, int& R, int& C) { const int st = b / 1024, sb = b % 1024, swz = sb ^ (((sb >> 9) & 1) << 5); R = (st >> 1) * 16 + swz / 64; C = (st & 1) * 32 + (swz % 64) / 2; }
__host__ __device__ __forceinline__ int perm32(int rho) { const int n = rho >> 4, i = rho & 15; return 8 * (i >> 2) + 4 * n + (i & 3); }

struct Unit { int pm, pn, om, tag; long ao, bo; };
struct Gemm { const bf16_t* A; const bf16_t* Bt; int K; };

__device__ __forceinline__ void tile_of(int wgid, int nwg, int nM, int nN, int& pm, int& pn) {
    { const int q = nwg / NXCD, r = nwg % NXCD, xcd = wgid % NXCD, off = wgid / NXCD; wgid = (xcd < r ? xcd * (q + 1) : r * (q + 1) + (xcd - r) * q) + off; }
    const int nig = WGM * nN, gid = wgid / nig, fm = gid * WGM, gsz = (nM - fm) < WGM ? (nM - fm) : WGM;
    pm = fm + ((wgid % nig) % gsz); pn = (wgid % nig) / gsz;
}
struct StaticOrder {
    int nM, nN, nwg, G, c; long tst;
    __device__ void init(int M, int N, int K, int G_, int c_) { nM = M / BM; nN = N / BM; nwg = nM * nN; G = G_; c = c_; tst = (long)BM * K * 2; }
    __device__ __forceinline__ bool next(int i, Unit& u) const {
        const long L = (long)i * G + c; if (L >= nwg) return false;
        tile_of((int)L, nwg, nM, nN, u.pm, u.pn); u.om = u.pm; u.tag = 0; u.ao = (long)u.pm * tst; u.bo = (long)u.pn * tst; return true;
    }
    __device__ __forceinline__ void a_ready(const Unit&) const {}
    __device__ __forceinline__ void done(const Unit&) const {}
};
struct MergeOrder {
    StaticOrder b; long as, bs;
    __device__ __forceinline__ bool next(int i, Unit& u) const {
        const int ti = i / 3, tg = i - 3 * ti; if (!b.next(ti, u)) return false;
        u.tag = tg; u.ao += (long)tg * as; u.bo += (long)tg * bs; return true;
    }
    __device__ __forceinline__ void a_ready(const Unit&) const {}
    __device__ __forceinline__ void done(const Unit&) const {}
};
struct MoeOrder {
    int t0, nt, nN, nwg, G, c; long tA, tB, eB; int c0, c1, c2, c3, c4, c5, c6; bool a_local, o_local;
    __device__ __forceinline__ bool next(int i, Unit& u) const {
        const long L = (long)i * G + c; if (L >= nwg) return false;
        int pl, pn; tile_of((int)L, nwg, nt, nN, pl, pn);
        const int gt = t0 + pl; const int e = (gt >= c0) + (gt >= c1) + (gt >= c2) + (gt >= c3) + (gt >= c4) + (gt >= c5) + (gt >= c6);
        u.pm = gt; u.pn = pn; u.tag = e; u.om = o_local ? pl : gt; u.ao = (long)(a_local ? pl : gt) * tA; u.bo = (long)e * eB + (long)pn * tB; return true;
    }
    __device__ __forceinline__ void a_ready(const Unit&) const {}
    __device__ __forceinline__ void done(const Unit&) const {}
};

typedef __bf16 bf16x2_t __attribute__((ext_vector_type(2)));
__device__ __forceinline__ unsigned cvt_pk_bf16(float lo, float hi) { f32x2 v = {lo, hi}; bf16x2_t b = __builtin_convertvector(v, bf16x2_t); return __builtin_bit_cast(unsigned, b); }
__device__ __forceinline__ float bf_lo(unsigned w) { return __uint_as_float(w << 16); }
__device__ __forceinline__ float bf_hi(unsigned w) { return __uint_as_float(w & 0xffff0000u); }
__device__ __forceinline__ float sigm(float x) { return __builtin_amdgcn_rcpf(1.0f + __builtin_amdgcn_exp2f(-1.4426950408889634f * x)); }
__device__ __forceinline__ u32x4 pack8(f32x4 v0, f32x4 v1) { u32x4 w; w.x = cvt_pk_bf16(v0[0], v0[1]); w.y = cvt_pk_bf16(v0[2], v0[3]); w.z = cvt_pk_bf16(v1[0], v1[1]); w.w = cvt_pk_bf16(v1[2], v1[3]); return w; }

struct EpiProj {
    static constexpr bool PERM = true, AFTER_DRAIN = false;
    bf16_t* O; size_t split_stride; float qscale, wscale;
    __device__ __forceinline__ void operator()(const f32x4 (&acc)[2][2][4][2], const Unit& u, int wr, int wc, int fr, int fq) const {
        const int t = u.pn / 6, lt = u.pn - 6 * t; bf16_t* base = O + (size_t)t * split_stride; const float sc = (lt < 2 ? qscale : 1.f) * wscale;
        const int row0 = u.om * BM + wr * 64 + fr, col0 = lt * BM + wc * 32 + 8 * fq;
        if (t == 1) {
#pragma unroll
            for (int ai = 0; ai < 2; ++ai)
#pragma unroll
                for (int m = 0; m < 4; ++m) { const int row = row0 + ai * HALF + m * 16;
#pragma unroll
                    for (int bj = 0; bj < 2; ++bj) { const int lc = col0 + bj * HALF; bf16_t* p;
                        if (lt < 2) p = base + (size_t)row * 512 + lc;
                        else { const int l2 = lc & 511, hd = l2 >> 6, d = l2 & 63; p = base + (size_t)(lt < 4 ? 1 : 2) * ((size_t)32768 * 512) + ((size_t)((row >> 12) * 8 + hd) * 4096 + (row & 4095)) * 64 + d; }
                        *(u32x4*)p = pack8(acc[ai][bj][m][0] * sc, acc[ai][bj][m][1] * sc); } }
            return; }
#pragma unroll
        for (int ai = 0; ai < 2; ++ai)
#pragma unroll
            for (int m = 0; m < 4; ++m) { bf16_t* rowp = base + (size_t)(row0 + ai * HALF + m * 16) * 1536 + col0;
#pragma unroll
                for (int bj = 0; bj < 2; ++bj) *(u32x4*)(rowp + bj * HALF) = pack8(acc[ai][bj][m][0] * sc, acc[ai][bj][m][1] * sc); }
    }
};
struct EpiGate {
    static constexpr bool PERM = true, AFTER_DRAIN = false;
    bf16_t* O; int ldc; const float* bias; float wscale;
    __device__ __forceinline__ void operator()(const f32x4 (&acc)[2][2][4][2], const Unit& u, int wr, int wc, int fr, int fq) const {
        const int row0 = u.om * BM + wr * 64 + fr, col0 = u.pn * BM + wc * 32 + 8 * fq;
        f32x4 bv[2][2];
#pragma unroll
        for (int bj = 0; bj < 2; ++bj)
#pragma unroll
            for (int n = 0; n < 2; ++n) bv[bj][n] = *(const f32x4*)(bias + col0 + bj * HALF + 4 * n);
#pragma unroll
        for (int ai = 0; ai < 2; ++ai)
#pragma unroll
            for (int m = 0; m < 4; ++m) { bf16_t* rowp = O + (size_t)(row0 + ai * HALF + m * 16) * ldc + col0;
#pragma unroll
                for (int bj = 0; bj < 2; ++bj) { f32x4 v0 = acc[ai][bj][m][0] * wscale + bv[bj][0], v1 = acc[ai][bj][m][1] * wscale + bv[bj][1];
#pragma unroll
                    for (int i = 0; i < 4; ++i) { v0[i] = sigm(v0[i]); v1[i] = sigm(v1[i]); }
                    *(u32x4*)(rowp + bj * HALF) = pack8(v0, v1); } }
    }
};
struct EpiMerge {
    static constexpr bool PERM = true, AFTER_DRAIN = false;
    const bf16_t* gates; bf16_t* O;
    __device__ __forceinline__ void operator()(const f32x4 (&acc)[2][2][4][2], const Unit& u, int wr, int wc, int fr, int fq) const {
        const int row0 = u.om * BM + wr * 64 + fr, col0 = u.pn * BM + wc * 32 + 8 * fq; const int tg = u.tag;
        const bf16_t* const gp = gates + (size_t)tg * 1024 + col0; bf16_t* const op0 = O + col0;
#pragma unroll
        for (int ai = 0; ai < 2; ++ai) {
            u32x4 gw[4][2], ow[4][2];
#pragma unroll
            for (int m = 0; m < 4; ++m)
#pragma unroll
                for (int bj = 0; bj < 2; ++bj) { const size_t row = (size_t)(row0 + ai * HALF + m * 16);
                    gw[m][bj] = *(const u32x4*)(gp + row * 3072 + bj * HALF);
                    ow[m][bj] = (tg != 0) ? *(const u32x4*)(op0 + row * 1024 + bj * HALF) : (u32x4){0u, 0u, 0u, 0u}; }
#pragma unroll
            for (int m = 0; m < 4; ++m)
#pragma unroll
                for (int bj = 0; bj < 2; ++bj) { const size_t row = (size_t)(row0 + ai * HALF + m * 16); const u32x4 g = gw[m][bj], w = ow[m][bj];
                    f32x4 v0 = acc[ai][bj][m][0], v1 = acc[ai][bj][m][1];
                    v0[0] = v0[0] * bf_lo(g.x) + bf_lo(w.x); v0[1] = v0[1] * bf_hi(g.x) + bf_hi(w.x); v0[2] = v0[2] * bf_lo(g.y) + bf_lo(w.y); v0[3] = v0[3] * bf_hi(g.y) + bf_hi(w.y);
                    v1[0] = v1[0] * bf_lo(g.z) + bf_lo(w.z); v1[1] = v1[1] * bf_hi(g.z) + bf_hi(w.z); v1[2] = v1[2] * bf_lo(g.w) + bf_lo(w.w); v1[3] = v1[3] * bf_hi(g.w) + bf_hi(w.w);
                    *(u32x4*)(op0 + row * 1024 + bj * HALF) = pack8(v0, v1); }
            asm volatile("" ::: "memory"); }
    }
};
struct EpiRes {
    static constexpr bool PERM = false, AFTER_DRAIN = false;
    const float* base; float* out; float sc;
    __device__ __forceinline__ void operator()(const f32x4 (&acc)[2][2][4][2], const Unit& u, int wr, int wc, int fr, int fq) const {
        const int row0 = u.om * BM + wr * 64 + fr, col0 = u.pn * BM + wc * 32 + 4 * fq;
#pragma unroll
        for (int ai = 0; ai < 2; ++ai)
#pragma unroll
            for (int m = 0; m < 4; ++m) { const size_t off = (size_t)(row0 + ai * HALF + m * 16) * 1024 + col0;
#pragma unroll
                for (int bj = 0; bj < 2; ++bj)
#pragma unroll
                    for (int n = 0; n < 2; ++n) { const f32x4 bs = *(const f32x4*)(base + off + bj * HALF + n * 16); *(f32x4*)(out + off + bj * HALF + n * 16) = bs + acc[ai][bj][m][n] * sc; } }
    }
};
struct EpiResB {
    static constexpr bool PERM = true, AFTER_DRAIN = false;
    const void* base; bf16_t* out; float sc; int base_f32;
    __device__ __forceinline__ void operator()(const f32x4 (&acc)[2][2][4][2], const Unit& u, int wr, int wc, int fr, int fq) const {
        const int row0 = u.om * BM + wr * 64 + fr, col0 = u.pn * BM + wc * 32 + 8 * fq;
        if (base_f32) { const float* bp = (const float*)base;
#pragma unroll
            for (int ai = 0; ai < 2; ++ai)
#pragma unroll
                for (int m = 0; m < 4; ++m) { const size_t off = (size_t)(row0 + ai * HALF + m * 16) * 1024 + col0;
#pragma unroll
                    for (int bj = 0; bj < 2; ++bj) { const f32x4 b0 = *(const f32x4*)(bp + off + bj * HALF), b1 = *(const f32x4*)(bp + off + bj * HALF + 4);
                        *(u32x4*)(out + off + bj * HALF) = pack8(b0 + acc[ai][bj][m][0] * sc, b1 + acc[ai][bj][m][1] * sc); } }
        } else { const bf16_t* bp = (const bf16_t*)base;
#pragma unroll
            for (int ai = 0; ai < 2; ++ai)
#pragma unroll
                for (int m = 0; m < 4; ++m) { const size_t off = (size_t)(row0 + ai * HALF + m * 16) * 1024 + col0;
#pragma unroll
                    for (int bj = 0; bj < 2; ++bj) { const u32x4 w = *(const u32x4*)(bp + off + bj * HALF);
                        const f32x4 b0 = {__uint_as_float(w.x << 16), __uint_as_float(w.x & 0xffff0000u), __uint_as_float(w.y << 16), __uint_as_float(w.y & 0xffff0000u)};
                        const f32x4 b1 = {__uint_as_float(w.z << 16), __uint_as_float(w.z & 0xffff0000u), __uint_as_float(w.w << 16), __uint_as_float(w.w & 0xffff0000u)};
                        *(u32x4*)(out + off + bj * HALF) = pack8(b0 + acc[ai][bj][m][0] * sc, b1 + acc[ai][bj][m][1] * sc); } }
        }
    }
};
struct EpiSwiglu {
    static constexpr bool PERM = true, AFTER_DRAIN = false;
    bf16_t* O; int ldc;
    __device__ __forceinline__ void operator()(const f32x4 (&acc)[2][2][4][2], const Unit& u, int wr, int wc, int fr, int fq) const {
        const int row0 = u.om * BM + wr * 64 + fr, col0 = u.pn * HALF + wc * 32 + 8 * fq;
#pragma unroll
        for (int ai = 0; ai < 2; ++ai)
#pragma unroll
            for (int m = 0; m < 4; ++m) { f32x4 v0, v1;
#pragma unroll
                for (int i = 0; i < 4; ++i) { const float g0 = acc[ai][0][m][0][i], g1 = acc[ai][0][m][1][i]; v0[i] = g0 * sigm(g0) * acc[ai][1][m][0][i]; v1[i] = g1 * sigm(g1) * acc[ai][1][m][1][i]; }
                *(u32x4*)(O + (size_t)(row0 + ai * HALF + m * 16) * ldc + col0) = pack8(v0, v1); }
    }
};
__device__ __forceinline__ unsigned pk4_fp8(float a, float b, float c, float d) {
    a = __builtin_fminf(__builtin_fmaxf(a, -448.f), 448.f); b = __builtin_fminf(__builtin_fmaxf(b, -448.f), 448.f); c = __builtin_fminf(__builtin_fmaxf(c, -448.f), 448.f); d = __builtin_fminf(__builtin_fmaxf(d, -448.f), 448.f);
    int w = __builtin_amdgcn_cvt_pk_fp8_f32(a, b, 0, false); w = __builtin_amdgcn_cvt_pk_fp8_f32(c, d, w, true); return (unsigned)w; }
struct EpiSwigluF8 {
    static constexpr bool PERM = true, AFTER_DRAIN = false;
    unsigned char* O; int ldc;
    __device__ __forceinline__ void operator()(const f32x4 (&acc)[2][2][4][2], const Unit& u, int wr, int wc, int fr, int fq) const {
        const int row0 = u.om * BM + wr * 64 + fr, col0 = u.pn * HALF + wc * 32 + 8 * fq;
#pragma unroll
        for (int ai = 0; ai < 2; ++ai)
#pragma unroll
            for (int m = 0; m < 4; ++m) { f32x4 v0, v1;
#pragma unroll
                for (int i = 0; i < 4; ++i) { const float g0 = acc[ai][0][m][0][i] * F8_WINV, g1 = acc[ai][0][m][1][i] * F8_WINV; v0[i] = g0 * sigm(g0) * (acc[ai][1][m][0][i] * F8_WINV); v1[i] = g1 * sigm(g1) * (acc[ai][1][m][1][i] * F8_WINV); }
                u32x2 w; w.x = pk4_fp8(v0[0], v0[1], v0[2], v0[3]); w.y = pk4_fp8(v1[0], v1[1], v1[2], v1[3]);
                *(u32x2*)(O + (size_t)(row0 + ai * HALF + m * 16) * ldc + col0) = w; }
    }
};
struct EpiMoeDown {
    static constexpr bool PERM = true, AFTER_DRAIN = false;
    bf16_t* O; const float* w; float scale;
    __device__ __forceinline__ void operator()(const f32x4 (&acc)[2][2][4][2], const Unit& u, int wr, int wc, int fr, int fq) const {
        const int row0 = u.om * BM + wr * 64 + fr, col0 = u.pn * BM + wc * 32 + 8 * fq;
#pragma unroll
        for (int ai = 0; ai < 2; ++ai)
#pragma unroll
            for (int m = 0; m < 4; ++m) { const size_t row = (size_t)(row0 + ai * HALF + m * 16); const float sc = w[row] * scale;
#pragma unroll
                for (int bj = 0; bj < 2; ++bj) *(u32x4*)(O + row * 1024 + col0 + bj * HALF) = pack8(acc[ai][bj][m][0] * sc, acc[ai][bj][m][1] * sc); }
    }
};
template <class Epi, class Sched, bool ALIGN_EPI = false, bool SP2 = false, bool F8 = false>
__device__ __forceinline__ void gemm_phase(PG8_LAS unsigned char* lds, const Gemm g, const Sched& S, const Epi& E, const int tid_in) {
    const int tid = tid_in, wid = __builtin_amdgcn_readfirstlane(tid >> 6), lane = tid & 63, wr = wid >> 2, wc = wid & 3, fr = lane & 15, fq = lane >> 4;
    const int K = g.K, nt = K / BK;
    unsigned voffA[2], voffB[2];
#pragma unroll
    for (int i = 0; i < 2; ++i) { int R, C; stage_rc(tid * 16 + i * 8192, R, C); const int Rb = Epi::PERM ? ((R & ~31) + perm32(R & 31)) : R;
        voffA[i] = (unsigned)(R * K + C) * 2u; voffB[i] = (unsigned)(Rb * K + C) * 2u; }
    const size_t kstep = (size_t)(BK * 2);
    const size_t hstep = (size_t)HALF * K * 2;
    const unsigned ldsw = (unsigned)wid * 1024u;
    const int aoff = lds_byte(wr * 64 + fr, fq * 8), boff = lds_byte(wc * 32 + fr, fq * 8);
#define PG8_SA(b, h) (((b) * 2 + (h)) * HTB)
#define PG8_SB(b, h) ((4 + (b) * 2 + (h)) * HTB)
#define PG8_STAGE(bufoff, gbase, voff) do { _Pragma("unroll") for (int _i = 0; _i < 2; ++_i) \
        __builtin_amdgcn_global_load_lds((const unsigned*)((const char*)(gbase) + (voff)[_i]), (PG8_LAS unsigned*)(lds + (bufoff) + ldsw + _i * 8192), 16, 0, 0); } while (0)
#define PG8_LDA(dst, b, h) do { _Pragma("unroll") for (int m = 0; m < 4; ++m) _Pragma("unroll") for (int k = 0; k < 2; ++k) dst[m][k] = *(const PG8_LAS bf16x8*)(lds + PG8_SA(b, h) + aoff + m * 2048 + k * 1024); } while (0)
#define PG8_LDB(dst, b, h) do { _Pragma("unroll") for (int n = 0; n < 2; ++n) _Pragma("unroll") for (int k = 0; k < 2; ++k) dst[n][k] = *(const PG8_LAS bf16x8*)(lds + PG8_SB(b, h) + boff + n * 2048 + k * 1024); } while (0)
#define PG8_CAT8(x) __builtin_bit_cast(v8i32, __builtin_shufflevector((x)[0], (x)[1], 0, 1, 2, 3, 4, 5, 6, 7, 8, 9, 10, 11, 12, 13, 14, 15))
#define PG8_MMA(ai, bj, At, Bt) do { __builtin_amdgcn_s_setprio(1); if constexpr (F8) { _Pragma("unroll") for (int m = 0; m < 4; ++m) _Pragma("unroll") for (int n = 0; n < 2; ++n) \
        asm volatile("v_mfma_f32_16x16x128_f8f6f4 %0, %1, %2, %0" : "+v"(acc[ai][bj][m][n]) : "v"(PG8_CAT8(Bt[n])), "v"(PG8_CAT8(At[m]))); } else { \
        _Pragma("unroll") for (int m = 0; m < 4; ++m) _Pragma("unroll") for (int n = 0; n < 2; ++n) _Pragma("unroll") for (int k = 0; k < 2; ++k) \
        acc[ai][bj][m][n] = __builtin_amdgcn_mfma_f32_16x16x32_bf16(Bt[n][k], At[m][k], acc[ai][bj][m][n], 0, 0, 0); } __builtin_amdgcn_s_setprio(0); } while (0)
#define PG8_WAIT_V(n) asm volatile("s_waitcnt vmcnt(" #n ")" ::: "memory")
#define PG8_WAIT_L(n) asm volatile("s_waitcnt lgkmcnt(" #n ")" ::: "memory")
#define PG8_BAR __builtin_amdgcn_s_barrier()
#define PG8_SCHED __builtin_amdgcn_sched_barrier(0)
    Unit cur, nxt; int ui = 0;
    if (!S.next(0, cur)) return;
    f32x4 acc[2][2][4][2];
#pragma unroll
    for (int a = 0; a < 2; ++a)
#pragma unroll
        for (int b = 0; b < 2; ++b)
#pragma unroll
            for (int m = 0; m < 4; ++m)
#pragma unroll
                for (int n = 0; n < 2; ++n) { acc[a][b][m][n] = (f32x4){0.f, 0.f, 0.f, 0.f}; if constexpr (F8) asm volatile("" : "+v"(acc[a][b][m][n])); }
    bf16x8 At[4][2], B0[2][2], B1[2][2];
    const char* cA = (const char*)g.A + cur.ao; const char* cB = (const char*)g.Bt + cur.bo;
    S.a_ready(cur);
    if constexpr (SP2) {
        PG8_STAGE(PG8_SB(0, 0), cB, voffB); PG8_STAGE(PG8_SB(0, 1), cB + hstep, voffB); PG8_STAGE(PG8_SA(0, 0), cA, voffA); PG8_STAGE(PG8_SA(0, 1), cA + hstep, voffA);
        if (wr == 1) PG8_BAR;
        PG8_WAIT_V(2); PG8_BAR;
        PG8_STAGE(PG8_SB(1, 0), cB + kstep, voffB); PG8_STAGE(PG8_SA(1, 0), cA + kstep, voffA); PG8_STAGE(PG8_SB(1, 1), cB + hstep + kstep, voffB);
        PG8_WAIT_V(6); PG8_BAR;
    } else {
        PG8_STAGE(PG8_SB(0, 0), cB, voffB); PG8_STAGE(PG8_SA(0, 0), cA, voffA); PG8_STAGE(PG8_SB(0, 1), cB + hstep, voffB); PG8_STAGE(PG8_SA(0, 1), cA + hstep, voffA);
        if (wr == 1) PG8_BAR;
        PG8_WAIT_V(4); PG8_BAR;
        PG8_STAGE(PG8_SB(1, 0), cB + kstep, voffB); PG8_STAGE(PG8_SA(1, 0), cA + kstep, voffA); PG8_STAGE(PG8_SB(1, 1), cB + hstep + kstep, voffB);
        PG8_WAIT_V(6); PG8_BAR;
    }
    for (;;) {
        const bool has_next = S.next(ui + 1, nxt);
        const char* nA = has_next ? (const char*)g.A + nxt.ao : cA; const char* nB = has_next ? (const char*)g.Bt + nxt.bo : cB;
#pragma nounroll
        for (int t = 0; t < nt; t += 2) {
            const bool last = (t == nt - 2);
            const char* a1 = cA + (size_t)(t + 1) * kstep;
            const char* a2 = last ? nA : cA + (size_t)(t + 2) * kstep; const char* b2 = last ? nB : cB + (size_t)(t + 2) * kstep;
            const char* a3 = a2 + kstep; const char* b3 = b2 + kstep;
            if (last && has_next) S.a_ready(nxt);
            if constexpr (SP2) {
            PG8_LDB(B0, 0, 0); PG8_LDB(B1, 0, 1); PG8_SCHED; PG8_LDA(At, 0, 0); PG8_STAGE(PG8_SA(1, 1), a1 + hstep, voffA);
            PG8_WAIT_V(8); PG8_WAIT_L(0); PG8_BAR; PG8_MMA(0, 0, At, B0); PG8_MMA(0, 1, At, B1); PG8_BAR; PG8_SCHED;
            PG8_LDA(At, 0, 1); PG8_STAGE(PG8_SB(0, 0), b2, voffB); PG8_STAGE(PG8_SB(0, 1), b2 + hstep, voffB); PG8_STAGE(PG8_SA(0, 0), a2, voffA);
            PG8_WAIT_V(8); PG8_WAIT_L(0); PG8_BAR; PG8_MMA(1, 0, At, B0); PG8_MMA(1, 1, At, B1); PG8_BAR; PG8_SCHED;
            PG8_LDB(B0, 1, 0); PG8_LDB(B1, 1, 1); PG8_SCHED; PG8_LDA(At, 1, 0); PG8_STAGE(PG8_SA(0, 1), a2 + hstep, voffA);
            PG8_WAIT_V(8); PG8_WAIT_L(0); PG8_BAR; PG8_MMA(0, 0, At, B0); PG8_MMA(0, 1, At, B1); PG8_BAR; PG8_SCHED;
            PG8_LDA(At, 1, 1); PG8_STAGE(PG8_SB(1, 0), b3, voffB); PG8_STAGE(PG8_SB(1, 1), b3 + hstep, voffB); PG8_STAGE(PG8_SA(1, 0), a3, voffA);
            PG8_WAIT_V(8); PG8_WAIT_L(0); PG8_BAR; PG8_MMA(1, 0, At, B0); PG8_MMA(1, 1, At, B1); PG8_BAR; PG8_SCHED;
            } else {
            PG8_LDB(B0, 0, 0); PG8_SCHED; PG8_LDA(At, 0, 0); PG8_STAGE(PG8_SA(1, 1), a1 + hstep, voffA);
            PG8_WAIT_L(8); PG8_BAR; PG8_WAIT_L(0); PG8_MMA(0, 0, At, B0); PG8_BAR; PG8_SCHED;
            PG8_LDB(B1, 0, 1); PG8_STAGE(PG8_SB(0, 0), b2, voffB);
            PG8_BAR; PG8_WAIT_L(0); PG8_MMA(0, 1, At, B1); PG8_BAR;
            PG8_LDA(At, 0, 1); PG8_STAGE(PG8_SA(0, 0), a2, voffA);
            PG8_BAR; PG8_WAIT_L(0); PG8_MMA(1, 0, At, B0); PG8_BAR; PG8_SCHED;
            PG8_STAGE(PG8_SB(0, 1), b2 + hstep, voffB);
            PG8_WAIT_V(6); PG8_BAR; PG8_MMA(1, 1, At, B1); PG8_BAR;
            PG8_LDB(B0, 1, 0); PG8_SCHED; PG8_LDA(At, 1, 0); PG8_STAGE(PG8_SA(0, 1), a2 + hstep, voffA);
            PG8_WAIT_L(8); PG8_BAR; PG8_WAIT_L(0); PG8_MMA(0, 0, At, B0); PG8_BAR; PG8_SCHED;
            PG8_LDB(B1, 1, 1); PG8_STAGE(PG8_SB(1, 0), b3, voffB);
            PG8_BAR; PG8_WAIT_L(0); PG8_MMA(0, 1, At, B1); PG8_BAR;
            PG8_LDA(At, 1, 1); PG8_STAGE(PG8_SA(1, 0), a3, voffA);
            PG8_BAR; PG8_WAIT_L(0); PG8_MMA(1, 0, At, B0); PG8_BAR; PG8_SCHED;
            PG8_STAGE(PG8_SB(1, 1), b3 + hstep, voffB);
            PG8_WAIT_V(6); PG8_BAR; PG8_MMA(1, 1, At, B1); PG8_BAR;
            }
        }
        if constexpr (ALIGN_EPI) { if (wr == 0) PG8_BAR; }
        if constexpr (F8) asm volatile("s_nop 15\n\ts_nop 15" ::: "memory");
        if constexpr (!Epi::AFTER_DRAIN) { E(acc, cur, wr, wc, fr, fq); S.done(cur); }
        if (!has_next) break;
#pragma unroll
        for (int a = 0; a < 2; ++a)
#pragma unroll
            for (int b = 0; b < 2; ++b)
#pragma unroll
                for (int m = 0; m < 4; ++m)
#pragma unroll
                    for (int n = 0; n < 2; ++n) { acc[a][b][m][n] = (f32x4){0.f, 0.f, 0.f, 0.f}; if constexpr (F8) asm volatile("" : "+v"(acc[a][b][m][n])); }
        cur = nxt; cA = nA; cB = nB; ++ui;
        if constexpr (ALIGN_EPI) { if (wr == 1) PG8_BAR; }
    }
    PG8_WAIT_V(0);
    if constexpr (!ALIGN_EPI) { if (wr == 0) PG8_BAR; }
    PG8_BAR;
    if constexpr (Epi::AFTER_DRAIN) { E.fused(acc, cur, wr, wc, fr, fq, lds, wid, lane); S.done(cur); }
#undef PG8_SA
#undef PG8_SB
#undef PG8_STAGE
#undef PG8_LDA
#undef PG8_LDB
#undef PG8_MMA
#undef PG8_CAT8
#undef PG8_WAIT_V
#undef PG8_WAIT_L
#undef PG8_BAR
#undef PG8_SCHED
}
}

namespace att {
#define LAS __attribute__((address_space(3)))
typedef unsigned short bf16;
typedef __attribute__((ext_vector_type(8))) short bf16x8;
typedef __attribute__((ext_vector_type(4))) short s16x4;
typedef __attribute__((ext_vector_type(16))) float f32x16;
typedef __attribute__((ext_vector_type(4))) unsigned u32x4;
typedef float f32x2_t __attribute__((ext_vector_type(2))); typedef __bf16 bf16x2_t __attribute__((ext_vector_type(2)));
typedef short v4i16_t __attribute__((ext_vector_type(4)));
typedef LAS const char* lds_cptr;
constexpr int SEQ = 4096, PP = 1536;
constexpr float LOG2E = 1.4426950408889634f;
constexpr float NEGINF = -INFINITY;
__device__ __forceinline__ int crow(int r, int hi) { return (r & 3) + 8 * (r >> 2) + 4 * hi; }
__device__ __forceinline__ void glds16(const void* gsrc, unsigned lds_dst) { unsigned keep;
    asm volatile("s_mov_b32 %0, m0\n\ts_mov_b32 m0, %2\n\ts_nop 0\n\tglobal_load_lds_dwordx4 %1, off\n\ts_mov_b32 m0, %0" : "=&s"(keep) : "v"(gsrc), "s"(lds_dst) : "memory"); }
__device__ __forceinline__ unsigned cvtpk(float lo, float hi) { f32x2_t v = {lo, hi}; bf16x2_t b = __builtin_convertvector(v, bf16x2_t); return __builtin_bit_cast(unsigned, b); }
__device__ __forceinline__ s16x4 vtr(lds_cptr p) { return __builtin_bit_cast(s16x4, __builtin_amdgcn_ds_read_tr16_b64_v4i16((LAS v4i16_t*)p)); }
__device__ __forceinline__ bf16x8 ldk(lds_cptr p) { return *(const LAS bf16x8*)p; }
__device__ __forceinline__ float xhalf(float v, int hi) {
    auto rr = __builtin_amdgcn_permlane32_swap(__float_as_uint(v), __float_as_uint(v), false, false);
    return hi ? __uint_as_float(rr[0]) : __uint_as_float(rr[1]); }
template <int OF> __device__ __forceinline__ float swz_xor(float v) { return __int_as_float(__builtin_amdgcn_ds_swizzle(__float_as_int(v), (OF << 10) | 0x1f)); }
__device__ __forceinline__ float max16(const f32x16& p) { float a = fmaxf(fmaxf(p[0], p[1]), fmaxf(p[2], p[3]));
#pragma unroll
    for (int r = 4; r < 16; r += 4) a = fmaxf(a, fmaxf(fmaxf(p[r], p[r + 1]), fmaxf(p[r + 2], p[r + 3]))); return a; }
__device__ __forceinline__ float add_s(float a, float b) { float r; asm("v_add_f32_e32 %0, %1, %2" : "=v"(r) : "v"(a), "v"(b)); return r; }
__device__ __forceinline__ float max3_s(float a, float b, float c) { float r; asm("v_max3_f32 %0, %1, %2, %3" : "=v"(r) : "v"(a), "v"(b), "v"(c)); return r; }
__device__ __forceinline__ float sum16a(const f32x16& p) { float a = p[0];
#pragma unroll
    for (int r = 1; r < 16; ++r) a += p[r];
    return a; }
__device__ __forceinline__ float max16a(const f32x16& p) { float a = max3_s(p[0], p[1], p[2]), b = max3_s(p[3], p[4], p[5]);
    a = max3_s(a, p[6], p[7]); b = max3_s(b, p[8], p[9]); a = max3_s(a, p[10], p[11]); b = max3_s(b, p[12], p[13]); a = max3_s(a, p[14], p[15]); return max3_s(a, b, b); }
__device__ __forceinline__ float sum16(const f32x16& p) { float a = (p[0] + p[1]) + (p[2] + p[3]);
#pragma unroll
    for (int r = 4; r < 16; r += 4) a += (p[r] + p[r + 1]) + (p[r + 2] + p[r + 3]); return a; }
#define ATT_WAIT_BAR(N) asm volatile("s_waitcnt vmcnt(" #N ") lgkmcnt(0)\n\ts_barrier" ::: "memory")
#define ATT_LDSW() asm volatile("s_waitcnt lgkmcnt(0)" ::: "memory")
#define PACK8(P, B) (u32x4){cvtpk(P[B], P[B + 1]), cvtpk(P[B + 2], P[B + 3]), cvtpk(P[B + 4], P[B + 5]), cvtpk(P[B + 6], P[B + 7])}
#define ASBF(x) __builtin_bit_cast(bf16x8, x)
#define VFRAG(lo, hh) (bf16x8){lo[0], lo[1], lo[2], lo[3], hh[0], hh[1], hh[2], hh[3]}

constexpr int A_SLOT = 32768, A_NSLOT = 4, A_WSF = 131072, A_FLAGS = 135168, A_SLN = 135424, A_KN = 135936, A_XCH = 0, A_STG = 65536;
constexpr float A_THR = 8.f, A_DEAD = -150.f;
template <int MODE = 0> __device__ __forceinline__ void diff_unit(int b, int h, int qb, const bf16* __restrict__ PA, bf16* __restrict__ YA, float lam, float knmax0, float knmax1, LAS char* shm, const int tid, const int ro_mul = 1) {
    const int lane = tid & 63, r32 = lane & 31, hi = lane >> 5;
    const int wid = __builtin_amdgcn_readfirstlane(tid >> 6), comp = wid >> 2, g = wid & 3;
    const float slope2 = __builtin_amdgcn_exp2f(-2.f * (float)(h + 1)) * LOG2E;
    const long rowbase = (long)b * SEQ; const int q0 = qb * 128, qw0 = q0 + 32 * g, qi = qw0 + r32;
    const unsigned lds0 = (unsigned)(size_t)shm;
    LAS float* wsf = (LAS float*)(shm + A_WSF) + wid * 128;
    const bf16* kb_ = PA + rowbase * PP + 512 + h * 128; const bf16* vb_ = PA + rowbase * PP + 1024 + h * 128;
    const bf16* ksrc0 = kb_ + (long)lane * PP + wid * 8; const bf16* ksrc1 = ksrc0 + 64;
    const int pa = wid, pb = wid + 8;
    const bf16* vsrca = vb_ + (long)(16 * (pa & 3) + (lane >> 2)) * PP + (pa >> 2) * 32 + (lane & 3) * 8;
    const bf16* vsrcb = vb_ + (long)(16 * (pb & 3) + (lane >> 2)) * PP + (pb >> 2) * 32 + (lane & 3) * 8;
    const int NT = 2 * (qb + 1);
#define A_ISSUE(it_) do { const long ro_ = (long)(NT - 1 - (it_)) * 64 * PP * ro_mul; const unsigned sb_ = (unsigned)__builtin_amdgcn_readfirstlane(lds0 + (unsigned)(((it_) & 3) * A_SLOT)); \
        glds16(ksrc0 + ro_, sb_ + wid * 1024); glds16(ksrc1 + ro_, sb_ + 8192 + wid * 1024); glds16(vsrca + ro_, sb_ + 16384 + pa * 1024); glds16(vsrcb + ro_, sb_ + 16384 + pb * 1024); } while (0)
    const bf16* qp = PA + (rowbase + qi) * PP + h * 128 + comp * 64 + hi * 8;
    bf16x8 qr[4];
    asm volatile("global_load_dwordx4 %0, %1, off" : "=v"(qr[0]) : "v"(qp) : "memory"); asm volatile("global_load_dwordx4 %0, %1, off offset:32" : "=v"(qr[1]) : "v"(qp) : "memory");
    asm volatile("global_load_dwordx4 %0, %1, off offset:64" : "=v"(qr[2]) : "v"(qp) : "memory"); asm volatile("global_load_dwordx4 %0, %1, off offset:96" : "=v"(qr[3]) : "v"(qp) : "memory");
    const float sl4 = slope2 * 4.f * (float)hi;
    volatile LAS int* fl = (volatile LAS int*)(shm + A_FLAGS);
    A_ISSUE(0); A_ISSUE(1); if (NT > 2) A_ISSUE(2);
    float m_ref = NEGINF, l = 0.f; f32x16 o[4];
#pragma unroll
    for (int dq = 0; dq < 4; ++dq) { o[dq] = f32x16{}; asm volatile("" : "+v"(o[dq])); }
#define A_QKH(P, it_, hf_) do { const int kh_ = 64 * (NT - 1 - (it_)) + 32 * (hf_); { \
        const lds_cptr kp_ = shm + ((it_) & 3) * A_SLOT + comp * 8192 + hi * 1024 + r32 * 16 + (hf_) * 512; \
        float s2_ = slope2; asm volatile("" : "+v"(s2_));     \
        const float bs_ = s2_ * (float)(kh_ - qi) + sl4; \
        _Pragma("unroll") for (int r = 0; r < 16; ++r) P[r] = __builtin_fmaf(s2_, (float)((r & 3) + 8 * (r >> 2)), bs_); \
        _Pragma("unroll") for (int d0 = 0; d0 < 4; ++d0) P = __builtin_amdgcn_mfma_f32_32x32x16_bf16(ldk(kp_ + d0 * 2048), qr[d0], P, 0, 0, 0); } } while (0)
#define A_SVH(P, it_, hf_) do { const int kh_ = 64 * (NT - 1 - (it_)) + 32 * (hf_); if (kh_ <= qw0) { \
        if (kh_ == qw0) { _Pragma("unroll") for (int r = 0; r < 16; ++r) if (crow(r, hi) > r32) P[r] = NEGINF; } \
        float rm_ = max16a(P); rm_ = fmaxf(rm_, xhalf(rm_, hi)); \
        if (!__all(rm_ < m_ref + A_DEAD)) { \
            const float mnew_ = fmaxf(m_ref, rm_); \
            if (__any(mnew_ > m_ref + A_THR)) { const float alpha_ = __builtin_amdgcn_exp2f(m_ref - mnew_); l *= alpha_; m_ref = mnew_; \
                if (hi == 0) wsf[r32] = alpha_; ATT_LDSW(); \
                _Pragma("unroll") for (int r = 0; r < 16; ++r) { const float a_ = wsf[crow(r, hi)]; _Pragma("unroll") for (int dq = 0; dq < 4; ++dq) o[dq][r] *= a_; } } \
            _Pragma("unroll") for (int r = 0; r < 16; ++r) P[r] = __builtin_amdgcn_exp2f(P[r] - m_ref); \
            l += sum16a(P); \
            const u32x4 pw0_ = PACK8(P, 0), pw1_ = PACK8(P, 8); \
            const lds_cptr vp_ = shm + ((it_) & 3) * A_SLOT + 16384 + (hf_) * 2048 + ((lane >> 4) & 1) * 32 + (lane & 3) * 8 + (4 * hi + ((lane & 15) >> 2)) * 64; \
            _Pragma("unroll") for (int dq = 0; dq < 4; ++dq) { \
                const s16x4 l0_ = vtr(vp_ + dq * 4096), h0_ = vtr(vp_ + dq * 4096 + 512), l1_ = vtr(vp_ + dq * 4096 + 1024), h1_ = vtr(vp_ + dq * 4096 + 1536); \
                o[dq] = __builtin_amdgcn_mfma_f32_32x32x16_bf16(ASBF(pw0_), VFRAG(l0_, h0_), o[dq], 0, 0, 0); \
                o[dq] = __builtin_amdgcn_mfma_f32_32x32x16_bf16(ASBF(pw1_), VFRAG(l1_, h1_), o[dq], 0, 0, 0); } } } } while (0)
    f32x16 PH, PL;
    if (NT > 2) { ATT_WAIT_BAR(8); } else { ATT_WAIT_BAR(4); }
#pragma unroll
    for (int d0 = 0; d0 < 4; ++d0) asm volatile("" : "+v"(qr[d0]));
    float qkb;
    { float ss = 0.f;
#pragma unroll
      for (int d0 = 0; d0 < 4; ++d0)
#pragma unroll
          for (int e = 0; e < 8; ++e) { const float v = __uint_as_float((unsigned)(unsigned short)qr[d0][e] << 16); ss += v * v; }
      ss += xhalf(ss, hi); qkb = sqrtf(ss) * (comp ? knmax1 : knmax0) * 1.001f + 1.0f; }
    A_QKH(PH, 0, 1);
    for (int it = 0; it < ((MODE == 5) ? 1 : NT); ++it) {
        A_QKH(PL, it, 0);
        A_SVH(PH, it, 1);
        if (it + 1 < NT) {
            if (it + 2 < NT) { ATT_WAIT_BAR(4); } else { ATT_WAIT_BAR(0); }
            if (it > 0) { const volatile LAS int* f = fl + ((it - 1) & 1) * 8;
                if (f[0] & f[1] & f[2] & f[3] & f[4] & f[5] & f[6] & f[7]) break; }
            if (it + 3 < NT) A_ISSUE(it + 3);
            A_QKH(PH, it + 1, 1);
        }
        A_SVH(PL, it, 0);
        { const float bmax = slope2 * (float)(64 * (NT - 2 - it) + 63 - qi);
          const int dead = __all(qkb + bmax < m_ref + A_DEAD) ? 1 : 0;
          if (lane == 0) fl[(it & 1) * 8 + wid] = dead; }
    }
#undef A_ISSUE
#undef A_QKH
#undef A_SVH
    l += xhalf(l, hi);
    if (hi == 0) wsf[32 + r32] = __builtin_amdgcn_rcpf(l); ATT_LDSW();
#pragma unroll
    for (int r = 0; r < 16; ++r) { const float a = wsf[32 + crow(r, hi)];
#pragma unroll
        for (int dq = 0; dq < 4; ++dq) o[dq][r] *= a; }
    ATT_WAIT_BAR(0);
    LAS float* X = (LAS float*)(shm + A_XCH) + g * 4096;
    if (comp == 1) {
#pragma unroll
        for (int dq = 0; dq < 4; ++dq)
#pragma unroll
            for (int r = 0; r < 16; ++r) X[(dq * 16 + r) * 64 + lane] = o[dq][r];
    }
    ATT_WAIT_BAR(0);
    if (comp == 0) {
        float ss[16];
#pragma unroll
        for (int r = 0; r < 16; ++r) ss[r] = 0.f;
#pragma unroll
        for (int dq = 0; dq < 4; ++dq)
#pragma unroll
            for (int r = 0; r < 16; ++r) { const float d = o[dq][r] - lam * X[(dq * 16 + r) * 64 + lane]; o[dq][r] = d; ss[r] += d * d; }
#pragma unroll
        for (int r = 0; r < 16; ++r) { float s = ss[r];
            s += swz_xor<1>(s); s += swz_xor<2>(s); s += swz_xor<4>(s); s += swz_xor<8>(s); s += swz_xor<16>(s);
            ss[r] = __builtin_amdgcn_rsqf(s * (1.f / 128.f) + 1e-6f); }
        LAS bf16* stg = (LAS bf16*)(shm + A_STG) + g * 4096;
#pragma unroll
        for (int dq = 0; dq < 4; ++dq) { const float gn = ((const LAS float*)(shm + A_SLN))[dq * 32 + r32];
#pragma unroll
            for (int r = 0; r < 16; ++r) stg[crow(r, hi) * 128 + dq * 32 + r32] = (bf16)(cvtpk(o[dq][r] * ss[r] * gn, 0.f) & 0xffffu); }
        ATT_LDSW();
        bf16* Yw = YA + (rowbase + qw0) * 512 + h * 128;
#pragma unroll
        for (int i = 0; i < 8; ++i) { const int idx = i * 64 + lane, row = idx >> 4, ch = idx & 15; const u32x4 v = *(const LAS u32x4*)(stg + row * 128 + ch * 8); *(u32x4*)(Yw + (long)row * 512 + ch * 8) = v; }
    }
}

constexpr int B_V = 49152, B_WSF = 98304, B_STG = 100352;
struct DilU { int b, h, dil, res, blk, pat; };
__device__ __forceinline__ DilU dil_unit_of(int bh, int j) { DilU u; u.b = bh >> 3; u.h = bh & 7;
    if (j < 16) { u.pat = 0; u.dil = 1; u.res = 0; u.blk = j; } else if (j < 32) { u.pat = 1; u.dil = 4; u.res = (j - 16) >> 2; u.blk = (j - 16) & 3; } else { u.pat = 2; u.dil = 16; u.res = j - 32; u.blk = 0; }
    return u; }
__device__ __forceinline__ DilU dil_unit_at(int vcu, int i) { const int x = vcu >> 5, n = (vcu & 31) + 32 * i, q = n / 48; return dil_unit_of(8 * x + q, n - 48 * q); }
__device__ __forceinline__ void dil_phase(int vcu, const bf16* __restrict__ PB, bf16* __restrict__ BPb, float* __restrict__ BSTb, LAS char* shm, const int tid) {
    const int lane = tid & 63, r32 = lane & 31, hi = lane >> 5;
    const int wid = __builtin_amdgcn_readfirstlane(tid >> 6);
    const unsigned lds0 = (unsigned)(size_t)shm;
    const bf16* const KBh = PB + (size_t)32768 * 512; const bf16* const VBh = PB + (size_t)2 * 32768 * 512;
#define B_ISSUE_K(U) do { const bf16* kb_ = KBh + (size_t)((U).b * 8 + (U).h) * SEQ * 64 + wid * 8; const int jb_ = 256 * (U).blk - 128; \
        _Pragma("unroll") for (int T = 0; T < 6; ++T) { int j_ = jb_ + 64 * T + lane; j_ = j_ < 0 ? 0 : j_;     \
            glds16(kb_ + ((size_t)j_ * (U).dil + (U).res) * 64, (unsigned)__builtin_amdgcn_readfirstlane(lds0 + (unsigned)(T * 8192 + wid * 1024))); } } while (0)
#define B_ISSUE_V(U) do { const bf16* vb_ = VBh + (size_t)((U).b * 8 + (U).h) * SEQ * 64 + (wid >> 2) * 32 + (lane & 3) * 8; const int jb_ = 256 * (U).blk - 128 + 16 * (wid & 3) + (lane >> 2); \
        _Pragma("unroll") for (int T = 0; T < 6; ++T) { int j_ = jb_ + 64 * T; j_ = j_ < 0 ? 0 : j_; \
            glds16(vb_ + ((size_t)j_ * (U).dil + (U).res) * 64, (unsigned)__builtin_amdgcn_readfirstlane(lds0 + (unsigned)(B_V + T * 8192 + wid * 1024))); } } while (0)
#ifdef PROBE_BSEG
    unsigned long long bt_ = 0; int bseg_ = -1;
#define BSEG(k) do { if (blockIdx.x == 0 && tid == 0) { const unsigned long long t_ = __builtin_amdgcn_s_memrealtime(); if (bseg_ == PROBE_BSEG) *(volatile LAS unsigned*)(shm + 139264 + 640) += (unsigned)(t_ - bt_); bt_ = t_; bseg_ = (k); } } while (0)
#else
#define BSEG(k) do { } while (0)
#endif
#define B_ISSUE_Q(U) do { const bf16* qp_ = PB + ((long)(U).b * SEQ + (long)(256 * (U).blk + 32 * wid + r32) * (U).dil + (U).res) * 512 + (U).h * 64 + hi * 8; \
        asm volatile("global_load_dwordx4 %0, %1, off" : "+v"(qr[0]) : "v"(qp_) : "memory"); asm volatile("global_load_dwordx4 %0, %1, off offset:32" : "+v"(qr[1]) : "v"(qp_) : "memory"); \
        asm volatile("global_load_dwordx4 %0, %1, off offset:64" : "+v"(qr[2]) : "v"(qp_) : "memory"); asm volatile("global_load_dwordx4 %0, %1, off offset:96" : "+v"(qr[3]) : "v"(qp_) : "memory"); } while (0)
    DilU cur = dil_unit_at(vcu, 0);
    bf16x8 qr[4]; qr[0] = bf16x8{}; qr[1] = bf16x8{}; qr[2] = bf16x8{}; qr[3] = bf16x8{};
    B_ISSUE_K(cur); B_ISSUE_Q(cur);
    for (int i = 0; i < 12; ++i) {
        const bool has_next = i + 1 < 12; const DilU nxt = dil_unit_at(vcu, has_next ? i + 1 : i);
        BSEG(0);
        const int b = cur.b, h = cur.h, dil = cur.dil, res = cur.res, blk = cur.blk;
        const int hs = h + (h >> 1);
        const float sd = __builtin_amdgcn_exp2f(-(2.f / 3.f) * (float)(hs + 1)) * LOG2E * (float)dil;
        const long rowbase = (long)b * SEQ; const int i0 = 256 * blk;
        const int iq = i0 + 32 * wid + r32;
#ifdef PROBE_DUPV
        B_ISSUE_V(cur);
        B_ISSUE_V(cur);
        ATT_WAIT_BAR(12);
#else
        B_ISSUE_V(cur);
        ATT_WAIT_BAR(6);
#endif
        BSEG(1);
        f32x16 s[5];
#pragma unroll
        for (int g = 0; g < 5; ++g) { const int b0 = 32 * (wid + g), T = b0 >> 6, half = (b0 >> 5) & 1;
            const lds_cptr kp = shm + T * 8192 + hi * 1024 + (half * 32 + r32) * 16;
            const float base = -sd * (float)(128 - 32 * g + r32);
#pragma unroll
            for (int r = 0; r < 16; ++r) s[g][r] = base + sd * (float)crow(r, hi);
#pragma unroll
            for (int d0 = 0; d0 < 4; ++d0) s[g] = __builtin_amdgcn_mfma_f32_32x32x16_bf16(ldk(kp + d0 * 2048), qr[d0], s[g], 0, 0, 0); }
        asm volatile("s_waitcnt lgkmcnt(0)\n\ts_barrier" ::: "memory");
        BSEG(2);
        if (has_next) B_ISSUE_K(nxt);
        B_ISSUE_Q(nxt);
        BSEG(3);
#pragma unroll
        for (int r = 0; r < 16; ++r) { const int cr = crow(r, hi); if (cr < r32) s[0][r] = NEGINF; if (cr > r32) s[4][r] = NEGINF; }
        if (blk == 0) {
#pragma unroll
            for (int g = 0; g < 5; ++g)
#pragma unroll
                for (int r = 0; r < 16; ++r) if (32 * (wid + g) + crow(r, hi) < 128) s[g][r] = NEGINF;
        }
        float m = max16(s[0]);
#pragma unroll
        for (int g = 1; g < 5; ++g) m = fmaxf(m, max16(s[g]));
        m = fmaxf(m, xhalf(m, hi));
        float l = 0.f;
#pragma unroll
        for (int g = 0; g < 5; ++g) {
#pragma unroll
            for (int r = 0; r < 16; ++r) s[g][r] = __builtin_amdgcn_exp2f(s[g][r] - m);
            l += sum16a(s[g]); }
        l += xhalf(l, hi);
        BSEG(4);
        if (has_next) { ATT_WAIT_BAR(10); } else { ATT_WAIT_BAR(4); }

        BSEG(5);
        f32x16 o[2]; o[0] = f32x16{}; o[1] = f32x16{};
        const lds_cptr vp0 = shm + B_V + ((lane >> 4) & 1) * 32 + (lane & 3) * 8 + (4 * hi + ((lane & 15) >> 2)) * 64;
#pragma unroll
        for (int g = 0; g < 5; ++g) { const u32x4 pwa = PACK8(s[g], 0), pwb = PACK8(s[g], 8);
            const int B16 = 2 * (wid + g), T = B16 >> 2, ks = B16 & 3;
            const lds_cptr vp = vp0 + T * 8192 + ks * 1024;
#pragma unroll
            for (int d0 = 0; d0 < 2; ++d0) {
                const s16x4 la = vtr(vp + d0 * 4096), ha = vtr(vp + d0 * 4096 + 512), lb_ = vtr(vp + d0 * 4096 + 1024), hb = vtr(vp + d0 * 4096 + 1536);
                o[d0] = __builtin_amdgcn_mfma_f32_32x32x16_bf16(ASBF(pwa), VFRAG(la, ha), o[d0], 0, 0, 0);
                o[d0] = __builtin_amdgcn_mfma_f32_32x32x16_bf16(ASBF(pwb), VFRAG(lb_, hb), o[d0], 0, 0, 0); } }
        BSEG(6);
        bf16* OUT = BPb + (size_t)cur.pat * 32768 * 512; float* ST = BSTb + (size_t)cur.pat * 32768 * 16;
        LAS float* wsf = (LAS float*)(shm + B_WSF) + wid * 64;
        if (hi == 0) wsf[r32] = __builtin_amdgcn_rcpf(l); ATT_LDSW();
        LAS bf16* stg = (LAS bf16*)(shm + B_STG) + wid * 2048;
#pragma unroll
        for (int r = 0; r < 16; ++r) { const float a = wsf[crow(r, hi)];
#pragma unroll
            for (int d0 = 0; d0 < 2; ++d0) stg[crow(r, hi) * 64 + d0 * 32 + r32] = (bf16)(cvtpk(o[d0][r] * a, 0.f) & 0xffffu); }
        ATT_LDSW();
        const long tok = rowbase + (long)iq * dil + res;
        if (hi == 0) { f32x2_t ml = {m, l}; *(f32x2_t*)(ST + (tok * 8 + h) * 2) = ml; }
#pragma unroll
        for (int k = 0; k < 4; ++k) { const int row = k * 8 + (lane >> 3), ch = lane & 7; const u32x4 v = *(const LAS u32x4*)(stg + row * 64 + ch * 8);
            const long trow = rowbase + (long)(i0 + 32 * wid + row) * dil + res; *(u32x4*)(OUT + trow * 512 + h * 64 + ch * 8) = v; }
        asm volatile("s_waitcnt lgkmcnt(0)\n\ts_barrier" ::: "memory");
        cur = nxt;
    }
    BSEG(-1);
    ATT_WAIT_BAR(0);
#undef B_ISSUE_K
#undef B_ISSUE_Q
#undef B_ISSUE_V
}

constexpr int C_SLOT = 16384, C_FLAGS = 49152, C_STG = 53248;
constexpr float C_EXIT = -150.f;
__device__ __forceinline__ void sb_unit(int b, int h, int qb, const bf16* __restrict__ PC, bf16* __restrict__ YC, LAS char* shm, const int tid) {
    const int lane = tid & 63, r32 = lane & 31, hi = lane >> 5;
    const int wid = __builtin_amdgcn_readfirstlane(tid >> 6);
    const long rowbase = (long)b * SEQ; const int q0 = qb * 256, qw0 = q0 + 32 * wid, qi = qw0 + r32;
    const unsigned lds0 = (unsigned)(size_t)shm;
    volatile LAS int* fl = (volatile LAS int*)(shm + C_FLAGS);
    const bf16* ksrc = PC + (rowbase + lane) * PP + 512 + h * 64 + wid * 8;
    const bf16* vsrc = PC + (rowbase + 16 * (wid & 3) + (lane >> 2)) * PP + 1024 + h * 64 + (wid >> 2) * 32 + (lane & 3) * 8;
    const int NT = 4 * qb + 4;
#define C_ISSUE(t_, sl_) do { const long ro_ = (long)(t_) * 64 * PP; const unsigned sb_ = (unsigned)__builtin_amdgcn_readfirstlane(lds0 + (unsigned)(sl_)); \
        glds16(ksrc + ro_, sb_ + wid * 1024); glds16(vsrc + ro_, sb_ + 8192 + wid * 1024); } while (0)
    const bf16* qp = PC + (rowbase + qi) * PP + h * 64 + hi * 8;
    bf16x8 qr[4];
#pragma unroll
    for (int d0 = 0; d0 < 4; ++d0) qr[d0] = *(const bf16x8*)(qp + d0 * 16);
    C_ISSUE(NT - 1, 0); C_ISSUE(NT - 2, C_SLOT);
    float c = 1.f; bool wdone = false; f32x16 o[2]; o[0] = f32x16{}; o[1] = f32x16{};
    int sl = 0, sl2 = 2 * C_SLOT;
    for (int it = 0; it < NT; ++it) {
        if (it + 1 < NT) { ATT_WAIT_BAR(2); } else { ATT_WAIT_BAR(0); }
        if (it > 0) {
            const volatile LAS int* f = fl + ((it - 1) & 1) * 8;
            const int all = f[0] & f[1] & f[2] & f[3] & f[4] & f[5] & f[6] & f[7];
            if (all) break;
        }
        if (it + 2 < NT) C_ISSUE(NT - 3 - it, sl2);
        const int kbase = 64 * (NT - 1 - it);
        if (!wdone && kbase <= qw0) {
            const lds_cptr kp = shm + sl + hi * 1024 + r32 * 16;
            f32x16 p0 = f32x16{}, p1 = f32x16{};
#pragma unroll
            for (int d0 = 0; d0 < 4; ++d0) { const bf16x8 k0 = ldk(kp + d0 * 2048), k1 = ldk(kp + d0 * 2048 + 512);
                p0 = __builtin_amdgcn_mfma_f32_32x32x16_bf16(k0, qr[d0], p0, 0, 0, 0); p1 = __builtin_amdgcn_mfma_f32_32x32x16_bf16(k1, qr[d0], p1, 0, 0, 0); }
            if (kbase + 63 >= qw0) {
#pragma unroll
                for (int r = 0; r < 16; ++r) { const int kv = kbase + crow(r, hi); if (kv >= qi) p0[r] = NEGINF; if (kv + 32 >= qi) p1[r] = NEGINF; }
            }
            f32x16 N0, N1;
#pragma unroll
            for (int r = 0; r < 16; ++r) {
                { const float z = p0[r], e = __builtin_amdgcn_exp2f(-fabsf(z)), q = __builtin_amdgcn_rcpf(1.f + e), eq = e * q; const bool ps = z >= 0.f; p0[r] = ps ? q : eq; N0[r] = ps ? eq : q; }
                { const float z = p1[r], e = __builtin_amdgcn_exp2f(-fabsf(z)), q = __builtin_amdgcn_rcpf(1.f + e), eq = e * q; const bool ps = z >= 0.f; p1[r] = ps ? q : eq; N1[r] = ps ? eq : q; }
            }
            float T[8], U[8];
#pragma unroll
            for (int k = 0; k < 8; ++k) { const f32x16& Nx = (k < 4) ? N0 : N1; const int rb = 4 * (k & 3); T[k] = (Nx[rb] * Nx[rb + 1]) * (Nx[rb + 2] * Nx[rb + 3]); }
#pragma unroll
            for (int k = 0; k < 8; ++k) U[k] = xhalf(T[k], hi);
            float R = c;
#pragma unroll
            for (int k = 7; k >= 0; --k) {
                const float sufk = (hi == 0) ? R * U[k] : R;
                f32x16& Nx = (k < 4) ? N0 : N1; f32x16& Px = (k < 4) ? p0 : p1; const int rb = 4 * (k & 3);
                const float s3 = sufk, s2 = s3 * Nx[rb + 3], s1 = s2 * Nx[rb + 2], s0 = s1 * Nx[rb + 1];
                Px[rb + 3] *= s3; Px[rb + 2] *= s2; Px[rb + 1] *= s1; Px[rb + 0] *= s0;
                R *= T[k] * U[k];
            }
            c = R;
            const u32x4 pw0 = PACK8(p0, 0), pw1 = PACK8(p0, 8), pw2 = PACK8(p1, 0), pw3 = PACK8(p1, 8);
            const lds_cptr vp = shm + sl + 8192 + ((lane >> 4) & 1) * 32 + (lane & 3) * 8 + (4 * hi + ((lane & 15) >> 2)) * 64;
#pragma unroll
            for (int d0 = 0; d0 < 2; ++d0) {
                const s16x4 l0 = vtr(vp + d0 * 4096), h0 = vtr(vp + d0 * 4096 + 512), l1 = vtr(vp + d0 * 4096 + 1024), h1 = vtr(vp + d0 * 4096 + 1536);
                const s16x4 l2 = vtr(vp + d0 * 4096 + 2048), h2 = vtr(vp + d0 * 4096 + 2560), l3 = vtr(vp + d0 * 4096 + 3072), h3 = vtr(vp + d0 * 4096 + 3584);
                o[d0] = __builtin_amdgcn_mfma_f32_32x32x16_bf16(ASBF(pw0), VFRAG(l0, h0), o[d0], 0, 0, 0);
                o[d0] = __builtin_amdgcn_mfma_f32_32x32x16_bf16(ASBF(pw1), VFRAG(l1, h1), o[d0], 0, 0, 0);
                o[d0] = __builtin_amdgcn_mfma_f32_32x32x16_bf16(ASBF(pw2), VFRAG(l2, h2), o[d0], 0, 0, 0);
                o[d0] = __builtin_amdgcn_mfma_f32_32x32x16_bf16(ASBF(pw3), VFRAG(l3, h3), o[d0], 0, 0, 0);
            }
            wdone = __all(c == 0.f);
        }
        if (lane == 0) fl[(it & 1) * 8 + wid] = wdone ? 1 : 0;
        sl2 = sl; sl = (sl == 2 * C_SLOT) ? 0 : sl + C_SLOT;
    }
#undef C_ISSUE
    ATT_WAIT_BAR(0);
    LAS bf16* stg = (LAS bf16*)(shm + C_STG) + wid * 2048;
#pragma unroll
    for (int r = 0; r < 16; ++r)
#pragma unroll
        for (int d0 = 0; d0 < 2; ++d0) stg[crow(r, hi) * 64 + d0 * 32 + r32] = (bf16)(cvtpk(o[d0][r], 0.f) & 0xffffu);
    ATT_LDSW();
    bf16* Yw = YC + (rowbase + qw0) * 512 + h * 64;
#pragma unroll
    for (int i = 0; i < 4; ++i) { const int row = i * 8 + (lane >> 3), ch = lane & 7; const u32x4 v = *(const LAS u32x4*)(stg + row * 64 + ch * 8); *(u32x4*)(Yw + (long)row * 512 + ch * 8) = v; }
    ATT_WAIT_BAR(0);
}
#undef LAS
}

constexpr int NWAVES = 8;
constexpr int BATCH = 8, SEQ = 4096, D = 1024, M = BATCH * SEQ;
constexpr int BW = 512, NPROJ = 9 * BW, NGATE = 3 * D, DFF = 2816, DFX = 3584, NEXP = 8;
constexpr float EPS = 1e-6f, LOG2E_F = 1.4426950408889634f;
constexpr float C2 = 0.125f * LOG2E_F;
#ifndef GATE0_FP8
#define GATE0_FP8 1
#endif
#define GATE_FP8(L) (((L) == 0) ? (GATE0_FP8 != 0) : (MIX_FP8 >= 1))
#ifndef MIX_FP8
#define MIX_FP8 1
#endif
#ifndef DENSE_FP8
#define DENSE_FP8 0
#endif
#ifndef FFN_FP8
#define FFN_FP8 1
#endif
constexpr int MOE_CH_TILES = FFN_FP8 ? 128 : 64, MOE_MAX_TILES = 264, MOE_MAX_CH = FFN_FP8 ? 3 : 5;

constexpr size_t MiB = 1u << 20, KiB = 1u << 10;
constexpr size_t WS_CTL = 0, CTL_ZERO_BYTES = 1 * MiB;
constexpr size_t WS_WIN = 1 * MiB, WS_WG = 19 * MiB, WS_WB = 31 * MiB, WS_WO = 37 * MiB, WS_WGU = 41 * MiB, WS_WD = 52 * MiB;
constexpr size_t WS_BST = 58 * MiB;
constexpr size_t WS_TOKE = 64 * MiB, WS_TOKW = WS_TOKE + 128 * KiB, WS_SLOT = WS_TOKE + 384 * KiB, WS_SLW = WS_TOKE + 640 * KiB, WS_CNT = WS_TOKE + 960 * KiB, WS_MHDR = WS_TOKE + 992 * KiB;
constexpr size_t WS_H = 66 * MiB;
constexpr size_t WS_PA = 130 * MiB, WS_PB = 226 * MiB, WS_PC = 322 * MiB;
constexpr size_t WS_YA = 418 * MiB, WS_YB = 450 * MiB, WS_YC = 482 * MiB;
constexpr size_t WS_BP = 130 * MiB;
constexpr size_t WS_GATES = 226 * MiB;
constexpr size_t WS_ACT = 130 * MiB;
constexpr size_t WS_MWGU = 130 * MiB, WS_MWD = 242 * MiB;
constexpr size_t WS_HS = 298 * MiB;
constexpr size_t WS_MACT = 430 * MiB;
constexpr size_t WS_XB = 418 * MiB;
constexpr size_t WS_END = 482 * MiB;
constexpr size_t OUT_YA = 0, OUT_YB = 32 * MiB, OUT_YC = 64 * MiB, OUT_H8 = 96 * MiB, OUT_MACT8 = 0;
static_assert(FFN_FP8 == 1 && OUT_H8 + (size_t)M * D <= (size_t)M * D * 4 && OUT_MACT8 + (size_t)MOE_CH_TILES * 256 * DFX <= (size_t)M * D * 4, "d_out scratch map");
constexpr size_t WS8_MWGU = 130 * MiB, WS8_MWD = 186 * MiB, WS8_HS = 214 * MiB, WS8_YS = 280 * MiB, WS8_MACT = 412 * MiB;
static_assert(WS8_MWGU + (size_t)NEXP * 2 * DFX * D <= WS8_MWD && WS8_MWD + (size_t)NEXP * D * DFX <= WS8_HS && WS8_HS + (size_t)MOE_MAX_TILES * 256 * D <= WS8_YS && WS8_YS + (size_t)MOE_MAX_TILES * 256 * D * 2 <= WS_XB && WS_XB + (size_t)M * D * 2 <= WS_END, "d_ws map fp8");
static_assert(WS_WD + (size_t)D * DFF * 2 <= WS_BST && WS_HS + (size_t)MOE_MAX_TILES * 256 * D * 2 <= WS_MACT , "d_ws map");
static_assert(WS_MWGU + (size_t)NEXP * 2 * DFX * D * 2 <= WS_MWD && WS_MWD + (size_t)NEXP * D * DFX * 2 <= WS_HS && WS_ACT + (size_t)M * DFF * 2 <= WS_PC, "d_ws map 2");
constexpr int CW_BAR = 4096, CW_Q = 16384, CW_KM = 49152, CW_KC = 53248;

constexpr int RING_OFF = 0, LDSCTL_OFF = 139264, MISC_OFF = LDSCTL_OFF + 320, LTAB_OFF = LDSCTL_OFF + 1024;
constexpr int LDS_BYTES = 147456;

#define GAS __attribute__((address_space(1)))
#define LAS __attribute__((address_space(3)))
typedef unsigned short bf16;
typedef unsigned v4u __attribute__((ext_vector_type(4)));
typedef unsigned v2u __attribute__((ext_vector_type(2)));
typedef float f32x4 __attribute__((ext_vector_type(4)));
typedef float f32x2 __attribute__((ext_vector_type(2)));
typedef GAS unsigned gu32;
#define RLX_AGENT __ATOMIC_RELAXED, __HIP_MEMORY_SCOPE_AGENT
#define LDS_WAIT() asm volatile("s_waitcnt lgkmcnt(0)" ::: "memory")
#define VM_WAIT() asm volatile("s_waitcnt vmcnt(0)" ::: "memory")
__device__ __forceinline__ unsigned f2bf(float f) { unsigned u = __builtin_bit_cast(unsigned, f); return (u + 0x7fffu + ((u >> 16) & 1u)) >> 16; }
__device__ __forceinline__ unsigned pk2(float lo, float hi) { return f2bf(lo) | (f2bf(hi) << 16); }
__device__ __forceinline__ float bfl(unsigned w) { return __uint_as_float(w << 16); }
__device__ __forceinline__ float bfh(unsigned w) { return __uint_as_float(w & 0xffff0000u); }

#define XB_TMO      128
#define XB_XCNT(j)  (256  + 64 * (j))
#define XB_XSUB(j)  (1280 + 64 * (j))
#define XB_XGEN(j)  (2304 + 64 * (j))
#define XB_TOP      3328
#define XB_TOPGEN   3392
#define XCD_BAR_WORDS 3456
#define XB_SPIN_CAP (1u << 18)

__device__ __forceinline__ unsigned xb_ld(unsigned* p)              { return __hip_atomic_load(p, __ATOMIC_RELAXED, __HIP_MEMORY_SCOPE_AGENT); }
__device__ __forceinline__ unsigned xb_add(unsigned* p, unsigned v) { return __hip_atomic_fetch_add(p, v, __ATOMIC_RELAXED, __HIP_MEMORY_SCOPE_AGENT); }
__device__ __forceinline__ unsigned xb_xcc_id() { return (unsigned)__builtin_amdgcn_s_getreg((3 << 11) | 20) & 0xFu; }
#define XB_SPIN(cond, bar) do { unsigned _sp = 0; while (cond) { __builtin_amdgcn_s_sleep(1); \
    if ((++_sp & 255u) == 0u) { if (xb_ld(&(bar)[XB_TMO])) break; if (_sp > XB_SPIN_CAP) { atomicAdd(&(bar)[XB_TMO], 1u); break; } } } } while (0)

struct XcdBarrier {
    unsigned* bar; unsigned x;
    volatile LAS unsigned* st;
};

__device__ __forceinline__ XcdBarrier xcd_barrier_post(unsigned* bar, volatile LAS unsigned* st) {
    XcdBarrier b; b.bar = bar; b.x = xb_xcc_id(); b.st = st;
    if (threadIdx.x == 0) (void)xb_add(&bar[XB_XCNT(b.x)], 1u);
    return b;
}
__device__ __forceinline__ void xcd_barrier_complete(unsigned* bar, unsigned x, unsigned& nloc, unsigned& nx) {
    const unsigned G = gridDim.x * gridDim.y * gridDim.z;
    unsigned sum, cnt, mine, sp = 0u;
    for (;;) {
        sum = 0u; cnt = 0u; mine = 0u;
#pragma unroll
        for (unsigned j = 0; j < 16; ++j) { const unsigned c = xb_ld(&bar[XB_XCNT(j)]); sum += c; cnt += (c > 0u) ? 1u : 0u; mine = (j == x) ? c : mine; }
        if (sum == G) break;
        __builtin_amdgcn_s_sleep(1);
        if ((++sp & 255u) == 0u) { if (xb_ld(&bar[XB_TMO])) break; if (sp > XB_SPIN_CAP) { atomicAdd(&bar[XB_TMO], 1u); break; } }
    }
    nloc = mine > 0u ? mine : 1u; nx = cnt > 0u ? cnt : 1u;
}

__device__ __forceinline__ void xcd_barrier(const XcdBarrier& b) {
    asm volatile("s_waitcnt vmcnt(0)" ::: "memory");
    __syncthreads();
    if (threadIdx.x == 0) {
        unsigned* bar = b.bar;
        __builtin_amdgcn_s_waitcnt(0);
        unsigned nloc = b.st[0], nx = b.st[1];
        if (nloc == 0u) { xcd_barrier_complete(bar, b.x, nloc, nx); b.st[0] = nloc; b.st[1] = nx; }
        const unsigned old = xb_add(&bar[XB_XSUB(b.x)], 1u);
        const unsigned gen = old / nloc;
        if (old + 1u == (gen + 1u) * nloc) {
            __builtin_amdgcn_fence(__ATOMIC_RELEASE, "agent");
            asm volatile("s_waitcnt vmcnt(0)" ::: "memory");
            const unsigned og = xb_add(&bar[XB_TOP], 1u);
            const unsigned tg = og / nx;
            if (og + 1u == (tg + 1u) * nx) xb_add(&bar[XB_TOPGEN], 1u);
            else XB_SPIN(xb_ld(&bar[XB_TOPGEN]) == tg, bar);
            __builtin_amdgcn_fence(__ATOMIC_ACQUIRE, "agent");
            xb_add(&bar[XB_XGEN(b.x)], 1u);
            asm volatile("s_waitcnt vmcnt(0)" ::: "memory");
        } else {
            XB_SPIN(xb_ld(&bar[XB_XGEN(b.x)]) == gen, bar);
            __builtin_amdgcn_fence(__ATOMIC_ACQUIRE, "agent");
            asm volatile("s_waitcnt vmcnt(0)" ::: "memory");
        }
    }
    __syncthreads();
}


template <int OF> __device__ __forceinline__ float swz_f(float v) { return __int_as_float(__builtin_amdgcn_ds_swizzle(__float_as_int(v), (OF << 10) | 0x1f)); }
template <int OF> __device__ __forceinline__ int swz_i(int v) { return __builtin_amdgcn_ds_swizzle(v, (OF << 10) | 0x1f); }
__device__ __forceinline__ float x32_f(float v) { auto rr = __builtin_amdgcn_permlane32_swap(__float_as_uint(v), __float_as_uint(v), false, false); return __uint_as_float(rr[0]) + __uint_as_float(rr[1]); }
__device__ __forceinline__ int x32_i(int v) { auto rr = __builtin_amdgcn_permlane32_swap((unsigned)v, (unsigned)v, false, false); return (int)(rr[0] + rr[1]); }
__device__ __forceinline__ float wave_sum(float v) {
    v += swz_f<1>(v); v += swz_f<2>(v); v += swz_f<4>(v); v += swz_f<8>(v); v += swz_f<16>(v); return x32_f(v);
}
__device__ __forceinline__ int wave_sum_i(int v) { v += swz_i<1>(v); v += swz_i<2>(v); v += swz_i<4>(v); v += swz_i<8>(v); v += swz_i<16>(v); return x32_i(v); }
__device__ __forceinline__ void transpose_item(const float* W, int K, int N, bf16* WT, int row_off, LAS float* scr, int k0, int n0, int lane) {
    f32x4 wv_[8];
#pragma unroll
    for (int i = 0; i < 8; ++i) wv_[i] = *(const GAS f32x4*)(W + (size_t)(k0 + 8 * i + (lane >> 3)) * N + n0 + 4 * (lane & 7));
#pragma unroll
    for (int i = 0; i < 8; ++i) { LAS float* d = scr + (8 * i + (lane >> 3)) * 33 + 4 * (lane & 7); d[0] = wv_[i].x; d[1] = wv_[i].y; d[2] = wv_[i].z; d[3] = wv_[i].w; }
    LDS_WAIT(); asm volatile("" ::: "memory");
    const int c = lane & 7;
#pragma unroll
    for (int j = 0; j < 4; ++j) { const int n = (lane >> 3) + 8 * j; const LAS float* s = scr + (8 * c) * 33 + n;
        v4u o; o.x = pk2(s[0 * 33], s[1 * 33]); o.y = pk2(s[2 * 33], s[3 * 33]); o.z = pk2(s[4 * 33], s[5 * 33]); o.w = pk2(s[6 * 33], s[7 * 33]);
        *(GAS v4u*)(WT + (size_t)(row_off + n0 + n) * K + k0 + 8 * c) = o; }
    LDS_WAIT(); asm volatile("" ::: "memory");
}
__device__ __forceinline__ void conv_matrix(const float* W, int K, int N, bf16* WT, int mode, LAS float* scr, int gw, int ngw, int lane) {
    const int nblk = N / 32, items = (K / 64) * nblk;
    for (int it = gw; it < items; it += ngw) { const int kb = it / nblk, nb = it - kb * nblk, n0 = 32 * nb;
        const int d0 = mode == 0 ? n0 : (256 * (n0 >> 7) + (n0 & 127) + (mode == 2 ? 128 : 0));
        transpose_item(W, K, N, WT, d0 - n0, scr, 64 * kb, n0, lane); }
}
__device__ __forceinline__ void transpose_item8(const float* W, int K, int N, unsigned char* WT, int row_off, LAS float* scr, int k0, int n0, int lane) {
    f32x4 wv_[8];
#pragma unroll
    for (int i = 0; i < 8; ++i) wv_[i] = *(const GAS f32x4*)(W + (size_t)(k0 + 8 * i + (lane >> 3)) * N + n0 + 4 * (lane & 7));
#pragma unroll
    for (int i = 0; i < 8; ++i) { LAS float* d = scr + (8 * i + (lane >> 3)) * 33 + 4 * (lane & 7); d[0] = wv_[i].x; d[1] = wv_[i].y; d[2] = wv_[i].z; d[3] = wv_[i].w; }
    LDS_WAIT(); asm volatile("" ::: "memory");
    const int c = lane & 7; const float sc = (float)(1 << pg8::F8_WSHIFT);
#pragma unroll
    for (int j = 0; j < 4; ++j) { const int n = (lane >> 3) + 8 * j; const LAS float* s = scr + (8 * c) * 33 + n;
        v2u o; o.x = pg8::pk4_fp8(s[0 * 33] * sc, s[1 * 33] * sc, s[2 * 33] * sc, s[3 * 33] * sc); o.y = pg8::pk4_fp8(s[4 * 33] * sc, s[5 * 33] * sc, s[6 * 33] * sc, s[7 * 33] * sc);
        *(GAS v2u*)(WT + (size_t)(row_off + n0 + n) * K + k0 + 8 * c) = o; }
    LDS_WAIT(); asm volatile("" ::: "memory");
}
__device__ __forceinline__ void conv_matrix8(const float* W, int K, int N, unsigned char* WT, int mode, LAS float* scr, int gw, int ngw, int lane) {
    const int nblk = N / 32, items = (K / 64) * nblk;
    for (int it = gw; it < items; it += ngw) { const int kb = it / nblk, nb = it - kb * nblk, n0 = 32 * nb;
        const int d0 = mode == 0 ? n0 : (256 * (n0 >> 7) + (n0 & 127) + (mode == 2 ? 128 : 0));
        transpose_item8(W, K, N, WT, d0 - n0, scr, 64 * kb, n0, lane); }
}
__device__ __forceinline__ void store_row_fp8(unsigned char* orow, const f32x4 (&v)[4], int lane) {
    GAS unsigned* o4 = (GAS unsigned*)orow + lane;
#pragma unroll
    for (int j = 0; j < 4; ++j) o4[64 * j] = pg8::pk4_fp8(v[j].x, v[j].y, v[j].z, v[j].w);
}
__device__ __forceinline__ void rms_row(const float* xrow, const f32x4 (&g)[4], f32x4 (&v)[4], int lane) {
    const GAS f32x4* xr = (const GAS f32x4*)xrow + lane; float s2 = 0.f;
#pragma unroll
    for (int j = 0; j < 4; ++j) { v[j] = xr[64 * j]; s2 += (v[j].x * v[j].x + v[j].y * v[j].y) + (v[j].z * v[j].z + v[j].w * v[j].w); }
    const float rstd = 1.f / sqrtf(wave_sum(s2) * (1.f / D) + EPS);
#pragma unroll
    for (int j = 0; j < 4; ++j) v[j] = v[j] * rstd * g[j];
}
__device__ __forceinline__ f32x4 bf4(const v2u w) { return (f32x4){bfl(w.x), bfh(w.x), bfl(w.y), bfh(w.y)}; }
__device__ __forceinline__ void rms_row(const bf16* xrow, const f32x4 (&g)[4], f32x4 (&v)[4], int lane) {
    const GAS v2u* xr = (const GAS v2u*)xrow + lane; float s2 = 0.f; v2u w[4];
#pragma unroll
    for (int j = 0; j < 4; ++j) w[j] = xr[64 * j];
#pragma unroll
    for (int j = 0; j < 4; ++j) { v[j] = bf4(w[j]); s2 += (v[j].x * v[j].x + v[j].y * v[j].y) + (v[j].z * v[j].z + v[j].w * v[j].w); }
    const float rstd = 1.f / sqrtf(wave_sum(s2) * (1.f / D) + EPS);
#pragma unroll
    for (int j = 0; j < 4; ++j) v[j] = v[j] * rstd * g[j];
}
__device__ __forceinline__ void rms_row2(const bf16* xa, const bf16* xb, const f32x4 (&g)[4], f32x4 (&va)[4], f32x4 (&vb)[4], int lane) {
    const GAS v2u* pa = (const GAS v2u*)xa + lane; const GAS v2u* pb = (const GAS v2u*)xb + lane; float sa = 0.f, sb = 0.f; v2u wa[4], wb[4];
#pragma unroll
    for (int j = 0; j < 4; ++j) { wa[j] = pa[64 * j]; wb[j] = pb[64 * j]; }
#pragma unroll
    for (int j = 0; j < 4; ++j) { va[j] = bf4(wa[j]); vb[j] = bf4(wb[j]); sa += (va[j].x * va[j].x + va[j].y * va[j].y) + (va[j].z * va[j].z + va[j].w * va[j].w); sb += (vb[j].x * vb[j].x + vb[j].y * vb[j].y) + (vb[j].z * vb[j].z + vb[j].w * vb[j].w); }
    const float ra = 1.f / sqrtf(wave_sum(sa) * (1.f / D) + EPS), rb = 1.f / sqrtf(wave_sum(sb) * (1.f / D) + EPS);
#pragma unroll
    for (int j = 0; j < 4; ++j) { va[j] = va[j] * ra * g[j]; vb[j] = vb[j] * rb * g[j]; }
}
__device__ __forceinline__ void rms_row2(const float* xa, const float* xb, const f32x4 (&g)[4], f32x4 (&va)[4], f32x4 (&vb)[4], int lane) {
    const GAS f32x4* pa = (const GAS f32x4*)xa + lane; const GAS f32x4* pb = (const GAS f32x4*)xb + lane; float sa = 0.f, sb = 0.f;
#pragma unroll
    for (int j = 0; j < 4; ++j) { va[j] = pa[64 * j]; vb[j] = pb[64 * j]; }
#pragma unroll
    for (int j = 0; j < 4; ++j) { sa += (va[j].x * va[j].x + va[j].y * va[j].y) + (va[j].z * va[j].z + va[j].w * va[j].w); sb += (vb[j].x * vb[j].x + vb[j].y * vb[j].y) + (vb[j].z * vb[j].z + vb[j].w * vb[j].w); }
    const float ra = 1.f / sqrtf(wave_sum(sa) * (1.f / D) + EPS), rb = 1.f / sqrtf(wave_sum(sb) * (1.f / D) + EPS);
#pragma unroll
    for (int j = 0; j < 4; ++j) { va[j] = va[j] * ra * g[j]; vb[j] = vb[j] * rb * g[j]; }
}
__device__ __forceinline__ void store_row_bf16(bf16* orow, const f32x4 (&v)[4], int lane) {
    GAS v2u* o8 = (GAS v2u*)orow + lane;
#pragma unroll
    for (int j = 0; j < 4; ++j) { v2u w; w.x = pk2(v[j].x, v[j].y); w.y = pk2(v[j].z, v[j].w); o8[64 * j] = w; }
}


enum { PH_PRO = 0, PH_L = 20, NPHASE = 1 + 2 * PH_L };
struct Args { const float* in[18]; float* out; unsigned char* ws; int ph_lo, ph_hi; };
static_assert(sizeof(Args) == 18 * 8 + 8 + 8 + 8, "Args has no padding");

__global__ void __launch_bounds__(NWAVES * 64, 2) mega_fwd(Args args) {
    extern __shared__ __attribute__((aligned(16))) unsigned char lds_raw[];
    LAS unsigned char* const lds = (LAS unsigned char*)lds_raw;
    volatile LAS unsigned* const MISC = (volatile LAS unsigned*)(lds + MISC_OFF);
    const int wave_k = __builtin_amdgcn_readfirstlane((int)threadIdx.x >> 6);
    const int G = gridDim.x, bx = blockIdx.x; const int vcu = (G % 8 == 0) ? (bx % 8) * (G / 8) + bx / 8 : bx;
    const int NGW = G * NWAVES;
    unsigned char* const ws = args.ws;
    gu32* const ctl = (gu32*)(ws + WS_CTL);
    for (int u = threadIdx.x; u < (LDS_BYTES - LDSCTL_OFF) / 4; u += NWAVES * 64) ((LAS unsigned*)(lds + LDSCTL_OFF))[u] = 0u;
    __syncthreads();
#if MK_N_LAUNCHES == 1
    XcdBarrier bar = xcd_barrier_post((unsigned*)(ctl + CW_BAR), MISC + 8);
#ifndef PROBE_AMP
#define PROBE_AMP 1
#endif
#ifdef PROBE_CAT
#define SEAM() do { xcd_barrier(bar); if (bx == 0 && threadIdx.x == 0) { const unsigned long long tn_ = __builtin_amdgcn_s_memrealtime(); volatile LAS unsigned* pa_ = (volatile LAS unsigned*)(lds + LDSCTL_OFF + 640); if (cat_ == PROBE_CAT) pa_[0] += (unsigned)(tn_ - *(volatile LAS unsigned long long*)(lds + LDSCTL_OFF + 704)); *(volatile LAS unsigned long long*)(lds + LDSCTL_OFF + 704) = tn_; } } while (0)
#else
#define SEAM() xcd_barrier(bar)
#endif
#else
#define SEAM() do { } while (0)
#endif
    const int lo = args.ph_lo, hi = args.ph_hi;
#ifdef PROBE_CAT
    int cat_ = 0; if (bx == 0 && threadIdx.x == 0) *(volatile LAS unsigned long long*)(lds + LDSCTL_OFF + 704) = __builtin_amdgcn_s_memrealtime();
#define CAT(c) cat_ = (c)
#else
#define CAT(c) do { } while (0)
#endif
#define IN(k) (lo <= (k) && (k) < hi)
#ifndef REPG
#define REPG 1
#endif
#ifndef REPA
#define REPA 1
#endif
#ifndef REPA_A
#define REPA_A REPA
#endif
#ifndef REPA_C
#define REPA_C REPA
#endif
#ifndef REPA_B
#define REPA_B REPA
#endif
#ifndef REPT
#define REPT 1
#endif
#define PHASE_IDS() unsigned z0_ = 0u; asm volatile("" : "+s"(z0_)); int tidp = wave_k * 64 + (int)__builtin_amdgcn_mbcnt_hi(~0u, __builtin_amdgcn_mbcnt_lo(~0u, z0_)); asm volatile("" : "+v"(tidp)); const int tid = tidp, lane = tidp & 63, wave = __builtin_amdgcn_readfirstlane(tidp >> 6); const int gw = vcu * NWAVES + wave; LAS float* const scr = (LAS float*)(lds + RING_OFF + wave * 16384); (void)tid; (void)lane; (void)gw; (void)scr
#define INP(i) ([&]() -> const float* { int i_ = (i); asm volatile("" : "+s"(i_)); return args.in[i_]; }())
#define WSP(T, OFF) ([&]() -> T* { size_t o_ = (size_t)(OFF); asm volatile("" : "+s"(o_)); return (T*)(ws + o_); }())
#define x_in INP(0)
#define norm_mix INP(1)
#define w_in INP(2)
#define diff_lambda INP(3)
#define diff_subln INP(4)
#define w_gate INP(5)
#define b_gate INP(6)
#define w_branch INP(7)
#define w_out INP(8)
#define norm_ffn INP(9)
#define w_dg INP(10)
#define w_du INP(11)
#define w_dd INP(12)
#define w_router INP(13)
#define w_mg INP(14)
#define w_mu INP(15)
#define w_md INP(16)
#define norm_final INP(17)
#define xout (args.out)
#define Win_t WSP(bf16, WS_WIN)
#define Wg_t WSP(bf16, WS_WG)
#define Wb_t WSP(bf16, WS_WB)
#define Wo_t WSP(bf16, WS_WO)
#define Wgu_t WSP(bf16, WS_WGU)
#define Wd_t WSP(bf16, WS_WD)
#define Hb WSP(bf16, WS_H)
#define PA WSP(bf16, WS_PA)
#define PB WSP(bf16, WS_PB)
#define PC WSP(bf16, WS_PC)
#define OUTP(T, OFF) ([&]() -> T* { size_t o_ = (size_t)(OFF); asm volatile("" : "+s"(o_)); return (T*)((unsigned char*)args.out + o_); }())
#define YA OUTP(bf16, OUT_YA)
#define YC OUTP(bf16, OUT_YC)
#define YB OUTP(bf16, OUT_YB)
#define XB WSP(bf16, WS_XB)
#define BP WSP(bf16, WS_BP)
#define BST WSP(float, WS_BST)
#define GATES WSP(bf16, WS_GATES)
#define ACT WSP(bf16, WS_ACT)
#define MWgu WSP(bf16, WS_MWGU)
#define MWd WSP(bf16, WS_MWD)
#define HS WSP(bf16, WS_HS)
#define MACT WSP(bf16, WS_MACT)
#define TOKE WSP(int, WS_TOKE)
#define TOKW WSP(float, WS_TOKW)
#define SLOT WSP(int, WS_SLOT)
#define SLW WSP(float, WS_SLW)
#define CNT WSP(int, WS_CNT)
#define MHDR WSP(int, WS_MHDR)
#define Hb8 WSP(unsigned char, WS_H)
#define H8 OUTP(unsigned char, OUT_H8)
#define Win8 WSP(unsigned char, WS_WIN)
#define Wg8 WSP(unsigned char, WS_WG)
#define Wgu8 WSP(unsigned char, WS_WGU)
#define Wd8 WSP(unsigned char, WS_WD)
#define ACT8 WSP(unsigned char, WS_ACT)
#define MWgu8 WSP(unsigned char, WS8_MWGU)
#define MWd8 WSP(unsigned char, WS8_MWD)
#define HS8 WSP(unsigned char, WS8_HS)
#define YS8 WSP(bf16, WS8_YS)
#define MACT8 OUTP(unsigned char, OUT_MACT8)

    if (IN(PH_PRO)) { PHASE_IDS(); CAT(1);
        for (int L = 0; L < 2; ++L) {
#if MIX_FP8 >= 2
            conv_matrix8(w_in + (size_t)L * D * NPROJ, D, NPROJ, Win8 + (size_t)L * NPROJ * D, 0, scr, gw, NGW, lane);
#else
            conv_matrix(w_in + (size_t)L * D * NPROJ, D, NPROJ, Win_t + (size_t)L * NPROJ * D, 0, scr, gw, NGW, lane);
#endif
            if (GATE_FP8(L)) conv_matrix8(w_gate + (size_t)L * D * NGATE, D, NGATE, Wg8 + (size_t)L * NGATE * D * 2, 0, scr, gw, NGW, lane);
            else conv_matrix(w_gate + (size_t)L * D * NGATE, D, NGATE, Wg_t + (size_t)L * NGATE * D, 0, scr, gw, NGW, lane);
            for (int i = 0; i < 3; ++i) conv_matrix(w_branch + (size_t)(L * 3 + i) * BW * D, BW, D, Wb_t + (size_t)(L * 3 + i) * D * BW, 0, scr, gw, NGW, lane);
            conv_matrix(w_out + (size_t)L * D * D, D, D, Wo_t + (size_t)L * D * D, 0, scr, gw, NGW, lane);
        }
#if DENSE_FP8
        conv_matrix8(w_dg, D, DFF, Wgu8, 1, scr, gw, NGW, lane);
        conv_matrix8(w_du, D, DFF, Wgu8, 2, scr, gw, NGW, lane);
        conv_matrix8(w_dd, DFF, D, Wd8, 0, scr, gw, NGW, lane);
#else
        conv_matrix(w_dg, D, DFF, Wgu_t, 1, scr, gw, NGW, lane);
        conv_matrix(w_du, D, DFF, Wgu_t, 2, scr, gw, NGW, lane);
        conv_matrix(w_dd, DFF, D, Wd_t, 0, scr, gw, NGW, lane);
#endif
        {

            f32x4 g[4];
#pragma unroll
            for (int j = 0; j < 4; ++j) g[j] = ((const GAS f32x4*)(norm_mix) + lane)[64 * j];
            for (int m = gw; m < M; m += 2 * NGW) { f32x4 v[4], w[4]; rms_row2(x_in + (size_t)m * D, x_in + (size_t)(m + NGW) * D, g, v, w, lane);
                store_row_bf16(Hb + (size_t)m * D, v, lane); store_row_bf16(Hb + (size_t)(m + NGW) * D, w, lane);
                if (GATE0_FP8) { store_row_fp8(H8 + (size_t)m * D, v, lane); store_row_fp8(H8 + (size_t)(m + NGW) * D, w, lane); } }
        }
        SEAM();
    }

    for (int L = 0; L < 2; ++L) {
        const int P = 1 + L * PH_L;
        if (L == 1 && IN(P + 0)) { PHASE_IDS(); CAT(2);
            f32x4 g[4];
#pragma unroll
            for (int j = 0; j < 4; ++j) g[j] = ((const GAS f32x4*)(norm_mix + L * D) + lane)[64 * j];
            for (int m = gw; m < M; m += 2 * NGW) { f32x4 v[4], w[4]; rms_row2(XB + (size_t)m * D, XB + (size_t)(m + NGW) * D, g, v, w, lane);
                store_row_bf16(Hb + (size_t)m * D, v, lane); store_row_bf16(Hb + (size_t)(m + NGW) * D, w, lane);
                if (MIX_FP8 >= 1 && L == 1) { store_row_fp8(H8 + (size_t)m * D, v, lane); store_row_fp8(H8 + (size_t)(m + NGW) * D, w, lane); } }
            SEAM();
        }
        if (IN(P + 1)) { PHASE_IDS(); CAT(3);
#if MIX_FP8 >= 2
            pg8::Gemm g{(const bf16*)H8, (const bf16*)(Win8 + (size_t)L * NPROJ * D), D / 2}; pg8::StaticOrder S; S.init(M, NPROJ, D / 2, G, bx);
            pg8::EpiProj E{PA, (size_t)(WS_PB - WS_PA) / 2, C2, pg8::F8_WINV};
            pg8::gemm_phase<pg8::EpiProj, pg8::StaticOrder, true, true, true>(lds + RING_OFF, g, S, E, tidp);
#else
            pg8::Gemm g{Hb, Win_t + (size_t)L * NPROJ * D, D}; pg8::StaticOrder S; S.init(M, NPROJ, D, G, bx);
            pg8::EpiProj E{PA, (size_t)(WS_PB - WS_PA) / 2, C2, 1.f};
            for (int rep_ = 0; rep_ < REPG; ++rep_) { int tq_ = tidp; asm volatile("" : "+v"(tq_)); pg8::gemm_phase<pg8::EpiProj, pg8::StaticOrder, true, true>(lds + RING_OFF, g, S, E, tq_); }
#endif

            SEAM();
        }
        if (IN(P + 2)) { PHASE_IDS(); CAT(4);
            const float lam_init = 0.8f - 0.6f * expf(-0.3f * (float)L);
            float lam;
            { const float* lv = diff_lambda + L * 256; float s01 = lv[lane] * lv[64 + lane], s23 = lv[128 + lane] * lv[192 + lane];
              s01 += att::swz_xor<1>(s01); s01 += att::swz_xor<2>(s01); s01 += att::swz_xor<4>(s01); s01 += att::swz_xor<8>(s01); s01 += att::swz_xor<16>(s01); s01 += att::xhalf(s01, lane >> 5);
              s23 += att::swz_xor<1>(s23); s23 += att::swz_xor<2>(s23); s23 += att::swz_xor<4>(s23); s23 += att::swz_xor<8>(s23); s23 += att::swz_xor<16>(s23); s23 += att::xhalf(s23, lane >> 5);
              lam = expf(s01) - expf(s23) + lam_init; }
            { LAS int* qs = (LAS int*)(lds + LDSCTL_OFF + 512); const int grp = bx & 7;
              gu32* km = ctl + CW_KM + (L * 8 + grp) * 64; gu32* kc = ctl + CW_KC + (L * 8 + grp) * 64;
              { const int r0 = grp * SEQ + (bx >> 3) * 128 + wave * 16; float mx = 0.f;
                for (int r = 0; r < 16; ++r) { const v4u w = *(const GAS v4u*)(PA + (size_t)(r0 + r) * 1536 + 512 + lane * 8);
                    float ss = bfl(w.x) * bfl(w.x) + bfh(w.x) * bfh(w.x) + bfl(w.y) * bfl(w.y) + bfh(w.y) * bfh(w.y) + bfl(w.z) * bfl(w.z) + bfh(w.z) * bfh(w.z) + bfl(w.w) * bfl(w.w) + bfh(w.w) * bfh(w.w);
                    ss += att::swz_xor<1>(ss); ss += att::swz_xor<2>(ss); ss += att::swz_xor<4>(ss); mx = fmaxf(mx, ss); }
                if ((lane & 7) == 0) __hip_atomic_fetch_max(km + (lane >> 3), __float_as_uint(mx), RLX_AGENT);
                VM_WAIT(); __syncthreads();
                if (tid == 0) { __hip_atomic_fetch_add(kc, 1u, RLX_AGENT); unsigned sp = 0; while (__hip_atomic_load(kc, RLX_AGENT) < 32u && ++sp < (1u << 22)) __builtin_amdgcn_s_sleep(2);
                    qs[2] = (sp < (1u << 22)) ? 1 : 0; }
                __syncthreads(); }
              const bool kok = qs[2] != 0;
              gu32* ctrA = ctl + CW_Q + ((L * 2 + 0) * 8 + grp) * 64; gu32* ctrC = ctl + CW_Q + ((L * 2 + 1) * 8 + grp) * 64;
              { LAS float* sln = (LAS float*)(lds + RING_OFF + att::A_SLN); LAS float* knl = (LAS float*)(lds + RING_OFF + att::A_KN);
                if (tid < 128) sln[tid] = (diff_subln + L * 128)[tid] * (1.f - lam_init);
                if (tid >= 128 && tid < 136) knl[tid - 128] = kok ? sqrtf(__uint_as_float(__hip_atomic_load(km + (tid - 128), RLX_AGENT))) : INFINITY;
                __syncthreads(); }
              for (int rep_ = 0; rep_ < REPA_A; ++rep_) {
                  if (tid == 0) qs[0] = (int)__hip_atomic_fetch_add(ctrA + rep_ * 8192, 1u, RLX_AGENT);
                  __syncthreads();
                  int u = __builtin_amdgcn_readfirstlane(qs[0]);
                  while (u < 128) {
                      unsigned un_ = 0u; if (tid == 256) { gu32* cp_ = ctrA + rep_ * 8192; asm volatile("global_atomic_add %0, %1, %2, off sc0" : "=v"(un_) : "v"(cp_), "v"(1u) : "memory"); }
                      const LAS float* knl = (const LAS float*)(lds + RING_OFF + att::A_KN);
#ifdef PROBE_AMODE
                      if (rep_ != REPA_A - 1) att::diff_unit<PROBE_AMODE>(grp, u >> 5, 31 - (u & 31), PA, YA, lam, knl[2 * (u >> 5)], knl[2 * (u >> 5) + 1], (LAS char*)(lds + RING_OFF), tidp, 0); else
#endif
                      att::diff_unit<0>(grp, u >> 5, 31 - (u & 31), PA, YA, lam, knl[2 * (u >> 5)], knl[2 * (u >> 5) + 1], (LAS char*)(lds + RING_OFF), tidp);
                      if (tid == 256) { asm volatile("s_waitcnt vmcnt(0)" : "+v"(un_) :: "memory"); qs[0] = (int)un_; }
                      asm volatile("s_waitcnt lgkmcnt(0)\n\ts_barrier" ::: "memory");
                      u = __builtin_amdgcn_readfirstlane(qs[0]);
                  }
              }
              __syncthreads();
              for (int rep_ = 0; rep_ < REPA_C; ++rep_)
              for (;;) {
                  if (tid == 0) qs[1] = (int)__hip_atomic_fetch_add(ctrC + rep_ * 8192, 1u, RLX_AGENT);
                  __syncthreads();
                  const int u = __builtin_amdgcn_readfirstlane(qs[1]); if (u >= 128) break;
                  att::sb_unit(grp, u & 7, 15 - (u >> 3), PC, YC, (LAS char*)(lds + RING_OFF), tidp);
              }
            }
            SEAM();
        }
        if (IN(P + 3)) { PHASE_IDS(); CAT(5);
            att::dil_phase(vcu, PB, BP, BST, (LAS char*)(lds + RING_OFF), tidp);
            SEAM();
        }
        if (IN(P + 4)) { PHASE_IDS(); CAT(6);
            for (int m = gw; m < M; m += NGW) {
                const int hd = lane >> 3; f32x2 st[3]; float mx = -INFINITY;
#pragma unroll
                for (int p = 0; p < 3; ++p) { st[p] = *(const GAS f32x2*)(BST + ((size_t)p * M + m) * 16 + hd * 2); mx = fmaxf(mx, st[p].x); }
                float wgt[3], wsum = 0.f;
#pragma unroll
                for (int p = 0; p < 3; ++p) { wgt[p] = __builtin_amdgcn_exp2f(st[p].x - mx) * st[p].y; wsum += wgt[p]; }
                const float inv = 1.f / wsum; float acc[8];
#pragma unroll
                for (int k = 0; k < 8; ++k) acc[k] = 0.f;
#pragma unroll
                for (int p = 0; p < 3; ++p) { const v4u w = *(const GAS v4u*)(BP + ((size_t)p * M + m) * BW + lane * 8); const float f = wgt[p] * inv;
                    acc[0] += f * bfl(w.x); acc[1] += f * bfh(w.x); acc[2] += f * bfl(w.y); acc[3] += f * bfh(w.y); acc[4] += f * bfl(w.z); acc[5] += f * bfh(w.z); acc[6] += f * bfl(w.w); acc[7] += f * bfh(w.w); }
                v4u o; o.x = pk2(acc[0], acc[1]); o.y = pk2(acc[2], acc[3]); o.z = pk2(acc[4], acc[5]); o.w = pk2(acc[6], acc[7]);
                *(GAS v4u*)(YB + (size_t)m * BW + lane * 8) = o;
            }
            VM_WAIT(); __syncthreads();
            if (GATE_FP8(L)) {
                pg8::Gemm g{(const bf16*)H8, (const bf16*)(Wg8 + (size_t)L * NGATE * D * 2), D / 2}; pg8::StaticOrder S; S.init(M, NGATE, D / 2, G, bx);
                pg8::EpiGate E{GATES, NGATE, b_gate + L * NGATE, pg8::F8_WINV};
                pg8::gemm_phase<pg8::EpiGate, pg8::StaticOrder, true, true, true>(lds + RING_OFF, g, S, E, tidp);
            } else {
                pg8::Gemm g{Hb, Wg_t + (size_t)L * NGATE * D, D}; pg8::StaticOrder S; S.init(M, NGATE, D, G, bx);
                pg8::EpiGate E{GATES, NGATE, b_gate + L * NGATE, 1.f};
                for (int rep_ = 0; rep_ < REPG; ++rep_) { int tq_ = tidp; asm volatile("" : "+v"(tq_)); pg8::gemm_phase<pg8::EpiGate, pg8::StaticOrder, true, true>(lds + RING_OFF, g, S, E, tq_); }
            }

            SEAM();
        }
        if (IN(P + 5)) { PHASE_IDS(); CAT(7);
            pg8::Gemm g{YA, Wb_t + (size_t)L * 3 * D * BW, BW}; pg8::MergeOrder S; S.b.init(M, D, BW, G, bx);
            S.as = (long)(OUT_YB - OUT_YA); S.bs = (long)D * BW * 2;
            pg8::EpiMerge E{GATES, Hb};

 for (int rep_ = 0; rep_ < ((true) ? REPG : 1); ++rep_) { int tq_ = tidp; asm volatile("" : "+v"(tq_));  pg8::gemm_phase<pg8::EpiMerge, pg8::MergeOrder, true, true>(lds + RING_OFF, g, S, E, tq_); }

            SEAM();
        }
        if (IN(P + 6)) { PHASE_IDS(); CAT(8);
            pg8::Gemm g{Hb, Wo_t + (size_t)L * D * D, D}; pg8::StaticOrder S; S.init(M, D, D, G, bx);
            pg8::EpiResB E{(L == 0) ? (const void*)x_in : (const void*)XB, XB, 1.f, L == 0};

 for (int rep_ = 0; rep_ < ((L == 0) ? REPG : 1); ++rep_) { int tq_ = tidp; asm volatile("" : "+v"(tq_));  pg8::gemm_phase<pg8::EpiResB, pg8::StaticOrder, true, true>(lds + RING_OFF, g, S, E, tq_); }

            SEAM();
        }
        if (L == 0) {
            if (IN(P + 7)) { PHASE_IDS(); CAT(9);
                f32x4 g[4];
#pragma unroll
                for (int j = 0; j < 4; ++j) g[j] = ((const GAS f32x4*)(norm_ffn + L * D) + lane)[64 * j];
#if DENSE_FP8
                for (int m = gw; m < M; m += NGW) { f32x4 v[4]; rms_row(XB + (size_t)m * D, g, v, lane); store_row_fp8(Hb8 + (size_t)m * D, v, lane); }
#else
                for (int m = gw; m < M; m += 2 * NGW) { f32x4 v[4], w[4]; rms_row2(XB + (size_t)m * D, XB + (size_t)(m + NGW) * D, g, v, w, lane); store_row_bf16(Hb + (size_t)m * D, v, lane); store_row_bf16(Hb + (size_t)(m + NGW) * D, w, lane); }
#endif
                SEAM();
            }
            if (IN(P + 8)) { PHASE_IDS(); CAT(10);
#if DENSE_FP8
                pg8::Gemm g{(const bf16*)Hb8, (const bf16*)Wgu8, D / 2}; pg8::StaticOrder S; S.init(M, 2 * DFF, D / 2, G, bx);
                pg8::EpiSwigluF8 E{ACT8, DFF};
                for (int rep_ = 0; rep_ < REPG; ++rep_) { int tq_ = tidp; asm volatile("" : "+v"(tq_)); pg8::gemm_phase<pg8::EpiSwigluF8, pg8::StaticOrder, true, true, true>(lds + RING_OFF, g, S, E, tq_); }
#else
                pg8::Gemm g{Hb, Wgu_t, D}; pg8::StaticOrder S; S.init(M, 2 * DFF, D, G, bx);
                pg8::EpiSwiglu E{ACT, DFF};
                for (int rep_ = 0; rep_ < REPG; ++rep_) { int tq_ = tidp; asm volatile("" : "+v"(tq_)); pg8::gemm_phase<pg8::EpiSwiglu, pg8::StaticOrder, true, true>(lds + RING_OFF, g, S, E, tq_); }
#endif

                SEAM();
            }
            if (IN(P + 9)) { PHASE_IDS(); CAT(11);
#if DENSE_FP8
                pg8::EpiResB E{XB, XB, pg8::F8_WINV, 0};
                pg8::Gemm g{(const bf16*)ACT8, (const bf16*)Wd8, DFF / 2}; pg8::StaticOrder S; S.init(M, D, DFF / 2, G, bx);
                pg8::gemm_phase<pg8::EpiResB, pg8::StaticOrder, true, true, true>(lds + RING_OFF, g, S, E, tidp);
#else
                pg8::EpiResB E{XB, XB, 1.f, 0};
                pg8::Gemm g{ACT, Wd_t, DFF}; pg8::StaticOrder S; S.init(M, D, DFF, G, bx);
                pg8::gemm_phase<pg8::EpiResB, pg8::StaticOrder, true, true>(lds + RING_OFF, g, S, E, tidp);
#endif

                SEAM();
            }
        } else {
            if (IN(P + 7)) { PHASE_IDS(); CAT(12);
                LAS float* wr = (LAS float*)(lds + RING_OFF);
                LAS int* cl = (LAS int*)(lds + RING_OFF + 32768);
                for (int u = tid; u < D * NEXP; u += NWAVES * 64) wr[(u & 7) * D + (u >> 3)] = w_router[u];
                if (tid < NEXP) cl[tid] = 0;
                __syncthreads();
                f32x4 g[4];
#pragma unroll
                for (int j = 0; j < 4; ++j) g[j] = ((const GAS f32x4*)(norm_ffn + L * D) + lane)[64 * j];
                for (int k = 0; k < 16; ++k) { const int m = bx * 128 + wave + 8 * k;
                    f32x4 v[4]; rms_row(XB + (size_t)m * D, g, v, lane);
#if FFN_FP8
                    store_row_fp8(Hb8 + (size_t)m * D, v, lane);
#else
                    store_row_bf16(Hb + (size_t)m * D, v, lane);
#endif
                    float lg[NEXP];
#pragma unroll
                    for (int e = 0; e < NEXP; ++e) lg[e] = 0.f;
#pragma unroll
                    for (int j = 0; j < 4; ++j)
#pragma unroll
                        for (int e = 0; e < NEXP; ++e) { const f32x4 w4 = *(const LAS f32x4*)(wr + e * D + 4 * lane + 256 * j); lg[e] += (v[j].x * w4.x + v[j].y * w4.y) + (v[j].z * w4.z + v[j].w * w4.w); }
#pragma unroll
                    for (int e = 0; e < NEXP; ++e) lg[e] = wave_sum(lg[e]);
                    int e1 = 0; float v1 = lg[0];
#pragma unroll
                    for (int e = 1; e < NEXP; ++e) if (lg[e] > v1) { v1 = lg[e]; e1 = e; }
                    int e2 = -1; float v2 = -INFINITY;
#pragma unroll
                    for (int e = 0; e < NEXP; ++e) if (e != e1 && lg[e] > v2) { v2 = lg[e]; e2 = e; }
                    const float w1 = 1.f / (1.f + expf(v2 - v1));
                    if (lane == 0) { TOKE[m] = e1 | (e2 << 8); TOKW[2 * m] = w1; TOKW[2 * m + 1] = 1.f - w1; __hip_atomic_fetch_add(cl + e1, 1, __ATOMIC_RELAXED, __HIP_MEMORY_SCOPE_WORKGROUP); __hip_atomic_fetch_add(cl + e2, 1, __ATOMIC_RELAXED, __HIP_MEMORY_SCOPE_WORKGROUP); }
                }
                __syncthreads();
                if (tid < NEXP) CNT[bx * NEXP + tid] = cl[tid];
                __syncthreads();
                for (int e = 0; e < NEXP; ++e) {
#if FFN_FP8
                    conv_matrix8(w_mg + (size_t)e * D * DFX, D, DFX, MWgu8 + (size_t)e * 2 * DFX * D, 1, scr, gw, NGW, lane);
                    conv_matrix8(w_mu + (size_t)e * D * DFX, D, DFX, MWgu8 + (size_t)e * 2 * DFX * D, 2, scr, gw, NGW, lane);
                    conv_matrix8(w_md + (size_t)e * DFX * D, DFX, D, MWd8 + (size_t)e * D * DFX, 0, scr, gw, NGW, lane);
#else
                    conv_matrix(w_mg + (size_t)e * D * DFX, D, DFX, MWgu + (size_t)e * 2 * DFX * D, 1, scr, gw, NGW, lane);
                    conv_matrix(w_mu + (size_t)e * D * DFX, D, DFX, MWgu + (size_t)e * 2 * DFX * D, 2, scr, gw, NGW, lane);
                    conv_matrix(w_md + (size_t)e * DFX * D, DFX, D, MWd + (size_t)e * D * DFX, 0, scr, gw, NGW, lane);
#endif
                }
                SEAM();
            }
            if (IN(P + 8)) { PHASE_IDS(); CAT(13);
                LAS int* C = (LAS int*)(lds + RING_OFF);
                LAS int* TB = (LAS int*)(lds + RING_OFF + 8192);
                LAS int* SL = (LAS int*)(lds + RING_OFF + 8192 + 256);
                for (int u = tid; u < 256 * NEXP; u += NWAVES * 64) C[u] = CNT[u];
                __syncthreads();
                { const int e = wave; int tot = 0, pre = 0;
#pragma unroll
                  for (int q = 0; q < 4; ++q) { const int i = 4 * lane + q; const int cv = C[i * NEXP + e]; tot += cv; pre += (i < bx) ? cv : 0; }
                  tot = wave_sum_i(tot); pre = wave_sum_i(pre);
                  if (lane == 0) { TB[e] = pre; TB[8 + e] = tot; } }
                __syncthreads();
                if (tid == 0) { int base = 0, cum = 0;
                    for (int e = 0; e < NEXP; ++e) { TB[16 + e] = base; const int nt = (TB[8 + e] + 255) >> 8; base += nt * 256; cum += nt; if (bx == 0) MHDR[1 + e] = cum; }
                    if (bx == 0) MHDR[0] = cum; }
                __syncthreads();
                if (wave == 0) {
                    const int t0 = bx * 128 + 2 * lane; const int ea = TOKE[t0], eb = TOKE[t0 + 1];
                    int pe[4] = {ea & 255, ea >> 8, eb & 255, eb >> 8}; int slot[4] = {0, 0, 0, 0};
#pragma unroll
                    for (int e = 0; e < NEXP; ++e) { int mine = 0;
#pragma unroll
                        for (int q = 0; q < 4; ++q) mine += (pe[q] == e) ? 1 : 0;
                        int inc = mine;
#pragma unroll
                        for (int o = 1; o < 64; o <<= 1) { const int t = __builtin_amdgcn_ds_bpermute(((lane - o) & 63) << 2, inc); if (lane >= o) inc += t; }
                        int run = TB[16 + e] + TB[e] + inc - mine;
#pragma unroll
                        for (int q = 0; q < 4; ++q) if (pe[q] == e) { slot[q] = run; ++run; } }
                    const f32x4 wv = *(const GAS f32x4*)(TOKW + 2 * t0);
                    SL[4 * lane + 0] = slot[0]; SL[4 * lane + 1] = slot[1]; SL[4 * lane + 2] = slot[2]; SL[4 * lane + 3] = slot[3];
                    { v4u sv; sv.x = (unsigned)slot[0]; sv.y = (unsigned)slot[1]; sv.z = (unsigned)slot[2]; sv.w = (unsigned)slot[3]; *(GAS v4u*)(SLOT + 2 * t0) = sv; }
                    SLW[slot[0]] = wv.x; SLW[slot[1]] = wv.y; SLW[slot[2]] = wv.z; SLW[slot[3]] = wv.w;
                }
                __syncthreads();
                for (int k = 0; k < 16; ++k) { const int tl = wave + 8 * k; const int m = bx * 128 + tl; const int s0 = SL[2 * tl], s1 = SL[2 * tl + 1];
#if FFN_FP8
                    const v4u a = ((const GAS v4u*)(Hb8 + (size_t)m * D))[lane];
                    ((GAS v4u*)(HS8 + (size_t)s0 * D))[lane] = a; ((GAS v4u*)(HS8 + (size_t)s1 * D))[lane] = a; }
#else
                    const GAS v4u* src = (const GAS v4u*)(Hb + (size_t)m * D) + lane; const v4u a = src[0], b = src[64];
                    GAS v4u* d0 = (GAS v4u*)(HS + (size_t)s0 * D) + lane; GAS v4u* d1 = (GAS v4u*)(HS + (size_t)s1 * D) + lane;
                    d0[0] = a; d0[64] = b; d1[0] = a; d1[64] = b; }
#endif
                SEAM();
            }
            {
                int nt_all = 0, c0 = 0, c1 = 0, c2 = 0, c3 = 0, c4 = 0, c5 = 0, c6 = 0;
                if (hi > P + 9 && lo < P + 19) { const int* hd = MHDR;
                    nt_all = __builtin_amdgcn_readfirstlane(hd[0]); c0 = __builtin_amdgcn_readfirstlane(hd[1]); c1 = __builtin_amdgcn_readfirstlane(hd[2]); c2 = __builtin_amdgcn_readfirstlane(hd[3]);
                    c3 = __builtin_amdgcn_readfirstlane(hd[4]); c4 = __builtin_amdgcn_readfirstlane(hd[5]); c5 = __builtin_amdgcn_readfirstlane(hd[6]); c6 = __builtin_amdgcn_readfirstlane(hd[7]); }
                if (nt_all > MOE_MAX_TILES) nt_all = MOE_MAX_TILES;
                for (int ch = 0; ch < MOE_MAX_CH; ++ch) {
                    const int t0 = ch * MOE_CH_TILES; int nt = nt_all - t0; if (nt > MOE_CH_TILES) nt = MOE_CH_TILES;
                    if (nt <= 0) break;
                    if (IN(P + 9 + 2 * ch)) { PHASE_IDS(); CAT(14);
#if FFN_FP8
                        pg8::Gemm g{(const bf16*)HS8, (const bf16*)MWgu8, D / 2}; pg8::MoeOrder S{t0, nt, 2 * DFX / 256, nt * (2 * DFX / 256), G, bx, (long)256 * D, (long)256 * D, (long)2 * DFX * D, c0, c1, c2, c3, c4, c5, c6, false, true};
                        pg8::EpiSwigluF8 E{MACT8, DFX};
                        pg8::gemm_phase<pg8::EpiSwigluF8, pg8::MoeOrder, true, true, true>(lds + RING_OFF, g, S, E, tidp);
#else
                        pg8::Gemm g{HS, MWgu, D}; pg8::MoeOrder S{t0, nt, 2 * DFX / 256, nt * (2 * DFX / 256), G, bx, (long)256 * D * 2, (long)256 * D * 2, (long)2 * DFX * D * 2, c0, c1, c2, c3, c4, c5, c6, false, true};
                        pg8::EpiSwiglu E{MACT, DFX};
                        pg8::gemm_phase<pg8::EpiSwiglu, pg8::MoeOrder, true, true>(lds + RING_OFF, g, S, E, tidp);
#endif

                        SEAM();
                    }
                    if (IN(P + 10 + 2 * ch)) { PHASE_IDS(); CAT(15);
#if FFN_FP8
                        pg8::Gemm g{(const bf16*)MACT8, (const bf16*)MWd8, DFX / 2}; pg8::MoeOrder S{t0, nt, D / 256, nt * (D / 256), G, bx, (long)256 * DFX, (long)256 * DFX, (long)D * DFX, c0, c1, c2, c3, c4, c5, c6, true, false};
                        pg8::EpiMoeDown E{YS8, SLW, pg8::F8_WINV};
                        pg8::gemm_phase<pg8::EpiMoeDown, pg8::MoeOrder, true, true, true>(lds + RING_OFF, g, S, E, tidp);
#else
                        pg8::Gemm g{MACT, MWd, DFX}; pg8::MoeOrder S{t0, nt, D / 256, nt * (D / 256), G, bx, (long)256 * DFX * 2, (long)256 * DFX * 2, (long)D * DFX * 2, c0, c1, c2, c3, c4, c5, c6, true, false};
                        pg8::EpiMoeDown E{HS, SLW, 1.f};
                        pg8::gemm_phase<pg8::EpiMoeDown, pg8::MoeOrder, true, true>(lds + RING_OFF, g, S, E, tidp);
#endif

                        SEAM();
                    }
                }
            }
            if (IN(P + 19)) { PHASE_IDS();
                f32x4 g[4];
#pragma unroll
                for (int j = 0; j < 4; ++j) g[j] = ((const GAS f32x4*)norm_final + lane)[64 * j];
                unsigned bad = 0u;
#if MK_N_LAUNCHES == 1
                bad = __hip_atomic_load(ctl + CW_BAR + XB_TMO, RLX_AGENT);
#endif
#ifdef PROBE_CAT
                CAT(16);
#endif
#if FFN_FP8
                const bf16* const ysb = YS8;
#else
                const bf16* const ysb = HS;
#endif
                for (int m = gw; m < M; m += 2 * NGW) {
                    const int ma = m, mb = m + NGW;
                    const v4u sl = (v4u){(unsigned)SLOT[2 * ma], (unsigned)SLOT[2 * ma + 1], (unsigned)SLOT[2 * mb], (unsigned)SLOT[2 * mb + 1]};
                    const GAS v2u* xa = (const GAS v2u*)(XB + (size_t)ma * D) + lane; const GAS v2u* xb = (const GAS v2u*)(XB + (size_t)mb * D) + lane;
                    const GAS v2u* a0 = (const GAS v2u*)(ysb + (size_t)sl.x * D) + lane; const GAS v2u* a1 = (const GAS v2u*)(ysb + (size_t)sl.y * D) + lane;
                    const GAS v2u* b0 = (const GAS v2u*)(ysb + (size_t)sl.z * D) + lane; const GAS v2u* b1 = (const GAS v2u*)(ysb + (size_t)sl.w * D) + lane;
                    f32x4 va[4], vb[4]; v2u xa4[4], xb4[4], pa0[4], pa1[4], pb0[4], pb1[4];
#pragma unroll
                    for (int j = 0; j < 4; ++j) { xa4[j] = xa[64 * j]; xb4[j] = xb[64 * j]; pa0[j] = a0[64 * j]; pa1[j] = a1[64 * j]; pb0[j] = b0[64 * j]; pb1[j] = b1[64 * j]; }
                    float sa = 0.f, sb = 0.f;
#pragma unroll
                    for (int j = 0; j < 4; ++j) { va[j] = bf4(xa4[j]); vb[j] = bf4(xb4[j]);
                        va[j].x += bfl(pa0[j].x) + bfl(pa1[j].x); va[j].y += bfh(pa0[j].x) + bfh(pa1[j].x); va[j].z += bfl(pa0[j].y) + bfl(pa1[j].y); va[j].w += bfh(pa0[j].y) + bfh(pa1[j].y);
                        vb[j].x += bfl(pb0[j].x) + bfl(pb1[j].x); vb[j].y += bfh(pb0[j].x) + bfh(pb1[j].x); vb[j].z += bfl(pb0[j].y) + bfl(pb1[j].y); vb[j].w += bfh(pb0[j].y) + bfh(pb1[j].y);
                        sa += (va[j].x * va[j].x + va[j].y * va[j].y) + (va[j].z * va[j].z + va[j].w * va[j].w); sb += (vb[j].x * vb[j].x + vb[j].y * vb[j].y) + (vb[j].z * vb[j].z + vb[j].w * vb[j].w); }
                    const float ra = 1.f / sqrtf(wave_sum(sa) * (1.f / D) + EPS), rb = 1.f / sqrtf(wave_sum(sb) * (1.f / D) + EPS);
                    GAS f32x4* oa = (GAS f32x4*)(xout + (size_t)ma * D) + lane; GAS f32x4* ob = (GAS f32x4*)(xout + (size_t)mb * D) + lane;
                    const float q = __builtin_nanf("");
#pragma unroll
                    for (int j = 0; j < 4; ++j) { f32x4 o = va[j] * ra * g[j], p = vb[j] * rb * g[j]; if (bad) { o = (f32x4){q, q, q, q}; p = o; } oa[64 * j] = o; ob[64 * j] = p; }
                }
#ifdef PROBE_CAT
                if (bx == 0 && tid == 0) { { const unsigned long long tn_ = __builtin_amdgcn_s_memrealtime(); volatile LAS unsigned* pa_ = (volatile LAS unsigned*)(lds + LDSCTL_OFF + 640); if (cat_ == PROBE_CAT) pa_[0] += (unsigned)(tn_ - *(volatile LAS unsigned long long*)(lds + LDSCTL_OFF + 704)); } const unsigned ticks = *(volatile LAS unsigned*)(lds + LDSCTL_OFF + 640); const unsigned long long te_ = __builtin_amdgcn_s_memrealtime(); const unsigned long long tw_ = (unsigned long long)ticks * PROBE_AMP; while (__builtin_amdgcn_s_memrealtime() - te_ < (tw_ < 5000000ull ? tw_ : 5000000ull)) __builtin_amdgcn_s_sleep(8); }
#endif
            }
        }
    }
#undef IN
#undef SEAM
}

extern "C" void kernel_launch(void* const* d_in, const int* in_sizes, int n_in, void* d_out, int out_size, void* d_ws, size_t ws_size, hipStream_t stream) {
    static int grid = 0;
    if (grid == 0) {
        if (n_in != 18 || in_sizes[0] != M * D || out_size != M * D || ws_size < WS_END) { fprintf(stderr, "kernel_launch: unexpected shapes (n_in %d, in0 %d, out %d, ws %zu < %zu); nothing launched\n", n_in, n_in > 0 ? in_sizes[0] : -1, out_size, ws_size, (size_t)WS_END); grid = -1; return; }
        int dev = 0, cus = 0, per_cu = 0;
        if (hipGetDevice(&dev) != hipSuccess || hipDeviceGetAttribute(&cus, hipDeviceAttributeMultiprocessorCount, dev) != hipSuccess) { grid = -1; return; }
        if (hipFuncSetAttribute((const void*)mega_fwd, hipFuncAttributeMaxDynamicSharedMemorySize, LDS_BYTES) != hipSuccess) { fprintf(stderr, "kernel_launch: hipFuncSetAttribute failed\n"); grid = -1; return; }
        if (hipOccupancyMaxActiveBlocksPerMultiprocessor(&per_cu, (const void*)mega_fwd, NWAVES * 64, LDS_BYTES) != hipSuccess || per_cu < 1) fprintf(stderr, "kernel_launch: occupancy query reports %d workgroups per CU\n", per_cu);
        (void)hipGetLastError();
        grid = cus;
        if (grid != 256) { fprintf(stderr, "kernel_launch: built for 256 CUs, device has %d; nothing launched\n", cus); grid = -1; return; }
    }
    if (grid < 0) return;
    if (hipMemsetAsync((char*)d_ws + WS_CTL, 0, CTL_ZERO_BYTES, stream) != hipSuccess) return;
    Args a{};
    for (int i = 0; i < 18; ++i) a.in[i] = (const float*)d_in[i];
    a.out = (float*)d_out; a.ws = (unsigned char*)d_ws;
#if MK_N_LAUNCHES == 1
    a.ph_lo = 0; a.ph_hi = NPHASE;
    hipLaunchKernelGGL(mega_fwd, dim3(grid), dim3(NWAVES * 64), LDS_BYTES, stream, a);
#else
    for (int p = 0; p < NPHASE; ++p) {
        const int r = (p - 1) % PH_L, L = (p - 1) / PH_L;
        if (p > 0 && L == 0 && r >= 10) continue;
        a.ph_lo = p; a.ph_hi = p + 1;
        hipLaunchKernelGGL(mega_fwd, dim3(grid), dim3(NWAVES * 64), LDS_BYTES, stream, a);
    }
#endif
}
```

```cpp
#include <hip/hip_runtime.h>
#include <cstdio>
#include <cstdint>

#ifndef MK_N_LAUNCHES
#define MK_N_LAUNCHES 1
#endif

namespace pg8 {
#define PG8_LAS __attribute__((address_space(3)))
typedef unsigned short bf16_t;
typedef short bf16x8 __attribute__((ext_vector_type(8)));
typedef float f32x4 __attribute__((ext_vector_type(4)));
typedef float f32x2 __attribute__((ext_vector_type(2)));
typedef unsigned u32x4 __attribute__((ext_vector_type(4)));
typedef int v8i32 __attribute__((ext_vector_type(8)));
typedef unsigned u32x2 __attribute__((ext_vector_type(2)));
constexpr int F8_WSHIFT = 6;
constexpr float F8_WINV = 1.f / (float)(1 << F8_WSHIFT);
constexpr int BM = 256, BK = 64, HALF = 128, HTB = HALF * BK * 2  , STAGE_BYTES = 8 * HTB, NXCD = 8, WGM = 8;

__host__ __device__ __forceinline__ int lds_byte(int r, int c) { const int st = (r >> 4) * 2 + (c >> 5), rr = r & 15, cc = c & 31, ob = rr * 64 + cc * 2; return st * 1024 + (ob ^ (((ob >> 9) & 1) << 5)); }
__host__ __device__ __forceinline__ void stage_rc(int b, int& R, int& C) { const int st = b / 1024, sb = b % 1024, swz = sb ^ (((sb >> 9) & 1) << 5); R = (st >> 1) * 16 + swz / 64; C = (st & 1) * 32 + (swz % 64) / 2; }
__host__ __device__ __forceinline__ int perm32(int rho) { const int n = rho >> 4, i = rho & 15; return 8 * (i >> 2) + 4 * n + (i & 3); }

struct Unit { int pm, pn, om, tag; long ao, bo; };
struct Gemm { const bf16_t* A; const bf16_t* Bt; int K; };

__device__ __forceinline__ void tile_of(int wgid, int nwg, int nM, int nN, int& pm, int& pn) {
    { const int q = nwg / NXCD, r = nwg % NXCD, xcd = wgid % NXCD, off = wgid / NXCD; wgid = (xcd < r ? xcd * (q + 1) : r * (q + 1) + (xcd - r) * q) + off; }
    const int nig = WGM * nN, gid = wgid / nig, fm = gid * WGM, gsz = (nM - fm) < WGM ? (nM - fm) : WGM;
    pm = fm + ((wgid % nig) % gsz); pn = (wgid % nig) / gsz;
}
struct StaticOrder {
    int nM, nN, nwg, G, c; long tst;
    __device__ void init(int M, int N, int K, int G_, int c_) { nM = M / BM; nN = N / BM; nwg = nM * nN; G = G_; c = c_; tst = (long)BM * K * 2; }
    __device__ __forceinline__ bool next(int i, Unit& u) const {
        const long L = (long)i * G + c; if (L >= nwg) return false;
        tile_of((int)L, nwg, nM, nN, u.pm, u.pn); u.om = u.pm; u.tag = 0; u.ao = (long)u.pm * tst; u.bo = (long)u.pn * tst; return true;
    }
    __device__ __forceinline__ void a_ready(const Unit&) const {}
    __device__ __forceinline__ void done(const Unit&) const {}
};
struct MergeOrder {
    StaticOrder b; long as, bs;
    __device__ __forceinline__ bool next(int i, Unit& u) const {
        const int ti = i / 3, tg = i - 3 * ti; if (!b.next(ti, u)) return false;
        u.tag = tg; u.ao += (long)tg * as; u.bo += (long)tg * bs; return true;
    }
    __device__ __forceinline__ void a_ready(const Unit&) const {}
    __device__ __forceinline__ void done(const Unit&) const {}
};
struct MoeOrder {
    int t0, nt, nN, nwg, G, c; long tA, tB, eB; int c0, c1, c2, c3, c4, c5, c6; bool a_local, o_local;
    __device__ __forceinline__ bool next(int i, Unit& u) const {
        const long L = (long)i * G + c; if (L >= nwg) return false;
        int pl, pn; tile_of((int)L, nwg, nt, nN, pl, pn);
        const int gt = t0 + pl; const int e = (gt >= c0) + (gt >= c1) + (gt >= c2) + (gt >= c3) + (gt >= c4) + (gt >= c5) + (gt >= c6);
        u.pm = gt; u.pn = pn; u.tag = e; u.om = o_local ? pl : gt; u.ao = (long)(a_local ? pl : gt) * tA; u.bo = (long)e * eB + (long)pn * tB; return true;
    }
    __device__ __forceinline__ void a_ready(const Unit&) const {}
    __device__ __forceinline__ void done(const Unit&) const {}
};

typedef __bf16 bf16x2_t __attribute__((ext_vector_type(2)));
__device__ __forceinline__ unsigned cvt_pk_bf16(float lo, float hi) { f32x2 v = {lo, hi}; bf16x2_t b = __builtin_convertvector(v, bf16x2_t); return __builtin_bit_cast(unsigned, b); }
__device__ __forceinline__ float bf_lo(unsigned w) { return __uint_as_float(w << 16); }
__device__ __forceinline__ float bf_hi(unsigned w) { return __uint_as_float(w & 0xffff0000u); }
__device__ __forceinline__ float sigm(float x) { return __builtin_amdgcn_rcpf(1.0f + __builtin_amdgcn_exp2f(-1.4426950408889634f * x)); }
__device__ __forceinline__ u32x4 pack8(f32x4 v0, f32x4 v1) { u32x4 w; w.x = cvt_pk_bf16(v0[0], v0[1]); w.y = cvt_pk_bf16(v0[2], v0[3]); w.z = cvt_pk_bf16(v1[0], v1[1]); w.w = cvt_pk_bf16(v1[2], v1[3]); return w; }

struct EpiProj {
    static constexpr bool PERM = true, AFTER_DRAIN = false;
    bf16_t* O; size_t split_stride; float qscale, wscale;
    __device__ __forceinline__ void operator()(const f32x4 (&acc)[2][2][4][2], const Unit& u, int wr, int wc, int fr, int fq) const {
        const int t = u.pn / 6, lt = u.pn - 6 * t; bf16_t* base = O + (size_t)t * split_stride; const float sc = (lt < 2 ? qscale : 1.f) * wscale;
        const int row0 = u.om * BM + wr * 64 + fr, col0 = lt * BM + wc * 32 + 8 * fq;
        if (t == 1) {
#pragma unroll
            for (int ai = 0; ai < 2; ++ai)
#pragma unroll
                for (int m = 0; m < 4; ++m) { const int row = row0 + ai * HALF + m * 16;
#pragma unroll
                    for (int bj = 0; bj < 2; ++bj) { const int lc = col0 + bj * HALF; bf16_t* p;
                        if (lt < 2) p = base + (size_t)row * 512 + lc;
                        else { const int l2 = lc & 511, hd = l2 >> 6, d = l2 & 63; p = base + (size_t)(lt < 4 ? 1 : 2) * ((size_t)32768 * 512) + ((size_t)((row >> 12) * 8 + hd) * 4096 + (row & 4095)) * 64 + d; }
                        *(u32x4*)p = pack8(acc[ai][bj][m][0] * sc, acc[ai][bj][m][1] * sc); } }
            return; }
#pragma unroll
        for (int ai = 0; ai < 2; ++ai)
#pragma unroll
            for (int m = 0; m < 4; ++m) { bf16_t* rowp = base + (size_t)(row0 + ai * HALF + m * 16) * 1536 + col0;
#pragma unroll
                for (int bj = 0; bj < 2; ++bj) *(u32x4*)(rowp + bj * HALF) = pack8(acc[ai][bj][m][0] * sc, acc[ai][bj][m][1] * sc); }
    }
};
struct EpiGate {
    static constexpr bool PERM = true, AFTER_DRAIN = false;
    bf16_t* O; int ldc; const float* bias; float wscale;
    __device__ __forceinline__ void operator()(const f32x4 (&acc)[2][2][4][2], const Unit& u, int wr, int wc, int fr, int fq) const {
        const int row0 = u.om * BM + wr * 64 + fr, col0 = u.pn * BM + wc * 32 + 8 * fq;
        f32x4 bv[2][2];
#pragma unroll
        for (int bj = 0; bj < 2; ++bj)
#pragma unroll
            for (int n = 0; n < 2; ++n) bv[bj][n] = *(const f32x4*)(bias + col0 + bj * HALF + 4 * n);
#pragma unroll
        for (int ai = 0; ai < 2; ++ai)
#pragma unroll
            for (int m = 0; m < 4; ++m) { bf16_t* rowp = O + (size_t)(row0 + ai * HALF + m * 16) * ldc + col0;
#pragma unroll
                for (int bj = 0; bj < 2; ++bj) { f32x4 v0 = acc[ai][bj][m][0] * wscale + bv[bj][0], v1 = acc[ai][bj][m][1] * wscale + bv[bj][1];
#pragma unroll
                    for (int i = 0; i < 4; ++i) { v0[i] = sigm(v0[i]); v1[i] = sigm(v1[i]); }
                    *(u32x4*)(rowp + bj * HALF) = pack8(v0, v1); } }
    }
};
struct EpiMerge {
    static constexpr bool PERM = true, AFTER_DRAIN = false;
    const bf16_t* gates; bf16_t* O;
    __device__ __forceinline__ void operator()(const f32x4 (&acc)[2][2][4][2], const Unit& u, int wr, int wc, int fr, int fq) const {
        const int row0 = u.om * BM + wr * 64 + fr, col0 = u.pn * BM + wc * 32 + 8 * fq; const int tg = u.tag;
        const bf16_t* const gp = gates + (size_t)tg * 1024 + col0; bf16_t* const op0 = O + col0;
#pragma unroll
        for (int ai = 0; ai < 2; ++ai) {
            u32x4 gw[4][2], ow[4][2];
#pragma unroll
            for (int m = 0; m < 4; ++m)
#pragma unroll
                for (int bj = 0; bj < 2; ++bj) { const size_t row = (size_t)(row0 + ai * HALF + m * 16);
                    gw[m][bj] = *(const u32x4*)(gp + row * 3072 + bj * HALF);
                    ow[m][bj] = (tg != 0) ? *(const u32x4*)(op0 + row * 1024 + bj * HALF) : (u32x4){0u, 0u, 0u, 0u}; }
#pragma unroll
            for (int m = 0; m < 4; ++m)
#pragma unroll
                for (int bj = 0; bj < 2; ++bj) { const size_t row = (size_t)(row0 + ai * HALF + m * 16); const u32x4 g = gw[m][bj], w = ow[m][bj];
                    f32x4 v0 = acc[ai][bj][m][0], v1 = acc[ai][bj][m][1];
                    v0[0] = v0[0] * bf_lo(g.x) + bf_lo(w.x); v0[1] = v0[1] * bf_hi(g.x) + bf_hi(w.x); v0[2] = v0[2] * bf_lo(g.y) + bf_lo(w.y); v0[3] = v0[3] * bf_hi(g.y) + bf_hi(w.y);
                    v1[0] = v1[0] * bf_lo(g.z) + bf_lo(w.z); v1[1] = v1[1] * bf_hi(g.z) + bf_hi(w.z); v1[2] = v1[2] * bf_lo(g.w) + bf_lo(w.w); v1[3] = v1[3] * bf_hi(g.w) + bf_hi(w.w);
                    *(u32x4*)(op0 + row * 1024 + bj * HALF) = pack8(v0, v1); }
            asm volatile("" ::: "memory"); }
    }
};
struct EpiRes {
    static constexpr bool PERM = false, AFTER_DRAIN = false;
    const float* base; float* out; float sc;
    __device__ __forceinline__ void operator()(const f32x4 (&acc)[2][2][4][2], const Unit& u, int wr, int wc, int fr, int fq) const {
        const int row0 = u.om * BM + wr * 64 + fr, col0 = u.pn * BM + wc * 32 + 4 * fq;
#pragma unroll
        for (int ai = 0; ai < 2; ++ai)
#pragma unroll
            for (int m = 0; m < 4; ++m) { const size_t off = (size_t)(row0 + ai * HALF + m * 16) * 1024 + col0;
#pragma unroll
                for (int bj = 0; bj < 2; ++bj)
#pragma unroll
                    for (int n = 0; n < 2; ++n) { const f32x4 bs = *(const f32x4*)(base + off + bj * HALF + n * 16); *(f32x4*)(out + off + bj * HALF + n * 16) = bs + acc[ai][bj][m][n] * sc; } }
    }
};
struct EpiResB {
    static constexpr bool PERM = true, AFTER_DRAIN = false;
    const void* base; bf16_t* out; float sc; int base_f32;
    __device__ __forceinline__ void operator()(const f32x4 (&acc)[2][2][4][2], const Unit& u, int wr, int wc, int fr, int fq) const {
        const int row0 = u.om * BM + wr * 64 + fr, col0 = u.pn * BM + wc * 32 + 8 * fq;
        if (base_f32) { const float* bp = (const float*)base;
#pragma unroll
            for (int ai = 0; ai < 2; ++ai)
#pragma unroll
                for (int m = 0; m < 4; ++m) { const size_t off = (size_t)(row0 + ai * HALF + m * 16) * 1024 + col0;
#pragma unroll
                    for (int bj = 0; bj < 2; ++bj) { const f32x4 b0 = *(const f32x4*)(bp + off + bj * HALF), b1 = *(const f32x4*)(bp + off + bj * HALF + 4);
                        *(u32x4*)(out + off + bj * HALF) = pack8(b0 + acc[ai][bj][m][0] * sc, b1 + acc[ai][bj][m][1] * sc); } }
        } else { const bf16_t* bp = (const bf16_t*)base;
#pragma unroll
            for (int ai = 0; ai < 2; ++ai)
#pragma unroll
                for (int m = 0; m < 4; ++m) { const size_t off = (size_t)(row0 + ai * HALF + m * 16) * 1024 + col0;
#pragma unroll
                    for (int bj = 0; bj < 2; ++bj) { const u32x4 w = *(const u32x4*)(bp + off + bj * HALF);
                        const f32x4 b0 = {__uint_as_float(w.x << 16), __uint_as_float(w.x & 0xffff0000u), __uint_as_float(w.y << 16), __uint_as_float(w.y & 0xffff0000u)};
                        const f32x4 b1 = {__uint_as_float(w.z << 16), __uint_as_float(w.z & 0xffff0000u), __uint_as_float(w.w << 16), __uint_as_float(w.w & 0xffff0000u)};
                        *(u32x4*)(out + off + bj * HALF) = pack8(b0 + acc[ai][bj][m][0] * sc, b1 + acc[ai][bj][m][1] * sc); } }
        }
    }
};
struct EpiSwiglu {
    static constexpr bool PERM = true, AFTER_DRAIN = false;
    bf16_t* O; int ldc;
    __device__ __forceinline__ void operator()(const f32x4 (&acc)[2][2][4][2], const Unit& u, int wr, int wc, int fr, int fq) const {
        const int row0 = u.om * BM + wr * 64 + fr, col0 = u.pn * HALF + wc * 32 + 8 * fq;
#pragma unroll
        for (int ai = 0; ai < 2; ++ai)
#pragma unroll
            for (int m = 0; m < 4; ++m) { f32x4 v0, v1;
#pragma unroll
                for (int i = 0; i < 4; ++i) { const float g0 = acc[ai][0][m][0][i], g1 = acc[ai][0][m][1][i]; v0[i] = g0 * sigm(g0) * acc[ai][1][m][0][i]; v1[i] = g1 * sigm(g1) * acc[ai][1][m][1][i]; }
                *(u32x4*)(O + (size_t)(row0 + ai * HALF + m * 16) * ldc + col0) = pack8(v0, v1); }
    }
};
__device__ __forceinline__ unsigned pk4_fp8(float a, float b, float c, float d) {
    a = __builtin_fminf(__builtin_fmaxf(a, -448.f), 448.f); b = __builtin_fminf(__builtin_fmaxf(b, -448.f), 448.f); c = __builtin_fminf(__builtin_fmaxf(c, -448.f), 448.f); d = __builtin_fminf(__builtin_fmaxf(d, -448.f), 448.f);
    int w = __builtin_amdgcn_cvt_pk_fp8_f32(a, b, 0, false); w = __builtin_amdgcn_cvt_pk_fp8_f32(c, d, w, true); return (unsigned)w; }
struct EpiSwigluF8 {
    static constexpr bool PERM = true, AFTER_DRAIN = false;
    unsigned char* O; int ldc;
    __device__ __forceinline__ void operator()(const f32x4 (&acc)[2][2][4][2], const Unit& u, int wr, int wc, int fr, int fq) const {
        const int row0 = u.om * BM + wr * 64 + fr, col0 = u.pn * HALF + wc * 32 + 8 * fq;
#pragma unroll
        for (int ai = 0; ai < 2; ++ai)
#pragma unroll
            for (int m = 0; m < 4; ++m) { f32x4 v0, v1;
#pragma unroll
                for (int i = 0; i < 4; ++i) { const float g0 = acc[ai][0][m][0][i] * F8_WINV, g1 = acc[ai][0][m][1][i] * F8_WINV; v0[i] = g0 * sigm(g0) * (acc[ai][1][m][0][i] * F8_WINV); v1[i] = g1 * sigm(g1) * (acc[ai][1][m][1][i] * F8_WINV); }
                u32x2 w; w.x = pk4_fp8(v0[0], v0[1], v0[2], v0[3]); w.y = pk4_fp8(v1[0], v1[1], v1[2], v1[3]);
                *(u32x2*)(O + (size_t)(row0 + ai * HALF + m * 16) * ldc + col0) = w; }
    }
};
struct EpiMoeDown {
    static constexpr bool PERM = true, AFTER_DRAIN = false;
    bf16_t* O; const float* w; float scale;
    __device__ __forceinline__ void operator()(const f32x4 (&acc)[2][2][4][2], const Unit& u, int wr, int wc, int fr, int fq) const {
        const int row0 = u.om * BM + wr * 64 + fr, col0 = u.pn * BM + wc * 32 + 8 * fq;
#pragma unroll
        for (int ai = 0; ai < 2; ++ai)
#pragma unroll
            for (int m = 0; m < 4; ++m) { const size_t row = (size_t)(row0 + ai * HALF + m * 16); const float sc = w[row] * scale;
#pragma unroll
                for (int bj = 0; bj < 2; ++bj) *(u32x4*)(O + row * 1024 + col0 + bj * HALF) = pack8(acc[ai][bj][m][0] * sc, acc[ai][bj][m][1] * sc); }
    }
};
template <class Epi, class Sched, bool ALIGN_EPI = false, bool SP2 = false, bool F8 = false>
__device__ __forceinline__ void gemm_phase(PG8_LAS unsigned char* lds, const Gemm g, const Sched& S, const Epi& E, const int tid_in) {
    const int tid = tid_in, wid = __builtin_amdgcn_readfirstlane(tid >> 6), lane = tid & 63, wr = wid >> 2, wc = wid & 3, fr = lane & 15, fq = lane >> 4;
    const int K = g.K, nt = K / BK;
    unsigned voffA[2], voffB[2];
#pragma unroll
    for (int i = 0; i < 2; ++i) { int R, C; stage_rc(tid * 16 + i * 8192, R, C); const int Rb = Epi::PERM ? ((R & ~31) + perm32(R & 31)) : R;
        voffA[i] = (unsigned)(R * K + C) * 2u; voffB[i] = (unsigned)(Rb * K + C) * 2u; }
    const size_t kstep = (size_t)(BK * 2);
    const size_t hstep = (size_t)HALF * K * 2;
    const unsigned ldsw = (unsigned)wid * 1024u;
    const int aoff = lds_byte(wr * 64 + fr, fq * 8), boff = lds_byte(wc * 32 + fr, fq * 8);
#define PG8_SA(b, h) (((b) * 2 + (h)) * HTB)
#define PG8_SB(b, h) ((4 + (b) * 2 + (h)) * HTB)
#define PG8_STAGE(bufoff, gbase, voff) do { _Pragma("unroll") for (int _i = 0; _i < 2; ++_i) \
        __builtin_amdgcn_global_load_lds((const unsigned*)((const char*)(gbase) + (voff)[_i]), (PG8_LAS unsigned*)(lds + (bufoff) + ldsw + _i * 8192), 16, 0, 0); } while (0)
#define PG8_LDA(dst, b, h) do { _Pragma("unroll") for (int m = 0; m < 4; ++m) _Pragma("unroll") for (int k = 0; k < 2; ++k) dst[m][k] = *(const PG8_LAS bf16x8*)(lds + PG8_SA(b, h) + aoff + m * 2048 + k * 1024); } while (0)
#define PG8_LDB(dst, b, h) do { _Pragma("unroll") for (int n = 0; n < 2; ++n) _Pragma("unroll") for (int k = 0; k < 2; ++k) dst[n][k] = *(const PG8_LAS bf16x8*)(lds + PG8_SB(b, h) + boff + n * 2048 + k * 1024); } while (0)
#define PG8_CAT8(x) __builtin_bit_cast(v8i32, __builtin_shufflevector((x)[0], (x)[1], 0, 1, 2, 3, 4, 5, 6, 7, 8, 9, 10, 11, 12, 13, 14, 15))
#define PG8_MMA(ai, bj, At, Bt) do { __builtin_amdgcn_s_setprio(1); if constexpr (F8) { _Pragma("unroll") for (int m = 0; m < 4; ++m) _Pragma("unroll") for (int n = 0; n < 2; ++n) \
        asm volatile("v_mfma_f32_16x16x128_f8f6f4 %0, %1, %2, %0" : "+v"(acc[ai][bj][m][n]) : "v"(PG8_CAT8(Bt[n])), "v"(PG8_CAT8(At[m]))); } else { \
        _Pragma("unroll") for (int m = 0; m < 4; ++m) _Pragma("unroll") for (int n = 0; n < 2; ++n) _Pragma("unroll") for (int k = 0; k < 2; ++k) \
        acc[ai][bj][m][n] = __builtin_amdgcn_mfma_f32_16x16x32_bf16(Bt[n][k], At[m][k], acc[ai][bj][m][n], 0, 0, 0); } __builtin_amdgcn_s_setprio(0); } while (0)
#define PG8_WAIT_V(n) asm volatile("s_waitcnt vmcnt(" #n ")" ::: "memory")
#define PG8_WAIT_L(n) asm volatile("s_waitcnt lgkmcnt(" #n ")" ::: "memory")
#define PG8_BAR __builtin_amdgcn_s_barrier()
#define PG8_SCHED __builtin_amdgcn_sched_barrier(0)
    Unit cur, nxt; int ui = 0;
    if (!S.next(0, cur)) return;
    f32x4 acc[2][2][4][2];
#pragma unroll
    for (int a = 0; a < 2; ++a)
#pragma unroll
        for (int b = 0; b < 2; ++b)
#pragma unroll
            for (int m = 0; m < 4; ++m)
#pragma unroll
                for (int n = 0; n < 2; ++n) { acc[a][b][m][n] = (f32x4){0.f, 0.f, 0.f, 0.f}; if constexpr (F8) asm volatile("" : "+v"(acc[a][b][m][n])); }
    bf16x8 At[4][2], B0[2][2], B1[2][2];
    const char* cA = (const char*)g.A + cur.ao; const char* cB = (const char*)g.Bt + cur.bo;
    S.a_ready(cur);
    if constexpr (SP2) {
        PG8_STAGE(PG8_SB(0, 0), cB, voffB); PG8_STAGE(PG8_SB(0, 1), cB + hstep, voffB); PG8_STAGE(PG8_SA(0, 0), cA, voffA); PG8_STAGE(PG8_SA(0, 1), cA + hstep, voffA);
        if (wr == 1) PG8_BAR;
        PG8_WAIT_V(2); PG8_BAR;
        PG8_STAGE(PG8_SB(1, 0), cB + kstep, voffB); PG8_STAGE(PG8_SA(1, 0), cA + kstep, voffA); PG8_STAGE(PG8_SB(1, 1), cB + hstep + kstep, voffB);
        PG8_WAIT_V(6); PG8_BAR;
    } else {
        PG8_STAGE(PG8_SB(0, 0), cB, voffB); PG8_STAGE(PG8_SA(0, 0), cA, voffA); PG8_STAGE(PG8_SB(0, 1), cB + hstep, voffB); PG8_STAGE(PG8_SA(0, 1), cA + hstep, voffA);
        if (wr == 1) PG8_BAR;
        PG8_WAIT_V(4); PG8_BAR;
        PG8_STAGE(PG8_SB(1, 0), cB + kstep, voffB); PG8_STAGE(PG8_SA(1, 0), cA + kstep, voffA); PG8_STAGE(PG8_SB(1, 1), cB + hstep + kstep, voffB);
        PG8_WAIT_V(6); PG8_BAR;
    }
    for (;;) {
        const bool has_next = S.next(ui + 1, nxt);
        const char* nA = has_next ? (const char*)g.A + nxt.ao : cA; const char* nB = has_next ? (const char*)g.Bt + nxt.bo : cB;
#pragma nounroll
        for (int t = 0; t < nt; t += 2) {
            const bool last = (t == nt - 2);
            const char* a1 = cA + (size_t)(t + 1) * kstep;
            const char* a2 = last ? nA : cA + (size_t)(t + 2) * kstep; const char* b2 = last ? nB : cB + (size_t)(t + 2) * kstep;
            const char* a3 = a2 + kstep; const char* b3 = b2 + kstep;
            if (last && has_next) S.a_ready(nxt);
            if constexpr (SP2) {
            PG8_LDB(B0, 0, 0); PG8_LDB(B1, 0, 1); PG8_SCHED; PG8_LDA(At, 0, 0); PG8_STAGE(PG8_SA(1, 1), a1 + hstep, voffA);
            PG8_WAIT_V(8); PG8_WAIT_L(0); PG8_BAR; PG8_MMA(0, 0, At, B0); PG8_MMA(0, 1, At, B1); PG8_BAR; PG8_SCHED;
            PG8_LDA(At, 0, 1); PG8_STAGE(PG8_SB(0, 0), b2, voffB); PG8_STAGE(PG8_SB(0, 1), b2 + hstep, voffB); PG8_STAGE(PG8_SA(0, 0), a2, voffA);
            PG8_WAIT_V(8); PG8_WAIT_L(0); PG8_BAR; PG8_MMA(1, 0, At, B0); PG8_MMA(1, 1, At, B1); PG8_BAR; PG8_SCHED;
            PG8_LDB(B0, 1, 0); PG8_LDB(B1, 1, 1); PG8_SCHED; PG8_LDA(At, 1, 0); PG8_STAGE(PG8_SA(0, 1), a2 + hstep, voffA);
            PG8_WAIT_V(8); PG8_WAIT_L(0); PG8_BAR; PG8_MMA(0, 0, At, B0); PG8_MMA(0, 1, At, B1); PG8_BAR; PG8_SCHED;
            PG8_LDA(At, 1, 1); PG8_STAGE(PG8_SB(1, 0), b3, voffB); PG8_STAGE(PG8_SB(1, 1), b3 + hstep, voffB); PG8_STAGE(PG8_SA(1, 0), a3, voffA);
            PG8_WAIT_V(8); PG8_WAIT_L(0); PG8_BAR; PG8_MMA(1, 0, At, B0); PG8_MMA(1, 1, At, B1); PG8_BAR; PG8_SCHED;
            } else {
            PG8_LDB(B0, 0, 0); PG8_SCHED; PG8_LDA(At, 0, 0); PG8_STAGE(PG8_SA(1, 1), a1 + hstep, voffA);
            PG8_WAIT_L(8); PG8_BAR; PG8_WAIT_L(0); PG8_MMA(0, 0, At, B0); PG8_BAR; PG8_SCHED;
            PG8_LDB(B1, 0, 1); PG8_STAGE(PG8_SB(0, 0), b2, voffB);
            PG8_BAR; PG8_WAIT_L(0); PG8_MMA(0, 1, At, B1); PG8_BAR;
            PG8_LDA(At, 0, 1); PG8_STAGE(PG8_SA(0, 0), a2, voffA);
            PG8_BAR; PG8_WAIT_L(0); PG8_MMA(1, 0, At, B0); PG8_BAR; PG8_SCHED;
            PG8_STAGE(PG8_SB(0, 1), b2 + hstep, voffB);
            PG8_WAIT_V(6); PG8_BAR; PG8_MMA(1, 1, At, B1); PG8_BAR;
            PG8_LDB(B0, 1, 0); PG8_SCHED; PG8_LDA(At, 1, 0); PG8_STAGE(PG8_SA(0, 1), a2 + hstep, voffA);
            PG8_WAIT_L(8); PG8_BAR; PG8_WAIT_L(0); PG8_MMA(0, 0, At, B0); PG8_BAR; PG8_SCHED;
            PG8_LDB(B1, 1, 1); PG8_STAGE(PG8_SB(1, 0), b3, voffB);
            PG8_BAR; PG8_WAIT_L(0); PG8_MMA(0, 1, At, B1); PG8_BAR;
            PG8_LDA(At, 1, 1); PG8_STAGE(PG8_SA(1, 0), a3, voffA);
            PG8_BAR; PG8_WAIT_L(0); PG8_MMA(1, 0, At, B0); PG8_BAR; PG8_SCHED;
            PG8_STAGE(PG8_SB(1, 1), b3 + hstep, voffB);
            PG8_WAIT_V(6); PG8_BAR; PG8_MMA(1, 1, At, B1); PG8_BAR;
            }
        }
        if constexpr (ALIGN_EPI) { if (wr == 0) PG8_BAR; }
        if constexpr (F8) asm volatile("s_nop 15\n\ts_nop 15" ::: "memory");
        if constexpr (!Epi::AFTER_DRAIN) { E(acc, cur, wr, wc, fr, fq); S.done(cur); }
        if (!has_next) break;
#pragma unroll
        for (int a = 0; a < 2; ++a)
#pragma unroll
            for (int b = 0; b < 2; ++b)
#pragma unroll
                for (int m = 0; m < 4; ++m)
#pragma unroll
                    for (int n = 0; n < 2; ++n) { acc[a][b][m][n] = (f32x4){0.f, 0.f, 0.f, 0.f}; if constexpr (F8) asm volatile("" : "+v"(acc[a][b][m][n])); }
        cur = nxt; cA = nA; cB = nB; ++ui;
        if constexpr (ALIGN_EPI) { if (wr == 1) PG8_BAR; }
    }
    PG8_WAIT_V(0);
    if constexpr (!ALIGN_EPI) { if (wr == 0) PG8_BAR; }
    PG8_BAR;
    if constexpr (Epi::AFTER_DRAIN) { E.fused(acc, cur, wr, wc, fr, fq, lds, wid, lane); S.done(cur); }
#undef PG8_SA
#undef PG8_SB
#undef PG8_STAGE
#undef PG8_LDA
#undef PG8_LDB
#undef PG8_MMA
#undef PG8_CAT8
#undef PG8_WAIT_V
#undef PG8_WAIT_L
#undef PG8_BAR
#undef PG8_SCHED
}
}

namespace att {
#define LAS __attribute__((address_space(3)))
typedef unsigned short bf16;
typedef __attribute__((ext_vector_type(8))) short bf16x8;
typedef __attribute__((ext_vector_type(4))) short s16x4;
typedef __attribute__((ext_vector_type(16))) float f32x16;
typedef __attribute__((ext_vector_type(4))) unsigned u32x4;
typedef float f32x2_t __attribute__((ext_vector_type(2))); typedef __bf16 bf16x2_t __attribute__((ext_vector_type(2)));
typedef short v4i16_t __attribute__((ext_vector_type(4)));
typedef LAS const char* lds_cptr;
constexpr int SEQ = 4096, PP = 1536;
constexpr float LOG2E = 1.4426950408889634f;
constexpr float NEGINF = -INFINITY;
__device__ __forceinline__ int crow(int r, int hi) { return (r & 3) + 8 * (r >> 2) + 4 * hi; }
__device__ __forceinline__ void glds16(const void* gsrc, unsigned lds_dst) { unsigned keep;
    asm volatile("s_mov_b32 %0, m0\n\ts_mov_b32 m0, %2\n\ts_nop 0\n\tglobal_load_lds_dwordx4 %1, off\n\ts_mov_b32 m0, %0" : "=&s"(keep) : "v"(gsrc), "s"(lds_dst) : "memory"); }
__device__ __forceinline__ unsigned cvtpk(float lo, float hi) { f32x2_t v = {lo, hi}; bf16x2_t b = __builtin_convertvector(v, bf16x2_t); return __builtin_bit_cast(unsigned, b); }
__device__ __forceinline__ s16x4 vtr(lds_cptr p) { return __builtin_bit_cast(s16x4, __builtin_amdgcn_ds_read_tr16_b64_v4i16((LAS v4i16_t*)p)); }
__device__ __forceinline__ bf16x8 ldk(lds_cptr p) { return *(const LAS bf16x8*)p; }
__device__ __forceinline__ float xhalf(float v, int hi) {
    auto rr = __builtin_amdgcn_permlane32_swap(__float_as_uint(v), __float_as_uint(v), false, false);
    return hi ? __uint_as_float(rr[0]) : __uint_as_float(rr[1]); }
template <int OF> __device__ __forceinline__ float swz_xor(float v) { return __int_as_float(__builtin_amdgcn_ds_swizzle(__float_as_int(v), (OF << 10) | 0x1f)); }
__device__ __forceinline__ float max16(const f32x16& p) { float a = fmaxf(fmaxf(p[0], p[1]), fmaxf(p[2], p[3]));
#pragma unroll
    for (int r = 4; r < 16; r += 4) a = fmaxf(a, fmaxf(fmaxf(p[r], p[r + 1]), fmaxf(p[r + 2], p[r + 3]))); return a; }
__device__ __forceinline__ float add_s(float a, float b) { float r; asm("v_add_f32_e32 %0, %1, %2" : "=v"(r) : "v"(a), "v"(b)); return r; }
__device__ __forceinline__ float max3_s(float a, float b, float c) { float r; asm("v_max3_f32 %0, %1, %2, %3" : "=v"(r) : "v"(a), "v"(b), "v"(c)); return r; }
__device__ __forceinline__ float sum16a(const f32x16& p) { float a = p[0];
#pragma unroll
    for (int r = 1; r < 16; ++r) a += p[r];
    return a; }
__device__ __forceinline__ float max16a(const f32x16& p) { float a = max3_s(p[0], p[1], p[2]), b = max3_s(p[3], p[4], p[5]);
    a = max3_s(a, p[6], p[7]); b = max3_s(b, p[8], p[9]); a = max3_s(a, p[10], p[11]); b = max3_s(b, p[12], p[13]); a = max3_s(a, p[14], p[15]); return max3_s(a, b, b); }
__device__ __forceinline__ float sum16(const f32x16& p) { float a = (p[0] + p[1]) + (p[2] + p[3]);
#pragma unroll
    for (int r = 4; r < 16; r += 4) a += (p[r] + p[r + 1]) + (p[r + 2] + p[r + 3]); return a; }
#define ATT_WAIT_BAR(N) asm volatile("s_waitcnt vmcnt(" #N ") lgkmcnt(0)\n\ts_barrier" ::: "memory")
#define ATT_LDSW() asm volatile("s_waitcnt lgkmcnt(0)" ::: "memory")
#define PACK8(P, B) (u32x4){cvtpk(P[B], P[B + 1]), cvtpk(P[B + 2], P[B + 3]), cvtpk(P[B + 4], P[B + 5]), cvtpk(P[B + 6], P[B + 7])}
#define ASBF(x) __builtin_bit_cast(bf16x8, x)
#define VFRAG(lo, hh) (bf16x8){lo[0], lo[1], lo[2], lo[3], hh[0], hh[1], hh[2], hh[3]}

constexpr int A_SLOT = 32768, A_NSLOT = 4, A_WSF = 131072, A_FLAGS = 135168, A_SLN = 135424, A_KN = 135936, A_XCH = 0, A_STG = 65536;
constexpr float A_THR = 8.f, A_DEAD = -150.f;
template <int MODE = 0> __device__ __forceinline__ void diff_unit(int b, int h, int qb, const bf16* __restrict__ PA, bf16* __restrict__ YA, float lam, const LAS float* knl, const __attribute__((address_space(1))) unsigned* qctr, LAS int* qslot, LAS char* shm, const int tid, const int ro_mul = 1) {
    const int lane = tid & 63, r32 = lane & 31, hi = lane >> 5;
    const int wid = __builtin_amdgcn_readfirstlane(tid >> 6), comp = wid >> 2, g = wid & 3;
    const float slope2 = __builtin_amdgcn_exp2f(-2.f * (float)(h + 1)) * LOG2E;
    const long rowbase = (long)b * SEQ; const int q0 = qb * 128, qw0 = q0 + 32 * g, qi = qw0 + r32;
    const unsigned lds0 = (unsigned)(size_t)shm;
    LAS float* wsf = (LAS float*)(shm + A_WSF) + wid * 128;
    const bf16* kb_ = PA + rowbase * PP + 512 + h * 128; const bf16* vb_ = PA + rowbase * PP + 1024 + h * 128;
    const bf16* ksrc0 = kb_ + (long)lane * PP + wid * 8; const bf16* ksrc1 = ksrc0 + 64;
    const int pa = wid, pb = wid + 8;
    const bf16* vsrca = vb_ + (long)(16 * (pa & 3) + (lane >> 2)) * PP + (pa >> 2) * 32 + (lane & 3) * 8;
    const bf16* vsrcb = vb_ + (long)(16 * (pb & 3) + (lane >> 2)) * PP + (pb >> 2) * 32 + (lane & 3) * 8;
    const int NT = 2 * (qb + 1);
#define A_ISSUE(it_) do { const long ro_ = (long)(NT - 1 - (it_)) * 64 * PP * ro_mul; const unsigned sb_ = (unsigned)__builtin_amdgcn_readfirstlane(lds0 + (unsigned)(((it_) & 3) * A_SLOT)); \
        glds16(ksrc0 + ro_, sb_ + wid * 1024); glds16(ksrc1 + ro_, sb_ + 8192 + wid * 1024); glds16(vsrca + ro_, sb_ + 16384 + pa * 1024); glds16(vsrcb + ro_, sb_ + 16384 + pb * 1024); } while (0)
    const bf16* qp = PA + (rowbase + qi) * PP + h * 128 + comp * 64 + hi * 8;
    unsigned un_ = 0u;
    if (tid == 0) asm volatile("global_atomic_add %0, %1, %2, off sc0" : "=v"(un_) : "v"(qctr), "v"(1u) : "memory");
    bf16x8 qr[4];
    asm volatile("global_load_dwordx4 %0, %1, off" : "=v"(qr[0]) : "v"(qp) : "memory"); asm volatile("global_load_dwordx4 %0, %1, off offset:32" : "=v"(qr[1]) : "v"(qp) : "memory");
    asm volatile("global_load_dwordx4 %0, %1, off offset:64" : "=v"(qr[2]) : "v"(qp) : "memory"); asm volatile("global_load_dwordx4 %0, %1, off offset:96" : "=v"(qr[3]) : "v"(qp) : "memory");
    const float sl4 = slope2 * 4.f * (float)hi;
    volatile LAS int* fl = (volatile LAS int*)(shm + A_FLAGS);
    A_ISSUE(0); A_ISSUE(1); if (NT > 2) A_ISSUE(2);
    float m_ref = NEGINF, l = 0.f; f32x16 o[4];
#pragma unroll
    for (int dq = 0; dq < 4; ++dq) { o[dq] = f32x16{}; asm volatile("" : "+v"(o[dq])); }
#define A_QKH(P, it_, hf_) do { const int kh_ = 64 * (NT - 1 - (it_)) + 32 * (hf_); { \
        const lds_cptr kp_ = shm + ((it_) & 3) * A_SLOT + comp * 8192 + hi * 1024 + r32 * 16 + (hf_) * 512; \
        float s2_ = slope2; asm volatile("" : "+v"(s2_));     \
        const float bs_ = s2_ * (float)(kh_ - qi) + sl4; \
        _Pragma("unroll") for (int r = 0; r < 16; ++r) P[r] = __builtin_fmaf(s2_, (float)((r & 3) + 8 * (r >> 2)), bs_); \
        _Pragma("unroll") for (int d0 = 0; d0 < 4; ++d0) P = __builtin_amdgcn_mfma_f32_32x32x16_bf16(ldk(kp_ + d0 * 2048), qr[d0], P, 0, 0, 0); } } while (0)
#define A_SVH(P, it_, hf_) do { const int kh_ = 64 * (NT - 1 - (it_)) + 32 * (hf_); if (kh_ <= qw0) { \
        if (kh_ == qw0) { _Pragma("unroll") for (int r = 0; r < 16; ++r) if (crow(r, hi) > r32) P[r] = NEGINF; } \
        float rm_ = max16a(P); rm_ = fmaxf(rm_, xhalf(rm_, hi)); \
        if (!__all(rm_ < m_ref + A_DEAD)) { \
            const float mnew_ = fmaxf(m_ref, rm_); \
            if (__any(mnew_ > m_ref + A_THR)) { const float alpha_ = __builtin_amdgcn_exp2f(m_ref - mnew_); l *= alpha_; m_ref = mnew_; \
                if (hi == 0) wsf[r32] = alpha_; ATT_LDSW(); \
                _Pragma("unroll") for (int r = 0; r < 16; ++r) { const float a_ = wsf[crow(r, hi)]; _Pragma("unroll") for (int dq = 0; dq < 4; ++dq) o[dq][r] *= a_; } } \
            _Pragma("unroll") for (int r = 0; r < 16; ++r) P[r] = __builtin_amdgcn_exp2f(P[r] - m_ref); \
            l += sum16a(P); \
            const u32x4 pw0_ = PACK8(P, 0), pw1_ = PACK8(P, 8); \
            const lds_cptr vp_ = shm + ((it_) & 3) * A_SLOT + 16384 + (hf_) * 2048 + ((lane >> 4) & 1) * 32 + (lane & 3) * 8 + (4 * hi + ((lane & 15) >> 2)) * 64; \
            _Pragma("unroll") for (int dq = 0; dq < 4; ++dq) { \
                const s16x4 l0_ = vtr(vp_ + dq * 4096), h0_ = vtr(vp_ + dq * 4096 + 512), l1_ = vtr(vp_ + dq * 4096 + 1024), h1_ = vtr(vp_ + dq * 4096 + 1536); \
                o[dq] = __builtin_amdgcn_mfma_f32_32x32x16_bf16(ASBF(pw0_), VFRAG(l0_, h0_), o[dq], 0, 0, 0); \
                o[dq] = __builtin_amdgcn_mfma_f32_32x32x16_bf16(ASBF(pw1_), VFRAG(l1_, h1_), o[dq], 0, 0, 0); } } } } while (0)
    f32x16 PH, PL;
    if (NT > 2) { ATT_WAIT_BAR(8); } else { ATT_WAIT_BAR(4); }
#pragma unroll
    for (int d0 = 0; d0 < 4; ++d0) asm volatile("" : "+v"(qr[d0]));
    float qkb;
    { float ss = 0.f;
#pragma unroll
      for (int d0 = 0; d0 < 4; ++d0)
#pragma unroll
          for (int e = 0; e < 8; ++e) { const float v = __uint_as_float((unsigned)(unsigned short)qr[d0][e] << 16); ss += v * v; }
      ss += xhalf(ss, hi); qkb = sqrtf(ss) * knl[2 * h + comp] * 1.001f + 1.0f; }
    A_QKH(PH, 0, 1);
    for (int it = 0; it < ((MODE == 5) ? 1 : NT); ++it) {
        A_QKH(PL, it, 0);
        A_SVH(PH, it, 1);
        if (it + 1 < NT) {
            if (it + 2 < NT) { ATT_WAIT_BAR(4); } else { ATT_WAIT_BAR(0); }
            if (it > 0) { const volatile LAS int* f = fl + ((it - 1) & 1) * 8;
                if (f[0] & f[1] & f[2] & f[3] & f[4] & f[5] & f[6] & f[7]) break; }
            if (it + 3 < NT) A_ISSUE(it + 3);
            A_QKH(PH, it + 1, 1);
        }
        A_SVH(PL, it, 0);
        { const float bmax = slope2 * (float)(64 * (NT - 2 - it) + 63 - qi);
          const int dead = __all(qkb + bmax < m_ref + A_DEAD) ? 1 : 0;
          if (lane == 0) fl[(it & 1) * 8 + wid] = dead; }
    }
#undef A_ISSUE
#undef A_QKH
#undef A_SVH
    l += xhalf(l, hi);
    if (hi == 0) wsf[32 + r32] = __builtin_amdgcn_rcpf(l); ATT_LDSW();
#pragma unroll
    for (int r = 0; r < 16; ++r) { const float a = wsf[32 + crow(r, hi)];
#pragma unroll
        for (int dq = 0; dq < 4; ++dq) o[dq][r] *= a; }
    ATT_WAIT_BAR(0);
    if (tid == 0) { asm volatile("" : "+v"(un_)); *qslot = (int)un_; }
    LAS float* X = (LAS float*)(shm + A_XCH) + g * 4096;
    if (comp == 1) {
#pragma unroll
        for (int dq = 0; dq < 4; ++dq)
#pragma unroll
            for (int r = 0; r < 16; ++r) X[(dq * 16 + r) * 64 + lane] = o[dq][r];
    }
    ATT_WAIT_BAR(0);
    if (comp == 0) {
        float ss[16];
#pragma unroll
        for (int r = 0; r < 16; ++r) ss[r] = 0.f;
#pragma unroll
        for (int dq = 0; dq < 4; ++dq)
#pragma unroll
            for (int r = 0; r < 16; ++r) { const float d = o[dq][r] - lam * X[(dq * 16 + r) * 64 + lane]; o[dq][r] = d; ss[r] += d * d; }
#pragma unroll
        for (int r = 0; r < 16; ++r) { float s = ss[r];
            s += swz_xor<1>(s); s += swz_xor<2>(s); s += swz_xor<4>(s); s += swz_xor<8>(s); s += swz_xor<16>(s);
            ss[r] = __builtin_amdgcn_rsqf(s * (1.f / 128.f) + 1e-6f); }
        LAS bf16* stg = (LAS bf16*)(shm + A_STG) + g * 4096;
#pragma unroll
        for (int dq = 0; dq < 4; ++dq) { const float gn = ((const LAS float*)(shm + A_SLN))[dq * 32 + r32];
#pragma unroll
            for (int r = 0; r < 16; ++r) stg[crow(r, hi) * 128 + dq * 32 + r32] = (bf16)(cvtpk(o[dq][r] * ss[r] * gn, 0.f) & 0xffffu); }
        ATT_LDSW();
        bf16* Yw = YA + (rowbase + qw0) * 512 + h * 128;
#pragma unroll
        for (int i = 0; i < 8; ++i) { const int idx = i * 64 + lane, row = idx >> 4, ch = idx & 15; const u32x4 v = *(const LAS u32x4*)(stg + row * 128 + ch * 8); *(u32x4*)(Yw + (long)row * 512 + ch * 8) = v; }
    }
}

constexpr int B_V = 49152, B_WSF = 98304, B_STG = 100352;
struct DilU { int b, h, dil, res, blk, pat; };
__device__ __forceinline__ DilU dil_unit_of(int bh, int j) { DilU u; u.b = bh >> 3; u.h = bh & 7;
    if (j < 16) { u.pat = 0; u.dil = 1; u.res = 0; u.blk = j; } else if (j < 32) { u.pat = 1; u.dil = 4; u.res = (j - 16) >> 2; u.blk = (j - 16) & 3; } else { u.pat = 2; u.dil = 16; u.res = j - 32; u.blk = 0; }
    return u; }
__device__ __forceinline__ DilU dil_unit_at(int vcu, int i) { const int x = vcu >> 5, n = (vcu & 31) + 32 * i, q = n / 48; return dil_unit_of(8 * x + q, n - 48 * q); }
__device__ __forceinline__ void dil_phase(int vcu, const bf16* __restrict__ PB, bf16* __restrict__ BPb, float* __restrict__ BSTb, LAS char* shm, const int tid) {
    const int lane = tid & 63, r32 = lane & 31, hi = lane >> 5;
    const int wid = __builtin_amdgcn_readfirstlane(tid >> 6);
    const unsigned lds0 = (unsigned)(size_t)shm;
    const bf16* const KBh = PB + (size_t)32768 * 512; const bf16* const VBh = PB + (size_t)2 * 32768 * 512;
#define B_ISSUE_K(U) do { const bf16* kb_ = KBh + (size_t)((U).b * 8 + (U).h) * SEQ * 64 + wid * 8; const int jb_ = 256 * (U).blk - 128; \
        _Pragma("unroll") for (int T = 0; T < 6; ++T) { int j_ = jb_ + 64 * T + lane; j_ = j_ < 0 ? 0 : j_;     \
            glds16(kb_ + ((size_t)j_ * (U).dil + (U).res) * 64, (unsigned)__builtin_amdgcn_readfirstlane(lds0 + (unsigned)(T * 8192 + wid * 1024))); } } while (0)
#define B_ISSUE_V(U) do { const bf16* vb_ = VBh + (size_t)((U).b * 8 + (U).h) * SEQ * 64 + (wid >> 2) * 32 + (lane & 3) * 8; const int jb_ = 256 * (U).blk - 128 + 16 * (wid & 3) + (lane >> 2); \
        _Pragma("unroll") for (int T = 0; T < 6; ++T) { int j_ = jb_ + 64 * T; j_ = j_ < 0 ? 0 : j_; \
            glds16(vb_ + ((size_t)j_ * (U).dil + (U).res) * 64, (unsigned)__builtin_amdgcn_readfirstlane(lds0 + (unsigned)(B_V + T * 8192 + wid * 1024))); } } while (0)
#ifdef PROBE_BSEG
    unsigned long long bt_ = 0; int bseg_ = -1;
#define BSEG(k) do { if (blockIdx.x == 0 && tid == 0) { const unsigned long long t_ = __builtin_amdgcn_s_memrealtime(); if (bseg_ == PROBE_BSEG) *(volatile LAS unsigned*)(shm + 139264 + 640) += (unsigned)(t_ - bt_); bt_ = t_; bseg_ = (k); } } while (0)
#else
#define BSEG(k) do { } while (0)
#endif
#define B_ISSUE_Q(U) do { const bf16* qp_ = PB + ((long)(U).b * SEQ + (long)(256 * (U).blk + 32 * wid + r32) * (U).dil + (U).res) * 512 + (U).h * 64 + hi * 8; \
        asm volatile("global_load_dwordx4 %0, %1, off" : "+v"(qr[0]) : "v"(qp_) : "memory"); asm volatile("global_load_dwordx4 %0, %1, off offset:32" : "+v"(qr[1]) : "v"(qp_) : "memory"); \
        asm volatile("global_load_dwordx4 %0, %1, off offset:64" : "+v"(qr[2]) : "v"(qp_) : "memory"); asm volatile("global_load_dwordx4 %0, %1, off offset:96" : "+v"(qr[3]) : "v"(qp_) : "memory"); } while (0)
    DilU cur = dil_unit_at(vcu, 0);
    bf16x8 qr[4]; qr[0] = bf16x8{}; qr[1] = bf16x8{}; qr[2] = bf16x8{}; qr[3] = bf16x8{};
    B_ISSUE_K(cur); B_ISSUE_Q(cur);
    for (int i = 0; i < 12; ++i) {
        const bool has_next = i + 1 < 12; const DilU nxt = dil_unit_at(vcu, has_next ? i + 1 : i);
        BSEG(0);
        const int b = cur.b, h = cur.h, dil = cur.dil, res = cur.res, blk = cur.blk;
        const int hs = h + (h >> 1);
        const float sd = __builtin_amdgcn_exp2f(-(2.f / 3.f) * (float)(hs + 1)) * LOG2E * (float)dil;
        const long rowbase = (long)b * SEQ; const int i0 = 256 * blk;
        const int iq = i0 + 32 * wid + r32;
#ifdef PROBE_DUPV
        B_ISSUE_V(cur);
        B_ISSUE_V(cur);
        ATT_WAIT_BAR(12);
#else
        B_ISSUE_V(cur);
        ATT_WAIT_BAR(6);
#endif
        BSEG(1);
        f32x16 s[5];
#pragma unroll
        for (int g = 0; g < 5; ++g) { const int b0 = 32 * (wid + g), T = b0 >> 6, half = (b0 >> 5) & 1;
            const lds_cptr kp = shm + T * 8192 + hi * 1024 + (half * 32 + r32) * 16;
            const float base = -sd * (float)(128 - 32 * g + r32);
#pragma unroll
            for (int r = 0; r < 16; ++r) s[g][r] = base + sd * (float)crow(r, hi);
#pragma unroll
            for (int d0 = 0; d0 < 4; ++d0) s[g] = __builtin_amdgcn_mfma_f32_32x32x16_bf16(ldk(kp + d0 * 2048), qr[d0], s[g], 0, 0, 0); }
        asm volatile("s_waitcnt lgkmcnt(0)\n\ts_barrier" ::: "memory");
        BSEG(2);
        if (has_next) B_ISSUE_K(nxt);
        B_ISSUE_Q(nxt);
        BSEG(3);
#pragma unroll
        for (int r = 0; r < 16; ++r) { const int cr = crow(r, hi); if (cr < r32) s[0][r] = NEGINF; if (cr > r32) s[4][r] = NEGINF; }
        if (blk == 0) {
#pragma unroll
            for (int g = 0; g < 5; ++g)
#pragma unroll
                for (int r = 0; r < 16; ++r) if (32 * (wid + g) + crow(r, hi) < 128) s[g][r] = NEGINF;
        }
        float m = max16(s[0]);
#pragma unroll
        for (int g = 1; g < 5; ++g) m = fmaxf(m, max16(s[g]));
        m = fmaxf(m, xhalf(m, hi));
        float l = 0.f;
#pragma unroll
        for (int g = 0; g < 5; ++g) {
#pragma unroll
            for (int r = 0; r < 16; ++r) s[g][r] = __builtin_amdgcn_exp2f(s[g][r] - m);
            l += sum16a(s[g]); }
        l += xhalf(l, hi);
        BSEG(4);
        if (has_next) { ATT_WAIT_BAR(10); } else { ATT_WAIT_BAR(4); }

        BSEG(5);
        f32x16 o[2]; o[0] = f32x16{}; o[1] = f32x16{};
        const lds_cptr vp0 = shm + B_V + ((lane >> 4) & 1) * 32 + (lane & 3) * 8 + (4 * hi + ((lane & 15) >> 2)) * 64;
#pragma unroll
        for (int g = 0; g < 5; ++g) { const u32x4 pwa = PACK8(s[g], 0), pwb = PACK8(s[g], 8);
            const int B16 = 2 * (wid + g), T = B16 >> 2, ks = B16 & 3;
            const lds_cptr vp = vp0 + T * 8192 + ks * 1024;
#pragma unroll
            for (int d0 = 0; d0 < 2; ++d0) {
                const s16x4 la = vtr(vp + d0 * 4096), ha = vtr(vp + d0 * 4096 + 512), lb_ = vtr(vp + d0 * 4096 + 1024), hb = vtr(vp + d0 * 4096 + 1536);
                o[d0] = __builtin_amdgcn_mfma_f32_32x32x16_bf16(ASBF(pwa), VFRAG(la, ha), o[d0], 0, 0, 0);
                o[d0] = __builtin_amdgcn_mfma_f32_32x32x16_bf16(ASBF(pwb), VFRAG(lb_, hb), o[d0], 0, 0, 0); } }
        BSEG(6);
        bf16* OUT = BPb + (size_t)cur.pat * 32768 * 512; float* ST = BSTb + (size_t)cur.pat * 32768 * 16;
        LAS float* wsf = (LAS float*)(shm + B_WSF) + wid * 64;
        if (hi == 0) wsf[r32] = __builtin_amdgcn_rcpf(l); ATT_LDSW();
        LAS bf16* stg = (LAS bf16*)(shm + B_STG) + wid * 2048;
#pragma unroll
        for (int r = 0; r < 16; ++r) { const float a = wsf[crow(r, hi)];
#pragma unroll
            for (int d0 = 0; d0 < 2; ++d0) stg[crow(r, hi) * 64 + d0 * 32 + r32] = (bf16)(cvtpk(o[d0][r] * a, 0.f) & 0xffffu); }
        ATT_LDSW();
        const long tok = rowbase + (long)iq * dil + res;
        if (hi == 0) { f32x2_t ml = {m, l}; *(f32x2_t*)(ST + (tok * 8 + h) * 2) = ml; }
#pragma unroll
        for (int k = 0; k < 4; ++k) { const int row = k * 8 + (lane >> 3), ch = lane & 7; const u32x4 v = *(const LAS u32x4*)(stg + row * 64 + ch * 8);
            const long trow = rowbase + (long)(i0 + 32 * wid + row) * dil + res; *(u32x4*)(OUT + trow * 512 + h * 64 + ch * 8) = v; }
        asm volatile("s_waitcnt lgkmcnt(0)\n\ts_barrier" ::: "memory");
        cur = nxt;
    }
    BSEG(-1);
    ATT_WAIT_BAR(0);
#undef B_ISSUE_K
#undef B_ISSUE_Q
#undef B_ISSUE_V
}

constexpr int C_SLOT = 16384, C_FLAGS = 49152, C_STG = 53248;
constexpr float C_EXIT = -150.f;
__device__ __forceinline__ void sb_unit(int b, int h, int qb, const bf16* __restrict__ PC, bf16* __restrict__ YC, const __attribute__((address_space(1))) unsigned* qctr, LAS int* qslot, LAS char* shm, const int tid) {
    const int lane = tid & 63, r32 = lane & 31, hi = lane >> 5;
    const int wid = __builtin_amdgcn_readfirstlane(tid >> 6);
    const long rowbase = (long)b * SEQ; const int q0 = qb * 256, qw0 = q0 + 32 * wid, qi = qw0 + r32;
    const unsigned lds0 = (unsigned)(size_t)shm;
    volatile LAS int* fl = (volatile LAS int*)(shm + C_FLAGS);
    const bf16* ksrc = PC + (rowbase + lane) * PP + 512 + h * 64 + wid * 8;
    const bf16* vsrc = PC + (rowbase + 16 * (wid & 3) + (lane >> 2)) * PP + 1024 + h * 64 + (wid >> 2) * 32 + (lane & 3) * 8;
    const int NT = 4 * qb + 4;
#define C_ISSUE(t_, sl_) do { const long ro_ = (long)(t_) * 64 * PP; const unsigned sb_ = (unsigned)__builtin_amdgcn_readfirstlane(lds0 + (unsigned)(sl_)); \
        glds16(ksrc + ro_, sb_ + wid * 1024); glds16(vsrc + ro_, sb_ + 8192 + wid * 1024); } while (0)
    const bf16* qp = PC + (rowbase + qi) * PP + h * 64 + hi * 8;
    unsigned un_ = 0u;
    if (tid == 0) asm volatile("global_atomic_add %0, %1, %2, off sc0" : "=v"(un_) : "v"(qctr), "v"(1u) : "memory");
    bf16x8 qr[4];
    asm volatile("global_load_dwordx4 %0, %1, off" : "=v"(qr[0]) : "v"(qp) : "memory"); asm volatile("global_load_dwordx4 %0, %1, off offset:32" : "=v"(qr[1]) : "v"(qp) : "memory");
    asm volatile("global_load_dwordx4 %0, %1, off offset:64" : "=v"(qr[2]) : "v"(qp) : "memory"); asm volatile("global_load_dwordx4 %0, %1, off offset:96" : "=v"(qr[3]) : "v"(qp) : "memory");
    C_ISSUE(NT - 1, 0); C_ISSUE(NT - 2, C_SLOT);
    float c = 1.f; bool wdone = false; f32x16 o[2]; o[0] = f32x16{}; o[1] = f32x16{};
    int sl = 0, sl2 = 2 * C_SLOT;
    for (int it = 0; it < NT; ++it) {
        if (it + 1 < NT) { ATT_WAIT_BAR(2); } else { ATT_WAIT_BAR(0); }
        if (it > 0) {
            const volatile LAS int* f = fl + ((it - 1) & 1) * 8;
            const int all = f[0] & f[1] & f[2] & f[3] & f[4] & f[5] & f[6] & f[7];
            if (all) break;
        }
        if (it + 2 < NT) C_ISSUE(NT - 3 - it, sl2);
        const int kbase = 64 * (NT - 1 - it);
        if (!wdone && kbase <= qw0) {
            const lds_cptr kp = shm + sl + hi * 1024 + r32 * 16;
            f32x16 p0 = f32x16{}, p1 = f32x16{};
#pragma unroll
            for (int d0 = 0; d0 < 4; ++d0) { const bf16x8 k0 = ldk(kp + d0 * 2048), k1 = ldk(kp + d0 * 2048 + 512);
                p0 = __builtin_amdgcn_mfma_f32_32x32x16_bf16(k0, qr[d0], p0, 0, 0, 0); p1 = __builtin_amdgcn_mfma_f32_32x32x16_bf16(k1, qr[d0], p1, 0, 0, 0); }
            if (kbase + 63 >= qw0) {
#pragma unroll
                for (int r = 0; r < 16; ++r) { const int kv = kbase + crow(r, hi); if (kv >= qi) p0[r] = NEGINF; if (kv + 32 >= qi) p1[r] = NEGINF; }
            }
            f32x16 N0, N1;
#pragma unroll
            for (int r = 0; r < 16; ++r) {
                { const float z = p0[r], e = __builtin_amdgcn_exp2f(-fabsf(z)), q = __builtin_amdgcn_rcpf(1.f + e), eq = e * q; const bool ps = z >= 0.f; p0[r] = ps ? q : eq; N0[r] = ps ? eq : q; }
                { const float z = p1[r], e = __builtin_amdgcn_exp2f(-fabsf(z)), q = __builtin_amdgcn_rcpf(1.f + e), eq = e * q; const bool ps = z >= 0.f; p1[r] = ps ? q : eq; N1[r] = ps ? eq : q; }
            }
            float T[8], U[8];
#pragma unroll
            for (int k = 0; k < 8; ++k) { const f32x16& Nx = (k < 4) ? N0 : N1; const int rb = 4 * (k & 3); T[k] = (Nx[rb] * Nx[rb + 1]) * (Nx[rb + 2] * Nx[rb + 3]); }
#pragma unroll
            for (int k = 0; k < 8; ++k) U[k] = xhalf(T[k], hi);
            float R = c;
#pragma unroll
            for (int k = 7; k >= 0; --k) {
                const float sufk = (hi == 0) ? R * U[k] : R;
                f32x16& Nx = (k < 4) ? N0 : N1; f32x16& Px = (k < 4) ? p0 : p1; const int rb = 4 * (k & 3);
                const float s3 = sufk, s2 = s3 * Nx[rb + 3], s1 = s2 * Nx[rb + 2], s0 = s1 * Nx[rb + 1];
                Px[rb + 3] *= s3; Px[rb + 2] *= s2; Px[rb + 1] *= s1; Px[rb + 0] *= s0;
                R *= T[k] * U[k];
            }
            c = R;
            const u32x4 pw0 = PACK8(p0, 0), pw1 = PACK8(p0, 8), pw2 = PACK8(p1, 0), pw3 = PACK8(p1, 8);
            const lds_cptr vp = shm + sl + 8192 + ((lane >> 4) & 1) * 32 + (lane & 3) * 8 + (4 * hi + ((lane & 15) >> 2)) * 64;
#pragma unroll
            for (int d0 = 0; d0 < 2; ++d0) {
                const s16x4 l0 = vtr(vp + d0 * 4096), h0 = vtr(vp + d0 * 4096 + 512), l1 = vtr(vp + d0 * 4096 + 1024), h1 = vtr(vp + d0 * 4096 + 1536);
                const s16x4 l2 = vtr(vp + d0 * 4096 + 2048), h2 = vtr(vp + d0 * 4096 + 2560), l3 = vtr(vp + d0 * 4096 + 3072), h3 = vtr(vp + d0 * 4096 + 3584);
                o[d0] = __builtin_amdgcn_mfma_f32_32x32x16_bf16(ASBF(pw0), VFRAG(l0, h0), o[d0], 0, 0, 0);
                o[d0] = __builtin_amdgcn_mfma_f32_32x32x16_bf16(ASBF(pw1), VFRAG(l1, h1), o[d0], 0, 0, 0);
                o[d0] = __builtin_amdgcn_mfma_f32_32x32x16_bf16(ASBF(pw2), VFRAG(l2, h2), o[d0], 0, 0, 0);
                o[d0] = __builtin_amdgcn_mfma_f32_32x32x16_bf16(ASBF(pw3), VFRAG(l3, h3), o[d0], 0, 0, 0);
            }
            wdone = __all(c == 0.f);
        }
        if (lane == 0) fl[(it & 1) * 8 + wid] = wdone ? 1 : 0;
        sl2 = sl; sl = (sl == 2 * C_SLOT) ? 0 : sl + C_SLOT;
    }
#undef C_ISSUE
    ATT_WAIT_BAR(0);
    if (tid == 0) { asm volatile("" : "+v"(un_)); *qslot = (int)un_; }
    LAS bf16* stg = (LAS bf16*)(shm + C_STG) + wid * 2048;
#pragma unroll
    for (int r = 0; r < 16; ++r)
#pragma unroll
        for (int d0 = 0; d0 < 2; ++d0) stg[crow(r, hi) * 64 + d0 * 32 + r32] = (bf16)(cvtpk(o[d0][r], 0.f) & 0xffffu);
    ATT_LDSW();
    bf16* Yw = YC + (rowbase + qw0) * 512 + h * 64;
#pragma unroll
    for (int i = 0; i < 4; ++i) { const int row = i * 8 + (lane >> 3), ch = lane & 7; const u32x4 v = *(const LAS u32x4*)(stg + row * 64 + ch * 8); *(u32x4*)(Yw + (long)row * 512 + ch * 8) = v; }
    asm volatile("s_waitcnt lgkmcnt(0)\n\ts_barrier" ::: "memory");
}
#undef LAS
}

constexpr int NWAVES = 8;
constexpr int BATCH = 8, SEQ = 4096, D = 1024, M = BATCH * SEQ;
constexpr int BW = 512, NPROJ = 9 * BW, NGATE = 3 * D, DFF = 2816, DFX = 3584, NEXP = 8;
constexpr float EPS = 1e-6f, LOG2E_F = 1.4426950408889634f;
constexpr float C2 = 0.125f * LOG2E_F;
#ifndef GATE0_FP8
#define GATE0_FP8 1
#endif
#define GATE_FP8(L) (((L) == 0) ? (GATE0_FP8 != 0) : (MIX_FP8 >= 1))
#ifndef MIX_FP8
#define MIX_FP8 1
#endif
#ifndef DENSE_FP8
#define DENSE_FP8 0
#endif
#ifndef FFN_FP8
#define FFN_FP8 1
#endif
constexpr int MOE_CH_TILES = FFN_FP8 ? 128 : 64, MOE_MAX_TILES = 264, MOE_MAX_CH = FFN_FP8 ? 3 : 5;

constexpr size_t MiB = 1u << 20, KiB = 1u << 10;
constexpr size_t WS_CTL = 0, CTL_ZERO_BYTES = 1 * MiB;
constexpr size_t WS_WIN = 1 * MiB, WS_WG = 19 * MiB, WS_WB = 31 * MiB, WS_WO = 37 * MiB, WS_WGU = 41 * MiB, WS_WD = 52 * MiB;
constexpr size_t WS_BST = 58 * MiB;
constexpr size_t WS_TOKE = 64 * MiB, WS_TOKW = WS_TOKE + 128 * KiB, WS_SLOT = WS_TOKE + 384 * KiB, WS_SLW = WS_TOKE + 640 * KiB, WS_CNT = WS_TOKE + 960 * KiB, WS_MHDR = WS_TOKE + 992 * KiB;
constexpr size_t WS_H = 66 * MiB;
constexpr size_t WS_PA = 130 * MiB, WS_PB = 226 * MiB, WS_PC = 322 * MiB;
constexpr size_t WS_YA = 418 * MiB, WS_YB = 450 * MiB, WS_YC = 482 * MiB;
constexpr size_t WS_BP = 130 * MiB;
constexpr size_t WS_GATES = 226 * MiB;
constexpr size_t WS_ACT = 130 * MiB;
constexpr size_t WS_MWGU = 130 * MiB, WS_MWD = 242 * MiB;
constexpr size_t WS_HS = 298 * MiB;
constexpr size_t WS_MACT = 430 * MiB;
constexpr size_t WS_XB = 418 * MiB;
constexpr size_t WS_END = 482 * MiB;
constexpr size_t OUT_YA = 0, OUT_YB = 32 * MiB, OUT_YC = 64 * MiB, OUT_H8 = 96 * MiB, OUT_MACT8 = 0;
static_assert(FFN_FP8 == 1 && OUT_H8 + (size_t)M * D <= (size_t)M * D * 4 && OUT_MACT8 + (size_t)MOE_CH_TILES * 256 * DFX <= (size_t)M * D * 4, "d_out scratch map");
constexpr size_t WS8_MWGU = 130 * MiB, WS8_MWD = 186 * MiB, WS8_HS = 214 * MiB, WS8_YS = 280 * MiB, WS8_MACT = 412 * MiB;
static_assert(WS8_MWGU + (size_t)NEXP * 2 * DFX * D <= WS8_MWD && WS8_MWD + (size_t)NEXP * D * DFX <= WS8_HS && WS8_HS + (size_t)MOE_MAX_TILES * 256 * D <= WS8_YS && WS8_YS + (size_t)MOE_MAX_TILES * 256 * D * 2 <= WS_XB && WS_XB + (size_t)M * D * 2 <= WS_END, "d_ws map fp8");
static_assert(WS_WD + (size_t)D * DFF * 2 <= WS_BST && WS_HS + (size_t)MOE_MAX_TILES * 256 * D * 2 <= WS_MACT , "d_ws map");
static_assert(WS_MWGU + (size_t)NEXP * 2 * DFX * D * 2 <= WS_MWD && WS_MWD + (size_t)NEXP * D * DFX * 2 <= WS_HS && WS_ACT + (size_t)M * DFF * 2 <= WS_PC, "d_ws map 2");
constexpr int CW_BAR = 4096, CW_Q = 16384, CW_KM = 49152, CW_KC = 53248;

constexpr int RING_OFF = 0, LDSCTL_OFF = 139264, MISC_OFF = LDSCTL_OFF + 320, LTAB_OFF = LDSCTL_OFF + 1024;
constexpr int LDS_BYTES = 147456;

#define GAS __attribute__((address_space(1)))
#define LAS __attribute__((address_space(3)))
typedef unsigned short bf16;
typedef unsigned v4u __attribute__((ext_vector_type(4)));
typedef unsigned v2u __attribute__((ext_vector_type(2)));
typedef float f32x4 __attribute__((ext_vector_type(4)));
typedef float f32x2 __attribute__((ext_vector_type(2)));
typedef GAS unsigned gu32;
#define RLX_AGENT __ATOMIC_RELAXED, __HIP_MEMORY_SCOPE_AGENT
#define LDS_WAIT() asm volatile("s_waitcnt lgkmcnt(0)" ::: "memory")
#define VM_WAIT() asm volatile("s_waitcnt vmcnt(0)" ::: "memory")
__device__ __forceinline__ unsigned f2bf(float f) { unsigned u = __builtin_bit_cast(unsigned, f); return (u + 0x7fffu + ((u >> 16) & 1u)) >> 16; }
__device__ __forceinline__ unsigned pk2(float lo, float hi) { return f2bf(lo) | (f2bf(hi) << 16); }
__device__ __forceinline__ float bfl(unsigned w) { return __uint_as_float(w << 16); }
__device__ __forceinline__ float bfh(unsigned w) { return __uint_as_float(w & 0xffff0000u); }

#define XB_TMO      128
#define XB_XCNT(j)  (256  + 64 * (j))
#define XB_XSUB(j)  (1280 + 64 * (j))
#define XB_XGEN(j)  (2304 + 64 * (j))
#define XB_TOP      3328
#define XB_TOPGEN   3392
#define XCD_BAR_WORDS 3456
#define XB_SPIN_CAP (1u << 18)

__device__ __forceinline__ unsigned xb_ld(unsigned* p)              { return __hip_atomic_load(p, __ATOMIC_RELAXED, __HIP_MEMORY_SCOPE_AGENT); }
__device__ __forceinline__ unsigned xb_add(unsigned* p, unsigned v) { return __hip_atomic_fetch_add(p, v, __ATOMIC_RELAXED, __HIP_MEMORY_SCOPE_AGENT); }
__device__ __forceinline__ unsigned xb_xcc_id() { return (unsigned)__builtin_amdgcn_s_getreg((3 << 11) | 20) & 0xFu; }
#define XB_SPIN(cond, bar) do { unsigned _sp = 0; while (cond) { __builtin_amdgcn_s_sleep(1); \
    if ((++_sp & 255u) == 0u) { if (xb_ld(&(bar)[XB_TMO])) break; if (_sp > XB_SPIN_CAP) { atomicAdd(&(bar)[XB_TMO], 1u); break; } } } } while (0)

struct XcdBarrier {
    unsigned* bar; unsigned x;
    volatile LAS unsigned* st;
};

__device__ __forceinline__ XcdBarrier xcd_barrier_post(unsigned* bar, volatile LAS unsigned* st) {
    XcdBarrier b; b.bar = bar; b.x = xb_xcc_id(); b.st = st;
    if (threadIdx.x == 0) (void)xb_add(&bar[XB_XCNT(b.x)], 1u);
    return b;
}
__device__ __forceinline__ void xcd_barrier_complete(unsigned* bar, unsigned x, unsigned& nloc, unsigned& nx) {
    const unsigned G = gridDim.x * gridDim.y * gridDim.z;
    unsigned sum, cnt, mine, sp = 0u;
    for (;;) {
        sum = 0u; cnt = 0u; mine = 0u;
#pragma unroll
        for (unsigned j = 0; j < 16; ++j) { const unsigned c = xb_ld(&bar[XB_XCNT(j)]); sum += c; cnt += (c > 0u) ? 1u : 0u; mine = (j == x) ? c : mine; }
        if (sum == G) break;
        __builtin_amdgcn_s_sleep(1);
        if ((++sp & 255u) == 0u) { if (xb_ld(&bar[XB_TMO])) break; if (sp > XB_SPIN_CAP) { atomicAdd(&bar[XB_TMO], 1u); break; } }
    }
    nloc = mine > 0u ? mine : 1u; nx = cnt > 0u ? cnt : 1u;
}

__device__ __forceinline__ void xcd_barrier(const XcdBarrier& b) {
    asm volatile("s_waitcnt vmcnt(0)" ::: "memory");
    __syncthreads();
    if (threadIdx.x == 0) {
        unsigned* bar = b.bar;
        __builtin_amdgcn_s_waitcnt(0);
        unsigned nloc = b.st[0], nx = b.st[1];
        if (nloc == 0u) { xcd_barrier_complete(bar, b.x, nloc, nx); b.st[0] = nloc; b.st[1] = nx; }
        const unsigned old = xb_add(&bar[XB_XSUB(b.x)], 1u);
        const unsigned gen = old / nloc;
        if (old + 1u == (gen + 1u) * nloc) {
            __builtin_amdgcn_fence(__ATOMIC_RELEASE, "agent");
            asm volatile("s_waitcnt vmcnt(0)" ::: "memory");
            const unsigned og = xb_add(&bar[XB_TOP], 1u);
            const unsigned tg = og / nx;
            if (og + 1u == (tg + 1u) * nx) xb_add(&bar[XB_TOPGEN], 1u);
            else XB_SPIN(xb_ld(&bar[XB_TOPGEN]) == tg, bar);
            __builtin_amdgcn_fence(__ATOMIC_ACQUIRE, "agent");
            xb_add(&bar[XB_XGEN(b.x)], 1u);
            asm volatile("s_waitcnt vmcnt(0)" ::: "memory");
        } else {
            XB_SPIN(xb_ld(&bar[XB_XGEN(b.x)]) == gen, bar);
            __builtin_amdgcn_fence(__ATOMIC_ACQUIRE, "agent");
            asm volatile("s_waitcnt vmcnt(0)" ::: "memory");
        }
    }
    __syncthreads();
}


template <int OF> __device__ __forceinline__ float swz_f(float v) { return __int_as_float(__builtin_amdgcn_ds_swizzle(__float_as_int(v), (OF << 10) | 0x1f)); }
template <int OF> __device__ __forceinline__ int swz_i(int v) { return __builtin_amdgcn_ds_swizzle(v, (OF << 10) | 0x1f); }
__device__ __forceinline__ float x32_f(float v) { auto rr = __builtin_amdgcn_permlane32_swap(__float_as_uint(v), __float_as_uint(v), false, false); return __uint_as_float(rr[0]) + __uint_as_float(rr[1]); }
__device__ __forceinline__ int x32_i(int v) { auto rr = __builtin_amdgcn_permlane32_swap((unsigned)v, (unsigned)v, false, false); return (int)(rr[0] + rr[1]); }
__device__ __forceinline__ float wave_sum(float v) {
    v += swz_f<1>(v); v += swz_f<2>(v); v += swz_f<4>(v); v += swz_f<8>(v); v += swz_f<16>(v); return x32_f(v);
}
__device__ __forceinline__ int wave_sum_i(int v) { v += swz_i<1>(v); v += swz_i<2>(v); v += swz_i<4>(v); v += swz_i<8>(v); v += swz_i<16>(v); return x32_i(v); }
__device__ __forceinline__ void transpose_item(const float* W, int K, int N, bf16* WT, int row_off, LAS float* scr, int k0, int n0, int lane) {
    f32x4 wv_[8];
#pragma unroll
    for (int i = 0; i < 8; ++i) wv_[i] = *(const GAS f32x4*)(W + (size_t)(k0 + 8 * i + (lane >> 3)) * N + n0 + 4 * (lane & 7));
#pragma unroll
    for (int i = 0; i < 8; ++i) { LAS float* d = scr + (8 * i + (lane >> 3)) * 33 + 4 * (lane & 7); d[0] = wv_[i].x; d[1] = wv_[i].y; d[2] = wv_[i].z; d[3] = wv_[i].w; }
    LDS_WAIT(); asm volatile("" ::: "memory");
    const int c = lane & 7;
#pragma unroll
    for (int j = 0; j < 4; ++j) { const int n = (lane >> 3) + 8 * j; const LAS float* s = scr + (8 * c) * 33 + n;
        v4u o; o.x = pk2(s[0 * 33], s[1 * 33]); o.y = pk2(s[2 * 33], s[3 * 33]); o.z = pk2(s[4 * 33], s[5 * 33]); o.w = pk2(s[6 * 33], s[7 * 33]);
        *(GAS v4u*)(WT + (size_t)(row_off + n0 + n) * K + k0 + 8 * c) = o; }
    LDS_WAIT(); asm volatile("" ::: "memory");
}
__device__ __forceinline__ void conv_matrix(const float* W, int K, int N, bf16* WT, int mode, LAS float* scr, int gw, int ngw, int lane) {
    const int nblk = N / 32, items = (K / 64) * nblk;
    for (int it = gw; it < items; it += ngw) { const int kb = it / nblk, nb = it - kb * nblk, n0 = 32 * nb;
        const int d0 = mode == 0 ? n0 : (256 * (n0 >> 7) + (n0 & 127) + (mode == 2 ? 128 : 0));
        transpose_item(W, K, N, WT, d0 - n0, scr, 64 * kb, n0, lane); }
}
__device__ __forceinline__ void transpose_item8(const float* W, int K, int N, unsigned char* WT, int row_off, LAS float* scr, int k0, int n0, int lane) {
    f32x4 wv_[8];
#pragma unroll
    for (int i = 0; i < 8; ++i) wv_[i] = *(const GAS f32x4*)(W + (size_t)(k0 + 8 * i + (lane >> 3)) * N + n0 + 4 * (lane & 7));
#pragma unroll
    for (int i = 0; i < 8; ++i) { LAS float* d = scr + (8 * i + (lane >> 3)) * 33 + 4 * (lane & 7); d[0] = wv_[i].x; d[1] = wv_[i].y; d[2] = wv_[i].z; d[3] = wv_[i].w; }
    LDS_WAIT(); asm volatile("" ::: "memory");
    const int c = lane & 7; const float sc = (float)(1 << pg8::F8_WSHIFT);
#pragma unroll
    for (int j = 0; j < 4; ++j) { const int n = (lane >> 3) + 8 * j; const LAS float* s = scr + (8 * c) * 33 + n;
        v2u o; o.x = pg8::pk4_fp8(s[0 * 33] * sc, s[1 * 33] * sc, s[2 * 33] * sc, s[3 * 33] * sc); o.y = pg8::pk4_fp8(s[4 * 33] * sc, s[5 * 33] * sc, s[6 * 33] * sc, s[7 * 33] * sc);
        *(GAS v2u*)(WT + (size_t)(row_off + n0 + n) * K + k0 + 8 * c) = o; }
    LDS_WAIT(); asm volatile("" ::: "memory");
}
__device__ __forceinline__ void conv_matrix8(const float* W, int K, int N, unsigned char* WT, int mode, LAS float* scr, int gw, int ngw, int lane) {
    const int nblk = N / 32, items = (K / 64) * nblk;
    for (int it = gw; it < items; it += ngw) { const int kb = it / nblk, nb = it - kb * nblk, n0 = 32 * nb;
        const int d0 = mode == 0 ? n0 : (256 * (n0 >> 7) + (n0 & 127) + (mode == 2 ? 128 : 0));
        transpose_item8(W, K, N, WT, d0 - n0, scr, 64 * kb, n0, lane); }
}
__device__ __forceinline__ void store_row_fp8(unsigned char* orow, const f32x4 (&v)[4], int lane) {
    GAS unsigned* o4 = (GAS unsigned*)orow + lane;
#pragma unroll
    for (int j = 0; j < 4; ++j) o4[64 * j] = pg8::pk4_fp8(v[j].x, v[j].y, v[j].z, v[j].w);
}
__device__ __forceinline__ void rms_row(const float* xrow, const f32x4 (&g)[4], f32x4 (&v)[4], int lane) {
    const GAS f32x4* xr = (const GAS f32x4*)xrow + lane; float s2 = 0.f;
#pragma unroll
    for (int j = 0; j < 4; ++j) { v[j] = xr[64 * j]; s2 += (v[j].x * v[j].x + v[j].y * v[j].y) + (v[j].z * v[j].z + v[j].w * v[j].w); }
    const float rstd = 1.f / sqrtf(wave_sum(s2) * (1.f / D) + EPS);
#pragma unroll
    for (int j = 0; j < 4; ++j) v[j] = v[j] * rstd * g[j];
}
__device__ __forceinline__ f32x4 bf4(const v2u w) { return (f32x4){bfl(w.x), bfh(w.x), bfl(w.y), bfh(w.y)}; }
__device__ __forceinline__ void rms_row(const bf16* xrow, const f32x4 (&g)[4], f32x4 (&v)[4], int lane) {
    const GAS v2u* xr = (const GAS v2u*)xrow + lane; float s2 = 0.f; v2u w[4];
#pragma unroll
    for (int j = 0; j < 4; ++j) w[j] = xr[64 * j];
#pragma unroll
    for (int j = 0; j < 4; ++j) { v[j] = bf4(w[j]); s2 += (v[j].x * v[j].x + v[j].y * v[j].y) + (v[j].z * v[j].z + v[j].w * v[j].w); }
    const float rstd = 1.f / sqrtf(wave_sum(s2) * (1.f / D) + EPS);
#pragma unroll
    for (int j = 0; j < 4; ++j) v[j] = v[j] * rstd * g[j];
}
__device__ __forceinline__ void rms_row2(const bf16* xa, const bf16* xb, const f32x4 (&g)[4], f32x4 (&va)[4], f32x4 (&vb)[4], int lane) {
    const GAS v2u* pa = (const GAS v2u*)xa + lane; const GAS v2u* pb = (const GAS v2u*)xb + lane; float sa = 0.f, sb = 0.f; v2u wa[4], wb[4];
#pragma unroll
    for (int j = 0; j < 4; ++j) { wa[j] = pa[64 * j]; wb[j] = pb[64 * j]; }
#pragma unroll
    for (int j = 0; j < 4; ++j) { va[j] = bf4(wa[j]); vb[j] = bf4(wb[j]); sa += (va[j].x * va[j].x + va[j].y * va[j].y) + (va[j].z * va[j].z + va[j].w * va[j].w); sb += (vb[j].x * vb[j].x + vb[j].y * vb[j].y) + (vb[j].z * vb[j].z + vb[j].w * vb[j].w); }
    const float ra = 1.f / sqrtf(wave_sum(sa) * (1.f / D) + EPS), rb = 1.f / sqrtf(wave_sum(sb) * (1.f / D) + EPS);
#pragma unroll
    for (int j = 0; j < 4; ++j) { va[j] = va[j] * ra * g[j]; vb[j] = vb[j] * rb * g[j]; }
}
__device__ __forceinline__ void rms_row2(const float* xa, const float* xb, const f32x4 (&g)[4], f32x4 (&va)[4], f32x4 (&vb)[4], int lane) {
    const GAS f32x4* pa = (const GAS f32x4*)xa + lane; const GAS f32x4* pb = (const GAS f32x4*)xb + lane; float sa = 0.f, sb = 0.f;
#pragma unroll
    for (int j = 0; j < 4; ++j) { va[j] = pa[64 * j]; vb[j] = pb[64 * j]; }
#pragma unroll
    for (int j = 0; j < 4; ++j) { sa += (va[j].x * va[j].x + va[j].y * va[j].y) + (va[j].z * va[j].z + va[j].w * va[j].w); sb += (vb[j].x * vb[j].x + vb[j].y * vb[j].y) + (vb[j].z * vb[j].z + vb[j].w * vb[j].w); }
    const float ra = 1.f / sqrtf(wave_sum(sa) * (1.f / D) + EPS), rb = 1.f / sqrtf(wave_sum(sb) * (1.f / D) + EPS);
#pragma unroll
    for (int j = 0; j < 4; ++j) { va[j] = va[j] * ra * g[j]; vb[j] = vb[j] * rb * g[j]; }
}
__device__ __forceinline__ void store_row_bf16(bf16* orow, const f32x4 (&v)[4], int lane) {
    GAS v2u* o8 = (GAS v2u*)orow + lane;
#pragma unroll
    for (int j = 0; j < 4; ++j) { v2u w; w.x = pk2(v[j].x, v[j].y); w.y = pk2(v[j].z, v[j].w); o8[64 * j] = w; }
}


enum { PH_PRO = 0, PH_L = 20, NPHASE = 1 + 2 * PH_L };
struct Args { const float* in[18]; float* out; unsigned char* ws; int ph_lo, ph_hi; };
static_assert(sizeof(Args) == 18 * 8 + 8 + 8 + 8, "Args has no padding");

__global__ void __launch_bounds__(NWAVES * 64, 2) mega_fwd(Args args) {
    extern __shared__ __attribute__((aligned(16))) unsigned char lds_raw[];
    LAS unsigned char* const lds = (LAS unsigned char*)lds_raw;
    volatile LAS unsigned* const MISC = (volatile LAS unsigned*)(lds + MISC_OFF);
    const int wave_k = __builtin_amdgcn_readfirstlane((int)threadIdx.x >> 6);
    const int G = gridDim.x, bx = blockIdx.x; const int vcu = (G % 8 == 0) ? (bx % 8) * (G / 8) + bx / 8 : bx;
    const int NGW = G * NWAVES;
    unsigned char* const ws = args.ws;
    gu32* const ctl = (gu32*)(ws + WS_CTL);
    for (int u = threadIdx.x; u < (LDS_BYTES - LDSCTL_OFF) / 4; u += NWAVES * 64) ((LAS unsigned*)(lds + LDSCTL_OFF))[u] = 0u;
    __syncthreads();
#if MK_N_LAUNCHES == 1
    XcdBarrier bar = xcd_barrier_post((unsigned*)(ctl + CW_BAR), MISC + 8);
#ifndef PROBE_AMP
#define PROBE_AMP 1
#endif
#ifdef PROBE_CAT
#define SEAM() do { xcd_barrier(bar); if (bx == 0 && threadIdx.x == 0) { const unsigned long long tn_ = __builtin_amdgcn_s_memrealtime(); volatile LAS unsigned* pa_ = (volatile LAS unsigned*)(lds + LDSCTL_OFF + 640); if (cat_ == PROBE_CAT) pa_[0] += (unsigned)(tn_ - *(volatile LAS unsigned long long*)(lds + LDSCTL_OFF + 704)); *(volatile LAS unsigned long long*)(lds + LDSCTL_OFF + 704) = tn_; } } while (0)
#else
#define SEAM() xcd_barrier(bar)
#endif
#else
#define SEAM() do { } while (0)
#endif
    const int lo = args.ph_lo, hi = args.ph_hi;
#ifdef PROBE_CAT
    int cat_ = 0; if (bx == 0 && threadIdx.x == 0) *(volatile LAS unsigned long long*)(lds + LDSCTL_OFF + 704) = __builtin_amdgcn_s_memrealtime();
#define CAT(c) cat_ = (c)
#define STAMP(c) do { if (bx == 0 && threadIdx.x == 0) { const unsigned long long tn_ = __builtin_amdgcn_s_memrealtime(); volatile LAS unsigned* pa_ = (volatile LAS unsigned*)(lds + LDSCTL_OFF + 640); if (cat_ == PROBE_CAT) pa_[0] += (unsigned)(tn_ - *(volatile LAS unsigned long long*)(lds + LDSCTL_OFF + 704)); *(volatile LAS unsigned long long*)(lds + LDSCTL_OFF + 704) = tn_; } cat_ = (c); } while (0)
#else
#define CAT(c) do { } while (0)
#define STAMP(c) do { } while (0)
#endif
#define IN(k) (lo <= (k) && (k) < hi)
#ifndef REPG
#define REPG 1
#endif
#ifndef REPA
#define REPA 1
#endif
#ifndef REPA_A
#define REPA_A REPA
#endif
#ifndef REPA_C
#define REPA_C REPA
#endif
#ifndef REPA_B
#define REPA_B REPA
#endif
#ifndef REPT
#define REPT 1
#endif
#define PHASE_IDS() unsigned z0_ = 0u; asm volatile("" : "+s"(z0_)); int tidp = wave_k * 64 + (int)__builtin_amdgcn_mbcnt_hi(~0u, __builtin_amdgcn_mbcnt_lo(~0u, z0_)); asm volatile("" : "+v"(tidp)); const int tid = tidp, lane = tidp & 63, wave = __builtin_amdgcn_readfirstlane(tidp >> 6); const int gw = vcu * NWAVES + wave; LAS float* const scr = (LAS float*)(lds + RING_OFF + wave * 16384); (void)tid; (void)lane; (void)gw; (void)scr
#define INP(i) ([&]() -> const float* { int i_ = (i); asm volatile("" : "+s"(i_)); return args.in[i_]; }())
#define WSP(T, OFF) ([&]() -> T* { size_t o_ = (size_t)(OFF); asm volatile("" : "+s"(o_)); return (T*)(ws + o_); }())
#define x_in INP(0)
#define norm_mix INP(1)
#define w_in INP(2)
#define diff_lambda INP(3)
#define diff_subln INP(4)
#define w_gate INP(5)
#define b_gate INP(6)
#define w_branch INP(7)
#define w_out INP(8)
#define norm_ffn INP(9)
#define w_dg INP(10)
#define w_du INP(11)
#define w_dd INP(12)
#define w_router INP(13)
#define w_mg INP(14)
#define w_mu INP(15)
#define w_md INP(16)
#define norm_final INP(17)
#define xout (args.out)
#define Win_t WSP(bf16, WS_WIN)
#define Wg_t WSP(bf16, WS_WG)
#define Wb_t WSP(bf16, WS_WB)
#define Wo_t WSP(bf16, WS_WO)
#define Wgu_t WSP(bf16, WS_WGU)
#define Wd_t WSP(bf16, WS_WD)
#define Hb WSP(bf16, WS_H)
#define PA WSP(bf16, WS_PA)
#define PB WSP(bf16, WS_PB)
#define PC WSP(bf16, WS_PC)
#define OUTP(T, OFF) ([&]() -> T* { size_t o_ = (size_t)(OFF); asm volatile("" : "+s"(o_)); return (T*)((unsigned char*)args.out + o_); }())
#define YA OUTP(bf16, OUT_YA)
#define YC OUTP(bf16, OUT_YC)
#define YB OUTP(bf16, OUT_YB)
#define XB WSP(bf16, WS_XB)
#define BP WSP(bf16, WS_BP)
#define BST WSP(float, WS_BST)
#define GATES WSP(bf16, WS_GATES)
#define ACT WSP(bf16, WS_ACT)
#define MWgu WSP(bf16, WS_MWGU)
#define MWd WSP(bf16, WS_MWD)
#define HS WSP(bf16, WS_HS)
#define MACT WSP(bf16, WS_MACT)
#define TOKE WSP(int, WS_TOKE)
#define TOKW WSP(float, WS_TOKW)
#define SLOT WSP(int, WS_SLOT)
#define SLW WSP(float, WS_SLW)
#define CNT WSP(int, WS_CNT)
#define MHDR WSP(int, WS_MHDR)
#define Hb8 WSP(unsigned char, WS_H)
#define H8 OUTP(unsigned char, OUT_H8)
#define Win8 WSP(unsigned char, WS_WIN)
#define Wg8 WSP(unsigned char, WS_WG)
#define Wgu8 WSP(unsigned char, WS_WGU)
#define Wd8 WSP(unsigned char, WS_WD)
#define ACT8 WSP(unsigned char, WS_ACT)
#define MWgu8 WSP(unsigned char, WS8_MWGU)
#define MWd8 WSP(unsigned char, WS8_MWD)
#define HS8 WSP(unsigned char, WS8_HS)
#define YS8 WSP(bf16, WS8_YS)
#define MACT8 OUTP(unsigned char, OUT_MACT8)

    if (IN(PH_PRO)) { PHASE_IDS(); CAT(1);
        for (int L = 0; L < 2; ++L) {
#if MIX_FP8 >= 2
            conv_matrix8(w_in + (size_t)L * D * NPROJ, D, NPROJ, Win8 + (size_t)L * NPROJ * D, 0, scr, gw, NGW, lane);
#else
            conv_matrix(w_in + (size_t)L * D * NPROJ, D, NPROJ, Win_t + (size_t)L * NPROJ * D, 0, scr, gw, NGW, lane);
#endif
            if (GATE_FP8(L)) conv_matrix8(w_gate + (size_t)L * D * NGATE, D, NGATE, Wg8 + (size_t)L * NGATE * D * 2, 0, scr, gw, NGW, lane);
            else conv_matrix(w_gate + (size_t)L * D * NGATE, D, NGATE, Wg_t + (size_t)L * NGATE * D, 0, scr, gw, NGW, lane);
            for (int i = 0; i < 3; ++i) conv_matrix(w_branch + (size_t)(L * 3 + i) * BW * D, BW, D, Wb_t + (size_t)(L * 3 + i) * D * BW, 0, scr, gw, NGW, lane);
            conv_matrix(w_out + (size_t)L * D * D, D, D, Wo_t + (size_t)L * D * D, 0, scr, gw, NGW, lane);
        }
#if DENSE_FP8
        conv_matrix8(w_dg, D, DFF, Wgu8, 1, scr, gw, NGW, lane);
        conv_matrix8(w_du, D, DFF, Wgu8, 2, scr, gw, NGW, lane);
        conv_matrix8(w_dd, DFF, D, Wd8, 0, scr, gw, NGW, lane);
#else
        conv_matrix(w_dg, D, DFF, Wgu_t, 1, scr, gw, NGW, lane);
        conv_matrix(w_du, D, DFF, Wgu_t, 2, scr, gw, NGW, lane);
        conv_matrix(w_dd, DFF, D, Wd_t, 0, scr, gw, NGW, lane);
#endif
        {

            f32x4 g[4];
#pragma unroll
            for (int j = 0; j < 4; ++j) g[j] = ((const GAS f32x4*)(norm_mix) + lane)[64 * j];
            for (int m = gw; m < M; m += 2 * NGW) { f32x4 v[4], w[4]; rms_row2(x_in + (size_t)m * D, x_in + (size_t)(m + NGW) * D, g, v, w, lane);
                store_row_bf16(Hb + (size_t)m * D, v, lane); store_row_bf16(Hb + (size_t)(m + NGW) * D, w, lane);
                if (GATE0_FP8) { store_row_fp8(H8 + (size_t)m * D, v, lane); store_row_fp8(H8 + (size_t)(m + NGW) * D, w, lane); } }
        }
        SEAM();
    }

    for (int L = 0; L < 2; ++L) {
        const int P = 1 + L * PH_L;
        if (L == 1 && IN(P + 0)) { PHASE_IDS(); CAT(2);
            f32x4 g[4];
#pragma unroll
            for (int j = 0; j < 4; ++j) g[j] = ((const GAS f32x4*)(norm_mix + L * D) + lane)[64 * j];
            for (int m = gw; m < M; m += 2 * NGW) { f32x4 v[4], w[4]; rms_row2(XB + (size_t)m * D, XB + (size_t)(m + NGW) * D, g, v, w, lane);
                store_row_bf16(Hb + (size_t)m * D, v, lane); store_row_bf16(Hb + (size_t)(m + NGW) * D, w, lane);
                if (MIX_FP8 >= 1 && L == 1) { store_row_fp8(H8 + (size_t)m * D, v, lane); store_row_fp8(H8 + (size_t)(m + NGW) * D, w, lane); } }
            SEAM();
        }
        if (IN(P + 1)) { PHASE_IDS(); CAT(3);
#if MIX_FP8 >= 2
            pg8::Gemm g{(const bf16*)H8, (const bf16*)(Win8 + (size_t)L * NPROJ * D), D / 2}; pg8::StaticOrder S; S.init(M, NPROJ, D / 2, G, bx);
            pg8::EpiProj E{PA, (size_t)(WS_PB - WS_PA) / 2, C2, pg8::F8_WINV};
            pg8::gemm_phase<pg8::EpiProj, pg8::StaticOrder, true, true, true>(lds + RING_OFF, g, S, E, tidp);
#else
            pg8::Gemm g{Hb, Win_t + (size_t)L * NPROJ * D, D}; pg8::StaticOrder S; S.init(M, NPROJ, D, G, bx);
            pg8::EpiProj E{PA, (size_t)(WS_PB - WS_PA) / 2, C2, 1.f};
            for (int rep_ = 0; rep_ < REPG; ++rep_) { int tq_ = tidp; asm volatile("" : "+v"(tq_)); pg8::gemm_phase<pg8::EpiProj, pg8::StaticOrder, true, true>(lds + RING_OFF, g, S, E, tq_); }
#endif

            SEAM();
        }
        if (IN(P + 2)) { PHASE_IDS(); CAT(40);
            const float lam_init = 0.8f - 0.6f * expf(-0.3f * (float)L);
            float lam;
            { const float* lv = diff_lambda + L * 256; float s01 = lv[lane] * lv[64 + lane], s23 = lv[128 + lane] * lv[192 + lane];
              s01 += att::swz_xor<1>(s01); s01 += att::swz_xor<2>(s01); s01 += att::swz_xor<4>(s01); s01 += att::swz_xor<8>(s01); s01 += att::swz_xor<16>(s01); s01 += att::xhalf(s01, lane >> 5);
              s23 += att::swz_xor<1>(s23); s23 += att::swz_xor<2>(s23); s23 += att::swz_xor<4>(s23); s23 += att::swz_xor<8>(s23); s23 += att::swz_xor<16>(s23); s23 += att::xhalf(s23, lane >> 5);
              lam = expf(s01) - expf(s23) + lam_init; }
            { LAS int* qs = (LAS int*)(lds + LDSCTL_OFF + 512); const int grp = bx & 7;
              gu32* km = ctl + CW_KM + (L * 8 + grp) * 64; gu32* kc = ctl + CW_KC + (L * 8 + grp) * 64;
              { const int r0 = grp * SEQ + (bx >> 3) * 128 + wave * 16; float mx = 0.f;
                for (int r = 0; r < 16; ++r) { const v4u w = *(const GAS v4u*)(PA + (size_t)(r0 + r) * 1536 + 512 + lane * 8);
                    float ss = bfl(w.x) * bfl(w.x) + bfh(w.x) * bfh(w.x) + bfl(w.y) * bfl(w.y) + bfh(w.y) * bfh(w.y) + bfl(w.z) * bfl(w.z) + bfh(w.z) * bfh(w.z) + bfl(w.w) * bfl(w.w) + bfh(w.w) * bfh(w.w);
                    ss += att::swz_xor<1>(ss); ss += att::swz_xor<2>(ss); ss += att::swz_xor<4>(ss); mx = fmaxf(mx, ss); }
                if ((lane & 7) == 0) __hip_atomic_fetch_max(km + (lane >> 3), __float_as_uint(mx), RLX_AGENT);
                VM_WAIT(); __syncthreads();
                if (tid == 0) __hip_atomic_fetch_add(kc, 1u, RLX_AGENT); }
              STAMP(41);
              gu32* ctrA = ctl + CW_Q + ((L * 2 + 0) * 8 + grp) * 64; gu32* ctrC = ctl + CW_Q + ((L * 2 + 1) * 8 + grp) * 64;
              LAS float* const knl = (LAS float*)(lds + RING_OFF + att::A_KN);
              { LAS float* sln = (LAS float*)(lds + RING_OFF + att::A_SLN);
                if (tid < 128) sln[tid] = (diff_subln + L * 128)[tid] * (1.f - lam_init);
                if (tid >= 128 && tid < 136) knl[tid - 128] = INFINITY;
                if (tid == 136) qs[3] = 0; }
              for (int rep_ = 0; rep_ < REPA_A; ++rep_) {
                  if (tid == 0) qs[0] = (int)__hip_atomic_fetch_add(ctrA + rep_ * 8192, 1u, RLX_AGENT);
                  __syncthreads();
                  int u = __builtin_amdgcn_readfirstlane(qs[0]);
                  while (u < 128) {
                      if (qs[3] == 0 && wave == 2) {
                          const unsigned c_ = (unsigned)__builtin_amdgcn_readfirstlane((int)__hip_atomic_load(kc, RLX_AGENT));
                          if (c_ >= 32u) { if (lane < 8) knl[lane] = sqrtf(__uint_as_float(__hip_atomic_load(km + lane, RLX_AGENT))); if (lane == 0) qs[3] = 1; } }
#ifdef PROBE_AMODE
                      if (rep_ != REPA_A - 1) att::diff_unit<PROBE_AMODE>(grp, 3 - (u >> 5), 31 - (u & 31), PA, YA, lam, knl, ctrA + rep_ * 8192, qs, (LAS char*)(lds + RING_OFF), tidp, 0); else
#endif
                      att::diff_unit<0>(grp, 3 - (u >> 5), 31 - (u & 31), PA, YA, lam, knl, ctrA + rep_ * 8192, qs, (LAS char*)(lds + RING_OFF), tidp);
                      asm volatile("s_waitcnt lgkmcnt(0)\n\ts_barrier" ::: "memory");
                      u = __builtin_amdgcn_readfirstlane(qs[0]);
                  }
              }
              __syncthreads();
              STAMP(42);
              for (int rep_ = 0; rep_ < REPA_C; ++rep_) {
                  if (tid == 0) qs[1] = (int)__hip_atomic_fetch_add(ctrC + rep_ * 8192, 1u, RLX_AGENT);
                  __syncthreads();
                  int u = __builtin_amdgcn_readfirstlane(qs[1]);
                  while (u < 128) {
                      att::sb_unit(grp, u & 7, 15 - (u >> 3), PC, YC, ctrC + rep_ * 8192, qs + 1, (LAS char*)(lds + RING_OFF), tidp);
                      u = __builtin_amdgcn_readfirstlane(qs[1]);
                  }
              }
            }
            STAMP(43);
            SEAM();
        }
        if (IN(P + 3)) { PHASE_IDS(); CAT(5);
            att::dil_phase(vcu, PB, BP, BST, (LAS char*)(lds + RING_OFF), tidp);
            SEAM();
        }
        if (IN(P + 4)) { PHASE_IDS(); CAT(6);
            for (int m = gw; m < M; m += NGW) {
                const int hd = lane >> 3; f32x2 st[3]; float mx = -INFINITY;
#pragma unroll
                for (int p = 0; p < 3; ++p) { st[p] = *(const GAS f32x2*)(BST + ((size_t)p * M + m) * 16 + hd * 2); mx = fmaxf(mx, st[p].x); }
                float wgt[3], wsum = 0.f;
#pragma unroll
                for (int p = 0; p < 3; ++p) { wgt[p] = __builtin_amdgcn_exp2f(st[p].x - mx) * st[p].y; wsum += wgt[p]; }
                const float inv = 1.f / wsum; float acc[8];
#pragma unroll
                for (int k = 0; k < 8; ++k) acc[k] = 0.f;
#pragma unroll
                for (int p = 0; p < 3; ++p) { const v4u w = *(const GAS v4u*)(BP + ((size_t)p * M + m) * BW + lane * 8); const float f = wgt[p] * inv;
                    acc[0] += f * bfl(w.x); acc[1] += f * bfh(w.x); acc[2] += f * bfl(w.y); acc[3] += f * bfh(w.y); acc[4] += f * bfl(w.z); acc[5] += f * bfh(w.z); acc[6] += f * bfl(w.w); acc[7] += f * bfh(w.w); }
                v4u o; o.x = pk2(acc[0], acc[1]); o.y = pk2(acc[2], acc[3]); o.z = pk2(acc[4], acc[5]); o.w = pk2(acc[6], acc[7]);
                *(GAS v4u*)(YB + (size_t)m * BW + lane * 8) = o;
            }
            VM_WAIT(); __syncthreads();
            if (GATE_FP8(L)) {
                pg8::Gemm g{(const bf16*)H8, (const bf16*)(Wg8 + (size_t)L * NGATE * D * 2), D / 2}; pg8::StaticOrder S; S.init(M, NGATE, D / 2, G, bx);
                pg8::EpiGate E{GATES, NGATE, b_gate + L * NGATE, pg8::F8_WINV};
                pg8::gemm_phase<pg8::EpiGate, pg8::StaticOrder, true, true, true>(lds + RING_OFF, g, S, E, tidp);
            } else {
                pg8::Gemm g{Hb, Wg_t + (size_t)L * NGATE * D, D}; pg8::StaticOrder S; S.init(M, NGATE, D, G, bx);
                pg8::EpiGate E{GATES, NGATE, b_gate + L * NGATE, 1.f};
                for (int rep_ = 0; rep_ < REPG; ++rep_) { int tq_ = tidp; asm volatile("" : "+v"(tq_)); pg8::gemm_phase<pg8::EpiGate, pg8::StaticOrder, true, true>(lds + RING_OFF, g, S, E, tq_); }
            }

            SEAM();
        }
        if (IN(P + 5)) { PHASE_IDS(); CAT(7);
            pg8::Gemm g{YA, Wb_t + (size_t)L * 3 * D * BW, BW}; pg8::MergeOrder S; S.b.init(M, D, BW, G, bx);
            S.as = (long)(OUT_YB - OUT_YA); S.bs = (long)D * BW * 2;
            pg8::EpiMerge E{GATES, Hb};

 for (int rep_ = 0; rep_ < ((true) ? REPG : 1); ++rep_) { int tq_ = tidp; asm volatile("" : "+v"(tq_));  pg8::gemm_phase<pg8::EpiMerge, pg8::MergeOrder, true, true>(lds + RING_OFF, g, S, E, tq_); }

            SEAM();
        }
        if (IN(P + 6)) { PHASE_IDS(); CAT(8);
            pg8::Gemm g{Hb, Wo_t + (size_t)L * D * D, D}; pg8::StaticOrder S; S.init(M, D, D, G, bx);
            pg8::EpiResB E{(L == 0) ? (const void*)x_in : (const void*)XB, XB, 1.f, L == 0};

 for (int rep_ = 0; rep_ < ((L == 0) ? REPG : 1); ++rep_) { int tq_ = tidp; asm volatile("" : "+v"(tq_));  pg8::gemm_phase<pg8::EpiResB, pg8::StaticOrder, true, true>(lds + RING_OFF, g, S, E, tq_); }

            SEAM();
        }
        if (L == 0) {
            if (IN(P + 7)) { PHASE_IDS(); CAT(9);
                f32x4 g[4];
#pragma unroll
                for (int j = 0; j < 4; ++j) g[j] = ((const GAS f32x4*)(norm_ffn + L * D) + lane)[64 * j];
#if DENSE_FP8
                for (int m = gw; m < M; m += NGW) { f32x4 v[4]; rms_row(XB + (size_t)m * D, g, v, lane); store_row_fp8(Hb8 + (size_t)m * D, v, lane); }
#else
                for (int m = gw; m < M; m += 2 * NGW) { f32x4 v[4], w[4]; rms_row2(XB + (size_t)m * D, XB + (size_t)(m + NGW) * D, g, v, w, lane); store_row_bf16(Hb + (size_t)m * D, v, lane); store_row_bf16(Hb + (size_t)(m + NGW) * D, w, lane); }
#endif
                SEAM();
            }
            if (IN(P + 8)) { PHASE_IDS(); CAT(10);
#if DENSE_FP8
                pg8::Gemm g{(const bf16*)Hb8, (const bf16*)Wgu8, D / 2}; pg8::StaticOrder S; S.init(M, 2 * DFF, D / 2, G, bx);
                pg8::EpiSwigluF8 E{ACT8, DFF};
                for (int rep_ = 0; rep_ < REPG; ++rep_) { int tq_ = tidp; asm volatile("" : "+v"(tq_)); pg8::gemm_phase<pg8::EpiSwigluF8, pg8::StaticOrder, true, true, true>(lds + RING_OFF, g, S, E, tq_); }
#else
                pg8::Gemm g{Hb, Wgu_t, D}; pg8::StaticOrder S; S.init(M, 2 * DFF, D, G, bx);
                pg8::EpiSwiglu E{ACT, DFF};
                for (int rep_ = 0; rep_ < REPG; ++rep_) { int tq_ = tidp; asm volatile("" : "+v"(tq_)); pg8::gemm_phase<pg8::EpiSwiglu, pg8::StaticOrder, true, true>(lds + RING_OFF, g, S, E, tq_); }
#endif

                SEAM();
            }
            if (IN(P + 9)) { PHASE_IDS(); CAT(11);
#if DENSE_FP8
                pg8::EpiResB E{XB, XB, pg8::F8_WINV, 0};
                pg8::Gemm g{(const bf16*)ACT8, (const bf16*)Wd8, DFF / 2}; pg8::StaticOrder S; S.init(M, D, DFF / 2, G, bx);
                pg8::gemm_phase<pg8::EpiResB, pg8::StaticOrder, true, true, true>(lds + RING_OFF, g, S, E, tidp);
#else
                pg8::EpiResB E{XB, XB, 1.f, 0};
                pg8::Gemm g{ACT, Wd_t, DFF}; pg8::StaticOrder S; S.init(M, D, DFF, G, bx);
                pg8::gemm_phase<pg8::EpiResB, pg8::StaticOrder, true, true>(lds + RING_OFF, g, S, E, tidp);
#endif

                SEAM();
            }
        } else {
            if (IN(P + 7)) { PHASE_IDS(); CAT(12);
                LAS float* wr = (LAS float*)(lds + RING_OFF);
                LAS int* cl = (LAS int*)(lds + RING_OFF + 32768);
                for (int u = tid; u < D * NEXP; u += NWAVES * 64) wr[(u & 7) * D + (u >> 3)] = w_router[u];
                if (tid < NEXP) cl[tid] = 0;
                __syncthreads();
                f32x4 g[4];
#pragma unroll
                for (int j = 0; j < 4; ++j) g[j] = ((const GAS f32x4*)(norm_ffn + L * D) + lane)[64 * j];
                for (int k = 0; k < 16; ++k) { const int m = bx * 128 + wave + 8 * k;
                    f32x4 v[4]; rms_row(XB + (size_t)m * D, g, v, lane);
#if FFN_FP8
                    store_row_fp8(Hb8 + (size_t)m * D, v, lane);
#else
                    store_row_bf16(Hb + (size_t)m * D, v, lane);
#endif
                    float lg[NEXP];
#pragma unroll
                    for (int e = 0; e < NEXP; ++e) lg[e] = 0.f;
#pragma unroll
                    for (int j = 0; j < 4; ++j)
#pragma unroll
                        for (int e = 0; e < NEXP; ++e) { const f32x4 w4 = *(const LAS f32x4*)(wr + e * D + 4 * lane + 256 * j); lg[e] += (v[j].x * w4.x + v[j].y * w4.y) + (v[j].z * w4.z + v[j].w * w4.w); }
#pragma unroll
                    for (int e = 0; e < NEXP; ++e) lg[e] = wave_sum(lg[e]);
                    int e1 = 0; float v1 = lg[0];
#pragma unroll
                    for (int e = 1; e < NEXP; ++e) if (lg[e] > v1) { v1 = lg[e]; e1 = e; }
                    int e2 = -1; float v2 = -INFINITY;
#pragma unroll
                    for (int e = 0; e < NEXP; ++e) if (e != e1 && lg[e] > v2) { v2 = lg[e]; e2 = e; }
                    const float w1 = 1.f / (1.f + expf(v2 - v1));
                    if (lane == 0) { TOKE[m] = e1 | (e2 << 8); TOKW[2 * m] = w1; TOKW[2 * m + 1] = 1.f - w1; __hip_atomic_fetch_add(cl + e1, 1, __ATOMIC_RELAXED, __HIP_MEMORY_SCOPE_WORKGROUP); __hip_atomic_fetch_add(cl + e2, 1, __ATOMIC_RELAXED, __HIP_MEMORY_SCOPE_WORKGROUP); }
                }
                __syncthreads();
                if (tid < NEXP) CNT[bx * NEXP + tid] = cl[tid];
                __syncthreads();
                for (int e = 0; e < NEXP; ++e) {
#if FFN_FP8
                    conv_matrix8(w_mg + (size_t)e * D * DFX, D, DFX, MWgu8 + (size_t)e * 2 * DFX * D, 1, scr, gw, NGW, lane);
                    conv_matrix8(w_mu + (size_t)e * D * DFX, D, DFX, MWgu8 + (size_t)e * 2 * DFX * D, 2, scr, gw, NGW, lane);
                    conv_matrix8(w_md + (size_t)e * DFX * D, DFX, D, MWd8 + (size_t)e * D * DFX, 0, scr, gw, NGW, lane);
#else
                    conv_matrix(w_mg + (size_t)e * D * DFX, D, DFX, MWgu + (size_t)e * 2 * DFX * D, 1, scr, gw, NGW, lane);
                    conv_matrix(w_mu + (size_t)e * D * DFX, D, DFX, MWgu + (size_t)e * 2 * DFX * D, 2, scr, gw, NGW, lane);
                    conv_matrix(w_md + (size_t)e * DFX * D, DFX, D, MWd + (size_t)e * D * DFX, 0, scr, gw, NGW, lane);
#endif
                }
                SEAM();
            }
            if (IN(P + 8)) { PHASE_IDS(); CAT(13);
                LAS int* C = (LAS int*)(lds + RING_OFF);
                LAS int* TB = (LAS int*)(lds + RING_OFF + 8192);
                LAS int* SL = (LAS int*)(lds + RING_OFF + 8192 + 256);
                for (int u = tid; u < 256 * NEXP; u += NWAVES * 64) C[u] = CNT[u];
                __syncthreads();
                { const int e = wave; int tot = 0, pre = 0;
#pragma unroll
                  for (int q = 0; q < 4; ++q) { const int i = 4 * lane + q; const int cv = C[i * NEXP + e]; tot += cv; pre += (i < bx) ? cv : 0; }
                  tot = wave_sum_i(tot); pre = wave_sum_i(pre);
                  if (lane == 0) { TB[e] = pre; TB[8 + e] = tot; } }
                __syncthreads();
                if (tid == 0) { int base = 0, cum = 0;
                    for (int e = 0; e < NEXP; ++e) { TB[16 + e] = base; const int nt = (TB[8 + e] + 255) >> 8; base += nt * 256; cum += nt; if (bx == 0) MHDR[1 + e] = cum; }
                    if (bx == 0) MHDR[0] = cum; }
                __syncthreads();
                if (wave == 0) {
                    const int t0 = bx * 128 + 2 * lane; const int ea = TOKE[t0], eb = TOKE[t0 + 1];
                    int pe[4] = {ea & 255, ea >> 8, eb & 255, eb >> 8}; int slot[4] = {0, 0, 0, 0};
#pragma unroll
                    for (int e = 0; e < NEXP; ++e) { int mine = 0;
#pragma unroll
                        for (int q = 0; q < 4; ++q) mine += (pe[q] == e) ? 1 : 0;
                        int inc = mine;
#pragma unroll
                        for (int o = 1; o < 64; o <<= 1) { const int t = __builtin_amdgcn_ds_bpermute(((lane - o) & 63) << 2, inc); if (lane >= o) inc += t; }
                        int run = TB[16 + e] + TB[e] + inc - mine;
#pragma unroll
                        for (int q = 0; q < 4; ++q) if (pe[q] == e) { slot[q] = run; ++run; } }
                    const f32x4 wv = *(const GAS f32x4*)(TOKW + 2 * t0);
                    SL[4 * lane + 0] = slot[0]; SL[4 * lane + 1] = slot[1]; SL[4 * lane + 2] = slot[2]; SL[4 * lane + 3] = slot[3];
                    { v4u sv; sv.x = (unsigned)slot[0]; sv.y = (unsigned)slot[1]; sv.z = (unsigned)slot[2]; sv.w = (unsigned)slot[3]; *(GAS v4u*)(SLOT + 2 * t0) = sv; }
                    SLW[slot[0]] = wv.x; SLW[slot[1]] = wv.y; SLW[slot[2]] = wv.z; SLW[slot[3]] = wv.w;
                }
                __syncthreads();
                for (int k = 0; k < 16; ++k) { const int tl = wave + 8 * k; const int m = bx * 128 + tl; const int s0 = SL[2 * tl], s1 = SL[2 * tl + 1];
#if FFN_FP8
                    const v4u a = ((const GAS v4u*)(Hb8 + (size_t)m * D))[lane];
                    ((GAS v4u*)(HS8 + (size_t)s0 * D))[lane] = a; ((GAS v4u*)(HS8 + (size_t)s1 * D))[lane] = a; }
#else
                    const GAS v4u* src = (const GAS v4u*)(Hb + (size_t)m * D) + lane; const v4u a = src[0], b = src[64];
                    GAS v4u* d0 = (GAS v4u*)(HS + (size_t)s0 * D) + lane; GAS v4u* d1 = (GAS v4u*)(HS + (size_t)s1 * D) + lane;
                    d0[0] = a; d0[64] = b; d1[0] = a; d1[64] = b; }
#endif
                SEAM();
            }
            {
                int nt_all = 0, c0 = 0, c1 = 0, c2 = 0, c3 = 0, c4 = 0, c5 = 0, c6 = 0;
                if (hi > P + 9 && lo < P + 19) { const int* hd = MHDR;
                    nt_all = __builtin_amdgcn_readfirstlane(hd[0]); c0 = __builtin_amdgcn_readfirstlane(hd[1]); c1 = __builtin_amdgcn_readfirstlane(hd[2]); c2 = __builtin_amdgcn_readfirstlane(hd[3]);
                    c3 = __builtin_amdgcn_readfirstlane(hd[4]); c4 = __builtin_amdgcn_readfirstlane(hd[5]); c5 = __builtin_amdgcn_readfirstlane(hd[6]); c6 = __builtin_amdgcn_readfirstlane(hd[7]); }
                if (nt_all > MOE_MAX_TILES) nt_all = MOE_MAX_TILES;
                for (int ch = 0; ch < MOE_MAX_CH; ++ch) {
                    const int t0 = ch * MOE_CH_TILES; int nt = nt_all - t0; if (nt > MOE_CH_TILES) nt = MOE_CH_TILES;
                    if (nt <= 0) break;
                    if (IN(P + 9 + 2 * ch)) { PHASE_IDS(); CAT(14);
#if FFN_FP8
                        pg8::Gemm g{(const bf16*)HS8, (const bf16*)MWgu8, D / 2}; pg8::MoeOrder S{t0, nt, 2 * DFX / 256, nt * (2 * DFX / 256), G, bx, (long)256 * D, (long)256 * D, (long)2 * DFX * D, c0, c1, c2, c3, c4, c5, c6, false, true};
                        pg8::EpiSwigluF8 E{MACT8, DFX};
                        pg8::gemm_phase<pg8::EpiSwigluF8, pg8::MoeOrder, true, true, true>(lds + RING_OFF, g, S, E, tidp);
#else
                        pg8::Gemm g{HS, MWgu, D}; pg8::MoeOrder S{t0, nt, 2 * DFX / 256, nt * (2 * DFX / 256), G, bx, (long)256 * D * 2, (long)256 * D * 2, (long)2 * DFX * D * 2, c0, c1, c2, c3, c4, c5, c6, false, true};
                        pg8::EpiSwiglu E{MACT, DFX};
                        pg8::gemm_phase<pg8::EpiSwiglu, pg8::MoeOrder, true, true>(lds + RING_OFF, g, S, E, tidp);
#endif

                        SEAM();
                    }
                    if (IN(P + 10 + 2 * ch)) { PHASE_IDS(); CAT(15);
#if FFN_FP8
                        pg8::Gemm g{(const bf16*)MACT8, (const bf16*)MWd8, DFX / 2}; pg8::MoeOrder S{t0, nt, D / 256, nt * (D / 256), G, bx, (long)256 * DFX, (long)256 * DFX, (long)D * DFX, c0, c1, c2, c3, c4, c5, c6, true, false};
                        pg8::EpiMoeDown E{YS8, SLW, pg8::F8_WINV};
                        pg8::gemm_phase<pg8::EpiMoeDown, pg8::MoeOrder, true, true, true>(lds + RING_OFF, g, S, E, tidp);
#else
                        pg8::Gemm g{MACT, MWd, DFX}; pg8::MoeOrder S{t0, nt, D / 256, nt * (D / 256), G, bx, (long)256 * DFX * 2, (long)256 * DFX * 2, (long)D * DFX * 2, c0, c1, c2, c3, c4, c5, c6, true, false};
                        pg8::EpiMoeDown E{HS, SLW, 1.f};
                        pg8::gemm_phase<pg8::EpiMoeDown, pg8::MoeOrder, true, true>(lds + RING_OFF, g, S, E, tidp);
#endif

                        SEAM();
                    }
                }
            }
            if (IN(P + 19)) { PHASE_IDS();
                f32x4 g[4];
#pragma unroll
                for (int j = 0; j < 4; ++j) g[j] = ((const GAS f32x4*)norm_final + lane)[64 * j];
                unsigned bad = 0u;
#if MK_N_LAUNCHES == 1
                bad = __hip_atomic_load(ctl + CW_BAR + XB_TMO, RLX_AGENT);
#endif
#ifdef PROBE_CAT
                CAT(16);
#endif
#if FFN_FP8
                const bf16* const ysb = YS8;
#else
                const bf16* const ysb = HS;
#endif
                for (int m = gw; m < M; m += 2 * NGW) {
                    const int ma = m, mb = m + NGW;
                    const v4u sl = (v4u){(unsigned)SLOT[2 * ma], (unsigned)SLOT[2 * ma + 1], (unsigned)SLOT[2 * mb], (unsigned)SLOT[2 * mb + 1]};
                    const GAS v2u* xa = (const GAS v2u*)(XB + (size_t)ma * D) + lane; const GAS v2u* xb = (const GAS v2u*)(XB + (size_t)mb * D) + lane;
                    const GAS v2u* a0 = (const GAS v2u*)(ysb + (size_t)sl.x * D) + lane; const GAS v2u* a1 = (const GAS v2u*)(ysb + (size_t)sl.y * D) + lane;
                    const GAS v2u* b0 = (const GAS v2u*)(ysb + (size_t)sl.z * D) + lane; const GAS v2u* b1 = (const GAS v2u*)(ysb + (size_t)sl.w * D) + lane;
                    f32x4 va[4], vb[4]; v2u xa4[4], xb4[4], pa0[4], pa1[4], pb0[4], pb1[4];
#pragma unroll
                    for (int j = 0; j < 4; ++j) { xa4[j] = xa[64 * j]; xb4[j] = xb[64 * j]; pa0[j] = a0[64 * j]; pa1[j] = a1[64 * j]; pb0[j] = b0[64 * j]; pb1[j] = b1[64 * j]; }
                    float sa = 0.f, sb = 0.f;
#pragma unroll
                    for (int j = 0; j < 4; ++j) { va[j] = bf4(xa4[j]); vb[j] = bf4(xb4[j]);
                        va[j].x += bfl(pa0[j].x) + bfl(pa1[j].x); va[j].y += bfh(pa0[j].x) + bfh(pa1[j].x); va[j].z += bfl(pa0[j].y) + bfl(pa1[j].y); va[j].w += bfh(pa0[j].y) + bfh(pa1[j].y);
                        vb[j].x += bfl(pb0[j].x) + bfl(pb1[j].x); vb[j].y += bfh(pb0[j].x) + bfh(pb1[j].x); vb[j].z += bfl(pb0[j].y) + bfl(pb1[j].y); vb[j].w += bfh(pb0[j].y) + bfh(pb1[j].y);
                        sa += (va[j].x * va[j].x + va[j].y * va[j].y) + (va[j].z * va[j].z + va[j].w * va[j].w); sb += (vb[j].x * vb[j].x + vb[j].y * vb[j].y) + (vb[j].z * vb[j].z + vb[j].w * vb[j].w); }
                    const float ra = 1.f / sqrtf(wave_sum(sa) * (1.f / D) + EPS), rb = 1.f / sqrtf(wave_sum(sb) * (1.f / D) + EPS);
                    GAS f32x4* oa = (GAS f32x4*)(xout + (size_t)ma * D) + lane; GAS f32x4* ob = (GAS f32x4*)(xout + (size_t)mb * D) + lane;
                    const float q = __builtin_nanf("");
#pragma unroll
                    for (int j = 0; j < 4; ++j) { f32x4 o = va[j] * ra * g[j], p = vb[j] * rb * g[j]; if (bad) { o = (f32x4){q, q, q, q}; p = o; } oa[64 * j] = o; ob[64 * j] = p; }
                }
#ifdef PROBE_CAT
                if (bx == 0 && tid == 0) { { const unsigned long long tn_ = __builtin_amdgcn_s_memrealtime(); volatile LAS unsigned* pa_ = (volatile LAS unsigned*)(lds + LDSCTL_OFF + 640); if (cat_ == PROBE_CAT) pa_[0] += (unsigned)(tn_ - *(volatile LAS unsigned long long*)(lds + LDSCTL_OFF + 704)); } const unsigned ticks = *(volatile LAS unsigned*)(lds + LDSCTL_OFF + 640); const unsigned long long te_ = __builtin_amdgcn_s_memrealtime(); const unsigned long long tw_ = (unsigned long long)ticks * PROBE_AMP; while (__builtin_amdgcn_s_memrealtime() - te_ < (tw_ < 5000000ull ? tw_ : 5000000ull)) __builtin_amdgcn_s_sleep(8); }
#endif
            }
        }
    }
#undef IN
#undef SEAM
}

extern "C" void kernel_launch(void* const* d_in, const int* in_sizes, int n_in, void* d_out, int out_size, void* d_ws, size_t ws_size, hipStream_t stream) {
    static int grid = 0;
    if (grid == 0) {
        if (n_in != 18 || in_sizes[0] != M * D || out_size != M * D || ws_size < WS_END) { fprintf(stderr, "kernel_launch: unexpected shapes (n_in %d, in0 %d, out %d, ws %zu < %zu); nothing launched\n", n_in, n_in > 0 ? in_sizes[0] : -1, out_size, ws_size, (size_t)WS_END); grid = -1; return; }
        int dev = 0, cus = 0, per_cu = 0;
        if (hipGetDevice(&dev) != hipSuccess || hipDeviceGetAttribute(&cus, hipDeviceAttributeMultiprocessorCount, dev) != hipSuccess) { grid = -1; return; }
        if (hipFuncSetAttribute((const void*)mega_fwd, hipFuncAttributeMaxDynamicSharedMemorySize, LDS_BYTES) != hipSuccess) { fprintf(stderr, "kernel_launch: hipFuncSetAttribute failed\n"); grid = -1; return; }
        if (hipOccupancyMaxActiveBlocksPerMultiprocessor(&per_cu, (const void*)mega_fwd, NWAVES * 64, LDS_BYTES) != hipSuccess || per_cu < 1) fprintf(stderr, "kernel_launch: occupancy query reports %d workgroups per CU\n", per_cu);
        (void)hipGetLastError();
        grid = cus;
        if (grid != 256) { fprintf(stderr, "kernel_launch: built for 256 CUs, device has %d; nothing launched\n", cus); grid = -1; return; }
    }
    if (grid < 0) return;
    if (hipMemsetAsync((char*)d_ws + WS_CTL, 0, CTL_ZERO_BYTES, stream) != hipSuccess) return;
    Args a{};
    for (int i = 0; i < 18; ++i) a.in[i] = (const float*)d_in[i];
    a.out = (float*)d_out; a.ws = (unsigned char*)d_ws;
#if MK_N_LAUNCHES == 1
    a.ph_lo = 0; a.ph_hi = NPHASE;
    hipLaunchKernelGGL(mega_fwd, dim3(grid), dim3(NWAVES * 64), LDS_BYTES, stream, a);
#else
    for (int p = 0; p < NPHASE; ++p) {
        const int r = (p - 1) % PH_L, L = (p - 1) / PH_L;
        if (p > 0 && L == 0 && r >= 10) continue;
        a.ph_lo = p; a.ph_hi = p + 1;
        hipLaunchKernelGGL(mega_fwd, dim3(grid), dim3(NWAVES * 64), LDS_BYTES, stream, a);
    }
#endif
}
```

```cpp
#include <hip/hip_runtime.h>
#include <cstdio>
#include <cstdint>

#ifndef MK_N_LAUNCHES
#define MK_N_LAUNCHES 1
#endif

namespace pg8 {
#define PG8_LAS __attribute__((address_space(3)))
typedef unsigned short bf16_t;
typedef short bf16x8 __attribute__((ext_vector_type(8)));
typedef float f32x4 __attribute__((ext_vector_type(4)));
typedef float f32x2 __attribute__((ext_vector_type(2)));
typedef unsigned u32x4 __attribute__((ext_vector_type(4)));
typedef int v8i32 __attribute__((ext_vector_type(8)));
typedef unsigned u32x2 __attribute__((ext_vector_type(2)));
constexpr int F8_WSHIFT = 6;
constexpr float F8_WINV = 1.f / (float)(1 << F8_WSHIFT);
constexpr int BM = 256, BK = 64, HALF = 128, HTB = HALF * BK * 2  , STAGE_BYTES = 8 * HTB, NXCD = 8, WGM = 8;

__host__ __device__ __forceinline__ int lds_byte(int r, int c) { const int st = (r >> 4) * 2 + (c >> 5), rr = r & 15, cc = c & 31, ob = rr * 64 + cc * 2; return st * 1024 + (ob ^ (((ob >> 9) & 1) << 5)); }
__host__ __device__ __forceinline__ void stage_rc(int b, int& R, int& C) { const int st = b / 1024, sb = b % 1024, swz = sb ^ (((sb >> 9) & 1) << 5); R = (st >> 1) * 16 + swz / 64; C = (st & 1) * 32 + (swz % 64) / 2; }
__host__ __device__ __forceinline__ int perm32(int rho) { const int n = rho >> 4, i = rho & 15; return 8 * (i >> 2) + 4 * n + (i & 3); }

struct Unit { int pm, pn, om, tag; long ao, bo; };
struct Gemm { const bf16_t* A; const bf16_t* Bt; int K; };

__device__ __forceinline__ void tile_of(int wgid, int nwg, int nM, int nN, int& pm, int& pn) {
    { const int q = nwg / NXCD, r = nwg % NXCD, xcd = wgid % NXCD, off = wgid / NXCD; wgid = (xcd < r ? xcd * (q + 1) : r * (q + 1) + (xcd - r) * q) + off; }
    const int nig = WGM * nN, gid = wgid / nig, fm = gid * WGM, gsz = (nM - fm) < WGM ? (nM - fm) : WGM;
    pm = fm + ((wgid % nig) % gsz); pn = (wgid % nig) / gsz;
}
struct StaticOrder {
    int nM, nN, nwg, G, c; long tst;
    __device__ void init(int M, int N, int K, int G_, int c_) { nM = M / BM; nN = N / BM; nwg = nM * nN; G = G_; c = c_; tst = (long)BM * K * 2; }
    __device__ __forceinline__ bool next(int i, Unit& u) const {
        const long L = (long)i * G + c; if (L >= nwg) return false;
        tile_of((int)L, nwg, nM, nN, u.pm, u.pn); u.om = u.pm; u.tag = 0; u.ao = (long)u.pm * tst; u.bo = (long)u.pn * tst; return true;
    }
    __device__ __forceinline__ void a_ready(const Unit&) const {}
    __device__ __forceinline__ void done(const Unit&) const {}
};
struct MergeOrder {
    StaticOrder b; long as, bs;
    __device__ __forceinline__ bool next(int i, Unit& u) const {
        const int ti = i / 3, tg = i - 3 * ti; if (!b.next(ti, u)) return false;
        u.tag = tg; u.ao += (long)tg * as; u.bo += (long)tg * bs; return true;
    }
    __device__ __forceinline__ void a_ready(const Unit&) const {}
    __device__ __forceinline__ void done(const Unit&) const {}
};
struct MoeOrder {
    int t0, nt, nN, nwg, G, c; long tA, tB, eB; int c0, c1, c2, c3, c4, c5, c6; bool a_local, o_local;
    __device__ __forceinline__ bool next(int i, Unit& u) const {
        const long L = (long)i * G + c; if (L >= nwg) return false;
        int pl, pn; tile_of((int)L, nwg, nt, nN, pl, pn);
        const int gt = t0 + pl; const int e = (gt >= c0) + (gt >= c1) + (gt >= c2) + (gt >= c3) + (gt >= c4) + (gt >= c5) + (gt >= c6);
        u.pm = gt; u.pn = pn; u.tag = e; u.om = o_local ? pl : gt; u.ao = (long)(a_local ? pl : gt) * tA; u.bo = (long)e * eB + (long)pn * tB; return true;
    }
    __device__ __forceinline__ void a_ready(const Unit&) const {}
    __device__ __forceinline__ void done(const Unit&) const {}
};

typedef __bf16 bf16x2_t __attribute__((ext_vector_type(2)));
__device__ __forceinline__ unsigned cvt_pk_bf16(float lo, float hi) { f32x2 v = {lo, hi}; bf16x2_t b = __builtin_convertvector(v, bf16x2_t); return __builtin_bit_cast(unsigned, b); }
__device__ __forceinline__ float bf_lo(unsigned w) { return __uint_as_float(w << 16); }
__device__ __forceinline__ float bf_hi(unsigned w) { return __uint_as_float(w & 0xffff0000u); }
__device__ __forceinline__ float sigm(float x) { return __builtin_amdgcn_rcpf(1.0f + __builtin_amdgcn_exp2f(-1.4426950408889634f * x)); }
__device__ __forceinline__ u32x4 pack8(f32x4 v0, f32x4 v1) { u32x4 w; w.x = cvt_pk_bf16(v0[0], v0[1]); w.y = cvt_pk_bf16(v0[2], v0[3]); w.z = cvt_pk_bf16(v1[0], v1[1]); w.w = cvt_pk_bf16(v1[2], v1[3]); return w; }

struct EpiProj {
    static constexpr bool PERM = true, AFTER_DRAIN = false;
    bf16_t* O; size_t split_stride; float qscale, wscale;
    __device__ __forceinline__ void operator()(const f32x4 (&acc)[2][2][4][2], const Unit& u, int wr, int wc, int fr, int fq) const {
        const int t = u.pn / 6, lt = u.pn - 6 * t; bf16_t* base = O + (size_t)t * split_stride; const float sc = (lt < 2 ? qscale : 1.f) * wscale;
        const int row0 = u.om * BM + wr * 64 + fr, col0 = lt * BM + wc * 32 + 8 * fq;
        if (t == 1) {
#pragma unroll
            for (int ai = 0; ai < 2; ++ai)
#pragma unroll
                for (int m = 0; m < 4; ++m) { const int row = row0 + ai * HALF + m * 16;
#pragma unroll
                    for (int bj = 0; bj < 2; ++bj) { const int lc = col0 + bj * HALF; bf16_t* p;
                        if (lt < 2) p = base + (size_t)row * 512 + lc;
                        else { const int l2 = lc & 511, hd = l2 >> 6, d = l2 & 63; p = base + (size_t)(lt < 4 ? 1 : 2) * ((size_t)32768 * 512) + ((size_t)((row >> 12) * 8 + hd) * 4096 + (row & 4095)) * 64 + d; }
                        *(u32x4*)p = pack8(acc[ai][bj][m][0] * sc, acc[ai][bj][m][1] * sc); } }
            return; }
#pragma unroll
        for (int ai = 0; ai < 2; ++ai)
#pragma unroll
            for (int m = 0; m < 4; ++m) { bf16_t* rowp = base + (size_t)(row0 + ai * HALF + m * 16) * 1536 + col0;
#pragma unroll
                for (int bj = 0; bj < 2; ++bj) *(u32x4*)(rowp + bj * HALF) = pack8(acc[ai][bj][m][0] * sc, acc[ai][bj][m][1] * sc); }
    }
};
struct EpiGate {
    static constexpr bool PERM = true, AFTER_DRAIN = false;
    bf16_t* O; int ldc; const float* bias; float wscale;
    __device__ __forceinline__ void operator()(const f32x4 (&acc)[2][2][4][2], const Unit& u, int wr, int wc, int fr, int fq) const {
        const int row0 = u.om * BM + wr * 64 + fr, col0 = u.pn * BM + wc * 32 + 8 * fq;
        f32x4 bv[2][2];
#pragma unroll
        for (int bj = 0; bj < 2; ++bj)
#pragma unroll
            for (int n = 0; n < 2; ++n) bv[bj][n] = *(const f32x4*)(bias + col0 + bj * HALF + 4 * n);
#pragma unroll
        for (int ai = 0; ai < 2; ++ai)
#pragma unroll
            for (int m = 0; m < 4; ++m) { bf16_t* rowp = O + (size_t)(row0 + ai * HALF + m * 16) * ldc + col0;
#pragma unroll
                for (int bj = 0; bj < 2; ++bj) { f32x4 v0 = acc[ai][bj][m][0] * wscale + bv[bj][0], v1 = acc[ai][bj][m][1] * wscale + bv[bj][1];
#pragma unroll
                    for (int i = 0; i < 4; ++i) { v0[i] = sigm(v0[i]); v1[i] = sigm(v1[i]); }
                    *(u32x4*)(rowp + bj * HALF) = pack8(v0, v1); } }
    }
};
struct EpiMerge {
    static constexpr bool PERM = true, AFTER_DRAIN = false;
    const bf16_t* gates; bf16_t* O;
    __device__ __forceinline__ void operator()(const f32x4 (&acc)[2][2][4][2], const Unit& u, int wr, int wc, int fr, int fq) const {
        const int row0 = u.om * BM + wr * 64 + fr, col0 = u.pn * BM + wc * 32 + 8 * fq; const int tg = u.tag;
        const bf16_t* const gp = gates + (size_t)tg * 1024 + col0; bf16_t* const op0 = O + col0;
#pragma unroll
        for (int ai = 0; ai < 2; ++ai) {
            u32x4 gw[4][2], ow[4][2];
#pragma unroll
            for (int m = 0; m < 4; ++m)
#pragma unroll
                for (int bj = 0; bj < 2; ++bj) { const size_t row = (size_t)(row0 + ai * HALF + m * 16);
                    gw[m][bj] = *(const u32x4*)(gp + row * 3072 + bj * HALF);
                    ow[m][bj] = (tg != 0) ? *(const u32x4*)(op0 + row * 1024 + bj * HALF) : (u32x4){0u, 0u, 0u, 0u}; }
#pragma unroll
            for (int m = 0; m < 4; ++m)
#pragma unroll
                for (int bj = 0; bj < 2; ++bj) { const size_t row = (size_t)(row0 + ai * HALF + m * 16); const u32x4 g = gw[m][bj], w = ow[m][bj];
                    f32x4 v0 = acc[ai][bj][m][0], v1 = acc[ai][bj][m][1];
                    v0[0] = v0[0] * bf_lo(g.x) + bf_lo(w.x); v0[1] = v0[1] * bf_hi(g.x) + bf_hi(w.x); v0[2] = v0[2] * bf_lo(g.y) + bf_lo(w.y); v0[3] = v0[3] * bf_hi(g.y) + bf_hi(w.y);
                    v1[0] = v1[0] * bf_lo(g.z) + bf_lo(w.z); v1[1] = v1[1] * bf_hi(g.z) + bf_hi(w.z); v1[2] = v1[2] * bf_lo(g.w) + bf_lo(w.w); v1[3] = v1[3] * bf_hi(g.w) + bf_hi(w.w);
                    *(u32x4*)(op0 + row * 1024 + bj * HALF) = pack8(v0, v1); }
            asm volatile("" ::: "memory"); }
    }
};
struct EpiRes {
    static constexpr bool PERM = false, AFTER_DRAIN = false;
    const float* base; float* out; float sc;
    __device__ __forceinline__ void operator()(const f32x4 (&acc)[2][2][4][2], const Unit& u, int wr, int wc, int fr, int fq) const {
        const int row0 = u.om * BM + wr * 64 + fr, col0 = u.pn * BM + wc * 32 + 4 * fq;
#pragma unroll
        for (int ai = 0; ai < 2; ++ai)
#pragma unroll
            for (int m = 0; m < 4; ++m) { const size_t off = (size_t)(row0 + ai * HALF + m * 16) * 1024 + col0;
#pragma unroll
                for (int bj = 0; bj < 2; ++bj)
#pragma unroll
                    for (int n = 0; n < 2; ++n) { const f32x4 bs = *(const f32x4*)(base + off + bj * HALF + n * 16); *(f32x4*)(out + off + bj * HALF + n * 16) = bs + acc[ai][bj][m][n] * sc; } }
    }
};
struct EpiResB {
    static constexpr bool PERM = true, AFTER_DRAIN = false;
    const void* base; bf16_t* out; float sc; int base_f32;
    __device__ __forceinline__ void operator()(const f32x4 (&acc)[2][2][4][2], const Unit& u, int wr, int wc, int fr, int fq) const {
        const int row0 = u.om * BM + wr * 64 + fr, col0 = u.pn * BM + wc * 32 + 8 * fq;
        if (base_f32) { const float* bp = (const float*)base;
#pragma unroll
            for (int ai = 0; ai < 2; ++ai)
#pragma unroll
                for (int m = 0; m < 4; ++m) { const size_t off = (size_t)(row0 + ai * HALF + m * 16) * 1024 + col0;
#pragma unroll
                    for (int bj = 0; bj < 2; ++bj) { const f32x4 b0 = *(const f32x4*)(bp + off + bj * HALF), b1 = *(const f32x4*)(bp + off + bj * HALF + 4);
                        *(u32x4*)(out + off + bj * HALF) = pack8(b0 + acc[ai][bj][m][0] * sc, b1 + acc[ai][bj][m][1] * sc); } }
        } else { const bf16_t* bp = (const bf16_t*)base;
#pragma unroll
            for (int ai = 0; ai < 2; ++ai)
#pragma unroll
                for (int m = 0; m < 4; ++m) { const size_t off = (size_t)(row0 + ai * HALF + m * 16) * 1024 + col0;
#pragma unroll
                    for (int bj = 0; bj < 2; ++bj) { const u32x4 w = *(const u32x4*)(bp + off + bj * HALF);
                        const f32x4 b0 = {__uint_as_float(w.x << 16), __uint_as_float(w.x & 0xffff0000u), __uint_as_float(w.y << 16), __uint_as_float(w.y & 0xffff0000u)};
                        const f32x4 b1 = {__uint_as_float(w.z << 16), __uint_as_float(w.z & 0xffff0000u), __uint_as_float(w.w << 16), __uint_as_float(w.w & 0xffff0000u)};
                        *(u32x4*)(out + off + bj * HALF) = pack8(b0 + acc[ai][bj][m][0] * sc, b1 + acc[ai][bj][m][1] * sc); } }
        }
    }
};
struct EpiSwiglu {
    static constexpr bool PERM = true, AFTER_DRAIN = false;
    bf16_t* O; int ldc;
    __device__ __forceinline__ void operator()(const f32x4 (&acc)[2][2][4][2], const Unit& u, int wr, int wc, int fr, int fq) const {
        const int row0 = u.om * BM + wr * 64 + fr, col0 = u.pn * HALF + wc * 32 + 8 * fq;
#pragma unroll
        for (int ai = 0; ai < 2; ++ai)
#pragma unroll
            for (int m = 0; m < 4; ++m) { f32x4 v0, v1;
#pragma unroll
                for (int i = 0; i < 4; ++i) { const float g0 = acc[ai][0][m][0][i], g1 = acc[ai][0][m][1][i]; v0[i] = g0 * sigm(g0) * acc[ai][1][m][0][i]; v1[i] = g1 * sigm(g1) * acc[ai][1][m][1][i]; }
                *(u32x4*)(O + (size_t)(row0 + ai * HALF + m * 16) * ldc + col0) = pack8(v0, v1); }
    }
};
__device__ __forceinline__ unsigned pk4_fp8(float a, float b, float c, float d) {
    a = __builtin_fminf(__builtin_fmaxf(a, -448.f), 448.f); b = __builtin_fminf(__builtin_fmaxf(b, -448.f), 448.f); c = __builtin_fminf(__builtin_fmaxf(c, -448.f), 448.f); d = __builtin_fminf(__builtin_fmaxf(d, -448.f), 448.f);
    int w = __builtin_amdgcn_cvt_pk_fp8_f32(a, b, 0, false); w = __builtin_amdgcn_cvt_pk_fp8_f32(c, d, w, true); return (unsigned)w; }
struct EpiSwigluF8 {
    static constexpr bool PERM = true, AFTER_DRAIN = false;
    unsigned char* O; int ldc;
    __device__ __forceinline__ void operator()(const f32x4 (&acc)[2][2][4][2], const Unit& u, int wr, int wc, int fr, int fq) const {
        const int row0 = u.om * BM + wr * 64 + fr, col0 = u.pn * HALF + wc * 32 + 8 * fq;
#pragma unroll
        for (int ai = 0; ai < 2; ++ai)
#pragma unroll
            for (int m = 0; m < 4; ++m) { f32x4 v0, v1;
#pragma unroll
                for (int i = 0; i < 4; ++i) { const float g0 = acc[ai][0][m][0][i] * F8_WINV, g1 = acc[ai][0][m][1][i] * F8_WINV; v0[i] = g0 * sigm(g0) * (acc[ai][1][m][0][i] * F8_WINV); v1[i] = g1 * sigm(g1) * (acc[ai][1][m][1][i] * F8_WINV); }
                u32x2 w; w.x = pk4_fp8(v0[0], v0[1], v0[2], v0[3]); w.y = pk4_fp8(v1[0], v1[1], v1[2], v1[3]);
                *(u32x2*)(O + (size_t)(row0 + ai * HALF + m * 16) * ldc + col0) = w; }
    }
};
struct EpiMoeDown {
    static constexpr bool PERM = true, AFTER_DRAIN = false;
    bf16_t* O; const float* w; float scale;
    __device__ __forceinline__ void operator()(const f32x4 (&acc)[2][2][4][2], const Unit& u, int wr, int wc, int fr, int fq) const {
        const int row0 = u.om * BM + wr * 64 + fr, col0 = u.pn * BM + wc * 32 + 8 * fq;
#pragma unroll
        for (int ai = 0; ai < 2; ++ai)
#pragma unroll
            for (int m = 0; m < 4; ++m) { const size_t row = (size_t)(row0 + ai * HALF + m * 16); const float sc = w[row] * scale;
#pragma unroll
                for (int bj = 0; bj < 2; ++bj) *(u32x4*)(O + row * 1024 + col0 + bj * HALF) = pack8(acc[ai][bj][m][0] * sc, acc[ai][bj][m][1] * sc); }
    }
};
template <class Epi, class Sched, bool ALIGN_EPI = false, bool SP2 = false, bool F8 = false>
__device__ __forceinline__ void gemm_phase(PG8_LAS unsigned char* lds, const Gemm g, const Sched& S, const Epi& E, const int tid_in) {
    const int tid = tid_in, wid = __builtin_amdgcn_readfirstlane(tid >> 6), lane = tid & 63, wr = wid >> 2, wc = wid & 3, fr = lane & 15, fq = lane >> 4;
    const int K = g.K, nt = K / BK;
    unsigned voffA[2], voffB[2];
#pragma unroll
    for (int i = 0; i < 2; ++i) { int R, C; stage_rc(tid * 16 + i * 8192, R, C); const int Rb = Epi::PERM ? ((R & ~31) + perm32(R & 31)) : R;
        voffA[i] = (unsigned)(R * K + C) * 2u; voffB[i] = (unsigned)(Rb * K + C) * 2u; }
    const size_t kstep = (size_t)(BK * 2);
    const size_t hstep = (size_t)HALF * K * 2;
    const unsigned ldsw = (unsigned)wid * 1024u;
    const int aoff = lds_byte(wr * 64 + fr, fq * 8), boff = lds_byte(wc * 32 + fr, fq * 8);
#define PG8_SA(b, h) (((b) * 2 + (h)) * HTB)
#define PG8_SB(b, h) ((4 + (b) * 2 + (h)) * HTB)
#define PG8_STAGE(bufoff, gbase, voff) do { _Pragma("unroll") for (int _i = 0; _i < 2; ++_i) \
        __builtin_amdgcn_global_load_lds((const unsigned*)((const char*)(gbase) + (voff)[_i]), (PG8_LAS unsigned*)(lds + (bufoff) + ldsw + _i * 8192), 16, 0, 0); } while (0)
#define PG8_LDA(dst, b, h) do { _Pragma("unroll") for (int m = 0; m < 4; ++m) _Pragma("unroll") for (int k = 0; k < 2; ++k) dst[m][k] = *(const PG8_LAS bf16x8*)(lds + PG8_SA(b, h) + aoff + m * 2048 + k * 1024); } while (0)
#define PG8_LDB(dst, b, h) do { _Pragma("unroll") for (int n = 0; n < 2; ++n) _Pragma("unroll") for (int k = 0; k < 2; ++k) dst[n][k] = *(const PG8_LAS bf16x8*)(lds + PG8_SB(b, h) + boff + n * 2048 + k * 1024); } while (0)
#define PG8_CAT8(x) __builtin_bit_cast(v8i32, __builtin_shufflevector((x)[0], (x)[1], 0, 1, 2, 3, 4, 5, 6, 7, 8, 9, 10, 11, 12, 13, 14, 15))
#define PG8_MMA(ai, bj, At, Bt) do { __builtin_amdgcn_s_setprio(1); if constexpr (F8) { _Pragma("unroll") for (int m = 0; m < 4; ++m) _Pragma("unroll") for (int n = 0; n < 2; ++n) \
        asm volatile("v_mfma_f32_16x16x128_f8f6f4 %0, %1, %2, %0" : "+v"(acc[ai][bj][m][n]) : "v"(PG8_CAT8(Bt[n])), "v"(PG8_CAT8(At[m]))); } else { \
        _Pragma("unroll") for (int m = 0; m < 4; ++m) _Pragma("unroll") for (int n = 0; n < 2; ++n) _Pragma("unroll") for (int k = 0; k < 2; ++k) \
        acc[ai][bj][m][n] = __builtin_amdgcn_mfma_f32_16x16x32_bf16(Bt[n][k], At[m][k], acc[ai][bj][m][n], 0, 0, 0); } __builtin_amdgcn_s_setprio(0); } while (0)
#define PG8_WAIT_V(n) asm volatile("s_waitcnt vmcnt(" #n ")" ::: "memory")
#define PG8_WAIT_L(n) asm volatile("s_waitcnt lgkmcnt(" #n ")" ::: "memory")
#define PG8_BAR __builtin_amdgcn_s_barrier()
#define PG8_SCHED __builtin_amdgcn_sched_barrier(0)
    Unit cur, nxt; int ui = 0;
    if (!S.next(0, cur)) return;
    f32x4 acc[2][2][4][2];
#pragma unroll
    for (int a = 0; a < 2; ++a)
#pragma unroll
        for (int b = 0; b < 2; ++b)
#pragma unroll
            for (int m = 0; m < 4; ++m)
#pragma unroll
                for (int n = 0; n < 2; ++n) { acc[a][b][m][n] = (f32x4){0.f, 0.f, 0.f, 0.f}; if constexpr (F8) asm volatile("" : "+v"(acc[a][b][m][n])); }
    bf16x8 At[4][2], B0[2][2], B1[2][2];
    const char* cA = (const char*)g.A + cur.ao; const char* cB = (const char*)g.Bt + cur.bo;
    S.a_ready(cur);
    if constexpr (SP2) {
        PG8_STAGE(PG8_SB(0, 0), cB, voffB); PG8_STAGE(PG8_SB(0, 1), cB + hstep, voffB); PG8_STAGE(PG8_SA(0, 0), cA, voffA); PG8_STAGE(PG8_SA(0, 1), cA + hstep, voffA);
        if (wr == 1) PG8_BAR;
        PG8_WAIT_V(2); PG8_BAR;
        PG8_STAGE(PG8_SB(1, 0), cB + kstep, voffB); PG8_STAGE(PG8_SA(1, 0), cA + kstep, voffA); PG8_STAGE(PG8_SB(1, 1), cB + hstep + kstep, voffB);
        PG8_WAIT_V(6); PG8_BAR;
    } else {
        PG8_STAGE(PG8_SB(0, 0), cB, voffB); PG8_STAGE(PG8_SA(0, 0), cA, voffA); PG8_STAGE(PG8_SB(0, 1), cB + hstep, voffB); PG8_STAGE(PG8_SA(0, 1), cA + hstep, voffA);
        if (wr == 1) PG8_BAR;
        PG8_WAIT_V(4); PG8_BAR;
        PG8_STAGE(PG8_SB(1, 0), cB + kstep, voffB); PG8_STAGE(PG8_SA(1, 0), cA + kstep, voffA); PG8_STAGE(PG8_SB(1, 1), cB + hstep + kstep, voffB);
        PG8_WAIT_V(6); PG8_BAR;
    }
    for (;;) {
        const bool has_next = S.next(ui + 1, nxt);
        const char* nA = has_next ? (const char*)g.A + nxt.ao : cA; const char* nB = has_next ? (const char*)g.Bt + nxt.bo : cB;
#pragma nounroll
        for (int t = 0; t < nt; t += 2) {
            const bool last = (t == nt - 2);
            const char* a1 = cA + (size_t)(t + 1) * kstep;
            const char* a2 = last ? nA : cA + (size_t)(t + 2) * kstep; const char* b2 = last ? nB : cB + (size_t)(t + 2) * kstep;
            const char* a3 = a2 + kstep; const char* b3 = b2 + kstep;
            if (last && has_next) S.a_ready(nxt);
            if constexpr (SP2) {
            PG8_LDB(B0, 0, 0); PG8_LDB(B1, 0, 1); PG8_SCHED; PG8_LDA(At, 0, 0); PG8_STAGE(PG8_SA(1, 1), a1 + hstep, voffA);
            PG8_WAIT_V(8); PG8_WAIT_L(0); PG8_BAR; PG8_MMA(0, 0, At, B0); PG8_MMA(0, 1, At, B1); PG8_BAR; PG8_SCHED;
            PG8_LDA(At, 0, 1); PG8_STAGE(PG8_SB(0, 0), b2, voffB); PG8_STAGE(PG8_SB(0, 1), b2 + hstep, voffB); PG8_STAGE(PG8_SA(0, 0), a2, voffA);
            PG8_WAIT_V(8); PG8_WAIT_L(0); PG8_BAR; PG8_MMA(1, 0, At, B0); PG8_MMA(1, 1, At, B1); PG8_BAR; PG8_SCHED;
            PG8_LDB(B0, 1, 0); PG8_LDB(B1, 1, 1); PG8_SCHED; PG8_LDA(At, 1, 0); PG8_STAGE(PG8_SA(0, 1), a2 + hstep, voffA);
            PG8_WAIT_V(8); PG8_WAIT_L(0); PG8_BAR; PG8_MMA(0, 0, At, B0); PG8_MMA(0, 1, At, B1); PG8_BAR; PG8_SCHED;
            PG8_LDA(At, 1, 1); PG8_STAGE(PG8_SB(1, 0), b3, voffB); PG8_STAGE(PG8_SB(1, 1), b3 + hstep, voffB); PG8_STAGE(PG8_SA(1, 0), a3, voffA);
            PG8_WAIT_V(8); PG8_WAIT_L(0); PG8_BAR; PG8_MMA(1, 0, At, B0); PG8_MMA(1, 1, At, B1); PG8_BAR; PG8_SCHED;
            } else {
            PG8_LDB(B0, 0, 0); PG8_SCHED; PG8_LDA(At, 0, 0); PG8_STAGE(PG8_SA(1, 1), a1 + hstep, voffA);
            PG8_WAIT_L(8); PG8_BAR; PG8_WAIT_L(0); PG8_MMA(0, 0, At, B0); PG8_BAR; PG8_SCHED;
            PG8_LDB(B1, 0, 1); PG8_STAGE(PG8_SB(0, 0), b2, voffB);
            PG8_BAR; PG8_WAIT_L(0); PG8_MMA(0, 1, At, B1); PG8_BAR;
            PG8_LDA(At, 0, 1); PG8_STAGE(PG8_SA(0, 0), a2, voffA);
            PG8_BAR; PG8_WAIT_L(0); PG8_MMA(1, 0, At, B0); PG8_BAR; PG8_SCHED;
            PG8_STAGE(PG8_SB(0, 1), b2 + hstep, voffB);
            PG8_WAIT_V(6); PG8_BAR; PG8_MMA(1, 1, At, B1); PG8_BAR;
            PG8_LDB(B0, 1, 0); PG8_SCHED; PG8_LDA(At, 1, 0); PG8_STAGE(PG8_SA(0, 1), a2 + hstep, voffA);
            PG8_WAIT_L(8); PG8_BAR; PG8_WAIT_L(0); PG8_MMA(0, 0, At, B0); PG8_BAR; PG8_SCHED;
            PG8_LDB(B1, 1, 1); PG8_STAGE(PG8_SB(1, 0), b3, voffB);
            PG8_BAR; PG8_WAIT_L(0); PG8_MMA(0, 1, At, B1); PG8_BAR;
            PG8_LDA(At, 1, 1); PG8_STAGE(PG8_SA(1, 0), a3, voffA);
            PG8_BAR; PG8_WAIT_L(0); PG8_MMA(1, 0, At, B0); PG8_BAR; PG8_SCHED;
            PG8_STAGE(PG8_SB(1, 1), b3 + hstep, voffB);
            PG8_WAIT_V(6); PG8_BAR; PG8_MMA(1, 1, At, B1); PG8_BAR;
            }
        }
        if constexpr (ALIGN_EPI) { if (wr == 0) PG8_BAR; }
        if constexpr (F8) asm volatile("s_nop 15\n\ts_nop 15" ::: "memory");
        if constexpr (!Epi::AFTER_DRAIN) { E(acc, cur, wr, wc, fr, fq); S.done(cur); }
        if (!has_next) break;
#pragma unroll
        for (int a = 0; a < 2; ++a)
#pragma unroll
            for (int b = 0; b < 2; ++b)
#pragma unroll
                for (int m = 0; m < 4; ++m)
#pragma unroll
                    for (int n = 0; n < 2; ++n) { acc[a][b][m][n] = (f32x4){0.f, 0.f, 0.f, 0.f}; if constexpr (F8) asm volatile("" : "+v"(acc[a][b][m][n])); }
        cur = nxt; cA = nA; cB = nB; ++ui;
        if constexpr (ALIGN_EPI) { if (wr == 1) PG8_BAR; }
    }
    PG8_WAIT_V(0);
    if constexpr (!ALIGN_EPI) { if (wr == 0) PG8_BAR; }
    PG8_BAR;
    if constexpr (Epi::AFTER_DRAIN) { E.fused(acc, cur, wr, wc, fr, fq, lds, wid, lane); S.done(cur); }
#undef PG8_SA
#undef PG8_SB
#undef PG8_STAGE
#undef PG8_LDA
#undef PG8_LDB
#undef PG8_MMA
#undef PG8_CAT8
#undef PG8_WAIT_V
#undef PG8_WAIT_L
#undef PG8_BAR
#undef PG8_SCHED
}
}

namespace att {
#define LAS __attribute__((address_space(3)))
typedef unsigned short bf16;
typedef __attribute__((ext_vector_type(8))) short bf16x8;
typedef __attribute__((ext_vector_type(4))) short s16x4;
typedef __attribute__((ext_vector_type(16))) float f32x16;
typedef __attribute__((ext_vector_type(4))) unsigned u32x4;
typedef float f32x2_t __attribute__((ext_vector_type(2))); typedef __bf16 bf16x2_t __attribute__((ext_vector_type(2)));
typedef short v4i16_t __attribute__((ext_vector_type(4)));
typedef LAS const char* lds_cptr;
constexpr int SEQ = 4096, PP = 1536;
constexpr float LOG2E = 1.4426950408889634f;
constexpr float NEGINF = -INFINITY;
__device__ __forceinline__ int crow(int r, int hi) { return (r & 3) + 8 * (r >> 2) + 4 * hi; }
__device__ __forceinline__ void glds16(const void* gsrc, unsigned lds_dst) { unsigned keep;
    asm volatile("s_mov_b32 %0, m0\n\ts_mov_b32 m0, %2\n\ts_nop 0\n\tglobal_load_lds_dwordx4 %1, off\n\ts_mov_b32 m0, %0" : "=&s"(keep) : "v"(gsrc), "s"(lds_dst) : "memory"); }
__device__ __forceinline__ unsigned cvtpk(float lo, float hi) { f32x2_t v = {lo, hi}; bf16x2_t b = __builtin_convertvector(v, bf16x2_t); return __builtin_bit_cast(unsigned, b); }
__device__ __forceinline__ s16x4 vtr(lds_cptr p) { return __builtin_bit_cast(s16x4, __builtin_amdgcn_ds_read_tr16_b64_v4i16((LAS v4i16_t*)p)); }
__device__ __forceinline__ bf16x8 ldk(lds_cptr p) { return *(const LAS bf16x8*)p; }
__device__ __forceinline__ float xhalf(float v, int hi) {
    auto rr = __builtin_amdgcn_permlane32_swap(__float_as_uint(v), __float_as_uint(v), false, false);
    return hi ? __uint_as_float(rr[0]) : __uint_as_float(rr[1]); }
template <int OF> __device__ __forceinline__ float swz_xor(float v) { return __int_as_float(__builtin_amdgcn_ds_swizzle(__float_as_int(v), (OF << 10) | 0x1f)); }
__device__ __forceinline__ float max16(const f32x16& p) { float a = fmaxf(fmaxf(p[0], p[1]), fmaxf(p[2], p[3]));
#pragma unroll
    for (int r = 4; r < 16; r += 4) a = fmaxf(a, fmaxf(fmaxf(p[r], p[r + 1]), fmaxf(p[r + 2], p[r + 3]))); return a; }
__device__ __forceinline__ float add_s(float a, float b) { float r; asm("v_add_f32_e32 %0, %1, %2" : "=v"(r) : "v"(a), "v"(b)); return r; }
__device__ __forceinline__ float max3_s(float a, float b, float c) { float r; asm("v_max3_f32 %0, %1, %2, %3" : "=v"(r) : "v"(a), "v"(b), "v"(c)); return r; }
__device__ __forceinline__ float sum16a(const f32x16& p) { float a = p[0];
#pragma unroll
    for (int r = 1; r < 16; ++r) a += p[r];
    return a; }
__device__ __forceinline__ float max16a(const f32x16& p) { float a = max3_s(p[0], p[1], p[2]), b = max3_s(p[3], p[4], p[5]);
    a = max3_s(a, p[6], p[7]); b = max3_s(b, p[8], p[9]); a = max3_s(a, p[10], p[11]); b = max3_s(b, p[12], p[13]); a = max3_s(a, p[14], p[15]); return max3_s(a, b, b); }
__device__ __forceinline__ float sum16(const f32x16& p) { float a = (p[0] + p[1]) + (p[2] + p[3]);
#pragma unroll
    for (int r = 4; r < 16; r += 4) a += (p[r] + p[r + 1]) + (p[r + 2] + p[r + 3]); return a; }
#define ATT_WAIT_BAR(N) asm volatile("s_waitcnt vmcnt(" #N ") lgkmcnt(0)\n\ts_barrier" ::: "memory")
#define ATT_LDSW() asm volatile("s_waitcnt lgkmcnt(0)" ::: "memory")
#define PACK8(P, B) (u32x4){cvtpk(P[B], P[B + 1]), cvtpk(P[B + 2], P[B + 3]), cvtpk(P[B + 4], P[B + 5]), cvtpk(P[B + 6], P[B + 7])}
#define ASBF(x) __builtin_bit_cast(bf16x8, x)
#define VFRAG(lo, hh) (bf16x8){lo[0], lo[1], lo[2], lo[3], hh[0], hh[1], hh[2], hh[3]}

constexpr int A_SLOT = 32768, A_NSLOT = 4, A_WSF = 131072, A_FLAGS = 135168, A_SLN = 135424, A_KN = 135936, A_XCH = 0, A_STG = 65536;
constexpr float A_THR = 8.f, A_DEAD = -64.f;
template <int MODE = 0> __device__ __forceinline__ void diff_unit(int b, int h, int qb, const bf16* __restrict__ PA, bf16* __restrict__ YA, float lam, const LAS float* knl, const __attribute__((address_space(1))) unsigned* qctr, LAS int* qslot, LAS char* shm, const int tid, const int ro_mul = 1) {
    const int lane = tid & 63, r32 = lane & 31, hi = lane >> 5;
    const int wid = __builtin_amdgcn_readfirstlane(tid >> 6), comp = wid >> 2, g = wid & 3;
    const float slope2 = __builtin_amdgcn_exp2f(-2.f * (float)(h + 1)) * LOG2E;
    const long rowbase = (long)b * SEQ; const int q0 = qb * 128, qw0 = q0 + 32 * g, qi = qw0 + r32;
    const unsigned lds0 = (unsigned)(size_t)shm;
    LAS float* wsf = (LAS float*)(shm + A_WSF) + wid * 128;
    const bf16* kb_ = PA + rowbase * PP + 512 + h * 128; const bf16* vb_ = PA + rowbase * PP + 1024 + h * 128;
    const bf16* ksrc0 = kb_ + (long)lane * PP + wid * 8; const bf16* ksrc1 = ksrc0 + 64;
    const int pa = wid, pb = wid + 8;
    const bf16* vsrca = vb_ + (long)(16 * (pa & 3) + (lane >> 2)) * PP + (pa >> 2) * 32 + (lane & 3) * 8;
    const bf16* vsrcb = vb_ + (long)(16 * (pb & 3) + (lane >> 2)) * PP + (pb >> 2) * 32 + (lane & 3) * 8;
    const int NT = 2 * (qb + 1);
#define A_ISSUE(it_) do { const long ro_ = (long)(NT - 1 - (it_)) * 64 * PP * ro_mul; const unsigned sb_ = (unsigned)__builtin_amdgcn_readfirstlane(lds0 + (unsigned)(((it_) & 3) * A_SLOT)); \
        glds16(ksrc0 + ro_, sb_ + wid * 1024); glds16(ksrc1 + ro_, sb_ + 8192 + wid * 1024); glds16(vsrca + ro_, sb_ + 16384 + pa * 1024); glds16(vsrcb + ro_, sb_ + 16384 + pb * 1024); } while (0)
    const bf16* qp = PA + (rowbase + qi) * PP + h * 128 + comp * 64 + hi * 8;
    unsigned un_ = 0u;
    if (tid == 0) asm volatile("global_atomic_add %0, %1, %2, off sc0" : "=v"(un_) : "v"(qctr), "v"(1u) : "memory");
    bf16x8 qr[4];
    asm volatile("global_load_dwordx4 %0, %1, off" : "=v"(qr[0]) : "v"(qp) : "memory"); asm volatile("global_load_dwordx4 %0, %1, off offset:32" : "=v"(qr[1]) : "v"(qp) : "memory");
    asm volatile("global_load_dwordx4 %0, %1, off offset:64" : "=v"(qr[2]) : "v"(qp) : "memory"); asm volatile("global_load_dwordx4 %0, %1, off offset:96" : "=v"(qr[3]) : "v"(qp) : "memory");
    const float sl4 = slope2 * 4.f * (float)hi;
    volatile LAS int* fl = (volatile LAS int*)(shm + A_FLAGS);
    A_ISSUE(0); A_ISSUE(1); if (NT > 2) A_ISSUE(2);
    float m_ref = NEGINF, l = 0.f; f32x16 o[4];
#pragma unroll
    for (int dq = 0; dq < 4; ++dq) { o[dq] = f32x16{}; asm volatile("" : "+v"(o[dq])); }
#define A_QKH(P, it_, hf_) do { const int kh_ = 64 * (NT - 1 - (it_)) + 32 * (hf_); { \
        const lds_cptr kp_ = shm + ((it_) & 3) * A_SLOT + comp * 8192 + hi * 1024 + r32 * 16 + (hf_) * 512; \
        float s2_ = slope2; asm volatile("" : "+v"(s2_));     \
        const float bs_ = s2_ * (float)(kh_ - qi) + sl4; \
        _Pragma("unroll") for (int r = 0; r < 16; ++r) P[r] = __builtin_fmaf(s2_, (float)((r & 3) + 8 * (r >> 2)), bs_); \
        _Pragma("unroll") for (int d0 = 0; d0 < 4; ++d0) P = __builtin_amdgcn_mfma_f32_32x32x16_bf16(ldk(kp_ + d0 * 2048), qr[d0], P, 0, 0, 0); } } while (0)
#define A_SVH(P, it_, hf_) do { const int kh_ = 64 * (NT - 1 - (it_)) + 32 * (hf_); if (kh_ <= qw0) { \
        const lds_cptr vp_ = shm + ((it_) & 3) * A_SLOT + 16384 + (hf_) * 2048 + ((lane >> 4) & 1) * 32 + (lane & 3) * 8 + (4 * hi + ((lane & 15) >> 2)) * 64; \
          \
        const s16x4 fa0_ = vtr(vp_), fa1_ = vtr(vp_ + 512), fa2_ = vtr(vp_ + 1024), fa3_ = vtr(vp_ + 1536), fb0_ = vtr(vp_ + 4096), fb1_ = vtr(vp_ + 4096 + 512), fb2_ = vtr(vp_ + 4096 + 1024), fb3_ = vtr(vp_ + 4096 + 1536); \
        __builtin_amdgcn_sched_barrier(0); \
        if (kh_ == qw0) { _Pragma("unroll") for (int r = 0; r < 16; ++r) if (crow(r, hi) > r32) P[r] = NEGINF; } \
        float rm_ = max16a(P); rm_ = fmaxf(rm_, xhalf(rm_, hi)); \
        if (!__all(rm_ < m_ref + A_DEAD)) { \
            const float mnew_ = fmaxf(m_ref, rm_); \
            if (__any(mnew_ > m_ref + A_THR)) { const float alpha_ = __builtin_amdgcn_exp2f(m_ref - mnew_); l *= alpha_; m_ref = mnew_; \
                if (hi == 0) wsf[r32] = alpha_; ATT_LDSW(); \
                _Pragma("unroll") for (int r = 0; r < 16; ++r) { const float a_ = wsf[crow(r, hi)]; _Pragma("unroll") for (int dq = 0; dq < 4; ++dq) o[dq][r] *= a_; } } \
            _Pragma("unroll") for (int r = 0; r < 16; ++r) P[r] = __builtin_amdgcn_exp2f(P[r] - m_ref); \
            l += sum16a(P); \
            const u32x4 pw0_ = PACK8(P, 0), pw1_ = PACK8(P, 8); \
            const s16x4 fc0_ = vtr(vp_ + 8192), fc1_ = vtr(vp_ + 8192 + 512), fc2_ = vtr(vp_ + 8192 + 1024), fc3_ = vtr(vp_ + 8192 + 1536), fd0_ = vtr(vp_ + 12288), fd1_ = vtr(vp_ + 12288 + 512), fd2_ = vtr(vp_ + 12288 + 1024), fd3_ = vtr(vp_ + 12288 + 1536); \
            o[0] = __builtin_amdgcn_mfma_f32_32x32x16_bf16(ASBF(pw0_), VFRAG(fa0_, fa1_), o[0], 0, 0, 0); o[1] = __builtin_amdgcn_mfma_f32_32x32x16_bf16(ASBF(pw0_), VFRAG(fb0_, fb1_), o[1], 0, 0, 0); \
            o[0] = __builtin_amdgcn_mfma_f32_32x32x16_bf16(ASBF(pw1_), VFRAG(fa2_, fa3_), o[0], 0, 0, 0); o[1] = __builtin_amdgcn_mfma_f32_32x32x16_bf16(ASBF(pw1_), VFRAG(fb2_, fb3_), o[1], 0, 0, 0); \
            o[2] = __builtin_amdgcn_mfma_f32_32x32x16_bf16(ASBF(pw0_), VFRAG(fc0_, fc1_), o[2], 0, 0, 0); o[3] = __builtin_amdgcn_mfma_f32_32x32x16_bf16(ASBF(pw0_), VFRAG(fd0_, fd1_), o[3], 0, 0, 0); \
            o[2] = __builtin_amdgcn_mfma_f32_32x32x16_bf16(ASBF(pw1_), VFRAG(fc2_, fc3_), o[2], 0, 0, 0); o[3] = __builtin_amdgcn_mfma_f32_32x32x16_bf16(ASBF(pw1_), VFRAG(fd2_, fd3_), o[3], 0, 0, 0); \
            __builtin_amdgcn_sched_group_barrier(0x100, 8, 0); __builtin_amdgcn_sched_group_barrier(0x008, 4, 0); __builtin_amdgcn_sched_group_barrier(0x008, 4, 0); } } } while (0)
    f32x16 PH, PL;
    if (NT > 2) { ATT_WAIT_BAR(8); } else { ATT_WAIT_BAR(4); }
#pragma unroll
    for (int d0 = 0; d0 < 4; ++d0) asm volatile("" : "+v"(qr[d0]));
    float qkb;
    { float ss = 0.f;
#pragma unroll
      for (int d0 = 0; d0 < 4; ++d0)
#pragma unroll
          for (int e = 0; e < 8; ++e) { const float v = __uint_as_float((unsigned)(unsigned short)qr[d0][e] << 16); ss += v * v; }
      ss += xhalf(ss, hi); qkb = sqrtf(ss) * knl[2 * h + comp] * 1.001f + 1.0f; }
    A_QKH(PH, 0, 1);
    for (int it = 0; it < ((MODE == 5) ? 1 : NT); ++it) {
        A_QKH(PL, it, 0);
        A_SVH(PH, it, 1);
        if (it + 1 < NT) {
            if (it + 2 < NT) { ATT_WAIT_BAR(4); } else { ATT_WAIT_BAR(0); }
            if (it > 0) { const volatile LAS int* f = fl + ((it - 1) & 1) * 8;
                if (f[0] & f[1] & f[2] & f[3] & f[4] & f[5] & f[6] & f[7]) break; }
            if (it + 3 < NT) A_ISSUE(it + 3);
            A_QKH(PH, it + 1, 1);
        }
        A_SVH(PL, it, 0);
        { const float bmax = slope2 * (float)(64 * (NT - 2 - it) + 63 - qi);
          const int dead = __all(qkb + bmax < m_ref + A_DEAD) ? 1 : 0;
          if (lane == 0) fl[(it & 1) * 8 + wid] = dead; }
    }
#undef A_ISSUE
#undef A_QKH
#undef A_SVH
    l += xhalf(l, hi);
    if (hi == 0) wsf[32 + r32] = __builtin_amdgcn_rcpf(l); ATT_LDSW();
#pragma unroll
    for (int r = 0; r < 16; ++r) { const float a = wsf[32 + crow(r, hi)];
#pragma unroll
        for (int dq = 0; dq < 4; ++dq) o[dq][r] *= a; }
    ATT_WAIT_BAR(0);
    if (tid == 0) { asm volatile("" : "+v"(un_)); *qslot = (int)un_; }
    LAS float* X = (LAS float*)(shm + A_XCH) + g * 4096;
    if (comp == 1) {
#pragma unroll
        for (int dq = 0; dq < 4; ++dq)
#pragma unroll
            for (int r = 0; r < 16; ++r) X[(dq * 16 + r) * 64 + lane] = o[dq][r];
    }
    ATT_WAIT_BAR(0);
    if (comp == 0) {
        float ss[16];
#pragma unroll
        for (int r = 0; r < 16; ++r) ss[r] = 0.f;
#pragma unroll
        for (int dq = 0; dq < 4; ++dq)
#pragma unroll
            for (int r = 0; r < 16; ++r) { const float d = o[dq][r] - lam * X[(dq * 16 + r) * 64 + lane]; o[dq][r] = d; ss[r] += d * d; }
#pragma unroll
        for (int r = 0; r < 16; ++r) { float s = ss[r];
            s += swz_xor<1>(s); s += swz_xor<2>(s); s += swz_xor<4>(s); s += swz_xor<8>(s); s += swz_xor<16>(s);
            ss[r] = __builtin_amdgcn_rsqf(s * (1.f / 128.f) + 1e-6f); }
        LAS bf16* stg = (LAS bf16*)(shm + A_STG) + g * 4096;
#pragma unroll
        for (int dq = 0; dq < 4; ++dq) { const float gn = ((const LAS float*)(shm + A_SLN))[dq * 32 + r32];
#pragma unroll
            for (int r = 0; r < 16; ++r) stg[crow(r, hi) * 128 + dq * 32 + r32] = (bf16)(cvtpk(o[dq][r] * ss[r] * gn, 0.f) & 0xffffu); }
        ATT_LDSW();
        bf16* Yw = YA + (rowbase + qw0) * 512 + h * 128;
#pragma unroll
        for (int i = 0; i < 8; ++i) { const int idx = i * 64 + lane, row = idx >> 4, ch = idx & 15; const u32x4 v = *(const LAS u32x4*)(stg + row * 128 + ch * 8); *(u32x4*)(Yw + (long)row * 512 + ch * 8) = v; }
    }
}

constexpr int B_V = 49152, B_WSF = 98304, B_STG = 100352;
struct DilU { int b, h, dil, res, blk, pat; };
__device__ __forceinline__ DilU dil_unit_of(int bh, int j) { DilU u; u.b = bh >> 3; u.h = bh & 7;
    if (j < 16) { u.pat = 0; u.dil = 1; u.res = 0; u.blk = j; } else if (j < 32) { u.pat = 1; u.dil = 4; u.res = (j - 16) >> 2; u.blk = (j - 16) & 3; } else { u.pat = 2; u.dil = 16; u.res = j - 32; u.blk = 0; }
    return u; }
__device__ __forceinline__ DilU dil_unit_at(int vcu, int i) { const int x = vcu >> 5, n = (vcu & 31) + 32 * i, q = n / 48; return dil_unit_of(8 * x + q, n - 48 * q); }
__device__ __forceinline__ void dil_phase(int vcu, const bf16* __restrict__ PB, bf16* __restrict__ BPb, float* __restrict__ BSTb, LAS char* shm, const int tid) {
    const int lane = tid & 63, r32 = lane & 31, hi = lane >> 5;
    const int wid = __builtin_amdgcn_readfirstlane(tid >> 6);
    const unsigned lds0 = (unsigned)(size_t)shm;
    const bf16* const KBh = PB + (size_t)32768 * 512; const bf16* const VBh = PB + (size_t)2 * 32768 * 512;
#define B_ISSUE_K(U) do { const bf16* kb_ = KBh + (size_t)((U).b * 8 + (U).h) * SEQ * 64 + wid * 8; const int jb_ = 256 * (U).blk - 128; \
        _Pragma("unroll") for (int T = 0; T < 6; ++T) { int j_ = jb_ + 64 * T + lane; j_ = j_ < 0 ? 0 : j_;     \
            glds16(kb_ + ((size_t)j_ * (U).dil + (U).res) * 64, (unsigned)__builtin_amdgcn_readfirstlane(lds0 + (unsigned)(T * 8192 + wid * 1024))); } } while (0)
#define B_ISSUE_V(U) do { const bf16* vb_ = VBh + (size_t)((U).b * 8 + (U).h) * SEQ * 64 + (wid >> 2) * 32 + (lane & 3) * 8; const int jb_ = 256 * (U).blk - 128 + 16 * (wid & 3) + (lane >> 2); \
        _Pragma("unroll") for (int T = 0; T < 6; ++T) { int j_ = jb_ + 64 * T; j_ = j_ < 0 ? 0 : j_; \
            glds16(vb_ + ((size_t)j_ * (U).dil + (U).res) * 64, (unsigned)__builtin_amdgcn_readfirstlane(lds0 + (unsigned)(B_V + T * 8192 + wid * 1024))); } } while (0)
#ifdef PROBE_BSEG
    unsigned long long bt_ = 0; int bseg_ = -1;
#define BSEG(k) do { if (blockIdx.x == 0 && tid == 0) { const unsigned long long t_ = __builtin_amdgcn_s_memrealtime(); if (bseg_ == PROBE_BSEG) *(volatile LAS unsigned*)(shm + 139264 + 640) += (unsigned)(t_ - bt_); bt_ = t_; bseg_ = (k); } } while (0)
#else
#define BSEG(k) do { } while (0)
#endif
#define B_ISSUE_Q(U) do { const bf16* qp_ = PB + ((long)(U).b * SEQ + (long)(256 * (U).blk + 32 * wid + r32) * (U).dil + (U).res) * 512 + (U).h * 64 + hi * 8; \
        asm volatile("global_load_dwordx4 %0, %1, off" : "+v"(qr[0]) : "v"(qp_) : "memory"); asm volatile("global_load_dwordx4 %0, %1, off offset:32" : "+v"(qr[1]) : "v"(qp_) : "memory"); \
        asm volatile("global_load_dwordx4 %0, %1, off offset:64" : "+v"(qr[2]) : "v"(qp_) : "memory"); asm volatile("global_load_dwordx4 %0, %1, off offset:96" : "+v"(qr[3]) : "v"(qp_) : "memory"); } while (0)
    DilU cur = dil_unit_at(vcu, 0);
    bf16x8 qr[4]; qr[0] = bf16x8{}; qr[1] = bf16x8{}; qr[2] = bf16x8{}; qr[3] = bf16x8{};
    B_ISSUE_K(cur); B_ISSUE_Q(cur);
    for (int i = 0; i < 12; ++i) {
        const bool has_next = i + 1 < 12; const DilU nxt = dil_unit_at(vcu, has_next ? i + 1 : i);
        BSEG(0);
        const int b = cur.b, h = cur.h, dil = cur.dil, res = cur.res, blk = cur.blk;
        const int hs = h + (h >> 1);
        const float sd = __builtin_amdgcn_exp2f(-(2.f / 3.f) * (float)(hs + 1)) * LOG2E * (float)dil;
        const long rowbase = (long)b * SEQ; const int i0 = 256 * blk;
        const int iq = i0 + 32 * wid + r32;
#ifdef PROBE_DUPV
        B_ISSUE_V(cur);
        B_ISSUE_V(cur);
        ATT_WAIT_BAR(12);
#else
        B_ISSUE_V(cur);
        ATT_WAIT_BAR(6);
#endif
        BSEG(1);
        f32x16 s[5];
#pragma unroll
        for (int g = 0; g < 5; ++g) { const int b0 = 32 * (wid + g), T = b0 >> 6, half = (b0 >> 5) & 1;
            const lds_cptr kp = shm + T * 8192 + hi * 1024 + (half * 32 + r32) * 16;
            const float base = -sd * (float)(128 - 32 * g + r32);
#pragma unroll
            for (int r = 0; r < 16; ++r) s[g][r] = base + sd * (float)crow(r, hi);
#pragma unroll
            for (int d0 = 0; d0 < 4; ++d0) s[g] = __builtin_amdgcn_mfma_f32_32x32x16_bf16(ldk(kp + d0 * 2048), qr[d0], s[g], 0, 0, 0); }
        asm volatile("s_waitcnt lgkmcnt(0)\n\ts_barrier" ::: "memory");
        BSEG(2);
        if (has_next) B_ISSUE_K(nxt);
        B_ISSUE_Q(nxt);
        BSEG(3);
#pragma unroll
        for (int r = 0; r < 16; ++r) { const int cr = crow(r, hi); if (cr < r32) s[0][r] = NEGINF; if (cr > r32) s[4][r] = NEGINF; }
        if (blk == 0) {
#pragma unroll
            for (int g = 0; g < 5; ++g)
#pragma unroll
                for (int r = 0; r < 16; ++r) if (32 * (wid + g) + crow(r, hi) < 128) s[g][r] = NEGINF;
        }
        float m = max16(s[0]);
#pragma unroll
        for (int g = 1; g < 5; ++g) m = fmaxf(m, max16(s[g]));
        m = fmaxf(m, xhalf(m, hi));
        float l = 0.f;
#pragma unroll
        for (int g = 0; g < 5; ++g) {
#pragma unroll
            for (int r = 0; r < 16; ++r) s[g][r] = __builtin_amdgcn_exp2f(s[g][r] - m);
            l += sum16a(s[g]); }
        l += xhalf(l, hi);
        BSEG(4);
        if (has_next) { ATT_WAIT_BAR(10); } else { ATT_WAIT_BAR(4); }

        BSEG(5);
        f32x16 o[2]; o[0] = f32x16{}; o[1] = f32x16{};
        const lds_cptr vp0 = shm + B_V + ((lane >> 4) & 1) * 32 + (lane & 3) * 8 + (4 * hi + ((lane & 15) >> 2)) * 64;
#pragma unroll
        for (int g = 0; g < 5; ++g) { const u32x4 pwa = PACK8(s[g], 0), pwb = PACK8(s[g], 8);
            const int B16 = 2 * (wid + g), T = B16 >> 2, ks = B16 & 3;
            const lds_cptr vp = vp0 + T * 8192 + ks * 1024;
#pragma unroll
            for (int d0 = 0; d0 < 2; ++d0) {
                const s16x4 la = vtr(vp + d0 * 4096), ha = vtr(vp + d0 * 4096 + 512), lb_ = vtr(vp + d0 * 4096 + 1024), hb = vtr(vp + d0 * 4096 + 1536);
                o[d0] = __builtin_amdgcn_mfma_f32_32x32x16_bf16(ASBF(pwa), VFRAG(la, ha), o[d0], 0, 0, 0);
                o[d0] = __builtin_amdgcn_mfma_f32_32x32x16_bf16(ASBF(pwb), VFRAG(lb_, hb), o[d0], 0, 0, 0); } }
        BSEG(6);
        bf16* OUT = BPb + (size_t)cur.pat * 32768 * 512; float* ST = BSTb + (size_t)cur.pat * 32768 * 16;
        LAS float* wsf = (LAS float*)(shm + B_WSF) + wid * 64;
        if (hi == 0) wsf[r32] = __builtin_amdgcn_rcpf(l); ATT_LDSW();
        LAS bf16* stg = (LAS bf16*)(shm + B_STG) + wid * 2048;
#pragma unroll
        for (int r = 0; r < 16; ++r) { const float a = wsf[crow(r, hi)];
#pragma unroll
            for (int d0 = 0; d0 < 2; ++d0) stg[crow(r, hi) * 64 + d0 * 32 + r32] = (bf16)(cvtpk(o[d0][r] * a, 0.f) & 0xffffu); }
        ATT_LDSW();
        const long tok = rowbase + (long)iq * dil + res;
        if (hi == 0) { f32x2_t ml = {m, l}; *(f32x2_t*)(ST + (tok * 8 + h) * 2) = ml; }
#pragma unroll
        for (int k = 0; k < 4; ++k) { const int row = k * 8 + (lane >> 3), ch = lane & 7; const u32x4 v = *(const LAS u32x4*)(stg + row * 64 + ch * 8);
            const long trow = rowbase + (long)(i0 + 32 * wid + row) * dil + res; *(u32x4*)(OUT + trow * 512 + h * 64 + ch * 8) = v; }
        asm volatile("s_waitcnt lgkmcnt(0)\n\ts_barrier" ::: "memory");
        cur = nxt;
    }
    BSEG(-1);
    ATT_WAIT_BAR(0);
#undef B_ISSUE_K
#undef B_ISSUE_Q
#undef B_ISSUE_V
}

constexpr int C_SLOT = 16384, C_FLAGS = 49152, C_STG = 53248;
__device__ __forceinline__ void sb_unit(int b, int h, int qb, const bf16* __restrict__ PC, bf16* __restrict__ YC, const __attribute__((address_space(1))) unsigned* qctr, LAS int* qslot, LAS char* shm, const int tid) {
    const int lane = tid & 63, r32 = lane & 31, hi = lane >> 5;
    const int wid = __builtin_amdgcn_readfirstlane(tid >> 6);
    const long rowbase = (long)b * SEQ; const int q0 = qb * 256, qw0 = q0 + 32 * wid, qi = qw0 + r32;
    const unsigned lds0 = (unsigned)(size_t)shm;
    volatile LAS int* fl = (volatile LAS int*)(shm + C_FLAGS);
    const bf16* ksrc = PC + (rowbase + lane) * PP + 512 + h * 64 + wid * 8;
    const bf16* vsrc = PC + (rowbase + 16 * (wid & 3) + (lane >> 2)) * PP + 1024 + h * 64 + (wid >> 2) * 32 + (lane & 3) * 8;
    const int NT = 4 * qb + 4;
#define C_ISSUE(t_, sl_) do { const long ro_ = (long)(t_) * 64 * PP; const unsigned sb_ = (unsigned)__builtin_amdgcn_readfirstlane(lds0 + (unsigned)(sl_)); \
        glds16(ksrc + ro_, sb_ + wid * 1024); glds16(vsrc + ro_, sb_ + 8192 + wid * 1024); } while (0)
    const bf16* qp = PC + (rowbase + qi) * PP + h * 64 + hi * 8;
    unsigned un_ = 0u;
    if (tid == 0) asm volatile("global_atomic_add %0, %1, %2, off sc0" : "=v"(un_) : "v"(qctr), "v"(1u) : "memory");
    bf16x8 qr[4];
    asm volatile("global_load_dwordx4 %0, %1, off" : "=v"(qr[0]) : "v"(qp) : "memory"); asm volatile("global_load_dwordx4 %0, %1, off offset:32" : "=v"(qr[1]) : "v"(qp) : "memory");
    asm volatile("global_load_dwordx4 %0, %1, off offset:64" : "=v"(qr[2]) : "v"(qp) : "memory"); asm volatile("global_load_dwordx4 %0, %1, off offset:96" : "=v"(qr[3]) : "v"(qp) : "memory");
    C_ISSUE(NT - 1, 0); C_ISSUE(NT - 2, C_SLOT);
    float c = 1.f; bool wdone = false; f32x16 o[2]; o[0] = f32x16{}; o[1] = f32x16{};
    int sl = 0, sl2 = 2 * C_SLOT;
    for (int it = 0; it < NT; ++it) {
        if (it + 1 < NT) { ATT_WAIT_BAR(2); } else { ATT_WAIT_BAR(0); }
        if (it > 0) {
            const volatile LAS int* f = fl + ((it - 1) & 1) * 8;
            const int all = f[0] & f[1] & f[2] & f[3] & f[4] & f[5] & f[6] & f[7];
            if (all) break;
        }
        if (it + 2 < NT) C_ISSUE(NT - 3 - it, sl2);
        const int kbase = 64 * (NT - 1 - it);
        if (!wdone && kbase <= qw0) {
            const lds_cptr kp = shm + sl + hi * 1024 + r32 * 16;
            f32x16 p0 = f32x16{}, p1 = f32x16{};
#pragma unroll
            for (int d0 = 0; d0 < 4; ++d0) { const bf16x8 k0 = ldk(kp + d0 * 2048), k1 = ldk(kp + d0 * 2048 + 512);
                p0 = __builtin_amdgcn_mfma_f32_32x32x16_bf16(k0, qr[d0], p0, 0, 0, 0); p1 = __builtin_amdgcn_mfma_f32_32x32x16_bf16(k1, qr[d0], p1, 0, 0, 0); }
            if (kbase + 63 >= qw0) {
#pragma unroll
                for (int r = 0; r < 16; ++r) { const int kv = kbase + crow(r, hi); if (kv >= qi) p0[r] = NEGINF; if (kv + 32 >= qi) p1[r] = NEGINF; }
            }
            f32x16 N0, N1;
#pragma unroll
            for (int r = 0; r < 16; ++r) {
                { const float z = p0[r], e = __builtin_amdgcn_exp2f(-fabsf(z)), q = __builtin_amdgcn_rcpf(1.f + e), eq = e * q; const bool ps = z >= 0.f; p0[r] = ps ? q : eq; N0[r] = ps ? eq : q; }
                { const float z = p1[r], e = __builtin_amdgcn_exp2f(-fabsf(z)), q = __builtin_amdgcn_rcpf(1.f + e), eq = e * q; const bool ps = z >= 0.f; p1[r] = ps ? q : eq; N1[r] = ps ? eq : q; }
            }
            float T[8], U[8];
#pragma unroll
            for (int k = 0; k < 8; ++k) { const f32x16& Nx = (k < 4) ? N0 : N1; const int rb = 4 * (k & 3); T[k] = (Nx[rb] * Nx[rb + 1]) * (Nx[rb + 2] * Nx[rb + 3]); }
#pragma unroll
            for (int k = 0; k < 8; ++k) U[k] = xhalf(T[k], hi);
            float R = c;
#pragma unroll
            for (int k = 7; k >= 0; --k) {
                const float sufk = (hi == 0) ? R * U[k] : R;
                f32x16& Nx = (k < 4) ? N0 : N1; f32x16& Px = (k < 4) ? p0 : p1; const int rb = 4 * (k & 3);
                const float s3 = sufk, s2 = s3 * Nx[rb + 3], s1 = s2 * Nx[rb + 2], s0 = s1 * Nx[rb + 1];
                Px[rb + 3] *= s3; Px[rb + 2] *= s2; Px[rb + 1] *= s1; Px[rb + 0] *= s0;
                R *= T[k] * U[k];
            }
            c = R;
            const u32x4 pw0 = PACK8(p0, 0), pw1 = PACK8(p0, 8), pw2 = PACK8(p1, 0), pw3 = PACK8(p1, 8);
            const lds_cptr vp = shm + sl + 8192 + ((lane >> 4) & 1) * 32 + (lane & 3) * 8 + (4 * hi + ((lane & 15) >> 2)) * 64;
#pragma unroll
            for (int d0 = 0; d0 < 2; ++d0) {
                const s16x4 l0 = vtr(vp + d0 * 4096), h0 = vtr(vp + d0 * 4096 + 512), l1 = vtr(vp + d0 * 4096 + 1024), h1 = vtr(vp + d0 * 4096 + 1536);
                const s16x4 l2 = vtr(vp + d0 * 4096 + 2048), h2 = vtr(vp + d0 * 4096 + 2560), l3 = vtr(vp + d0 * 4096 + 3072), h3 = vtr(vp + d0 * 4096 + 3584);
                o[d0] = __builtin_amdgcn_mfma_f32_32x32x16_bf16(ASBF(pw0), VFRAG(l0, h0), o[d0], 0, 0, 0);
                o[d0] = __builtin_amdgcn_mfma_f32_32x32x16_bf16(ASBF(pw1), VFRAG(l1, h1), o[d0], 0, 0, 0);
                o[d0] = __builtin_amdgcn_mfma_f32_32x32x16_bf16(ASBF(pw2), VFRAG(l2, h2), o[d0], 0, 0, 0);
                o[d0] = __builtin_amdgcn_mfma_f32_32x32x16_bf16(ASBF(pw3), VFRAG(l3, h3), o[d0], 0, 0, 0);
            }
            wdone = __all(c < 0x1p-64f);
        }
        if (lane == 0) fl[(it & 1) * 8 + wid] = wdone ? 1 : 0;
        sl2 = sl; sl = (sl == 2 * C_SLOT) ? 0 : sl + C_SLOT;
    }
#undef C_ISSUE
    ATT_WAIT_BAR(0);
    if (tid == 0) { asm volatile("" : "+v"(un_)); *qslot = (int)un_; }
    LAS bf16* stg = (LAS bf16*)(shm + C_STG) + wid * 2048;
#pragma unroll
    for (int r = 0; r < 16; ++r)
#pragma unroll
        for (int d0 = 0; d0 < 2; ++d0) stg[crow(r, hi) * 64 + d0 * 32 + r32] = (bf16)(cvtpk(o[d0][r], 0.f) & 0xffffu);
    ATT_LDSW();
    bf16* Yw = YC + (rowbase + qw0) * 512 + h * 64;
#pragma unroll
    for (int i = 0; i < 4; ++i) { const int row = i * 8 + (lane >> 3), ch = lane & 7; const u32x4 v = *(const LAS u32x4*)(stg + row * 64 + ch * 8); *(u32x4*)(Yw + (long)row * 512 + ch * 8) = v; }
    asm volatile("s_waitcnt lgkmcnt(0)\n\ts_barrier" ::: "memory");
}
#undef LAS
}

constexpr int NWAVES = 8;
constexpr int BATCH = 8, SEQ = 4096, D = 1024, M = BATCH * SEQ;
constexpr int BW = 512, NPROJ = 9 * BW, NGATE = 3 * D, DFF = 2816, DFX = 3584, NEXP = 8;
constexpr float EPS = 1e-6f, LOG2E_F = 1.4426950408889634f;
constexpr float C2 = 0.125f * LOG2E_F;
#ifndef GATE0_FP8
#define GATE0_FP8 1
#endif
#define GATE_FP8(L) (((L) == 0) ? (GATE0_FP8 != 0) : (MIX_FP8 >= 1))
#ifndef MIX_FP8
#define MIX_FP8 1
#endif
#ifndef DENSE_FP8
#define DENSE_FP8 0
#endif
#ifndef FFN_FP8
#define FFN_FP8 1
#endif
constexpr int MOE_CH_TILES = FFN_FP8 ? 128 : 64, MOE_MAX_TILES = 264, MOE_MAX_CH = FFN_FP8 ? 3 : 5;

constexpr size_t MiB = 1u << 20, KiB = 1u << 10;
constexpr size_t WS_CTL = 0, CTL_ZERO_BYTES = 1 * MiB;
constexpr size_t WS_WIN = 1 * MiB, WS_WG = 19 * MiB, WS_WB = 31 * MiB, WS_WO = 37 * MiB, WS_WGU = 41 * MiB, WS_WD = 52 * MiB;
constexpr size_t WS_BST = 58 * MiB;
constexpr size_t WS_TOKE = 64 * MiB, WS_TOKW = WS_TOKE + 128 * KiB, WS_SLOT = WS_TOKE + 384 * KiB, WS_SLW = WS_TOKE + 640 * KiB, WS_CNT = WS_TOKE + 960 * KiB, WS_MHDR = WS_TOKE + 992 * KiB;
constexpr size_t WS_H = 66 * MiB;
constexpr size_t WS_PA = 130 * MiB, WS_PB = 226 * MiB, WS_PC = 322 * MiB;
constexpr size_t WS_YA = 418 * MiB, WS_YB = 450 * MiB, WS_YC = 482 * MiB;
constexpr size_t WS_BP = 130 * MiB;
constexpr size_t WS_GATES = 226 * MiB;
constexpr size_t WS_ACT = 130 * MiB;
constexpr size_t WS_MWGU = 130 * MiB, WS_MWD = 242 * MiB;
constexpr size_t WS_HS = 298 * MiB;
constexpr size_t WS_MACT = 430 * MiB;
constexpr size_t WS_XB = 418 * MiB;
constexpr size_t WS_END = 482 * MiB;
constexpr size_t OUT_YA = 0, OUT_YB = 32 * MiB, OUT_YC = 64 * MiB, OUT_H8 = 96 * MiB, OUT_MACT8 = 0;
static_assert(FFN_FP8 == 1 && OUT_H8 + (size_t)M * D <= (size_t)M * D * 4 && OUT_MACT8 + (size_t)MOE_CH_TILES * 256 * DFX <= (size_t)M * D * 4, "d_out scratch map");
constexpr size_t WS8_MWGU = 130 * MiB, WS8_MWD = 186 * MiB, WS8_HS = 214 * MiB, WS8_YS = 280 * MiB, WS8_MACT = 412 * MiB;
static_assert(WS8_MWGU + (size_t)NEXP * 2 * DFX * D <= WS8_MWD && WS8_MWD + (size_t)NEXP * D * DFX <= WS8_HS && WS8_HS + (size_t)MOE_MAX_TILES * 256 * D <= WS8_YS && WS8_YS + (size_t)MOE_MAX_TILES * 256 * D * 2 <= WS_XB && WS_XB + (size_t)M * D * 2 <= WS_END, "d_ws map fp8");
static_assert(WS_WD + (size_t)D * DFF * 2 <= WS_BST && WS_HS + (size_t)MOE_MAX_TILES * 256 * D * 2 <= WS_MACT , "d_ws map");
static_assert(WS_MWGU + (size_t)NEXP * 2 * DFX * D * 2 <= WS_MWD && WS_MWD + (size_t)NEXP * D * DFX * 2 <= WS_HS && WS_ACT + (size_t)M * DFF * 2 <= WS_PC, "d_ws map 2");
constexpr int CW_BAR = 4096, CW_Q = 16384, CW_KM = 49152, CW_KC = 53248;

constexpr int RING_OFF = 0, LDSCTL_OFF = 139264, MISC_OFF = LDSCTL_OFF + 320, LTAB_OFF = LDSCTL_OFF + 1024;
constexpr int LDS_BYTES = 147456;

#define GAS __attribute__((address_space(1)))
#define LAS __attribute__((address_space(3)))
typedef unsigned short bf16;
typedef unsigned v4u __attribute__((ext_vector_type(4)));
typedef unsigned v2u __attribute__((ext_vector_type(2)));
typedef float f32x4 __attribute__((ext_vector_type(4)));
typedef float f32x2 __attribute__((ext_vector_type(2)));
typedef GAS unsigned gu32;
#define RLX_AGENT __ATOMIC_RELAXED, __HIP_MEMORY_SCOPE_AGENT
#define LDS_WAIT() asm volatile("s_waitcnt lgkmcnt(0)" ::: "memory")
#define VM_WAIT() asm volatile("s_waitcnt vmcnt(0)" ::: "memory")
__device__ __forceinline__ unsigned f2bf(float f) { unsigned u = __builtin_bit_cast(unsigned, f); return (u + 0x7fffu + ((u >> 16) & 1u)) >> 16; }
__device__ __forceinline__ unsigned pk2(float lo, float hi) { return f2bf(lo) | (f2bf(hi) << 16); }
__device__ __forceinline__ float bfl(unsigned w) { return __uint_as_float(w << 16); }
__device__ __forceinline__ float bfh(unsigned w) { return __uint_as_float(w & 0xffff0000u); }

#define XB_TMO      128
#define XB_XCNT(j)  (256  + 64 * (j))
#define XB_XSUB(j)  (1280 + 64 * (j))
#define XB_XGEN(j)  (2304 + 64 * (j))
#define XB_TOP      3328
#define XB_TOPGEN   3392
#define XCD_BAR_WORDS 3456
#define XB_SPIN_CAP (1u << 18)

__device__ __forceinline__ unsigned xb_ld(unsigned* p)              { return __hip_atomic_load(p, __ATOMIC_RELAXED, __HIP_MEMORY_SCOPE_AGENT); }
__device__ __forceinline__ unsigned xb_add(unsigned* p, unsigned v) { return __hip_atomic_fetch_add(p, v, __ATOMIC_RELAXED, __HIP_MEMORY_SCOPE_AGENT); }
__device__ __forceinline__ unsigned xb_xcc_id() { return (unsigned)__builtin_amdgcn_s_getreg((3 << 11) | 20) & 0xFu; }
#define XB_SPIN(cond, bar) do { unsigned _sp = 0; while (cond) { __builtin_amdgcn_s_sleep(1); \
    if ((++_sp & 255u) == 0u) { if (xb_ld(&(bar)[XB_TMO])) break; if (_sp > XB_SPIN_CAP) { atomicAdd(&(bar)[XB_TMO], 1u); break; } } } } while (0)

struct XcdBarrier {
    unsigned* bar; unsigned x;
    volatile LAS unsigned* st;
};

__device__ __forceinline__ XcdBarrier xcd_barrier_post(unsigned* bar, volatile LAS unsigned* st) {
    XcdBarrier b; b.bar = bar; b.x = xb_xcc_id(); b.st = st;
    if (threadIdx.x == 0) (void)xb_add(&bar[XB_XCNT(b.x)], 1u);
    return b;
}
__device__ __forceinline__ void xcd_barrier_complete(unsigned* bar, unsigned x, unsigned& nloc, unsigned& nx) {
    const unsigned G = gridDim.x * gridDim.y * gridDim.z;
    unsigned sum, cnt, mine, sp = 0u;
    for (;;) {
        sum = 0u; cnt = 0u; mine = 0u;
#pragma unroll
        for (unsigned j = 0; j < 16; ++j) { const unsigned c = xb_ld(&bar[XB_XCNT(j)]); sum += c; cnt += (c > 0u) ? 1u : 0u; mine = (j == x) ? c : mine; }
        if (sum == G) break;
        __builtin_amdgcn_s_sleep(1);
        if ((++sp & 255u) == 0u) { if (xb_ld(&bar[XB_TMO])) break; if (sp > XB_SPIN_CAP) { atomicAdd(&bar[XB_TMO], 1u); break; } }
    }
    nloc = mine > 0u ? mine : 1u; nx = cnt > 0u ? cnt : 1u;
}

__device__ __forceinline__ void xcd_barrier(const XcdBarrier& b) {
    asm volatile("s_waitcnt vmcnt(0)" ::: "memory");
    __syncthreads();
    if (threadIdx.x == 0) {
        unsigned* bar = b.bar;
        __builtin_amdgcn_s_waitcnt(0);
        unsigned nloc = b.st[0], nx = b.st[1];
        if (nloc == 0u) { xcd_barrier_complete(bar, b.x, nloc, nx); b.st[0] = nloc; b.st[1] = nx; }
        const unsigned old = xb_add(&bar[XB_XSUB(b.x)], 1u);
        const unsigned gen = old / nloc;
        if (old + 1u == (gen + 1u) * nloc) {
            __builtin_amdgcn_fence(__ATOMIC_RELEASE, "agent");
            asm volatile("s_waitcnt vmcnt(0)" ::: "memory");
            const unsigned og = xb_add(&bar[XB_TOP], 1u);
            const unsigned tg = og / nx;
            if (og + 1u == (tg + 1u) * nx) xb_add(&bar[XB_TOPGEN], 1u);
            else XB_SPIN(xb_ld(&bar[XB_TOPGEN]) == tg, bar);
            __builtin_amdgcn_fence(__ATOMIC_ACQUIRE, "agent");
            xb_add(&bar[XB_XGEN(b.x)], 1u);
            asm volatile("s_waitcnt vmcnt(0)" ::: "memory");
        } else {
            XB_SPIN(xb_ld(&bar[XB_XGEN(b.x)]) == gen, bar);
            __builtin_amdgcn_fence(__ATOMIC_ACQUIRE, "agent");
            asm volatile("s_waitcnt vmcnt(0)" ::: "memory");
        }
    }
    __syncthreads();
}


template <int OF> __device__ __forceinline__ float swz_f(float v) { return __int_as_float(__builtin_amdgcn_ds_swizzle(__float_as_int(v), (OF << 10) | 0x1f)); }
template <int OF> __device__ __forceinline__ int swz_i(int v) { return __builtin_amdgcn_ds_swizzle(v, (OF << 10) | 0x1f); }
__device__ __forceinline__ float x32_f(float v) { auto rr = __builtin_amdgcn_permlane32_swap(__float_as_uint(v), __float_as_uint(v), false, false); return __uint_as_float(rr[0]) + __uint_as_float(rr[1]); }
__device__ __forceinline__ int x32_i(int v) { auto rr = __builtin_amdgcn_permlane32_swap((unsigned)v, (unsigned)v, false, false); return (int)(rr[0] + rr[1]); }
__device__ __forceinline__ float wave_sum(float v) {
    v += swz_f<1>(v); v += swz_f<2>(v); v += swz_f<4>(v); v += swz_f<8>(v); v += swz_f<16>(v); return x32_f(v);
}
__device__ __forceinline__ int wave_sum_i(int v) { v += swz_i<1>(v); v += swz_i<2>(v); v += swz_i<4>(v); v += swz_i<8>(v); v += swz_i<16>(v); return x32_i(v); }
__device__ __forceinline__ void transpose_item(const float* W, int K, int N, bf16* WT, int row_off, LAS float* scr, int k0, int n0, int lane) {
    f32x4 wv_[8];
#pragma unroll
    for (int i = 0; i < 8; ++i) wv_[i] = *(const GAS f32x4*)(W + (size_t)(k0 + 8 * i + (lane >> 3)) * N + n0 + 4 * (lane & 7));
#pragma unroll
    for (int i = 0; i < 8; ++i) { LAS float* d = scr + (8 * i + (lane >> 3)) * 33 + 4 * (lane & 7); d[0] = wv_[i].x; d[1] = wv_[i].y; d[2] = wv_[i].z; d[3] = wv_[i].w; }
    LDS_WAIT(); asm volatile("" ::: "memory");
    const int c = lane & 7;
#pragma unroll
    for (int j = 0; j < 4; ++j) { const int n = (lane >> 3) + 8 * j; const LAS float* s = scr + (8 * c) * 33 + n;
        v4u o; o.x = pk2(s[0 * 33], s[1 * 33]); o.y = pk2(s[2 * 33], s[3 * 33]); o.z = pk2(s[4 * 33], s[5 * 33]); o.w = pk2(s[6 * 33], s[7 * 33]);
        *(GAS v4u*)(WT + (size_t)(row_off + n0 + n) * K + k0 + 8 * c) = o; }
    LDS_WAIT(); asm volatile("" ::: "memory");
}
__device__ __forceinline__ void conv_matrix(const float* W, int K, int N, bf16* WT, int mode, LAS float* scr, int gw, int ngw, int lane) {
    const int nblk = N / 32, items = (K / 64) * nblk;
    for (int it = gw; it < items; it += ngw) { const int kb = it / nblk, nb = it - kb * nblk, n0 = 32 * nb;
        const int d0 = mode == 0 ? n0 : (256 * (n0 >> 7) + (n0 & 127) + (mode == 2 ? 128 : 0));
        transpose_item(W, K, N, WT, d0 - n0, scr, 64 * kb, n0, lane); }
}
__device__ __forceinline__ void transpose_item8(const float* W, int K, int N, unsigned char* WT, int row_off, LAS float* scr, int k0, int n0, int lane) {
    f32x4 wv_[8];
#pragma unroll
    for (int i = 0; i < 8; ++i) wv_[i] = *(const GAS f32x4*)(W + (size_t)(k0 + 8 * i + (lane >> 3)) * N + n0 + 4 * (lane & 7));
#pragma unroll
    for (int i = 0; i < 8; ++i) { LAS float* d = scr + (8 * i + (lane >> 3)) * 33 + 4 * (lane & 7); d[0] = wv_[i].x; d[1] = wv_[i].y; d[2] = wv_[i].z; d[3] = wv_[i].w; }
    LDS_WAIT(); asm volatile("" ::: "memory");
    const int c = lane & 7; const float sc = (float)(1 << pg8::F8_WSHIFT);
#pragma unroll
    for (int j = 0; j < 4; ++j) { const int n = (lane >> 3) + 8 * j; const LAS float* s = scr + (8 * c) * 33 + n;
        v2u o; o.x = pg8::pk4_fp8(s[0 * 33] * sc, s[1 * 33] * sc, s[2 * 33] * sc, s[3 * 33] * sc); o.y = pg8::pk4_fp8(s[4 * 33] * sc, s[5 * 33] * sc, s[6 * 33] * sc, s[7 * 33] * sc);
        *(GAS v2u*)(WT + (size_t)(row_off + n0 + n) * K + k0 + 8 * c) = o; }
    LDS_WAIT(); asm volatile("" ::: "memory");
}
__device__ __forceinline__ void conv_matrix8(const float* W, int K, int N, unsigned char* WT, int mode, LAS float* scr, int gw, int ngw, int lane) {
    const int nblk = N / 32, items = (K / 64) * nblk;
    for (int it = gw; it < items; it += ngw) { const int kb = it / nblk, nb = it - kb * nblk, n0 = 32 * nb;
        const int d0 = mode == 0 ? n0 : (256 * (n0 >> 7) + (n0 & 127) + (mode == 2 ? 128 : 0));
        transpose_item8(W, K, N, WT, d0 - n0, scr, 64 * kb, n0, lane); }
}
__device__ __forceinline__ void store_row_fp8(unsigned char* orow, const f32x4 (&v)[4], int lane) {
    GAS unsigned* o4 = (GAS unsigned*)orow + lane;
#pragma unroll
    for (int j = 0; j < 4; ++j) o4[64 * j] = pg8::pk4_fp8(v[j].x, v[j].y, v[j].z, v[j].w);
}
__device__ __forceinline__ void rms_row(const float* xrow, const f32x4 (&g)[4], f32x4 (&v)[4], int lane) {
    const GAS f32x4* xr = (const GAS f32x4*)xrow + lane; float s2 = 0.f;
#pragma unroll
    for (int j = 0; j < 4; ++j) { v[j] = xr[64 * j]; s2 += (v[j].x * v[j].x + v[j].y * v[j].y) + (v[j].z * v[j].z + v[j].w * v[j].w); }
    const float rstd = 1.f / sqrtf(wave_sum(s2) * (1.f / D) + EPS);
#pragma unroll
    for (int j = 0; j < 4; ++j) v[j] = v[j] * rstd * g[j];
}
__device__ __forceinline__ f32x4 bf4(const v2u w) { return (f32x4){bfl(w.x), bfh(w.x), bfl(w.y), bfh(w.y)}; }
__device__ __forceinline__ void rms_row(const bf16* xrow, const f32x4 (&g)[4], f32x4 (&v)[4], int lane) {
    const GAS v2u* xr = (const GAS v2u*)xrow + lane; float s2 = 0.f; v2u w[4];
#pragma unroll
    for (int j = 0; j < 4; ++j) w[j] = xr[64 * j];
#pragma unroll
    for (int j = 0; j < 4; ++j) { v[j] = bf4(w[j]); s2 += (v[j].x * v[j].x + v[j].y * v[j].y) + (v[j].z * v[j].z + v[j].w * v[j].w); }
    const float rstd = 1.f / sqrtf(wave_sum(s2) * (1.f / D) + EPS);
#pragma unroll
    for (int j = 0; j < 4; ++j) v[j] = v[j] * rstd * g[j];
}
__device__ __forceinline__ void rms_row2(const bf16* xa, const bf16* xb, const f32x4 (&g)[4], f32x4 (&va)[4], f32x4 (&vb)[4], int lane) {
    const GAS v2u* pa = (const GAS v2u*)xa + lane; const GAS v2u* pb = (const GAS v2u*)xb + lane; float sa = 0.f, sb = 0.f; v2u wa[4], wb[4];
#pragma unroll
    for (int j = 0; j < 4; ++j) { wa[j] = pa[64 * j]; wb[j] = pb[64 * j]; }
#pragma unroll
    for (int j = 0; j < 4; ++j) { va[j] = bf4(wa[j]); vb[j] = bf4(wb[j]); sa += (va[j].x * va[j].x + va[j].y * va[j].y) + (va[j].z * va[j].z + va[j].w * va[j].w); sb += (vb[j].x * vb[j].x + vb[j].y * vb[j].y) + (vb[j].z * vb[j].z + vb[j].w * vb[j].w); }
    const float ra = 1.f / sqrtf(wave_sum(sa) * (1.f / D) + EPS), rb = 1.f / sqrtf(wave_sum(sb) * (1.f / D) + EPS);
#pragma unroll
    for (int j = 0; j < 4; ++j) { va[j] = va[j] * ra * g[j]; vb[j] = vb[j] * rb * g[j]; }
}
__device__ __forceinline__ void rms_row2(const float* xa, const float* xb, const f32x4 (&g)[4], f32x4 (&va)[4], f32x4 (&vb)[4], int lane) {
    const GAS f32x4* pa = (const GAS f32x4*)xa + lane; const GAS f32x4* pb = (const GAS f32x4*)xb + lane; float sa = 0.f, sb = 0.f;
#pragma unroll
    for (int j = 0; j < 4; ++j) { va[j] = pa[64 * j]; vb[j] = pb[64 * j]; }
#pragma unroll
    for (int j = 0; j < 4; ++j) { sa += (va[j].x * va[j].x + va[j].y * va[j].y) + (va[j].z * va[j].z + va[j].w * va[j].w); sb += (vb[j].x * vb[j].x + vb[j].y * vb[j].y) + (vb[j].z * vb[j].z + vb[j].w * vb[j].w); }
    const float ra = 1.f / sqrtf(wave_sum(sa) * (1.f / D) + EPS), rb = 1.f / sqrtf(wave_sum(sb) * (1.f / D) + EPS);
#pragma unroll
    for (int j = 0; j < 4; ++j) { va[j] = va[j] * ra * g[j]; vb[j] = vb[j] * rb * g[j]; }
}
__device__ __forceinline__ void store_row_bf16(bf16* orow, const f32x4 (&v)[4], int lane) {
    GAS v2u* o8 = (GAS v2u*)orow + lane;
#pragma unroll
    for (int j = 0; j < 4; ++j) { v2u w; w.x = pk2(v[j].x, v[j].y); w.y = pk2(v[j].z, v[j].w); o8[64 * j] = w; }
}


enum { PH_PRO = 0, PH_L = 20, NPHASE = 1 + 2 * PH_L };
struct Args { const float* in[18]; float* out; unsigned char* ws; int ph_lo, ph_hi; };
static_assert(sizeof(Args) == 18 * 8 + 8 + 8 + 8, "Args has no padding");

__global__ void __launch_bounds__(NWAVES * 64, 2) mega_fwd(Args args) {
    extern __shared__ __attribute__((aligned(16))) unsigned char lds_raw[];
    LAS unsigned char* const lds = (LAS unsigned char*)lds_raw;
    volatile LAS unsigned* const MISC = (volatile LAS unsigned*)(lds + MISC_OFF);
    const int wave_k = __builtin_amdgcn_readfirstlane((int)threadIdx.x >> 6);
    const int G = gridDim.x, bx = blockIdx.x; const int vcu = (G % 8 == 0) ? (bx % 8) * (G / 8) + bx / 8 : bx;
    const int NGW = G * NWAVES;
    unsigned char* const ws = args.ws;
    gu32* const ctl = (gu32*)(ws + WS_CTL);
    for (int u = threadIdx.x; u < (LDS_BYTES - LDSCTL_OFF) / 4; u += NWAVES * 64) ((LAS unsigned*)(lds + LDSCTL_OFF))[u] = 0u;
    __syncthreads();
#if MK_N_LAUNCHES == 1
    XcdBarrier bar = xcd_barrier_post((unsigned*)(ctl + CW_BAR), MISC + 8);
#ifndef PROBE_AMP
#define PROBE_AMP 1
#endif
#ifdef PROBE_CAT
#define SEAM() do { xcd_barrier(bar); if (bx == 0 && threadIdx.x == 0) { const unsigned long long tn_ = __builtin_amdgcn_s_memrealtime(); volatile LAS unsigned* pa_ = (volatile LAS unsigned*)(lds + LDSCTL_OFF + 640); if (cat_ == PROBE_CAT) pa_[0] += (unsigned)(tn_ - *(volatile LAS unsigned long long*)(lds + LDSCTL_OFF + 704)); *(volatile LAS unsigned long long*)(lds + LDSCTL_OFF + 704) = tn_; } } while (0)
#else
#define SEAM() xcd_barrier(bar)
#endif
#else
#define SEAM() do { } while (0)
#endif
    const int lo = args.ph_lo, hi = args.ph_hi;
#ifdef PROBE_CAT
    int cat_ = 0; if (bx == 0 && threadIdx.x == 0) *(volatile LAS unsigned long long*)(lds + LDSCTL_OFF + 704) = __builtin_amdgcn_s_memrealtime();
#define CAT(c) cat_ = (c)
#define STAMP(c) do { if (bx == 0 && threadIdx.x == 0) { const unsigned long long tn_ = __builtin_amdgcn_s_memrealtime(); volatile LAS unsigned* pa_ = (volatile LAS unsigned*)(lds + LDSCTL_OFF + 640); if (cat_ == PROBE_CAT) pa_[0] += (unsigned)(tn_ - *(volatile LAS unsigned long long*)(lds + LDSCTL_OFF + 704)); *(volatile LAS unsigned long long*)(lds + LDSCTL_OFF + 704) = tn_; } cat_ = (c); } while (0)
#else
#define CAT(c) do { } while (0)
#define STAMP(c) do { } while (0)
#endif
#define IN(k) (lo <= (k) && (k) < hi)
#ifndef REPG
#define REPG 1
#endif
#ifndef REPA
#define REPA 1
#endif
#ifndef REPA_A
#define REPA_A REPA
#endif
#ifndef REPA_C
#define REPA_C REPA
#endif
#ifndef REPA_B
#define REPA_B REPA
#endif
#ifndef REPT
#define REPT 1
#endif
#define PHASE_IDS() unsigned z0_ = 0u; asm volatile("" : "+s"(z0_)); int tidp = wave_k * 64 + (int)__builtin_amdgcn_mbcnt_hi(~0u, __builtin_amdgcn_mbcnt_lo(~0u, z0_)); asm volatile("" : "+v"(tidp)); const int tid = tidp, lane = tidp & 63, wave = __builtin_amdgcn_readfirstlane(tidp >> 6); const int gw = vcu * NWAVES + wave; LAS float* const scr = (LAS float*)(lds + RING_OFF + wave * 16384); (void)tid; (void)lane; (void)gw; (void)scr
#define INP(i) ([&]() -> const float* { int i_ = (i); asm volatile("" : "+s"(i_)); return args.in[i_]; }())
#define WSP(T, OFF) ([&]() -> T* { size_t o_ = (size_t)(OFF); asm volatile("" : "+s"(o_)); return (T*)(ws + o_); }())
#define x_in INP(0)
#define norm_mix INP(1)
#define w_in INP(2)
#define diff_lambda INP(3)
#define diff_subln INP(4)
#define w_gate INP(5)
#define b_gate INP(6)
#define w_branch INP(7)
#define w_out INP(8)
#define norm_ffn INP(9)
#define w_dg INP(10)
#define w_du INP(11)
#define w_dd INP(12)
#define w_router INP(13)
#define w_mg INP(14)
#define w_mu INP(15)
#define w_md INP(16)
#define norm_final INP(17)
#define xout (args.out)
#define Win_t WSP(bf16, WS_WIN)
#define Wg_t WSP(bf16, WS_WG)
#define Wb_t WSP(bf16, WS_WB)
#define Wo_t WSP(bf16, WS_WO)
#define Wgu_t WSP(bf16, WS_WGU)
#define Wd_t WSP(bf16, WS_WD)
#define Hb WSP(bf16, WS_H)
#define PA WSP(bf16, WS_PA)
#define PB WSP(bf16, WS_PB)
#define PC WSP(bf16, WS_PC)
#define OUTP(T, OFF) ([&]() -> T* { size_t o_ = (size_t)(OFF); asm volatile("" : "+s"(o_)); return (T*)((unsigned char*)args.out + o_); }())
#define YA OUTP(bf16, OUT_YA)
#define YC OUTP(bf16, OUT_YC)
#define YB OUTP(bf16, OUT_YB)
#define XB WSP(bf16, WS_XB)
#define BP WSP(bf16, WS_BP)
#define BST WSP(float, WS_BST)
#define GATES WSP(bf16, WS_GATES)
#define ACT WSP(bf16, WS_ACT)
#define MWgu WSP(bf16, WS_MWGU)
#define MWd WSP(bf16, WS_MWD)
#define HS WSP(bf16, WS_HS)
#define MACT WSP(bf16, WS_MACT)
#define TOKE WSP(int, WS_TOKE)
#define TOKW WSP(float, WS_TOKW)
#define SLOT WSP(int, WS_SLOT)
#define SLW WSP(float, WS_SLW)
#define CNT WSP(int, WS_CNT)
#define MHDR WSP(int, WS_MHDR)
#define Hb8 WSP(unsigned char, WS_H)
#define H8 OUTP(unsigned char, OUT_H8)
#define Win8 WSP(unsigned char, WS_WIN)
#define Wg8 WSP(unsigned char, WS_WG)
#define Wgu8 WSP(unsigned char, WS_WGU)
#define Wd8 WSP(unsigned char, WS_WD)
#define ACT8 WSP(unsigned char, WS_ACT)
#define MWgu8 WSP(unsigned char, WS8_MWGU)
#define MWd8 WSP(unsigned char, WS8_MWD)
#define HS8 WSP(unsigned char, WS8_HS)
#define YS8 WSP(bf16, WS8_YS)
#define MACT8 OUTP(unsigned char, OUT_MACT8)

    if (IN(PH_PRO)) { PHASE_IDS(); CAT(1);
        for (int L = 0; L < 2; ++L) {
#if MIX_FP8 >= 2
            conv_matrix8(w_in + (size_t)L * D * NPROJ, D, NPROJ, Win8 + (size_t)L * NPROJ * D, 0, scr, gw, NGW, lane);
#else
            conv_matrix(w_in + (size_t)L * D * NPROJ, D, NPROJ, Win_t + (size_t)L * NPROJ * D, 0, scr, gw, NGW, lane);
#endif
            if (GATE_FP8(L)) conv_matrix8(w_gate + (size_t)L * D * NGATE, D, NGATE, Wg8 + (size_t)L * NGATE * D * 2, 0, scr, gw, NGW, lane);
            else conv_matrix(w_gate + (size_t)L * D * NGATE, D, NGATE, Wg_t + (size_t)L * NGATE * D, 0, scr, gw, NGW, lane);
            for (int i = 0; i < 3; ++i) conv_matrix(w_branch + (size_t)(L * 3 + i) * BW * D, BW, D, Wb_t + (size_t)(L * 3 + i) * D * BW, 0, scr, gw, NGW, lane);
            conv_matrix(w_out + (size_t)L * D * D, D, D, Wo_t + (size_t)L * D * D, 0, scr, gw, NGW, lane);
        }
#if DENSE_FP8
        conv_matrix8(w_dg, D, DFF, Wgu8, 1, scr, gw, NGW, lane);
        conv_matrix8(w_du, D, DFF, Wgu8, 2, scr, gw, NGW, lane);
        conv_matrix8(w_dd, DFF, D, Wd8, 0, scr, gw, NGW, lane);
#else
        conv_matrix(w_dg, D, DFF, Wgu_t, 1, scr, gw, NGW, lane);
        conv_matrix(w_du, D, DFF, Wgu_t, 2, scr, gw, NGW, lane);
        conv_matrix(w_dd, DFF, D, Wd_t, 0, scr, gw, NGW, lane);
#endif
        {

            f32x4 g[4];
#pragma unroll
            for (int j = 0; j < 4; ++j) g[j] = ((const GAS f32x4*)(norm_mix) + lane)[64 * j];
            for (int m = gw; m < M; m += 2 * NGW) { f32x4 v[4], w[4]; rms_row2(x_in + (size_t)m * D, x_in + (size_t)(m + NGW) * D, g, v, w, lane);
                store_row_bf16(Hb + (size_t)m * D, v, lane); store_row_bf16(Hb + (size_t)(m + NGW) * D, w, lane);
                if (GATE0_FP8) { store_row_fp8(H8 + (size_t)m * D, v, lane); store_row_fp8(H8 + (size_t)(m + NGW) * D, w, lane); } }
        }
        SEAM();
    }

    for (int L = 0; L < 2; ++L) {
        const int P = 1 + L * PH_L;
        if (L == 1 && IN(P + 0)) { PHASE_IDS(); CAT(2);
            f32x4 g[4];
#pragma unroll
            for (int j = 0; j < 4; ++j) g[j] = ((const GAS f32x4*)(norm_mix + L * D) + lane)[64 * j];
            for (int m = gw; m < M; m += 2 * NGW) { f32x4 v[4], w[4]; rms_row2(XB + (size_t)m * D, XB + (size_t)(m + NGW) * D, g, v, w, lane);
                store_row_bf16(Hb + (size_t)m * D, v, lane); store_row_bf16(Hb + (size_t)(m + NGW) * D, w, lane);
                if (MIX_FP8 >= 1 && L == 1) { store_row_fp8(H8 + (size_t)m * D, v, lane); store_row_fp8(H8 + (size_t)(m + NGW) * D, w, lane); } }
            SEAM();
        }
        if (IN(P + 1)) { PHASE_IDS(); CAT(3);
#if MIX_FP8 >= 2
            pg8::Gemm g{(const bf16*)H8, (const bf16*)(Win8 + (size_t)L * NPROJ * D), D / 2}; pg8::StaticOrder S; S.init(M, NPROJ, D / 2, G, bx);
            pg8::EpiProj E{PA, (size_t)(WS_PB - WS_PA) / 2, C2, pg8::F8_WINV};
            pg8::gemm_phase<pg8::EpiProj, pg8::StaticOrder, true, true, true>(lds + RING_OFF, g, S, E, tidp);
#else
            pg8::Gemm g{Hb, Win_t + (size_t)L * NPROJ * D, D}; pg8::StaticOrder S; S.init(M, NPROJ, D, G, bx);
            pg8::EpiProj E{PA, (size_t)(WS_PB - WS_PA) / 2, C2, 1.f};
            for (int rep_ = 0; rep_ < REPG; ++rep_) { int tq_ = tidp; asm volatile("" : "+v"(tq_)); pg8::gemm_phase<pg8::EpiProj, pg8::StaticOrder, true, true>(lds + RING_OFF, g, S, E, tq_); }
#endif

            SEAM();
        }
        if (IN(P + 2)) { PHASE_IDS(); CAT(40);
            const float lam_init = 0.8f - 0.6f * expf(-0.3f * (float)L);
            float lam;
            { const float* lv = diff_lambda + L * 256; float s01 = lv[lane] * lv[64 + lane], s23 = lv[128 + lane] * lv[192 + lane];
              s01 += att::swz_xor<1>(s01); s01 += att::swz_xor<2>(s01); s01 += att::swz_xor<4>(s01); s01 += att::swz_xor<8>(s01); s01 += att::swz_xor<16>(s01); s01 += att::xhalf(s01, lane >> 5);
              s23 += att::swz_xor<1>(s23); s23 += att::swz_xor<2>(s23); s23 += att::swz_xor<4>(s23); s23 += att::swz_xor<8>(s23); s23 += att::swz_xor<16>(s23); s23 += att::xhalf(s23, lane >> 5);
              lam = expf(s01) - expf(s23) + lam_init; }
            { LAS int* qs = (LAS int*)(lds + LDSCTL_OFF + 512); const int grp = bx & 7;
              gu32* km = ctl + CW_KM + (L * 8 + grp) * 64; gu32* kc = ctl + CW_KC + (L * 8 + grp) * 64;
              { const int r0 = grp * SEQ + (bx >> 3) * 128 + wave * 16; float mx = 0.f; v4u kw[16];
#pragma unroll
                for (int r = 0; r < 16; ++r) kw[r] = *(const GAS v4u*)(PA + (size_t)(r0 + r) * 1536 + 512 + lane * 8);
#pragma unroll
                for (int r = 0; r < 16; ++r) { const v4u w = kw[r];
                    float ss = bfl(w.x) * bfl(w.x) + bfh(w.x) * bfh(w.x) + bfl(w.y) * bfl(w.y) + bfh(w.y) * bfh(w.y) + bfl(w.z) * bfl(w.z) + bfh(w.z) * bfh(w.z) + bfl(w.w) * bfl(w.w) + bfh(w.w) * bfh(w.w);
                    ss += att::swz_xor<1>(ss); ss += att::swz_xor<2>(ss); ss += att::swz_xor<4>(ss); mx = fmaxf(mx, ss); }
                if ((lane & 7) == 0) __hip_atomic_fetch_max(km + (lane >> 3), __float_as_uint(mx), RLX_AGENT);
                VM_WAIT(); __syncthreads();
                if (tid == 0) __hip_atomic_fetch_add(kc, 1u, RLX_AGENT); }
              STAMP(41);
              gu32* ctrA = ctl + CW_Q + ((L * 2 + 0) * 8 + grp) * 64; gu32* ctrC = ctl + CW_Q + ((L * 2 + 1) * 8 + grp) * 64;
              LAS float* const knl = (LAS float*)(lds + RING_OFF + att::A_KN);
              { LAS float* sln = (LAS float*)(lds + RING_OFF + att::A_SLN);
                if (tid < 128) sln[tid] = (diff_subln + L * 128)[tid] * (1.f - lam_init);
                if (tid >= 128 && tid < 136) knl[tid - 128] = INFINITY;
                if (tid == 136) qs[3] = 0; }
              for (int rep_ = 0; rep_ < REPA_A; ++rep_) {
                  if (tid == 0) qs[0] = (int)__hip_atomic_fetch_add(ctrA + rep_ * 8192, 1u, RLX_AGENT);
                  __syncthreads();
                  int u = __builtin_amdgcn_readfirstlane(qs[0]);
                  while (u < 128) {
                      if (qs[3] == 0 && wave == 2) {
                          const unsigned c_ = (unsigned)__builtin_amdgcn_readfirstlane((int)__hip_atomic_load(kc, RLX_AGENT));
                          if (c_ >= 32u) { if (lane < 8) knl[lane] = sqrtf(__uint_as_float(__hip_atomic_load(km + lane, RLX_AGENT))); if (lane == 0) qs[3] = 1; } }
#ifdef PROBE_AMODE
                      if (rep_ != REPA_A - 1) att::diff_unit<PROBE_AMODE>(grp, 3 - (u >> 5), 31 - (u & 31), PA, YA, lam, knl, ctrA + rep_ * 8192, qs, (LAS char*)(lds + RING_OFF), tidp, 0); else
#endif
                      att::diff_unit<0>(grp, 3 - (u >> 5), 31 - (u & 31), PA, YA, lam, knl, ctrA + rep_ * 8192, qs, (LAS char*)(lds + RING_OFF), tidp);
                      asm volatile("s_waitcnt lgkmcnt(0)\n\ts_barrier" ::: "memory");
                      u = __builtin_amdgcn_readfirstlane(qs[0]);
                  }
              }
              __syncthreads();
              STAMP(42);
              for (int rep_ = 0; rep_ < REPA_C; ++rep_) {
                  if (tid == 0) qs[1] = (int)__hip_atomic_fetch_add(ctrC + rep_ * 8192, 1u, RLX_AGENT);
                  __syncthreads();
                  int u = __builtin_amdgcn_readfirstlane(qs[1]);
                  while (u < 128) {
                      att::sb_unit(grp, u & 7, 15 - (u >> 3), PC, YC, ctrC + rep_ * 8192, qs + 1, (LAS char*)(lds + RING_OFF), tidp);
                      u = __builtin_amdgcn_readfirstlane(qs[1]);
                  }
              }
            }
            STAMP(43);
            SEAM();
        }
        if (IN(P + 3)) { PHASE_IDS(); CAT(5);
            att::dil_phase(vcu, PB, BP, BST, (LAS char*)(lds + RING_OFF), tidp);
            SEAM();
        }
        if (IN(P + 4)) { PHASE_IDS(); CAT(6);
            for (int m = gw; m < M; m += NGW) {
                const int hd = lane >> 3; f32x2 st[3]; float mx = -INFINITY;
#pragma unroll
                for (int p = 0; p < 3; ++p) { st[p] = *(const GAS f32x2*)(BST + ((size_t)p * M + m) * 16 + hd * 2); mx = fmaxf(mx, st[p].x); }
                float wgt[3], wsum = 0.f;
#pragma unroll
                for (int p = 0; p < 3; ++p) { wgt[p] = __builtin_amdgcn_exp2f(st[p].x - mx) * st[p].y; wsum += wgt[p]; }
                const float inv = 1.f / wsum; float acc[8];
#pragma unroll
                for (int k = 0; k < 8; ++k) acc[k] = 0.f;
#pragma unroll
                for (int p = 0; p < 3; ++p) { const v4u w = *(const GAS v4u*)(BP + ((size_t)p * M + m) * BW + lane * 8); const float f = wgt[p] * inv;
                    acc[0] += f * bfl(w.x); acc[1] += f * bfh(w.x); acc[2] += f * bfl(w.y); acc[3] += f * bfh(w.y); acc[4] += f * bfl(w.z); acc[5] += f * bfh(w.z); acc[6] += f * bfl(w.w); acc[7] += f * bfh(w.w); }
                v4u o; o.x = pk2(acc[0], acc[1]); o.y = pk2(acc[2], acc[3]); o.z = pk2(acc[4], acc[5]); o.w = pk2(acc[6], acc[7]);
                *(GAS v4u*)(YB + (size_t)m * BW + lane * 8) = o;
            }
            VM_WAIT(); __syncthreads();
            if (GATE_FP8(L)) {
                pg8::Gemm g{(const bf16*)H8, (const bf16*)(Wg8 + (size_t)L * NGATE * D * 2), D / 2}; pg8::StaticOrder S; S.init(M, NGATE, D / 2, G, bx);
                pg8::EpiGate E{GATES, NGATE, b_gate + L * NGATE, pg8::F8_WINV};
                pg8::gemm_phase<pg8::EpiGate, pg8::StaticOrder, true, true, true>(lds + RING_OFF, g, S, E, tidp);
            } else {
                pg8::Gemm g{Hb, Wg_t + (size_t)L * NGATE * D, D}; pg8::StaticOrder S; S.init(M, NGATE, D, G, bx);
                pg8::EpiGate E{GATES, NGATE, b_gate + L * NGATE, 1.f};
                for (int rep_ = 0; rep_ < REPG; ++rep_) { int tq_ = tidp; asm volatile("" : "+v"(tq_)); pg8::gemm_phase<pg8::EpiGate, pg8::StaticOrder, true, true>(lds + RING_OFF, g, S, E, tq_); }
            }

            SEAM();
        }
        if (IN(P + 5)) { PHASE_IDS(); CAT(7);
            pg8::Gemm g{YA, Wb_t + (size_t)L * 3 * D * BW, BW}; pg8::MergeOrder S; S.b.init(M, D, BW, G, bx);
            S.as = (long)(OUT_YB - OUT_YA); S.bs = (long)D * BW * 2;
            pg8::EpiMerge E{GATES, Hb};

 for (int rep_ = 0; rep_ < ((true) ? REPG : 1); ++rep_) { int tq_ = tidp; asm volatile("" : "+v"(tq_));  pg8::gemm_phase<pg8::EpiMerge, pg8::MergeOrder, true, true>(lds + RING_OFF, g, S, E, tq_); }

            SEAM();
        }
        if (IN(P + 6)) { PHASE_IDS(); CAT(8);
            pg8::Gemm g{Hb, Wo_t + (size_t)L * D * D, D}; pg8::StaticOrder S; S.init(M, D, D, G, bx);
            pg8::EpiResB E{(L == 0) ? (const void*)x_in : (const void*)XB, XB, 1.f, L == 0};

 for (int rep_ = 0; rep_ < ((L == 0) ? REPG : 1); ++rep_) { int tq_ = tidp; asm volatile("" : "+v"(tq_));  pg8::gemm_phase<pg8::EpiResB, pg8::StaticOrder, true, true>(lds + RING_OFF, g, S, E, tq_); }

            SEAM();
        }
        if (L == 0) {
            if (IN(P + 7)) { PHASE_IDS(); CAT(9);
                f32x4 g[4];
#pragma unroll
                for (int j = 0; j < 4; ++j) g[j] = ((const GAS f32x4*)(norm_ffn + L * D) + lane)[64 * j];
#if DENSE_FP8
                for (int m = gw; m < M; m += NGW) { f32x4 v[4]; rms_row(XB + (size_t)m * D, g, v, lane); store_row_fp8(Hb8 + (size_t)m * D, v, lane); }
#else
                for (int m = gw; m < M; m += 2 * NGW) { f32x4 v[4], w[4]; rms_row2(XB + (size_t)m * D, XB + (size_t)(m + NGW) * D, g, v, w, lane); store_row_bf16(Hb + (size_t)m * D, v, lane); store_row_bf16(Hb + (size_t)(m + NGW) * D, w, lane); }
#endif
                SEAM();
            }
            if (IN(P + 8)) { PHASE_IDS(); CAT(10);
#if DENSE_FP8
                pg8::Gemm g{(const bf16*)Hb8, (const bf16*)Wgu8, D / 2}; pg8::StaticOrder S; S.init(M, 2 * DFF, D / 2, G, bx);
                pg8::EpiSwigluF8 E{ACT8, DFF};
                for (int rep_ = 0; rep_ < REPG; ++rep_) { int tq_ = tidp; asm volatile("" : "+v"(tq_)); pg8::gemm_phase<pg8::EpiSwigluF8, pg8::StaticOrder, true, true, true>(lds + RING_OFF, g, S, E, tq_); }
#else
                pg8::Gemm g{Hb, Wgu_t, D}; pg8::StaticOrder S; S.init(M, 2 * DFF, D, G, bx);
                pg8::EpiSwiglu E{ACT, DFF};
                for (int rep_ = 0; rep_ < REPG; ++rep_) { int tq_ = tidp; asm volatile("" : "+v"(tq_)); pg8::gemm_phase<pg8::EpiSwiglu, pg8::StaticOrder, true, true>(lds + RING_OFF, g, S, E, tq_); }
#endif

                SEAM();
            }
            if (IN(P + 9)) { PHASE_IDS(); CAT(11);
#if DENSE_FP8
                pg8::EpiResB E{XB, XB, pg8::F8_WINV, 0};
                pg8::Gemm g{(const bf16*)ACT8, (const bf16*)Wd8, DFF / 2}; pg8::StaticOrder S; S.init(M, D, DFF / 2, G, bx);
                pg8::gemm_phase<pg8::EpiResB, pg8::StaticOrder, true, true, true>(lds + RING_OFF, g, S, E, tidp);
#else
                pg8::EpiResB E{XB, XB, 1.f, 0};
                pg8::Gemm g{ACT, Wd_t, DFF}; pg8::StaticOrder S; S.init(M, D, DFF, G, bx);
                pg8::gemm_phase<pg8::EpiResB, pg8::StaticOrder, true, true>(lds + RING_OFF, g, S, E, tidp);
#endif

                SEAM();
            }
        } else {
            if (IN(P + 7)) { PHASE_IDS(); CAT(12);
                LAS float* wr = (LAS float*)(lds + RING_OFF);
                LAS int* cl = (LAS int*)(lds + RING_OFF + 32768);
                for (int u = tid; u < D * NEXP; u += NWAVES * 64) wr[(u & 7) * D + (u >> 3)] = w_router[u];
                if (tid < NEXP) cl[tid] = 0;
                __syncthreads();
                f32x4 g[4];
#pragma unroll
                for (int j = 0; j < 4; ++j) g[j] = ((const GAS f32x4*)(norm_ffn + L * D) + lane)[64 * j];
                for (int k = 0; k < 16; ++k) { const int m = bx * 128 + wave + 8 * k;
                    f32x4 v[4]; rms_row(XB + (size_t)m * D, g, v, lane);
#if FFN_FP8
                    store_row_fp8(Hb8 + (size_t)m * D, v, lane);
#else
                    store_row_bf16(Hb + (size_t)m * D, v, lane);
#endif
                    float lg[NEXP];
#pragma unroll
                    for (int e = 0; e < NEXP; ++e) lg[e] = 0.f;
#pragma unroll
                    for (int j = 0; j < 4; ++j)
#pragma unroll
                        for (int e = 0; e < NEXP; ++e) { const f32x4 w4 = *(const LAS f32x4*)(wr + e * D + 4 * lane + 256 * j); lg[e] += (v[j].x * w4.x + v[j].y * w4.y) + (v[j].z * w4.z + v[j].w * w4.w); }
#pragma unroll
                    for (int e = 0; e < NEXP; ++e) lg[e] = wave_sum(lg[e]);
                    int e1 = 0; float v1 = lg[0];
#pragma unroll
                    for (int e = 1; e < NEXP; ++e) if (lg[e] > v1) { v1 = lg[e]; e1 = e; }
                    int e2 = -1; float v2 = -INFINITY;
#pragma unroll
                    for (int e = 0; e < NEXP; ++e) if (e != e1 && lg[e] > v2) { v2 = lg[e]; e2 = e; }
                    const float w1 = 1.f / (1.f + expf(v2 - v1));
                    if (lane == 0) { TOKE[m] = e1 | (e2 << 8); TOKW[2 * m] = w1; TOKW[2 * m + 1] = 1.f - w1; __hip_atomic_fetch_add(cl + e1, 1, __ATOMIC_RELAXED, __HIP_MEMORY_SCOPE_WORKGROUP); __hip_atomic_fetch_add(cl + e2, 1, __ATOMIC_RELAXED, __HIP_MEMORY_SCOPE_WORKGROUP); }
                }
                __syncthreads();
                if (tid < NEXP) CNT[bx * NEXP + tid] = cl[tid];
                __syncthreads();
                for (int e = 0; e < NEXP; ++e) {
#if FFN_FP8
                    conv_matrix8(w_mg + (size_t)e * D * DFX, D, DFX, MWgu8 + (size_t)e * 2 * DFX * D, 1, scr, gw, NGW, lane);
                    conv_matrix8(w_mu + (size_t)e * D * DFX, D, DFX, MWgu8 + (size_t)e * 2 * DFX * D, 2, scr, gw, NGW, lane);
                    conv_matrix8(w_md + (size_t)e * DFX * D, DFX, D, MWd8 + (size_t)e * D * DFX, 0, scr, gw, NGW, lane);
#else
                    conv_matrix(w_mg + (size_t)e * D * DFX, D, DFX, MWgu + (size_t)e * 2 * DFX * D, 1, scr, gw, NGW, lane);
                    conv_matrix(w_mu + (size_t)e * D * DFX, D, DFX, MWgu + (size_t)e * 2 * DFX * D, 2, scr, gw, NGW, lane);
                    conv_matrix(w_md + (size_t)e * DFX * D, DFX, D, MWd + (size_t)e * D * DFX, 0, scr, gw, NGW, lane);
#endif
                }
                SEAM();
            }
            if (IN(P + 8)) { PHASE_IDS(); CAT(13);
                LAS int* C = (LAS int*)(lds + RING_OFF);
                LAS int* TB = (LAS int*)(lds + RING_OFF + 8192);
                LAS int* SL = (LAS int*)(lds + RING_OFF + 8192 + 256);
                for (int u = tid; u < 256 * NEXP; u += NWAVES * 64) C[u] = CNT[u];
                __syncthreads();
                { const int e = wave; int tot = 0, pre = 0;
#pragma unroll
                  for (int q = 0; q < 4; ++q) { const int i = 4 * lane + q; const int cv = C[i * NEXP + e]; tot += cv; pre += (i < bx) ? cv : 0; }
                  tot = wave_sum_i(tot); pre = wave_sum_i(pre);
                  if (lane == 0) { TB[e] = pre; TB[8 + e] = tot; } }
                __syncthreads();
                if (tid == 0) { int base = 0, cum = 0;
                    for (int e = 0; e < NEXP; ++e) { TB[16 + e] = base; const int nt = (TB[8 + e] + 255) >> 8; base += nt * 256; cum += nt; if (bx == 0) MHDR[1 + e] = cum; }
                    if (bx == 0) MHDR[0] = cum; }
                __syncthreads();
                if (wave == 0) {
                    const int t0 = bx * 128 + 2 * lane; const int ea = TOKE[t0], eb = TOKE[t0 + 1];
                    int pe[4] = {ea & 255, ea >> 8, eb & 255, eb >> 8}; int slot[4] = {0, 0, 0, 0};
#pragma unroll
                    for (int e = 0; e < NEXP; ++e) { int mine = 0;
#pragma unroll
                        for (int q = 0; q < 4; ++q) mine += (pe[q] == e) ? 1 : 0;
                        int inc = mine;
#pragma unroll
                        for (int o = 1; o < 64; o <<= 1) { const int t = __builtin_amdgcn_ds_bpermute(((lane - o) & 63) << 2, inc); if (lane >= o) inc += t; }
                        int run = TB[16 + e] + TB[e] + inc - mine;
#pragma unroll
                        for (int q = 0; q < 4; ++q) if (pe[q] == e) { slot[q] = run; ++run; } }
                    const f32x4 wv = *(const GAS f32x4*)(TOKW + 2 * t0);
                    SL[4 * lane + 0] = slot[0]; SL[4 * lane + 1] = slot[1]; SL[4 * lane + 2] = slot[2]; SL[4 * lane + 3] = slot[3];
                    { v4u sv; sv.x = (unsigned)slot[0]; sv.y = (unsigned)slot[1]; sv.z = (unsigned)slot[2]; sv.w = (unsigned)slot[3]; *(GAS v4u*)(SLOT + 2 * t0) = sv; }
                    SLW[slot[0]] = wv.x; SLW[slot[1]] = wv.y; SLW[slot[2]] = wv.z; SLW[slot[3]] = wv.w;
                }
                __syncthreads();
                for (int k = 0; k < 16; ++k) { const int tl = wave + 8 * k; const int m = bx * 128 + tl; const int s0 = SL[2 * tl], s1 = SL[2 * tl + 1];
#if FFN_FP8
                    const v4u a = ((const GAS v4u*)(Hb8 + (size_t)m * D))[lane];
                    ((GAS v4u*)(HS8 + (size_t)s0 * D))[lane] = a; ((GAS v4u*)(HS8 + (size_t)s1 * D))[lane] = a; }
#else
                    const GAS v4u* src = (const GAS v4u*)(Hb + (size_t)m * D) + lane; const v4u a = src[0], b = src[64];
                    GAS v4u* d0 = (GAS v4u*)(HS + (size_t)s0 * D) + lane; GAS v4u* d1 = (GAS v4u*)(HS + (size_t)s1 * D) + lane;
                    d0[0] = a; d0[64] = b; d1[0] = a; d1[64] = b; }
#endif
                SEAM();
            }
            {
                int nt_all = 0, c0 = 0, c1 = 0, c2 = 0, c3 = 0, c4 = 0, c5 = 0, c6 = 0;
                if (hi > P + 9 && lo < P + 19) { const int* hd = MHDR;
                    nt_all = __builtin_amdgcn_readfirstlane(hd[0]); c0 = __builtin_amdgcn_readfirstlane(hd[1]); c1 = __builtin_amdgcn_readfirstlane(hd[2]); c2 = __builtin_amdgcn_readfirstlane(hd[3]);
                    c3 = __builtin_amdgcn_readfirstlane(hd[4]); c4 = __builtin_amdgcn_readfirstlane(hd[5]); c5 = __builtin_amdgcn_readfirstlane(hd[6]); c6 = __builtin_amdgcn_readfirstlane(hd[7]); }
                if (nt_all > MOE_MAX_TILES) nt_all = MOE_MAX_TILES;
                for (int ch = 0; ch < MOE_MAX_CH; ++ch) {
                    const int t0 = ch * MOE_CH_TILES; int nt = nt_all - t0; if (nt > MOE_CH_TILES) nt = MOE_CH_TILES;
                    if (nt <= 0) break;
                    if (IN(P + 9 + 2 * ch)) { PHASE_IDS(); CAT(14);
#if FFN_FP8
                        pg8::Gemm g{(const bf16*)HS8, (const bf16*)MWgu8, D / 2}; pg8::MoeOrder S{t0, nt, 2 * DFX / 256, nt * (2 * DFX / 256), G, bx, (long)256 * D, (long)256 * D, (long)2 * DFX * D, c0, c1, c2, c3, c4, c5, c6, false, true};
                        pg8::EpiSwigluF8 E{MACT8, DFX};
                        pg8::gemm_phase<pg8::EpiSwigluF8, pg8::MoeOrder, true, true, true>(lds + RING_OFF, g, S, E, tidp);
#else
                        pg8::Gemm g{HS, MWgu, D}; pg8::MoeOrder S{t0, nt, 2 * DFX / 256, nt * (2 * DFX / 256), G, bx, (long)256 * D * 2, (long)256 * D * 2, (long)2 * DFX * D * 2, c0, c1, c2, c3, c4, c5, c6, false, true};
                        pg8::EpiSwiglu E{MACT, DFX};
                        pg8::gemm_phase<pg8::EpiSwiglu, pg8::MoeOrder, true, true>(lds + RING_OFF, g, S, E, tidp);
#endif

                        SEAM();
                    }
                    if (IN(P + 10 + 2 * ch)) { PHASE_IDS(); CAT(15);
#if FFN_FP8
                        pg8::Gemm g{(const bf16*)MACT8, (const bf16*)MWd8, DFX / 2}; pg8::MoeOrder S{t0, nt, D / 256, nt * (D / 256), G, bx, (long)256 * DFX, (long)256 * DFX, (long)D * DFX, c0, c1, c2, c3, c4, c5, c6, true, false};
                        pg8::EpiMoeDown E{YS8, SLW, pg8::F8_WINV};
                        pg8::gemm_phase<pg8::EpiMoeDown, pg8::MoeOrder, true, true, true>(lds + RING_OFF, g, S, E, tidp);
#else
                        pg8::Gemm g{MACT, MWd, DFX}; pg8::MoeOrder S{t0, nt, D / 256, nt * (D / 256), G, bx, (long)256 * DFX * 2, (long)256 * DFX * 2, (long)D * DFX * 2, c0, c1, c2, c3, c4, c5, c6, true, false};
                        pg8::EpiMoeDown E{HS, SLW, 1.f};
                        pg8::gemm_phase<pg8::EpiMoeDown, pg8::MoeOrder, true, true>(lds + RING_OFF, g, S, E, tidp);
#endif

                        SEAM();
                    }
                }
            }
            if (IN(P + 19)) { PHASE_IDS();
                f32x4 g[4];
#pragma unroll
                for (int j = 0; j < 4; ++j) g[j] = ((const GAS f32x4*)norm_final + lane)[64 * j];
                unsigned bad = 0u;
#if MK_N_LAUNCHES == 1
                bad = __hip_atomic_load(ctl + CW_BAR + XB_TMO, RLX_AGENT);
#endif
#ifdef PROBE_CAT
                CAT(16);
#endif
#if FFN_FP8
                const bf16* const ysb = YS8;
#else
                const bf16* const ysb = HS;
#endif
                for (int m = gw; m < M; m += 2 * NGW) {
                    const int ma = m, mb = m + NGW;
                    const v4u sl = (v4u){(unsigned)SLOT[2 * ma], (unsigned)SLOT[2 * ma + 1], (unsigned)SLOT[2 * mb], (unsigned)SLOT[2 * mb + 1]};
                    const GAS v2u* xa = (const GAS v2u*)(XB + (size_t)ma * D) + lane; const GAS v2u* xb = (const GAS v2u*)(XB + (size_t)mb * D) + lane;
                    const GAS v2u* a0 = (const GAS v2u*)(ysb + (size_t)sl.x * D) + lane; const GAS v2u* a1 = (const GAS v2u*)(ysb + (size_t)sl.y * D) + lane;
                    const GAS v2u* b0 = (const GAS v2u*)(ysb + (size_t)sl.z * D) + lane; const GAS v2u* b1 = (const GAS v2u*)(ysb + (size_t)sl.w * D) + lane;
                    f32x4 va[4], vb[4]; v2u xa4[4], xb4[4], pa0[4], pa1[4], pb0[4], pb1[4];
#pragma unroll
                    for (int j = 0; j < 4; ++j) { xa4[j] = xa[64 * j]; xb4[j] = xb[64 * j]; pa0[j] = a0[64 * j]; pa1[j] = a1[64 * j]; pb0[j] = b0[64 * j]; pb1[j] = b1[64 * j]; }
                    float sa = 0.f, sb = 0.f;
#pragma unroll
                    for (int j = 0; j < 4; ++j) { va[j] = bf4(xa4[j]); vb[j] = bf4(xb4[j]);
                        va[j].x += bfl(pa0[j].x) + bfl(pa1[j].x); va[j].y += bfh(pa0[j].x) + bfh(pa1[j].x); va[j].z += bfl(pa0[j].y) + bfl(pa1[j].y); va[j].w += bfh(pa0[j].y) + bfh(pa1[j].y);
                        vb[j].x += bfl(pb0[j].x) + bfl(pb1[j].x); vb[j].y += bfh(pb0[j].x) + bfh(pb1[j].x); vb[j].z += bfl(pb0[j].y) + bfl(pb1[j].y); vb[j].w += bfh(pb0[j].y) + bfh(pb1[j].y);
                        sa += (va[j].x * va[j].x + va[j].y * va[j].y) + (va[j].z * va[j].z + va[j].w * va[j].w); sb += (vb[j].x * vb[j].x + vb[j].y * vb[j].y) + (vb[j].z * vb[j].z + vb[j].w * vb[j].w); }
                    const float ra = 1.f / sqrtf(wave_sum(sa) * (1.f / D) + EPS), rb = 1.f / sqrtf(wave_sum(sb) * (1.f / D) + EPS);
                    GAS f32x4* oa = (GAS f32x4*)(xout + (size_t)ma * D) + lane; GAS f32x4* ob = (GAS f32x4*)(xout + (size_t)mb * D) + lane;
                    const float q = __builtin_nanf("");
#pragma unroll
                    for (int j = 0; j < 4; ++j) { f32x4 o = va[j] * ra * g[j], p = vb[j] * rb * g[j]; if (bad) { o = (f32x4){q, q, q, q}; p = o; } oa[64 * j] = o; ob[64 * j] = p; }
                }
#ifdef PROBE_CAT
                if (bx == 0 && tid == 0) { { const unsigned long long tn_ = __builtin_amdgcn_s_memrealtime(); volatile LAS unsigned* pa_ = (volatile LAS unsigned*)(lds + LDSCTL_OFF + 640); if (cat_ == PROBE_CAT) pa_[0] += (unsigned)(tn_ - *(volatile LAS unsigned long long*)(lds + LDSCTL_OFF + 704)); } const unsigned ticks = *(volatile LAS unsigned*)(lds + LDSCTL_OFF + 640); const unsigned long long te_ = __builtin_amdgcn_s_memrealtime(); const unsigned long long tw_ = (unsigned long long)ticks * PROBE_AMP; while (__builtin_amdgcn_s_memrealtime() - te_ < (tw_ < 5000000ull ? tw_ : 5000000ull)) __builtin_amdgcn_s_sleep(8); }
#endif
            }
        }
    }
#undef IN
#undef SEAM
}

extern "C" void kernel_launch(void* const* d_in, const int* in_sizes, int n_in, void* d_out, int out_size, void* d_ws, size_t ws_size, hipStream_t stream) {
    static int grid = 0;
    if (grid == 0) {
        if (n_in != 18 || in_sizes[0] != M * D || out_size != M * D || ws_size < WS_END) { fprintf(stderr, "kernel_launch: unexpected shapes (n_in %d, in0 %d, out %d, ws %zu < %zu); nothing launched\n", n_in, n_in > 0 ? in_sizes[0] : -1, out_size, ws_size, (size_t)WS_END); grid = -1; return; }
        int dev = 0, cus = 0, per_cu = 0;
        if (hipGetDevice(&dev) != hipSuccess || hipDeviceGetAttribute(&cus, hipDeviceAttributeMultiprocessorCount, dev) != hipSuccess) { grid = -1; return; }
        if (hipFuncSetAttribute((const void*)mega_fwd, hipFuncAttributeMaxDynamicSharedMemorySize, LDS_BYTES) != hipSuccess) { fprintf(stderr, "kernel_launch: hipFuncSetAttribute failed\n"); grid = -1; return; }
        if (hipOccupancyMaxActiveBlocksPerMultiprocessor(&per_cu, (const void*)mega_fwd, NWAVES * 64, LDS_BYTES) != hipSuccess || per_cu < 1) fprintf(stderr, "kernel_launch: occupancy query reports %d workgroups per CU\n", per_cu);
        (void)hipGetLastError();
        grid = cus;
        if (grid != 256) { fprintf(stderr, "kernel_launch: built for 256 CUs, device has %d; nothing launched\n", cus); grid = -1; return; }
    }
    if (grid < 0) return;
    if (hipMemsetAsync((char*)d_ws + WS_CTL, 0, CTL_ZERO_BYTES, stream) != hipSuccess) return;
    Args a{};
    for (int i = 0; i < 18; ++i) a.in[i] = (const float*)d_in[i];
    a.out = (float*)d_out; a.ws = (unsigned char*)d_ws;
#if MK_N_LAUNCHES == 1
    a.ph_lo = 0; a.ph_hi = NPHASE;
    hipLaunchKernelGGL(mega_fwd, dim3(grid), dim3(NWAVES * 64), LDS_BYTES, stream, a);
#else
    for (int p = 0; p < NPHASE; ++p) {
        const int r = (p - 1) % PH_L, L = (p - 1) / PH_L;
        if (p > 0 && L == 0 && r >= 10) continue;
        a.ph_lo = p; a.ph_hi = p + 1;
        hipLaunchKernelGGL(mega_fwd, dim3(grid), dim3(NWAVES * 64), LDS_BYTES, stream, a);
    }
#endif
}
```

```cpp
#include <hip/hip_runtime.h>
#include <cstdio>
#include <cstdint>

#ifndef MK_N_LAUNCHES
#define MK_N_LAUNCHES 1
#endif

namespace pg8 {
#define PG8_LAS __attribute__((address_space(3)))
typedef unsigned short bf16_t;
typedef short bf16x8 __attribute__((ext_vector_type(8)));
typedef float f32x4 __attribute__((ext_vector_type(4)));
typedef float f32x2 __attribute__((ext_vector_type(2)));
typedef unsigned u32x4 __attribute__((ext_vector_type(4)));
typedef int v8i32 __attribute__((ext_vector_type(8)));
typedef unsigned u32x2 __attribute__((ext_vector_type(2)));
constexpr int F8_WSHIFT = 6;
constexpr float F8_WINV = 1.f / (float)(1 << F8_WSHIFT);
constexpr int BM = 256, BK = 64, HALF = 128, HTB = HALF * BK * 2  , STAGE_BYTES = 8 * HTB, NXCD = 8, WGM = 8;

__host__ __device__ __forceinline__ int lds_byte(int r, int c) { const int st = (r >> 4) * 2 + (c >> 5), rr = r & 15, cc = c & 31, ob = rr * 64 + cc * 2; return st * 1024 + (ob ^ (((ob >> 9) & 1) << 5)); }
__host__ __device__ __forceinline__ void stage_rc(int b, int& R, int& C) { const int st = b / 1024, sb = b % 1024, swz = sb ^ (((sb >> 9) & 1) << 5); R = (st >> 1) * 16 + swz / 64; C = (st & 1) * 32 + (swz % 64) / 2; }
__host__ __device__ __forceinline__ int perm32(int rho) { const int n = rho >> 4, i = rho & 15; return 8 * (i >> 2) + 4 * n + (i & 3); }

struct Unit { int pm, pn, om, tag; long ao, bo; };
struct Gemm { const bf16_t* A; const bf16_t* Bt; int K; int kt = 0; };

__device__ __forceinline__ void tile_of(int wgid, int nwg, int nM, int nN, int& pm, int& pn) {
    { const int q = nwg / NXCD, r = nwg % NXCD, xcd = wgid % NXCD, off = wgid / NXCD; wgid = (xcd < r ? xcd * (q + 1) : r * (q + 1) + (xcd - r) * q) + off; }
    const int nig = WGM * nN, gid = wgid / nig, fm = gid * WGM, gsz = (nM - fm) < WGM ? (nM - fm) : WGM;
    pm = fm + ((wgid % nig) % gsz); pn = (wgid % nig) / gsz;
}
struct StaticOrder {
    int nM, nN, nwg, G, c; long tst;
    __device__ void init(int M, int N, int K, int G_, int c_) { nM = M / BM; nN = N / BM; nwg = nM * nN; G = G_; c = c_; tst = (long)BM * K * 2; }
    __device__ __forceinline__ bool next(int i, Unit& u) const {
        const long L = (long)i * G + c; if (L >= nwg) return false;
        tile_of((int)L, nwg, nM, nN, u.pm, u.pn); u.om = u.pm; u.tag = 0; u.ao = (long)u.pm * tst; u.bo = (long)u.pn * tst; return true;
    }
    __device__ __forceinline__ void a_ready(const Unit&) const {}
    __device__ __forceinline__ void done(const Unit&) const {}
};
struct MergeOrder {
    StaticOrder b; long as, bs;
    __device__ __forceinline__ bool next(int i, Unit& u) const {
        const int ti = i / 3, tg = i - 3 * ti; if (!b.next(ti, u)) return false;
        u.tag = tg; u.ao += (long)tg * as; u.bo += (long)tg * bs; return true;
    }
    __device__ __forceinline__ void a_ready(const Unit&) const {}
    __device__ __forceinline__ void done(const Unit&) const {}
};
struct MoeOrder {
    int t0, nt, nN, nwg, G, c; long tA, tB, eB; int c0, c1, c2, c3, c4, c5, c6; bool a_local, o_local;
    __device__ __forceinline__ bool next(int i, Unit& u) const {
        const long L = (long)i * G + c; if (L >= nwg) return false;
        int pl, pn; tile_of((int)L, nwg, nt, nN, pl, pn);
        const int gt = t0 + pl; const int e = (gt >= c0) + (gt >= c1) + (gt >= c2) + (gt >= c3) + (gt >= c4) + (gt >= c5) + (gt >= c6);
        u.pm = gt; u.pn = pn; u.tag = e; u.om = o_local ? pl : gt; u.ao = (long)(a_local ? pl : gt) * tA; u.bo = (long)e * eB + (long)pn * tB; return true;
    }
    __device__ __forceinline__ void a_ready(const Unit&) const {}
    __device__ __forceinline__ void done(const Unit&) const {}
};

struct MoeOrderSK {
    int t0, nt, nN, ns, nwg, G, c; long tA, tB, eB, ks; int c0, c1, c2, c3, c4, c5, c6;
    __device__ __forceinline__ bool next(int i, Unit& u) const {
        const long L = (long)i * G + c; if (L >= nwg) return false;
        const int s = (int)(L % ns), L2 = (int)(L / ns); const int pl = L2 / nN, pn = L2 - pl * nN;
        const int gt = t0 + pl; const int e = (gt >= c0) + (gt >= c1) + (gt >= c2) + (gt >= c3) + (gt >= c4) + (gt >= c5) + (gt >= c6);
        u.pm = gt; u.pn = pn; u.tag = s; u.om = pl; u.ao = (long)pl * tA + (long)s * ks; u.bo = (long)e * eB + (long)pn * tB + (long)s * ks; return true;
    }
    __device__ __forceinline__ void a_ready(const Unit&) const {}
    __device__ __forceinline__ void done(const Unit&) const {}
};

typedef __bf16 bf16x2_t __attribute__((ext_vector_type(2)));
__device__ __forceinline__ unsigned cvt_pk_bf16(float lo, float hi) { f32x2 v = {lo, hi}; bf16x2_t b = __builtin_convertvector(v, bf16x2_t); return __builtin_bit_cast(unsigned, b); }
__device__ __forceinline__ float bf_lo(unsigned w) { return __uint_as_float(w << 16); }
__device__ __forceinline__ float bf_hi(unsigned w) { return __uint_as_float(w & 0xffff0000u); }
__device__ __forceinline__ float sigm(float x) { return __builtin_amdgcn_rcpf(1.0f + __builtin_amdgcn_exp2f(-1.4426950408889634f * x)); }
__device__ __forceinline__ u32x4 pack8(f32x4 v0, f32x4 v1) { u32x4 w; w.x = cvt_pk_bf16(v0[0], v0[1]); w.y = cvt_pk_bf16(v0[2], v0[3]); w.z = cvt_pk_bf16(v1[0], v1[1]); w.w = cvt_pk_bf16(v1[2], v1[3]); return w; }

struct EpiProj {
    static constexpr bool PERM = true, AFTER_DRAIN = false;
    bf16_t* O; size_t split_stride; float qscale, wscale;
    __device__ __forceinline__ void operator()(const f32x4 (&acc)[2][2][4][2], const Unit& u, int wr, int wc, int fr, int fq) const {
        const int t = u.pn / 6, lt = u.pn - 6 * t; bf16_t* base = O + (size_t)t * split_stride; const float sc = (lt < 2 ? qscale : 1.f) * wscale;
        const int row0 = u.om * BM + wr * 64 + fr, col0 = lt * BM + wc * 32 + 8 * fq;
        if (t == 1) {
#pragma unroll
            for (int ai = 0; ai < 2; ++ai)
#pragma unroll
                for (int m = 0; m < 4; ++m) { const int row = row0 + ai * HALF + m * 16;
#pragma unroll
                    for (int bj = 0; bj < 2; ++bj) { const int lc = col0 + bj * HALF; bf16_t* p;
                        if (lt < 2) p = base + (size_t)row * 512 + lc;
                        else { const int l2 = lc & 511, hd = l2 >> 6, d = l2 & 63; p = base + (size_t)(lt < 4 ? 1 : 2) * ((size_t)32768 * 512) + ((size_t)((row >> 12) * 8 + hd) * 4096 + (row & 4095)) * 64 + d; }
                        *(u32x4*)p = pack8(acc[ai][bj][m][0] * sc, acc[ai][bj][m][1] * sc); } }
            return; }
#pragma unroll
        for (int ai = 0; ai < 2; ++ai)
#pragma unroll
            for (int m = 0; m < 4; ++m) { bf16_t* rowp = base + (size_t)(row0 + ai * HALF + m * 16) * 1536 + col0;
#pragma unroll
                for (int bj = 0; bj < 2; ++bj) *(u32x4*)(rowp + bj * HALF) = pack8(acc[ai][bj][m][0] * sc, acc[ai][bj][m][1] * sc); }
    }
};
__device__ __forceinline__ unsigned pack_un8(const f32x4 v) { const unsigned a = (unsigned)(v[0] * 255.f + 0.5f), b = (unsigned)(v[1] * 255.f + 0.5f), c = (unsigned)(v[2] * 255.f + 0.5f), d = (unsigned)(v[3] * 255.f + 0.5f); return a | (b << 8) | (c << 16) | (d << 24); }
struct EpiGate {
    static constexpr bool PERM = true, AFTER_DRAIN = false;
    unsigned char* O; int ldc; const float* bias; float wscale;
    __device__ __forceinline__ void operator()(const f32x4 (&acc)[2][2][4][2], const Unit& u, int wr, int wc, int fr, int fq) const {
        const int row0 = u.om * BM + wr * 64 + fr, col0 = u.pn * BM + wc * 32 + 8 * fq;
        f32x4 bv[2][2];
#pragma unroll
        for (int bj = 0; bj < 2; ++bj)
#pragma unroll
            for (int n = 0; n < 2; ++n) bv[bj][n] = *(const f32x4*)(bias + col0 + bj * HALF + 4 * n) * -1.4426950408889634f;
        const float ws2 = wscale * -1.4426950408889634f;
#pragma unroll
        for (int ai = 0; ai < 2; ++ai)
#pragma unroll
            for (int m = 0; m < 4; ++m) { unsigned char* rowp = O + (size_t)(row0 + ai * HALF + m * 16) * ldc + col0;
#pragma unroll
                for (int bj = 0; bj < 2; ++bj) { f32x4 v0 = acc[ai][bj][m][0] * ws2 + bv[bj][0], v1 = acc[ai][bj][m][1] * ws2 + bv[bj][1];
#pragma unroll
                    for (int i = 0; i < 4; ++i) { v0[i] = __builtin_amdgcn_rcpf(1.0f + __builtin_amdgcn_exp2f(v0[i])); v1[i] = __builtin_amdgcn_rcpf(1.0f + __builtin_amdgcn_exp2f(v1[i])); }
                    u32x2 w8; w8.x = pack_un8(v0); w8.y = pack_un8(v1); *(u32x2*)(rowp + bj * HALF) = w8; } }
    }
};
struct EpiMerge {
    static constexpr bool PERM = true, AFTER_DRAIN = false;
    const unsigned char* gates; bf16_t* O;
    __device__ __forceinline__ void operator()(const f32x4 (&acc)[2][2][4][2], const Unit& u, int wr, int wc, int fr, int fq) const {
        const int row0 = u.om * BM + wr * 64 + fr, col0 = u.pn * BM + wc * 32 + 8 * fq; const int tg = u.tag;
        const unsigned char* const gp = gates + (size_t)tg * 1024 + col0; bf16_t* const op0 = O + col0;
        u32x2 gwa[2][4][2];
#pragma unroll
        for (int ai = 0; ai < 2; ++ai)
#pragma unroll
            for (int m = 0; m < 4; ++m)
#pragma unroll
                for (int bj = 0; bj < 2; ++bj) gwa[ai][m][bj] = *(const u32x2*)(gp + (size_t)(row0 + ai * HALF + m * 16) * 3072 + bj * HALF);
#pragma unroll
        for (int ai = 0; ai < 2; ++ai) {
            u32x2 gw[4][2]; u32x4 ow[4][2];
#pragma unroll
            for (int m = 0; m < 4; ++m)
#pragma unroll
                for (int bj = 0; bj < 2; ++bj) { const size_t row = (size_t)(row0 + ai * HALF + m * 16);
                    gw[m][bj] = gwa[ai][m][bj];
                    ow[m][bj] = (tg != 0) ? *(const u32x4*)(op0 + row * 1024 + bj * HALF) : (u32x4){0u, 0u, 0u, 0u}; }
#pragma unroll
            for (int m = 0; m < 4; ++m)
#pragma unroll
                for (int bj = 0; bj < 2; ++bj) { const size_t row = (size_t)(row0 + ai * HALF + m * 16); const u32x2 g = gw[m][bj]; const u32x4 w = ow[m][bj]; constexpr float I255 = 1.f / 255.f;
                    f32x4 v0 = acc[ai][bj][m][0] * I255, v1 = acc[ai][bj][m][1] * I255;
                    v0[0] = v0[0] * (float)(g.x & 0xffu) + bf_lo(w.x); v0[1] = v0[1] * (float)((g.x >> 8) & 0xffu) + bf_hi(w.x); v0[2] = v0[2] * (float)((g.x >> 16) & 0xffu) + bf_lo(w.y); v0[3] = v0[3] * (float)(g.x >> 24) + bf_hi(w.y);
                    v1[0] = v1[0] * (float)(g.y & 0xffu) + bf_lo(w.z); v1[1] = v1[1] * (float)((g.y >> 8) & 0xffu) + bf_hi(w.z); v1[2] = v1[2] * (float)((g.y >> 16) & 0xffu) + bf_lo(w.w); v1[3] = v1[3] * (float)(g.y >> 24) + bf_hi(w.w);
                    *(u32x4*)(op0 + row * 1024 + bj * HALF) = pack8(v0, v1); }
            asm volatile("" ::: "memory"); }
    }
};
struct EpiRes {
    static constexpr bool PERM = false, AFTER_DRAIN = false;
    const float* base; float* out; float sc;
    __device__ __forceinline__ void operator()(const f32x4 (&acc)[2][2][4][2], const Unit& u, int wr, int wc, int fr, int fq) const {
        const int row0 = u.om * BM + wr * 64 + fr, col0 = u.pn * BM + wc * 32 + 4 * fq;
#pragma unroll
        for (int ai = 0; ai < 2; ++ai)
#pragma unroll
            for (int m = 0; m < 4; ++m) { const size_t off = (size_t)(row0 + ai * HALF + m * 16) * 1024 + col0;
#pragma unroll
                for (int bj = 0; bj < 2; ++bj)
#pragma unroll
                    for (int n = 0; n < 2; ++n) { const f32x4 bs = *(const f32x4*)(base + off + bj * HALF + n * 16); *(f32x4*)(out + off + bj * HALF + n * 16) = bs + acc[ai][bj][m][n] * sc; } }
    }
};
struct EpiResB {
    static constexpr bool PERM = true, AFTER_DRAIN = false;
    const void* base; bf16_t* out; float sc; int base_f32;
    __device__ __forceinline__ void operator()(const f32x4 (&acc)[2][2][4][2], const Unit& u, int wr, int wc, int fr, int fq) const {
        const int row0 = u.om * BM + wr * 64 + fr, col0 = u.pn * BM + wc * 32 + 8 * fq;
        if (base_f32) { const float* bp = (const float*)base;
#pragma unroll
            for (int ai = 0; ai < 2; ++ai) { f32x4 b0[4][2], b1[4][2];
#pragma unroll
                for (int m = 0; m < 4; ++m)
#pragma unroll
                    for (int bj = 0; bj < 2; ++bj) { const size_t off = (size_t)(row0 + ai * HALF + m * 16) * 1024 + col0 + bj * HALF; b0[m][bj] = *(const f32x4*)(bp + off); b1[m][bj] = *(const f32x4*)(bp + off + 4); }
#pragma unroll
                for (int m = 0; m < 4; ++m)
#pragma unroll
                    for (int bj = 0; bj < 2; ++bj) { const size_t off = (size_t)(row0 + ai * HALF + m * 16) * 1024 + col0 + bj * HALF;
                        *(u32x4*)(out + off) = pack8(b0[m][bj] + acc[ai][bj][m][0] * sc, b1[m][bj] + acc[ai][bj][m][1] * sc); }
                asm volatile("" ::: "memory"); }
        } else { const bf16_t* bp = (const bf16_t*)base;
#pragma unroll
            for (int ai = 0; ai < 2; ++ai) { u32x4 wv[4][2];
#pragma unroll
                for (int m = 0; m < 4; ++m)
#pragma unroll
                    for (int bj = 0; bj < 2; ++bj) wv[m][bj] = *(const u32x4*)(bp + (size_t)(row0 + ai * HALF + m * 16) * 1024 + col0 + bj * HALF);
#pragma unroll
                for (int m = 0; m < 4; ++m)
#pragma unroll
                    for (int bj = 0; bj < 2; ++bj) { const size_t off = (size_t)(row0 + ai * HALF + m * 16) * 1024 + col0 + bj * HALF; const u32x4 w = wv[m][bj];
                        const f32x4 b0 = {__uint_as_float(w.x << 16), __uint_as_float(w.x & 0xffff0000u), __uint_as_float(w.y << 16), __uint_as_float(w.y & 0xffff0000u)};
                        const f32x4 b1 = {__uint_as_float(w.z << 16), __uint_as_float(w.z & 0xffff0000u), __uint_as_float(w.w << 16), __uint_as_float(w.w & 0xffff0000u)};
                        *(u32x4*)(out + off) = pack8(b0 + acc[ai][bj][m][0] * sc, b1 + acc[ai][bj][m][1] * sc); }
                asm volatile("" ::: "memory"); }
        }
    }
};
struct EpiMoeDownPart {
    static constexpr bool PERM = true, AFTER_DRAIN = false;
    float* O; const float* w; float scale; int row_base, rows;
    __device__ __forceinline__ void operator()(const f32x4 (&acc)[2][2][4][2], const Unit& u, int wr, int wc, int fr, int fq) const {
        const int row0 = u.om * BM + wr * 64 + fr, col0 = u.pn * BM + wc * 32 + 8 * fq;
        float rw[2][4];
#pragma unroll
        for (int ai = 0; ai < 2; ++ai)
#pragma unroll
            for (int m = 0; m < 4; ++m) rw[ai][m] = w[row_base + row0 + ai * HALF + m * 16];
#pragma unroll
        for (int ai = 0; ai < 2; ++ai)
#pragma unroll
            for (int m = 0; m < 4; ++m) { const int row = row0 + ai * HALF + m * 16; const float sc = rw[ai][m] * scale; float* op = O + ((size_t)u.tag * rows + row) * 1024 + col0;
#pragma unroll
                for (int bj = 0; bj < 2; ++bj) { *(f32x4*)(op + bj * HALF) = acc[ai][bj][m][0] * sc; *(f32x4*)(op + bj * HALF + 4) = acc[ai][bj][m][1] * sc; } }
    }
};
struct EpiSwiglu {
    static constexpr bool PERM = true, AFTER_DRAIN = false;
    bf16_t* O; int ldc;
    __device__ __forceinline__ void operator()(const f32x4 (&acc)[2][2][4][2], const Unit& u, int wr, int wc, int fr, int fq) const {
        const int row0 = u.om * BM + wr * 64 + fr, col0 = u.pn * HALF + wc * 32 + 8 * fq;
#pragma unroll
        for (int ai = 0; ai < 2; ++ai)
#pragma unroll
            for (int m = 0; m < 4; ++m) { f32x4 v0, v1;
#pragma unroll
                for (int i = 0; i < 4; ++i) { const float g0 = acc[ai][0][m][0][i], g1 = acc[ai][0][m][1][i]; v0[i] = g0 * sigm(g0) * acc[ai][1][m][0][i]; v1[i] = g1 * sigm(g1) * acc[ai][1][m][1][i]; }
                *(u32x4*)(O + (size_t)(row0 + ai * HALF + m * 16) * ldc + col0) = pack8(v0, v1); }
    }
};
__device__ __forceinline__ unsigned pk4_fp8(float a, float b, float c, float d) {
    a = __builtin_fminf(__builtin_fmaxf(a, -448.f), 448.f); b = __builtin_fminf(__builtin_fmaxf(b, -448.f), 448.f); c = __builtin_fminf(__builtin_fmaxf(c, -448.f), 448.f); d = __builtin_fminf(__builtin_fmaxf(d, -448.f), 448.f);
    int w = __builtin_amdgcn_cvt_pk_fp8_f32(a, b, 0, false); w = __builtin_amdgcn_cvt_pk_fp8_f32(c, d, w, true); return (unsigned)w; }
struct EpiSwigluF8 {
    static constexpr bool PERM = true, AFTER_DRAIN = false;
    unsigned char* O; int ldc; float wsc = F8_WINV;
    __device__ __forceinline__ void operator()(const f32x4 (&acc)[2][2][4][2], const Unit& u, int wr, int wc, int fr, int fq) const {
        const int row0 = u.om * BM + wr * 64 + fr, col0 = u.pn * HALF + wc * 32 + 8 * fq; const float wq = wsc * wsc, we = wsc * -1.4426950408889634f;
#pragma unroll
        for (int ai = 0; ai < 2; ++ai)
#pragma unroll
            for (int m = 0; m < 4; ++m) { f32x4 v0, v1;
#pragma unroll
                for (int i = 0; i < 4; ++i) { const float a0 = acc[ai][0][m][0][i], a1 = acc[ai][0][m][1][i];
                    v0[i] = (a0 * wq) * acc[ai][1][m][0][i] * __builtin_amdgcn_rcpf(1.0f + __builtin_amdgcn_exp2f(a0 * we)); v1[i] = (a1 * wq) * acc[ai][1][m][1][i] * __builtin_amdgcn_rcpf(1.0f + __builtin_amdgcn_exp2f(a1 * we)); }
                u32x2 w; w.x = pk4_fp8(v0[0], v0[1], v0[2], v0[3]); w.y = pk4_fp8(v1[0], v1[1], v1[2], v1[3]);
                *(u32x2*)(O + (size_t)(row0 + ai * HALF + m * 16) * ldc + col0) = w; }
    }
};
struct EpiMoeDown {
    static constexpr bool PERM = true, AFTER_DRAIN = false;
    bf16_t* O; const float* w; float scale;
    __device__ __forceinline__ void operator()(const f32x4 (&acc)[2][2][4][2], const Unit& u, int wr, int wc, int fr, int fq) const {
        const int row0 = u.om * BM + wr * 64 + fr, col0 = u.pn * BM + wc * 32 + 8 * fq;
        float rw[2][4];
#pragma unroll
        for (int ai = 0; ai < 2; ++ai)
#pragma unroll
            for (int m = 0; m < 4; ++m) rw[ai][m] = w[(size_t)(row0 + ai * HALF + m * 16)];
#pragma unroll
        for (int ai = 0; ai < 2; ++ai)
#pragma unroll
            for (int m = 0; m < 4; ++m) { const size_t row = (size_t)(row0 + ai * HALF + m * 16); const float sc = rw[ai][m] * scale;
#pragma unroll
                for (int bj = 0; bj < 2; ++bj) *(u32x4*)(O + row * 1024 + col0 + bj * HALF) = pack8(acc[ai][bj][m][0] * sc, acc[ai][bj][m][1] * sc); }
    }
};
template <class Epi, class Sched, bool ALIGN_EPI = false, bool SP2 = false, bool F8 = false>
__device__ __forceinline__ void gemm_phase(PG8_LAS unsigned char* lds, const Gemm g, const Sched& S, const Epi& E, const int tid_in) {
    const int tid = tid_in, wid = __builtin_amdgcn_readfirstlane(tid >> 6), lane = tid & 63, wr = wid >> 2, wc = wid & 3, fr = lane & 15, fq = lane >> 4;
    const int K = g.K, nt = g.kt ? g.kt : K / BK;
    unsigned voffA[2], voffB[2];
#pragma unroll
    for (int i = 0; i < 2; ++i) { int R, C; stage_rc(tid * 16 + i * 8192, R, C); const int Rb = Epi::PERM ? ((R & ~31) + perm32(R & 31)) : R;
        voffA[i] = (unsigned)(R * K + C) * 2u; voffB[i] = (unsigned)(Rb * K + C) * 2u; }
    const size_t kstep = (size_t)(BK * 2);
    const size_t hstep = (size_t)HALF * K * 2;
    const unsigned ldsw = (unsigned)wid * 1024u;
    const int aoff = lds_byte(wr * 64 + fr, fq * 8), boff = lds_byte(wc * 32 + fr, fq * 8);
#define PG8_SA(b, h) (((b) * 2 + (h)) * HTB)
#define PG8_SB(b, h) ((4 + (b) * 2 + (h)) * HTB)
#define PG8_STAGE(bufoff, gbase, voff) do { _Pragma("unroll") for (int _i = 0; _i < 2; ++_i) \
        __builtin_amdgcn_global_load_lds((const unsigned*)((const char*)(gbase) + (voff)[_i]), (PG8_LAS unsigned*)(lds + (bufoff) + ldsw + _i * 8192), 16, 0, 0); } while (0)
#define PG8_LDA(dst, b, h) do { _Pragma("unroll") for (int m = 0; m < 4; ++m) _Pragma("unroll") for (int k = 0; k < 2; ++k) dst[m][k] = *(const PG8_LAS bf16x8*)(lds + PG8_SA(b, h) + aoff + m * 2048 + k * 1024); } while (0)
#define PG8_LDB(dst, b, h) do { _Pragma("unroll") for (int n = 0; n < 2; ++n) _Pragma("unroll") for (int k = 0; k < 2; ++k) dst[n][k] = *(const PG8_LAS bf16x8*)(lds + PG8_SB(b, h) + boff + n * 2048 + k * 1024); } while (0)
#define PG8_CAT8(x) __builtin_bit_cast(v8i32, __builtin_shufflevector((x)[0], (x)[1], 0, 1, 2, 3, 4, 5, 6, 7, 8, 9, 10, 11, 12, 13, 14, 15))
#define PG8_MMA(ai, bj, At, Bt) do { __builtin_amdgcn_s_setprio(1); if constexpr (F8) { _Pragma("unroll") for (int m = 0; m < 4; ++m) _Pragma("unroll") for (int n = 0; n < 2; ++n) \
        asm volatile("v_mfma_f32_16x16x128_f8f6f4 %0, %1, %2, %0" : "+v"(acc[ai][bj][m][n]) : "v"(PG8_CAT8(Bt[n])), "v"(PG8_CAT8(At[m]))); } else { \
        _Pragma("unroll") for (int m = 0; m < 4; ++m) _Pragma("unroll") for (int n = 0; n < 2; ++n) _Pragma("unroll") for (int k = 0; k < 2; ++k) \
        acc[ai][bj][m][n] = __builtin_amdgcn_mfma_f32_16x16x32_bf16(Bt[n][k], At[m][k], acc[ai][bj][m][n], 0, 0, 0); } __builtin_amdgcn_s_setprio(0); } while (0)
#define PG8_WAIT_V(n) asm volatile("s_waitcnt vmcnt(" #n ")" ::: "memory")
#define PG8_WAIT_L(n) asm volatile("s_waitcnt lgkmcnt(" #n ")" ::: "memory")
#define PG8_BAR __builtin_amdgcn_s_barrier()
#define PG8_SCHED __builtin_amdgcn_sched_barrier(0)
    Unit cur, nxt; int ui = 0;
    if (!S.next(0, cur)) return;
    f32x4 acc[2][2][4][2];
#pragma unroll
    for (int a = 0; a < 2; ++a)
#pragma unroll
        for (int b = 0; b < 2; ++b)
#pragma unroll
            for (int m = 0; m < 4; ++m)
#pragma unroll
                for (int n = 0; n < 2; ++n) { acc[a][b][m][n] = (f32x4){0.f, 0.f, 0.f, 0.f}; if constexpr (F8) asm volatile("" : "+v"(acc[a][b][m][n])); }
    bf16x8 At[4][2], B0[2][2], B1[2][2];
    const char* cA = (const char*)g.A + cur.ao; const char* cB = (const char*)g.Bt + cur.bo;
    S.a_ready(cur);
    if constexpr (SP2) {
        PG8_STAGE(PG8_SB(0, 0), cB, voffB); PG8_STAGE(PG8_SB(0, 1), cB + hstep, voffB); PG8_STAGE(PG8_SA(0, 0), cA, voffA); PG8_STAGE(PG8_SA(0, 1), cA + hstep, voffA);
        if (wr == 1) PG8_BAR;
        PG8_WAIT_V(2); PG8_BAR;
        PG8_STAGE(PG8_SB(1, 0), cB + kstep, voffB); PG8_STAGE(PG8_SA(1, 0), cA + kstep, voffA); PG8_STAGE(PG8_SB(1, 1), cB + hstep + kstep, voffB);
        PG8_WAIT_V(6); PG8_BAR;
    } else {
        PG8_STAGE(PG8_SB(0, 0), cB, voffB); PG8_STAGE(PG8_SA(0, 0), cA, voffA); PG8_STAGE(PG8_SB(0, 1), cB + hstep, voffB); PG8_STAGE(PG8_SA(0, 1), cA + hstep, voffA);
        if (wr == 1) PG8_BAR;
        PG8_WAIT_V(4); PG8_BAR;
        PG8_STAGE(PG8_SB(1, 0), cB + kstep, voffB); PG8_STAGE(PG8_SA(1, 0), cA + kstep, voffA); PG8_STAGE(PG8_SB(1, 1), cB + hstep + kstep, voffB);
        PG8_WAIT_V(6); PG8_BAR;
    }
    for (;;) {
        const bool has_next = S.next(ui + 1, nxt);
        const char* nA = has_next ? (const char*)g.A + nxt.ao : cA; const char* nB = has_next ? (const char*)g.Bt + nxt.bo : cB;
#pragma nounroll
        for (int t = 0; t < nt; t += 2) {
            const bool last = (t == nt - 2);
            const char* a1 = cA + (size_t)(t + 1) * kstep;
            const char* a2 = last ? nA : cA + (size_t)(t + 2) * kstep; const char* b2 = last ? nB : cB + (size_t)(t + 2) * kstep;
            const char* a3 = a2 + kstep; const char* b3 = b2 + kstep;
            if (last && has_next) S.a_ready(nxt);
            if constexpr (SP2) {
            PG8_LDB(B0, 0, 0); PG8_LDB(B1, 0, 1); PG8_SCHED; PG8_LDA(At, 0, 0); PG8_STAGE(PG8_SA(1, 1), a1 + hstep, voffA);
            PG8_WAIT_V(8); PG8_WAIT_L(0); PG8_BAR; PG8_MMA(0, 0, At, B0); PG8_MMA(0, 1, At, B1); PG8_BAR; PG8_SCHED;
            PG8_LDA(At, 0, 1); PG8_STAGE(PG8_SB(0, 0), b2, voffB); PG8_STAGE(PG8_SB(0, 1), b2 + hstep, voffB); PG8_STAGE(PG8_SA(0, 0), a2, voffA);
            PG8_WAIT_V(8); PG8_WAIT_L(0); PG8_BAR; PG8_MMA(1, 0, At, B0); PG8_MMA(1, 1, At, B1); PG8_BAR; PG8_SCHED;
            PG8_LDB(B0, 1, 0); PG8_LDB(B1, 1, 1); PG8_SCHED; PG8_LDA(At, 1, 0); PG8_STAGE(PG8_SA(0, 1), a2 + hstep, voffA);
            PG8_WAIT_V(8); PG8_WAIT_L(0); PG8_BAR; PG8_MMA(0, 0, At, B0); PG8_MMA(0, 1, At, B1); PG8_BAR; PG8_SCHED;
            PG8_LDA(At, 1, 1); PG8_STAGE(PG8_SB(1, 0), b3, voffB); PG8_STAGE(PG8_SB(1, 1), b3 + hstep, voffB); PG8_STAGE(PG8_SA(1, 0), a3, voffA);
            PG8_WAIT_V(8); PG8_WAIT_L(0); PG8_BAR; PG8_MMA(1, 0, At, B0); PG8_MMA(1, 1, At, B1); PG8_BAR; PG8_SCHED;
            } else {
            PG8_LDB(B0, 0, 0); PG8_SCHED; PG8_LDA(At, 0, 0); PG8_STAGE(PG8_SA(1, 1), a1 + hstep, voffA);
            PG8_WAIT_L(8); PG8_BAR; PG8_WAIT_L(0); PG8_MMA(0, 0, At, B0); PG8_BAR; PG8_SCHED;
            PG8_LDB(B1, 0, 1); PG8_STAGE(PG8_SB(0, 0), b2, voffB);
            PG8_BAR; PG8_WAIT_L(0); PG8_MMA(0, 1, At, B1); PG8_BAR;
            PG8_LDA(At, 0, 1); PG8_STAGE(PG8_SA(0, 0), a2, voffA);
            PG8_BAR; PG8_WAIT_L(0); PG8_MMA(1, 0, At, B0); PG8_BAR; PG8_SCHED;
            PG8_STAGE(PG8_SB(0, 1), b2 + hstep, voffB);
            PG8_WAIT_V(6); PG8_BAR; PG8_MMA(1, 1, At, B1); PG8_BAR;
            PG8_LDB(B0, 1, 0); PG8_SCHED; PG8_LDA(At, 1, 0); PG8_STAGE(PG8_SA(0, 1), a2 + hstep, voffA);
            PG8_WAIT_L(8); PG8_BAR; PG8_WAIT_L(0); PG8_MMA(0, 0, At, B0); PG8_BAR; PG8_SCHED;
            PG8_LDB(B1, 1, 1); PG8_STAGE(PG8_SB(1, 0), b3, voffB);
            PG8_BAR; PG8_WAIT_L(0); PG8_MMA(0, 1, At, B1); PG8_BAR;
            PG8_LDA(At, 1, 1); PG8_STAGE(PG8_SA(1, 0), a3, voffA);
            PG8_BAR; PG8_WAIT_L(0); PG8_MMA(1, 0, At, B0); PG8_BAR; PG8_SCHED;
            PG8_STAGE(PG8_SB(1, 1), b3 + hstep, voffB);
            PG8_WAIT_V(6); PG8_BAR; PG8_MMA(1, 1, At, B1); PG8_BAR;
            }
        }
        if constexpr (ALIGN_EPI) { if (wr == 0) PG8_BAR; }
        if constexpr (F8) asm volatile("s_nop 15\n\ts_nop 15" ::: "memory");
        if constexpr (!Epi::AFTER_DRAIN) { E(acc, cur, wr, wc, fr, fq); S.done(cur); }
        if (!has_next) break;
#pragma unroll
        for (int a = 0; a < 2; ++a)
#pragma unroll
            for (int b = 0; b < 2; ++b)
#pragma unroll
                for (int m = 0; m < 4; ++m)
#pragma unroll
                    for (int n = 0; n < 2; ++n) { acc[a][b][m][n] = (f32x4){0.f, 0.f, 0.f, 0.f}; if constexpr (F8) asm volatile("" : "+v"(acc[a][b][m][n])); }
        cur = nxt; cA = nA; cB = nB; ++ui;
        if constexpr (ALIGN_EPI) { if (wr == 1) PG8_BAR; }
    }
    PG8_WAIT_V(0);
    if constexpr (!ALIGN_EPI) { if (wr == 0) PG8_BAR; }
    PG8_BAR;
    if constexpr (Epi::AFTER_DRAIN) { E.fused(acc, cur, wr, wc, fr, fq, lds, wid, lane); S.done(cur); }
#undef PG8_SA
#undef PG8_SB
#undef PG8_STAGE
#undef PG8_LDA
#undef PG8_LDB
#undef PG8_MMA
#undef PG8_CAT8
#undef PG8_WAIT_V
#undef PG8_WAIT_L
#undef PG8_BAR
#undef PG8_SCHED
}
}

namespace att {
#define LAS __attribute__((address_space(3)))
typedef unsigned short bf16;
typedef __attribute__((ext_vector_type(8))) short bf16x8;
typedef __attribute__((ext_vector_type(4))) short s16x4;
typedef __attribute__((ext_vector_type(16))) float f32x16;
typedef __attribute__((ext_vector_type(4))) unsigned u32x4;
typedef float f32x2_t __attribute__((ext_vector_type(2))); typedef float f32x4_t __attribute__((ext_vector_type(4))); typedef __bf16 bf16x2_t __attribute__((ext_vector_type(2)));
typedef short v4i16_t __attribute__((ext_vector_type(4)));
typedef LAS const char* lds_cptr;
constexpr int SEQ = 4096, PP = 1536;
constexpr float LOG2E = 1.4426950408889634f;
constexpr float NEGINF = -INFINITY;
__device__ __forceinline__ int crow(int r, int hi) { return (r & 3) + 8 * (r >> 2) + 4 * hi; }
__device__ __forceinline__ void glds16(const void* gsrc, unsigned lds_dst) { unsigned keep;
    asm volatile("s_mov_b32 %0, m0\n\ts_mov_b32 m0, %2\n\ts_nop 0\n\tglobal_load_lds_dwordx4 %1, off\n\ts_mov_b32 m0, %0" : "=&s"(keep) : "v"(gsrc), "s"(lds_dst) : "memory"); }
__device__ __forceinline__ unsigned cvtpk(float lo, float hi) { f32x2_t v = {lo, hi}; bf16x2_t b = __builtin_convertvector(v, bf16x2_t); return __builtin_bit_cast(unsigned, b); }
__device__ __forceinline__ s16x4 vtr(lds_cptr p) { return __builtin_bit_cast(s16x4, __builtin_amdgcn_ds_read_tr16_b64_v4i16((LAS v4i16_t*)p)); }
__device__ __forceinline__ bf16x8 ldk(lds_cptr p) { return *(const LAS bf16x8*)p; }
__device__ __forceinline__ float xhalf(float v, int hi) {
    auto rr = __builtin_amdgcn_permlane32_swap(__float_as_uint(v), __float_as_uint(v), false, false);
    return hi ? __uint_as_float(rr[0]) : __uint_as_float(rr[1]); }
template <int OF> __device__ __forceinline__ float swz_xor(float v) { return __int_as_float(__builtin_amdgcn_ds_swizzle(__float_as_int(v), (OF << 10) | 0x1f)); }
__device__ __forceinline__ float max16(const f32x16& p) { float a = fmaxf(fmaxf(p[0], p[1]), fmaxf(p[2], p[3]));
#pragma unroll
    for (int r = 4; r < 16; r += 4) a = fmaxf(a, fmaxf(fmaxf(p[r], p[r + 1]), fmaxf(p[r + 2], p[r + 3]))); return a; }
__device__ __forceinline__ float add_s(float a, float b) { float r; asm("v_add_f32_e32 %0, %1, %2" : "=v"(r) : "v"(a), "v"(b)); return r; }
__device__ __forceinline__ float max3_s(float a, float b, float c) { float r; asm("v_max3_f32 %0, %1, %2, %3" : "=v"(r) : "v"(a), "v"(b), "v"(c)); return r; }
__device__ __forceinline__ float sum16a(const f32x16& p) { float a = p[0];
#pragma unroll
    for (int r = 1; r < 16; ++r) a += p[r];
    return a; }
__device__ __forceinline__ float max16a(const f32x16& p) { float a = max3_s(p[0], p[1], p[2]), b = max3_s(p[3], p[4], p[5]);
    a = max3_s(a, p[6], p[7]); b = max3_s(b, p[8], p[9]); a = max3_s(a, p[10], p[11]); b = max3_s(b, p[12], p[13]); a = max3_s(a, p[14], p[15]); return max3_s(a, b, b); }
__device__ __forceinline__ float sum16(const f32x16& p) { float a = (p[0] + p[1]) + (p[2] + p[3]);
#pragma unroll
    for (int r = 4; r < 16; r += 4) a += (p[r] + p[r + 1]) + (p[r + 2] + p[r + 3]); return a; }
#define ATT_WAIT_BAR(N) asm volatile("s_waitcnt vmcnt(" #N ") lgkmcnt(0)\n\ts_barrier" ::: "memory")
#define ATT_LDSW() asm volatile("s_waitcnt lgkmcnt(0)" ::: "memory")
#define PACK8(P, B) (u32x4){cvtpk(P[B], P[B + 1]), cvtpk(P[B + 2], P[B + 3]), cvtpk(P[B + 4], P[B + 5]), cvtpk(P[B + 6], P[B + 7])}
#define ASBF(x) __builtin_bit_cast(bf16x8, x)
#define VFRAG(lo, hh) (bf16x8){lo[0], lo[1], lo[2], lo[3], hh[0], hh[1], hh[2], hh[3]}

constexpr int A_SLOT = 32768, A_NSLOT = 4, A_WSF = 131072, A_FLAGS = 135168, A_SLN = 135424, A_KN = 135936, A_XCH = 0, A_STG = 65536;
constexpr float A_THR = 8.f, A_DEAD = -64.f;
template <int MODE = 0> __device__ __forceinline__ void diff_unit(int b, int h, int qb, const bf16* __restrict__ PA, bf16* __restrict__ YA, float lam, const LAS float* knl, const __attribute__((address_space(1))) unsigned* qctr, LAS int* qslot, bf16x8 (&qr)[4], const bool pref, LAS char* shm, const int tid, const int ro_mul = 1) {
    const int lane = tid & 63, r32 = lane & 31, hi = lane >> 5;
    const int wid = __builtin_amdgcn_readfirstlane(tid >> 6), comp = wid >> 2, g = wid & 3;
    const float slope2 = __builtin_amdgcn_exp2f(-2.f * (float)(h + 1)) * LOG2E;
    const long rowbase = (long)b * SEQ; const int q0 = qb * 128, qw0 = q0 + 32 * g, qi = qw0 + r32;
    const unsigned lds0 = (unsigned)(size_t)shm;
    LAS float* wsf = (LAS float*)(shm + A_WSF) + wid * 128;
    const bf16* kb_ = PA + rowbase * PP + 512 + h * 128; const bf16* vb_ = PA + rowbase * PP + 1024 + h * 128;
    const bf16* ksrc0 = kb_ + (long)lane * PP + wid * 8; const bf16* ksrc1 = ksrc0 + 64;
    const int pa = wid, pb = wid + 8;
    const bf16* vsrca = vb_ + (long)(16 * (pa & 3) + (lane >> 2)) * PP + (pa >> 2) * 32 + (lane & 3) * 8;
    const bf16* vsrcb = vb_ + (long)(16 * (pb & 3) + (lane >> 2)) * PP + (pb >> 2) * 32 + (lane & 3) * 8;
    const int NT = 2 * (qb + 1);
#define A_ISSUE(it_) do { const long ro_ = (long)(NT - 1 - (it_)) * 64 * PP * ro_mul; const unsigned sb_ = (unsigned)__builtin_amdgcn_readfirstlane(lds0 + (unsigned)((((it_) + 3) & 3) * A_SLOT)); \
        glds16(ksrc0 + ro_, sb_ + wid * 1024); glds16(ksrc1 + ro_, sb_ + 8192 + wid * 1024); glds16(vsrca + ro_, sb_ + 16384 + pa * 1024); glds16(vsrcb + ro_, sb_ + 16384 + pb * 1024); } while (0)
    const bf16* qp = PA + (rowbase + qi) * PP + h * 128 + comp * 64 + hi * 8;
    unsigned un_ = 0u;
    if (tid == 0) asm volatile("global_atomic_add %0, %1, %2, off sc0" : "=v"(un_) : "v"(qctr), "v"(1u) : "memory");
#define A_QLOAD(QP) do { asm volatile("global_load_dwordx4 %0, %1, off" : "+v"(qr[0]) : "v"(QP) : "memory"); asm volatile("global_load_dwordx4 %0, %1, off offset:32" : "+v"(qr[1]) : "v"(QP) : "memory"); \
        asm volatile("global_load_dwordx4 %0, %1, off offset:64" : "+v"(qr[2]) : "v"(QP) : "memory"); asm volatile("global_load_dwordx4 %0, %1, off offset:96" : "+v"(qr[3]) : "v"(QP) : "memory"); } while (0)
    const float sl4 = slope2 * 4.f * (float)hi;
    volatile LAS int* fl = (volatile LAS int*)(shm + A_FLAGS);
    if (!pref) { A_QLOAD(qp); A_ISSUE(0); }
    A_ISSUE(1); if (NT > 2) A_ISSUE(2);
    float m_ref = NEGINF, l = 0.f; f32x16 o[4];
#pragma unroll
    for (int dq = 0; dq < 4; ++dq) { o[dq] = f32x16{}; asm volatile("" : "+v"(o[dq])); }
#define A_QKH(P, it_, hf_) do { const int kh_ = 64 * (NT - 1 - (it_)) + 32 * (hf_); { \
        const lds_cptr kp_ = shm + (((it_) + 3) & 3) * A_SLOT + comp * 8192 + hi * 1024 + r32 * 16 + (hf_) * 512; \
        float s2_ = slope2; asm volatile("" : "+v"(s2_));     \
        const float bs_ = s2_ * (float)(kh_ - qi) + sl4; \
        _Pragma("unroll") for (int r = 0; r < 16; ++r) P[r] = __builtin_fmaf(s2_, (float)((r & 3) + 8 * (r >> 2)), bs_); \
        _Pragma("unroll") for (int d0 = 0; d0 < 4; ++d0) P = __builtin_amdgcn_mfma_f32_32x32x16_bf16(ldk(kp_ + d0 * 2048), qr[d0], P, 0, 0, 0); } } while (0)
#define A_SVH(P, it_, hf_) do { const int kh_ = 64 * (NT - 1 - (it_)) + 32 * (hf_); if (kh_ <= qw0) { \
        const lds_cptr vp_ = shm + (((it_) + 3) & 3) * A_SLOT + 16384 + (hf_) * 2048 + ((lane >> 4) & 1) * 32 + (lane & 3) * 8 + (4 * hi + ((lane & 15) >> 2)) * 64; \
          \
        const s16x4 fa0_ = vtr(vp_), fa1_ = vtr(vp_ + 512), fa2_ = vtr(vp_ + 1024), fa3_ = vtr(vp_ + 1536), fb0_ = vtr(vp_ + 4096), fb1_ = vtr(vp_ + 4096 + 512), fb2_ = vtr(vp_ + 4096 + 1024), fb3_ = vtr(vp_ + 4096 + 1536); \
        __builtin_amdgcn_sched_barrier(0); \
        if (kh_ == qw0) { _Pragma("unroll") for (int r = 0; r < 16; ++r) if (crow(r, hi) > r32) P[r] = NEGINF; } \
        float rm_ = max16a(P); rm_ = fmaxf(rm_, xhalf(rm_, hi)); \
        if (!__all(rm_ < m_ref + A_DEAD)) { \
            const float mnew_ = fmaxf(m_ref, rm_); \
            if (__any(mnew_ > m_ref + A_THR)) { const float alpha_ = __builtin_amdgcn_exp2f(m_ref - mnew_); l *= alpha_; m_ref = mnew_; \
                _Pragma("unroll") for (int dq = 0; dq < 4; ++dq) _Pragma("unroll") for (int r = 0; r < 16; ++r) o[dq][r] *= alpha_; }     \
            _Pragma("unroll") for (int r = 0; r < 16; ++r) P[r] = __builtin_amdgcn_exp2f(P[r] - m_ref); \
            l += sum16a(P); \
            const u32x4 pw0_ = PACK8(P, 0), pw1_ = PACK8(P, 8); \
            const s16x4 fc0_ = vtr(vp_ + 8192), fc1_ = vtr(vp_ + 8192 + 512), fc2_ = vtr(vp_ + 8192 + 1024), fc3_ = vtr(vp_ + 8192 + 1536), fd0_ = vtr(vp_ + 12288), fd1_ = vtr(vp_ + 12288 + 512), fd2_ = vtr(vp_ + 12288 + 1024), fd3_ = vtr(vp_ + 12288 + 1536); \
            o[0] = __builtin_amdgcn_mfma_f32_32x32x16_bf16(VFRAG(fa0_, fa1_), ASBF(pw0_), o[0], 0, 0, 0); o[1] = __builtin_amdgcn_mfma_f32_32x32x16_bf16(VFRAG(fb0_, fb1_), ASBF(pw0_), o[1], 0, 0, 0); \
            o[0] = __builtin_amdgcn_mfma_f32_32x32x16_bf16(VFRAG(fa2_, fa3_), ASBF(pw1_), o[0], 0, 0, 0); o[1] = __builtin_amdgcn_mfma_f32_32x32x16_bf16(VFRAG(fb2_, fb3_), ASBF(pw1_), o[1], 0, 0, 0); \
            o[2] = __builtin_amdgcn_mfma_f32_32x32x16_bf16(VFRAG(fc0_, fc1_), ASBF(pw0_), o[2], 0, 0, 0); o[3] = __builtin_amdgcn_mfma_f32_32x32x16_bf16(VFRAG(fd0_, fd1_), ASBF(pw0_), o[3], 0, 0, 0); \
            o[2] = __builtin_amdgcn_mfma_f32_32x32x16_bf16(VFRAG(fc2_, fc3_), ASBF(pw1_), o[2], 0, 0, 0); o[3] = __builtin_amdgcn_mfma_f32_32x32x16_bf16(VFRAG(fd2_, fd3_), ASBF(pw1_), o[3], 0, 0, 0); \
            __builtin_amdgcn_sched_group_barrier(0x100, 8, 0); __builtin_amdgcn_sched_group_barrier(0x008, 4, 0); __builtin_amdgcn_sched_group_barrier(0x008, 4, 0); } } } while (0)
    f32x16 PH, PL;
    if (NT > 2) { ATT_WAIT_BAR(8); } else { ATT_WAIT_BAR(4); }
#pragma unroll
    for (int d0 = 0; d0 < 4; ++d0) asm volatile("" : "+v"(qr[d0]));
    float qkb;
    { float ss = 0.f;
#pragma unroll
      for (int d0 = 0; d0 < 4; ++d0)
#pragma unroll
          for (int e = 0; e < 8; ++e) { const float v = __uint_as_float((unsigned)(unsigned short)qr[d0][e] << 16); ss += v * v; }
      ss += xhalf(ss, hi); qkb = sqrtf(ss) * knl[2 * h + comp] * 1.001f + 1.0f; }
    if (wid >= 4) __builtin_amdgcn_s_setprio(1);
    A_QKH(PH, 0, 1);
    for (int it = 0; it < ((MODE == 5) ? 1 : NT); ++it) {
        A_QKH(PL, it, 0);
        A_SVH(PH, it, 1);
        if (it + 1 < NT) {
            if (it + 2 < NT) { ATT_WAIT_BAR(4); } else { ATT_WAIT_BAR(0); }
            int stop = 0;
            if (it > 0) { const volatile LAS int* f = fl + ((it - 1) & 1) * 8; stop = f[0] & f[1] & f[2] & f[3] & f[4] & f[5] & f[6] & f[7]; }
            if (it + 3 < NT) A_ISSUE(it + 3);
            A_QKH(PH, it + 1, 1);
            if (stop) break;
        }
        A_SVH(PL, it, 0);
        { const float bmax = slope2 * (float)(64 * (NT - 2 - it) + 63 - qi);
          const int dead = __all(qkb + bmax < m_ref + A_DEAD) ? 1 : 0;
          if (lane == 0) fl[(it & 1) * 8 + wid] = dead; }
    }
    __builtin_amdgcn_s_setprio(0);
#undef A_ISSUE
#undef A_QKH
#undef A_SVH
    l += xhalf(l, hi);
    { const float il = __builtin_amdgcn_rcpf(l);
#pragma unroll
      for (int dq = 0; dq < 4; ++dq)
#pragma unroll
          for (int r = 0; r < 16; ++r) o[dq][r] *= il; }
    ATT_WAIT_BAR(0);
    if (tid == 0) { asm volatile("" : "+v"(un_)); *qslot = (int)un_; }
    LAS float* X = (LAS float*)(shm + A_XCH) + g * 4096;
    if (comp == 1) {
#pragma unroll
        for (int dq = 0; dq < 4; ++dq)
#pragma unroll
            for (int r = 0; r < 16; ++r) X[(dq * 16 + r) * 64 + lane] = o[dq][r];
    }
    ATT_WAIT_BAR(0);
    { const int un = __builtin_amdgcn_readfirstlane(*(volatile LAS int*)qslot);
      if (un < 128) { const int hN = 3 - (un >> 5), qbN = 31 - (un & 31);
          const bf16* qpN = PA + (rowbase + qbN * 128 + 32 * g + r32) * PP + hN * 128 + comp * 64 + hi * 8;
          A_QLOAD(qpN);
          const long roN = ((long)(2 * qbN + 1) * 64 * PP) * ro_mul + (long)(hN - h) * 128; const unsigned sbN = (unsigned)__builtin_amdgcn_readfirstlane(lds0 + (unsigned)(3 * A_SLOT));
          glds16(ksrc0 + roN, sbN + wid * 1024); glds16(ksrc1 + roN, sbN + 8192 + wid * 1024); glds16(vsrca + roN, sbN + 16384 + pa * 1024); glds16(vsrcb + roN, sbN + 16384 + pb * 1024); } }
    if (comp == 0) {
        float ss = 0.f;
#pragma unroll
        for (int dq = 0; dq < 4; ++dq)
#pragma unroll
            for (int r = 0; r < 16; ++r) { const float d = o[dq][r] - lam * X[(dq * 16 + r) * 64 + lane]; o[dq][r] = d; ss += d * d; }
        ss += xhalf(ss, hi);
        const float rs = __builtin_amdgcn_rsqf(ss * (1.f / 128.f) + 1e-6f);
        LAS char* stg = shm + A_STG * 1 + g * 8192;
        const LAS float* sln = (const LAS float*)(shm + A_SLN);
#pragma unroll
        for (int dq = 0; dq < 4; ++dq)
#pragma unroll
            for (int kq = 0; kq < 4; ++kq) { const f32x4_t gn = *(const LAS f32x4_t*)(sln + dq * 32 + 8 * kq + 4 * hi); f32x2_t w2;
                w2.x = __uint_as_float(cvtpk(o[dq][4 * kq] * rs * gn.x, o[dq][4 * kq + 1] * rs * gn.y)); w2.y = __uint_as_float(cvtpk(o[dq][4 * kq + 2] * rs * gn.z, o[dq][4 * kq + 3] * rs * gn.w));
                *(LAS f32x2_t*)(stg + r32 * 256 + (((dq * 8 + 2 * kq + hi) ^ ((r32 & 7) << 1)) << 3)) = w2; }
        ATT_LDSW();
        bf16* Yw = YA + (rowbase + qw0) * 512 + h * 128;
#pragma unroll
        for (int i = 0; i < 8; ++i) { const int idx = i * 64 + lane, row = idx >> 4, ch = idx & 15; const u32x4 v = *(const LAS u32x4*)(stg + row * 256 + ((ch ^ (row & 7)) << 4)); *(u32x4*)(Yw + (long)row * 512 + ch * 8) = v; }
    }
}

constexpr int B_V = 49152, B_WSF = 98304, B_STG = 100352;
struct DilU { int b, h, dil, res, blk, pat; };
__device__ __forceinline__ DilU dil_unit_of(int bh, int j) { DilU u; u.b = bh >> 3; u.h = bh & 7;
    if (j < 16) { u.pat = 0; u.dil = 1; u.res = 0; u.blk = j; } else if (j < 32) { u.pat = 1; u.dil = 4; u.res = (j - 16) >> 2; u.blk = (j - 16) & 3; } else { u.pat = 2; u.dil = 16; u.res = j - 32; u.blk = 0; }
    return u; }
__device__ __forceinline__ DilU dil_unit_at(int vcu, int i) { const int x = vcu >> 5, n = (vcu & 31) + 32 * i, q = n / 48; return dil_unit_of(8 * x + q, n - 48 * q); }
__device__ __forceinline__ void dil_phase(int vcu, const bf16* __restrict__ PB, bf16* __restrict__ BPb, float* __restrict__ BSTb, LAS char* shm, const int tid) {
    const int lane = tid & 63, r32 = lane & 31, hi = lane >> 5;
    const int wid = __builtin_amdgcn_readfirstlane(tid >> 6);
    const unsigned lds0 = (unsigned)(size_t)shm;
    const bf16* const KBh = PB + (size_t)32768 * 512; const bf16* const VBh = PB + (size_t)2 * 32768 * 512;
#define B_ISSUE_K(U) do { const bf16* kb_ = KBh + (size_t)((U).b * 8 + (U).h) * SEQ * 64 + wid * 8; const int jb_ = 256 * (U).blk - 128; \
        _Pragma("unroll") for (int T = 0; T < 6; ++T) { int j_ = jb_ + 64 * T + lane; j_ = j_ < 0 ? 0 : j_;     \
            glds16(kb_ + ((size_t)j_ * (U).dil + (U).res) * 64, (unsigned)__builtin_amdgcn_readfirstlane(lds0 + (unsigned)(T * 8192 + wid * 1024))); } } while (0)
#define B_ISSUE_V(U) do { const bf16* vb_ = VBh + (size_t)((U).b * 8 + (U).h) * SEQ * 64 + (wid >> 2) * 32 + (lane & 3) * 8; const int jb_ = 256 * (U).blk - 128 + 16 * (wid & 3) + (lane >> 2); \
        _Pragma("unroll") for (int T = 0; T < 6; ++T) { int j_ = jb_ + 64 * T; j_ = j_ < 0 ? 0 : j_; \
            glds16(vb_ + ((size_t)j_ * (U).dil + (U).res) * 64, (unsigned)__builtin_amdgcn_readfirstlane(lds0 + (unsigned)(B_V + T * 8192 + wid * 1024))); } } while (0)
#ifdef PROBE_BSEG
    unsigned long long bt_ = 0; int bseg_ = -1;
#define BSEG(k) do { if (blockIdx.x == 0 && tid == 0) { const unsigned long long t_ = __builtin_amdgcn_s_memrealtime(); if (bseg_ == PROBE_BSEG) *(volatile LAS unsigned*)(shm + 139264 + 640) += (unsigned)(t_ - bt_); bt_ = t_; bseg_ = (k); } } while (0)
#else
#define BSEG(k) do { } while (0)
#endif
#define B_ISSUE_Q(U) do { const bf16* qp_ = PB + ((long)(U).b * SEQ + (long)(256 * (U).blk + 32 * wid + r32) * (U).dil + (U).res) * 512 + (U).h * 64 + hi * 8; \
        asm volatile("global_load_dwordx4 %0, %1, off" : "+v"(qr[0]) : "v"(qp_) : "memory"); asm volatile("global_load_dwordx4 %0, %1, off offset:32" : "+v"(qr[1]) : "v"(qp_) : "memory"); \
        asm volatile("global_load_dwordx4 %0, %1, off offset:64" : "+v"(qr[2]) : "v"(qp_) : "memory"); asm volatile("global_load_dwordx4 %0, %1, off offset:96" : "+v"(qr[3]) : "v"(qp_) : "memory"); } while (0)
    DilU cur = dil_unit_at(vcu, 0);
    bf16x8 qr[4]; qr[0] = bf16x8{}; qr[1] = bf16x8{}; qr[2] = bf16x8{}; qr[3] = bf16x8{};
    B_ISSUE_K(cur); B_ISSUE_Q(cur);
    for (int i = 0; i < 12; ++i) {
        const bool has_next = i + 1 < 12; const DilU nxt = dil_unit_at(vcu, has_next ? i + 1 : i);
        BSEG(0);
        const int b = cur.b, h = cur.h, dil = cur.dil, res = cur.res, blk = cur.blk;
        const int hs = h + (h >> 1);
        const float sd = __builtin_amdgcn_exp2f(-(2.f / 3.f) * (float)(hs + 1)) * LOG2E * (float)dil;
        const long rowbase = (long)b * SEQ; const int i0 = 256 * blk;
        const int iq = i0 + 32 * wid + r32;
#ifdef PROBE_DUPV
        B_ISSUE_V(cur);
        B_ISSUE_V(cur);
        ATT_WAIT_BAR(12);
#else
        B_ISSUE_V(cur);
        ATT_WAIT_BAR(6);
#endif
        BSEG(1);
        f32x16 s[5];
#pragma unroll
        for (int g = 0; g < 5; ++g) { const int b0 = 32 * (wid + g), T = b0 >> 6, half = (b0 >> 5) & 1;
            const lds_cptr kp = shm + T * 8192 + hi * 1024 + (half * 32 + r32) * 16;
            const float base = -sd * (float)(128 - 32 * g + r32);
#pragma unroll
            for (int r = 0; r < 16; ++r) s[g][r] = base + sd * (float)crow(r, hi);
#pragma unroll
            for (int d0 = 0; d0 < 4; ++d0) s[g] = __builtin_amdgcn_mfma_f32_32x32x16_bf16(ldk(kp + d0 * 2048), qr[d0], s[g], 0, 0, 0); }
        asm volatile("s_waitcnt lgkmcnt(0)\n\ts_barrier" ::: "memory");
        BSEG(2);
        if (has_next) B_ISSUE_K(nxt);
        B_ISSUE_Q(nxt);
        BSEG(3);
#pragma unroll
        for (int r = 0; r < 16; ++r) { const int cr = crow(r, hi); if (cr < r32) s[0][r] = NEGINF; if (cr > r32) s[4][r] = NEGINF; }
        if (blk == 0) {
#pragma unroll
            for (int g = 0; g < 5; ++g)
#pragma unroll
                for (int r = 0; r < 16; ++r) if (32 * (wid + g) + crow(r, hi) < 128) s[g][r] = NEGINF;
        }
        float m = max16(s[0]);
#pragma unroll
        for (int g = 1; g < 5; ++g) m = fmaxf(m, max16(s[g]));
        m = fmaxf(m, xhalf(m, hi));
        float l = 0.f;
#pragma unroll
        for (int g = 0; g < 5; ++g) {
#pragma unroll
            for (int r = 0; r < 16; ++r) s[g][r] = __builtin_amdgcn_exp2f(s[g][r] - m);
            l += sum16a(s[g]); }
        l += xhalf(l, hi);
        BSEG(4);
        if (has_next) { ATT_WAIT_BAR(10); } else { ATT_WAIT_BAR(4); }

        BSEG(5);
        f32x16 o[2]; o[0] = f32x16{}; o[1] = f32x16{};
        const lds_cptr vp0 = shm + B_V + ((lane >> 4) & 1) * 32 + (lane & 3) * 8 + (4 * hi + ((lane & 15) >> 2)) * 64;
#pragma unroll
        for (int g = 0; g < 5; ++g) { const u32x4 pwa = PACK8(s[g], 0), pwb = PACK8(s[g], 8);
            const int B16 = 2 * (wid + g), T = B16 >> 2, ks = B16 & 3;
            const lds_cptr vp = vp0 + T * 8192 + ks * 1024;
#pragma unroll
            for (int d0 = 0; d0 < 2; ++d0) {
                const s16x4 la = vtr(vp + d0 * 4096), ha = vtr(vp + d0 * 4096 + 512), lb_ = vtr(vp + d0 * 4096 + 1024), hb = vtr(vp + d0 * 4096 + 1536);
                o[d0] = __builtin_amdgcn_mfma_f32_32x32x16_bf16(VFRAG(la, ha), ASBF(pwa), o[d0], 0, 0, 0);
                o[d0] = __builtin_amdgcn_mfma_f32_32x32x16_bf16(VFRAG(lb_, hb), ASBF(pwb), o[d0], 0, 0, 0); } }
        BSEG(6);
        bf16* OUT = BPb + (size_t)cur.pat * 32768 * 512; float* ST = BSTb + (size_t)cur.pat * 32768 * 16;
        const float il = __builtin_amdgcn_rcpf(l);
        LAS char* stg = shm + B_STG + wid * 4096;
#pragma unroll
        for (int d0 = 0; d0 < 2; ++d0)
#pragma unroll
            for (int kq = 0; kq < 4; ++kq) { f32x2_t w2; w2.x = __uint_as_float(cvtpk(o[d0][4 * kq] * il, o[d0][4 * kq + 1] * il)); w2.y = __uint_as_float(cvtpk(o[d0][4 * kq + 2] * il, o[d0][4 * kq + 3] * il));
                *(LAS f32x2_t*)(stg + r32 * 128 + (((d0 * 8 + 2 * kq + hi) ^ ((r32 & 7) << 1)) << 3)) = w2; }
        ATT_LDSW();
        const long tok = rowbase + (long)iq * dil + res;
        if (hi == 0) { f32x2_t ml = {m, l}; *(f32x2_t*)(ST + (tok * 8 + h) * 2) = ml; }
#pragma unroll
        for (int k = 0; k < 4; ++k) { const int row = k * 8 + (lane >> 3), ch = lane & 7; const u32x4 v = *(const LAS u32x4*)(stg + row * 128 + ((ch ^ (row & 7)) << 4));
            const long trow = rowbase + (long)(i0 + 32 * wid + row) * dil + res; *(u32x4*)(OUT + trow * 512 + h * 64 + ch * 8) = v; }
        asm volatile("s_waitcnt lgkmcnt(0)\n\ts_barrier" ::: "memory");
        cur = nxt;
    }
    BSEG(-1);
    ATT_WAIT_BAR(0);
#undef B_ISSUE_K
#undef B_ISSUE_Q
#undef B_ISSUE_V
}

constexpr int C_SLOT = 16384, C_FLAGS = 49152, C_STG = 53248;
__device__ __forceinline__ void sb_unit(int b, int h, int qb, const bf16* __restrict__ PC, bf16* __restrict__ YC, const __attribute__((address_space(1))) unsigned* qctr, LAS int* qslot, LAS char* shm, const int tid) {
    const int lane = tid & 63, r32 = lane & 31, hi = lane >> 5;
    const int wid = __builtin_amdgcn_readfirstlane(tid >> 6);
    const long rowbase = (long)b * SEQ; const int q0 = qb * 256, qw0 = q0 + 32 * wid, qi = qw0 + r32;
    const unsigned lds0 = (unsigned)(size_t)shm;
    volatile LAS int* fl = (volatile LAS int*)(shm + C_FLAGS);
    const bf16* ksrc = PC + (rowbase + lane) * PP + 512 + h * 64 + wid * 8;
    const bf16* vsrc = PC + (rowbase + 16 * (wid & 3) + (lane >> 2)) * PP + 1024 + h * 64 + (wid >> 2) * 32 + (lane & 3) * 8;
    const int NT = 4 * qb + 4;
#define C_ISSUE(t_, sl_) do { const long ro_ = (long)(t_) * 64 * PP; const unsigned sb_ = (unsigned)__builtin_amdgcn_readfirstlane(lds0 + (unsigned)(sl_)); \
        glds16(ksrc + ro_, sb_ + wid * 1024); glds16(vsrc + ro_, sb_ + 8192 + wid * 1024); } while (0)
    const bf16* qp = PC + (rowbase + qi) * PP + h * 64 + hi * 8;
    unsigned un_ = 0u;
    if (tid == 0) asm volatile("global_atomic_add %0, %1, %2, off sc0" : "=v"(un_) : "v"(qctr), "v"(1u) : "memory");
    bf16x8 qr[4];
    asm volatile("global_load_dwordx4 %0, %1, off" : "=v"(qr[0]) : "v"(qp) : "memory"); asm volatile("global_load_dwordx4 %0, %1, off offset:32" : "=v"(qr[1]) : "v"(qp) : "memory");
    asm volatile("global_load_dwordx4 %0, %1, off offset:64" : "=v"(qr[2]) : "v"(qp) : "memory"); asm volatile("global_load_dwordx4 %0, %1, off offset:96" : "=v"(qr[3]) : "v"(qp) : "memory");
    C_ISSUE(NT - 1, 0); C_ISSUE(NT - 2, C_SLOT);
    float c = 1.f; bool wdone = false; f32x16 o[2]; o[0] = f32x16{}; o[1] = f32x16{};
    int sl = 0, sl2 = 2 * C_SLOT;
    for (int it = 0; it < NT; ++it) {
        if (it + 1 < NT) { ATT_WAIT_BAR(2); } else { ATT_WAIT_BAR(0); }
        if (it > 0) {
            const volatile LAS int* f = fl + ((it - 1) & 1) * 8;
            const int all = f[0] & f[1] & f[2] & f[3] & f[4] & f[5] & f[6] & f[7];
            if (all) break;
        }
        if (it + 2 < NT) C_ISSUE(NT - 3 - it, sl2);
        const int kbase = 64 * (NT - 1 - it);
        if (!wdone && kbase <= qw0) {
            const lds_cptr kp = shm + sl + hi * 1024 + r32 * 16;
            f32x16 p0 = f32x16{}, p1 = f32x16{};
#pragma unroll
            for (int d0 = 0; d0 < 4; ++d0) { const bf16x8 k0 = ldk(kp + d0 * 2048), k1 = ldk(kp + d0 * 2048 + 512);
                p0 = __builtin_amdgcn_mfma_f32_32x32x16_bf16(k0, qr[d0], p0, 0, 0, 0); p1 = __builtin_amdgcn_mfma_f32_32x32x16_bf16(k1, qr[d0], p1, 0, 0, 0); }
            const lds_cptr vp = shm + sl + 8192 + ((lane >> 4) & 1) * 32 + (lane & 3) * 8 + (4 * hi + ((lane & 15) >> 2)) * 64;
            s16x4 vf[2][8];
#pragma unroll
            for (int d0 = 0; d0 < 2; ++d0)
#pragma unroll
                for (int k = 0; k < 8; ++k) vf[d0][k] = vtr(vp + d0 * 4096 + k * 512);
            __builtin_amdgcn_sched_barrier(0);
            if (kbase + 63 >= qw0) {
#pragma unroll
                for (int r = 0; r < 16; ++r) { const int kv = kbase + crow(r, hi); if (kv >= qi) p0[r] = NEGINF; if (kv + 32 >= qi) p1[r] = NEGINF; }
            }
            f32x16 N0, N1;
#pragma unroll
            for (int r = 0; r < 16; ++r) {
                { const float z = p0[r], e = __builtin_amdgcn_exp2f(-fabsf(z)), q = __builtin_amdgcn_rcpf(1.f + e), eq = e * q; const bool ps = z >= 0.f; p0[r] = ps ? q : eq; N0[r] = ps ? eq : q; }
                { const float z = p1[r], e = __builtin_amdgcn_exp2f(-fabsf(z)), q = __builtin_amdgcn_rcpf(1.f + e), eq = e * q; const bool ps = z >= 0.f; p1[r] = ps ? q : eq; N1[r] = ps ? eq : q; }
            }
            float T[8], U[8];
#pragma unroll
            for (int k = 0; k < 8; ++k) { const f32x16& Nx = (k < 4) ? N0 : N1; const int rb = 4 * (k & 3); T[k] = (Nx[rb] * Nx[rb + 1]) * (Nx[rb + 2] * Nx[rb + 3]); }
#pragma unroll
            for (int k = 0; k < 8; ++k) U[k] = xhalf(T[k], hi);
            float R = c;
#pragma unroll
            for (int k = 7; k >= 0; --k) {
                const float sufk = (hi == 0) ? R * U[k] : R;
                f32x16& Nx = (k < 4) ? N0 : N1; f32x16& Px = (k < 4) ? p0 : p1; const int rb = 4 * (k & 3);
                const float s3 = sufk, s2 = s3 * Nx[rb + 3], s1 = s2 * Nx[rb + 2], s0 = s1 * Nx[rb + 1];
                Px[rb + 3] *= s3; Px[rb + 2] *= s2; Px[rb + 1] *= s1; Px[rb + 0] *= s0;
                R *= T[k] * U[k];
            }
            c = R;
            const u32x4 pw0 = PACK8(p0, 0), pw1 = PACK8(p0, 8), pw2 = PACK8(p1, 0), pw3 = PACK8(p1, 8);
#pragma unroll
            for (int d0 = 0; d0 < 2; ++d0) {
                const s16x4 l0 = vf[d0][0], h0 = vf[d0][1], l1 = vf[d0][2], h1 = vf[d0][3], l2 = vf[d0][4], h2 = vf[d0][5], l3 = vf[d0][6], h3 = vf[d0][7];
                o[d0] = __builtin_amdgcn_mfma_f32_32x32x16_bf16(VFRAG(l0, h0), ASBF(pw0), o[d0], 0, 0, 0);
                o[d0] = __builtin_amdgcn_mfma_f32_32x32x16_bf16(VFRAG(l1, h1), ASBF(pw1), o[d0], 0, 0, 0);
                o[d0] = __builtin_amdgcn_mfma_f32_32x32x16_bf16(VFRAG(l2, h2), ASBF(pw2), o[d0], 0, 0, 0);
                o[d0] = __builtin_amdgcn_mfma_f32_32x32x16_bf16(VFRAG(l3, h3), ASBF(pw3), o[d0], 0, 0, 0);
            }
            wdone = __all(c < 0x1p-64f);
        }
        if (lane == 0) fl[(it & 1) * 8 + wid] = wdone ? 1 : 0;
        sl2 = sl; sl = (sl == 2 * C_SLOT) ? 0 : sl + C_SLOT;
    }
#undef C_ISSUE
    ATT_WAIT_BAR(0);
    if (tid == 0) { asm volatile("" : "+v"(un_)); *qslot = (int)un_; }
    LAS char* stg = shm + C_STG + wid * 4096;
#pragma unroll
    for (int d0 = 0; d0 < 2; ++d0)
#pragma unroll
        for (int kq = 0; kq < 4; ++kq) { f32x2_t w2; w2.x = __uint_as_float(cvtpk(o[d0][4 * kq], o[d0][4 * kq + 1])); w2.y = __uint_as_float(cvtpk(o[d0][4 * kq + 2], o[d0][4 * kq + 3]));
            *(LAS f32x2_t*)(stg + r32 * 128 + (((d0 * 8 + 2 * kq + hi) ^ ((r32 & 7) << 1)) << 3)) = w2; }
    ATT_LDSW();
    bf16* Yw = YC + (rowbase + qw0) * 512 + h * 64;
#pragma unroll
    for (int i = 0; i < 4; ++i) { const int row = i * 8 + (lane >> 3), ch = lane & 7; const u32x4 v = *(const LAS u32x4*)(stg + row * 128 + ((ch ^ (row & 7)) << 4)); *(u32x4*)(Yw + (long)row * 512 + ch * 8) = v; }
    asm volatile("s_waitcnt lgkmcnt(0)\n\ts_barrier" ::: "memory");
}
#undef LAS
}

constexpr int NWAVES = 8;
constexpr int BATCH = 8, SEQ = 4096, D = 1024, M = BATCH * SEQ;
constexpr int BW = 512, NPROJ = 9 * BW, NGATE = 3 * D, DFF = 2816, DFX = 3584, NEXP = 8;
constexpr float EPS = 1e-6f, LOG2E_F = 1.4426950408889634f;
constexpr float C2 = 0.125f * LOG2E_F;
#ifndef GATE0_FP8
#define GATE0_FP8 1
#endif
#define GATE_FP8(L) (((L) == 0) ? (GATE0_FP8 != 0) : (MIX_FP8 >= 1))
#ifndef MIX_FP8
#define MIX_FP8 1
#endif
#ifndef DENSE_DOWN_FP8
#define DENSE_DOWN_FP8 1
#endif
#ifndef DENSE_FP8
#define DENSE_FP8 0
#endif
#ifndef FFN_FP8
#define FFN_FP8 1
#endif
constexpr int MOE_CH_TILES = FFN_FP8 ? 128 : 64, MOE_MAX_TILES = 264, MOE_MAX_CH = FFN_FP8 ? 3 : 5;

constexpr size_t MiB = 1u << 20, KiB = 1u << 10;
constexpr size_t WS_CTL = 0, CTL_ZERO_BYTES = 1 * MiB;
constexpr size_t WS_WIN = 1 * MiB, WS_WG = 19 * MiB, WS_WB = 31 * MiB, WS_WO = 37 * MiB, WS_WGU = 41 * MiB, WS_WD = 52 * MiB;
constexpr size_t WS_BST = 58 * MiB;
constexpr size_t WS_TOKE = 64 * MiB, WS_TOKW = WS_TOKE + 128 * KiB, WS_SLOT = WS_TOKE + 384 * KiB, WS_SLW = WS_TOKE + 640 * KiB, WS_CNT = WS_TOKE + 960 * KiB, WS_MHDR = WS_TOKE + 992 * KiB;
constexpr size_t WS_H = 66 * MiB;
constexpr size_t WS_PA = 130 * MiB, WS_PB = 226 * MiB, WS_PC = 322 * MiB;
constexpr size_t WS_YA = 418 * MiB, WS_YB = 450 * MiB, WS_YC = 482 * MiB;
constexpr size_t WS_BP = 130 * MiB;
constexpr size_t WS_GATES = 226 * MiB;
constexpr size_t WS_ACT = 130 * MiB;
constexpr size_t WS_MWGU = 130 * MiB, WS_MWD = 242 * MiB;
constexpr size_t WS_HS = 298 * MiB;
constexpr size_t WS_MACT = 430 * MiB;
constexpr size_t WS_XB = 418 * MiB;
constexpr size_t WS_PART = 482 * MiB;
constexpr size_t WS_END = 538 * MiB;
constexpr int MOE_SK = 7, MOE_SK_ROWS = (MOE_MAX_TILES - 2 * MOE_CH_TILES) * 256;
static_assert(MOE_MAX_CH == 3 && WS_PART + (size_t)MOE_SK * MOE_SK_ROWS * D * 4 <= WS_END, "split-K partials");
constexpr size_t OUT_YA = 0, OUT_YB = 32 * MiB, OUT_YC = 64 * MiB, OUT_H8 = 96 * MiB, OUT_MACT8 = 0;
static_assert(FFN_FP8 == 1 && OUT_H8 + (size_t)M * D <= (size_t)M * D * 4 && OUT_MACT8 + (size_t)MOE_CH_TILES * 256 * DFX <= (size_t)M * D * 4, "d_out scratch map");
constexpr size_t WS8_MWGU = 130 * MiB, WS8_MWD = 186 * MiB, WS8_HS = 214 * MiB, WS8_YS = 280 * MiB, WS8_MACT = 412 * MiB;
static_assert(WS8_MWGU + (size_t)NEXP * 2 * DFX * D <= WS8_MWD && WS8_MWD + (size_t)NEXP * D * DFX <= WS8_HS && WS8_HS + (size_t)MOE_MAX_TILES * 256 * D <= WS8_YS && WS8_YS + (size_t)MOE_MAX_TILES * 256 * D * 2 <= WS_XB && WS_XB + (size_t)M * D * 2 <= WS_END, "d_ws map fp8");
static_assert(WS_WD + (size_t)D * DFF * 2 <= WS_BST && WS_HS + (size_t)MOE_MAX_TILES * 256 * D * 2 <= WS_MACT , "d_ws map");
static_assert(WS_MWGU + (size_t)NEXP * 2 * DFX * D * 2 <= WS_MWD && WS_MWD + (size_t)NEXP * D * DFX * 2 <= WS_HS && WS_ACT + (size_t)M * DFF * 2 <= WS_PC, "d_ws map 2");
constexpr int CW_BAR = 4096, CW_Q = 16384, CW_KM = 49152, CW_KC = 53248;

constexpr int RING_OFF = 0, LDSCTL_OFF = 139264, MISC_OFF = LDSCTL_OFF + 320, LTAB_OFF = LDSCTL_OFF + 1024;
constexpr int LDS_BYTES = 147456;

#define GAS __attribute__((address_space(1)))
#define LAS __attribute__((address_space(3)))
typedef unsigned short bf16;
typedef unsigned v4u __attribute__((ext_vector_type(4)));
typedef unsigned v2u __attribute__((ext_vector_type(2)));
typedef float f32x4 __attribute__((ext_vector_type(4)));
typedef float f32x2 __attribute__((ext_vector_type(2)));
typedef GAS unsigned gu32;
#define RLX_AGENT __ATOMIC_RELAXED, __HIP_MEMORY_SCOPE_AGENT
#define LDS_WAIT() asm volatile("s_waitcnt lgkmcnt(0)" ::: "memory")
#define VM_WAIT() asm volatile("s_waitcnt vmcnt(0)" ::: "memory")
__device__ __forceinline__ unsigned f2bf(float f) { unsigned u = __builtin_bit_cast(unsigned, f); return (u + 0x7fffu + ((u >> 16) & 1u)) >> 16; }
__device__ __forceinline__ unsigned pk2(float lo, float hi) { return f2bf(lo) | (f2bf(hi) << 16); }
__device__ __forceinline__ float bfl(unsigned w) { return __uint_as_float(w << 16); }
__device__ __forceinline__ float bfh(unsigned w) { return __uint_as_float(w & 0xffff0000u); }

#define XB_TMO      128
#define XB_XCNT(j)  (256  + 64 * (j))
#define XB_XSUB(j)  (1280 + 64 * (j))
#define XB_XGEN(j)  (2304 + 64 * (j))
#define XB_TOP      3328
#define XB_TOPGEN   3392
#define XCD_BAR_WORDS 3456
#define XB_SPIN_CAP (1u << 18)

__device__ __forceinline__ unsigned xb_ld(unsigned* p)              { return __hip_atomic_load(p, __ATOMIC_RELAXED, __HIP_MEMORY_SCOPE_AGENT); }
__device__ __forceinline__ unsigned xb_add(unsigned* p, unsigned v) { return __hip_atomic_fetch_add(p, v, __ATOMIC_RELAXED, __HIP_MEMORY_SCOPE_AGENT); }
__device__ __forceinline__ unsigned xb_xcc_id() { return (unsigned)__builtin_amdgcn_s_getreg((3 << 11) | 20) & 0xFu; }
#define XB_SPIN(cond, bar) do { unsigned _sp = 0; while (cond) { __builtin_amdgcn_s_sleep(1); \
    if ((++_sp & 255u) == 0u) { if (xb_ld(&(bar)[XB_TMO])) break; if (_sp > XB_SPIN_CAP) { atomicAdd(&(bar)[XB_TMO], 1u); break; } } } } while (0)

struct XcdBarrier {
    unsigned* bar; unsigned x;
    volatile LAS unsigned* st;
};

__device__ __forceinline__ XcdBarrier xcd_barrier_post(unsigned* bar, volatile LAS unsigned* st) {
    XcdBarrier b; b.bar = bar; b.x = xb_xcc_id(); b.st = st;
    if (threadIdx.x == 0) (void)xb_add(&bar[XB_XCNT(b.x)], 1u);
    return b;
}
__device__ __forceinline__ void xcd_barrier_complete(unsigned* bar, unsigned x, unsigned& nloc, unsigned& nx) {
    const unsigned G = gridDim.x * gridDim.y * gridDim.z;
    unsigned sum, cnt, mine, sp = 0u;
    for (;;) {
        sum = 0u; cnt = 0u; mine = 0u;
#pragma unroll
        for (unsigned j = 0; j < 16; ++j) { const unsigned c = xb_ld(&bar[XB_XCNT(j)]); sum += c; cnt += (c > 0u) ? 1u : 0u; mine = (j == x) ? c : mine; }
        if (sum == G) break;
        __builtin_amdgcn_s_sleep(1);
        if ((++sp & 255u) == 0u) { if (xb_ld(&bar[XB_TMO])) break; if (sp > XB_SPIN_CAP) { atomicAdd(&bar[XB_TMO], 1u); break; } }
    }
    nloc = mine > 0u ? mine : 1u; nx = cnt > 0u ? cnt : 1u;
}

__device__ __forceinline__ void xcd_barrier(const XcdBarrier& b) {
    asm volatile("s_waitcnt vmcnt(0)" ::: "memory");
    __syncthreads();
    if (threadIdx.x == 0) {
        unsigned* bar = b.bar;
        __builtin_amdgcn_s_waitcnt(0);
        unsigned nloc = b.st[0], nx = b.st[1];
        if (nloc == 0u) { xcd_barrier_complete(bar, b.x, nloc, nx); b.st[0] = nloc; b.st[1] = nx; }
        const unsigned old = xb_add(&bar[XB_XSUB(b.x)], 1u);
        const unsigned gen = old / nloc;
        if (old + 1u == (gen + 1u) * nloc) {
            __builtin_amdgcn_fence(__ATOMIC_RELEASE, "agent");
            asm volatile("s_waitcnt vmcnt(0)" ::: "memory");
            const unsigned og = xb_add(&bar[XB_TOP], 1u);
            const unsigned tg = og / nx;
            if (og + 1u == (tg + 1u) * nx) xb_add(&bar[XB_TOPGEN], 1u);
            else XB_SPIN(xb_ld(&bar[XB_TOPGEN]) == tg, bar);
            __builtin_amdgcn_fence(__ATOMIC_ACQUIRE, "agent");
            xb_add(&bar[XB_XGEN(b.x)], 1u);
            asm volatile("s_waitcnt vmcnt(0)" ::: "memory");
        } else {
            XB_SPIN(xb_ld(&bar[XB_XGEN(b.x)]) == gen, bar);
            __builtin_amdgcn_fence(__ATOMIC_ACQUIRE, "agent");
            asm volatile("s_waitcnt vmcnt(0)" ::: "memory");
        }
    }
    __syncthreads();
}


template <int OF> __device__ __forceinline__ float swz_f(float v) { return __int_as_float(__builtin_amdgcn_ds_swizzle(__float_as_int(v), (OF << 10) | 0x1f)); }
template <int OF> __device__ __forceinline__ int swz_i(int v) { return __builtin_amdgcn_ds_swizzle(v, (OF << 10) | 0x1f); }
__device__ __forceinline__ float x32_f(float v) { auto rr = __builtin_amdgcn_permlane32_swap(__float_as_uint(v), __float_as_uint(v), false, false); return __uint_as_float(rr[0]) + __uint_as_float(rr[1]); }
__device__ __forceinline__ int x32_i(int v) { auto rr = __builtin_amdgcn_permlane32_swap((unsigned)v, (unsigned)v, false, false); return (int)(rr[0] + rr[1]); }
__device__ __forceinline__ float wave_sum(float v) {
    v += swz_f<1>(v); v += swz_f<2>(v); v += swz_f<4>(v); v += swz_f<8>(v); v += swz_f<16>(v); return x32_f(v);
}
__device__ __forceinline__ int wave_sum_i(int v) { v += swz_i<1>(v); v += swz_i<2>(v); v += swz_i<4>(v); v += swz_i<8>(v); v += swz_i<16>(v); return x32_i(v); }
__device__ __forceinline__ void transpose_item(const float* W, int K, int N, bf16* WT, int row_off, LAS float* scr, int k0, int n0, int lane) {
    f32x4 wv_[8];
#pragma unroll
    for (int i = 0; i < 8; ++i) wv_[i] = *(const GAS f32x4*)(W + (size_t)(k0 + 8 * i + (lane >> 3)) * N + n0 + 4 * (lane & 7));
#pragma unroll
    for (int i = 0; i < 8; ++i) { LAS float* d = scr + (8 * i + (lane >> 3)) * 33 + 4 * (lane & 7); d[0] = wv_[i].x; d[1] = wv_[i].y; d[2] = wv_[i].z; d[3] = wv_[i].w; }
    LDS_WAIT(); asm volatile("" ::: "memory");
    const int c = lane & 7;
#pragma unroll
    for (int j = 0; j < 4; ++j) { const int n = (lane >> 3) + 8 * j; const LAS float* s = scr + (8 * c) * 33 + n;
        v4u o; o.x = pk2(s[0 * 33], s[1 * 33]); o.y = pk2(s[2 * 33], s[3 * 33]); o.z = pk2(s[4 * 33], s[5 * 33]); o.w = pk2(s[6 * 33], s[7 * 33]);
        *(GAS v4u*)(WT + (size_t)(row_off + n0 + n) * K + k0 + 8 * c) = o; }
    LDS_WAIT(); asm volatile("" ::: "memory");
}
__device__ __forceinline__ void conv_matrix(const float* W, int K, int N, bf16* WT, int mode, LAS float* scr, int gw, int ngw, int lane) {
    const int nblk = N / 32, items = (K / 64) * nblk;
    for (int it = gw; it < items; it += ngw) { const int kb = it / nblk, nb = it - kb * nblk, n0 = 32 * nb;
        const int d0 = mode == 0 ? n0 : (256 * (n0 >> 7) + (n0 & 127) + (mode == 2 ? 128 : 0));
        transpose_item(W, K, N, WT, d0 - n0, scr, 64 * kb, n0, lane); }
}
__device__ __forceinline__ void transpose_item8(const float* W, int K, int N, unsigned char* WT, int row_off, LAS float* scr, int k0, int n0, int lane) {
    f32x4 wv_[8];
#pragma unroll
    for (int i = 0; i < 8; ++i) wv_[i] = *(const GAS f32x4*)(W + (size_t)(k0 + 8 * i + (lane >> 3)) * N + n0 + 4 * (lane & 7));
#pragma unroll
    for (int i = 0; i < 8; ++i) { LAS float* d = scr + (8 * i + (lane >> 3)) * 33 + 4 * (lane & 7); d[0] = wv_[i].x; d[1] = wv_[i].y; d[2] = wv_[i].z; d[3] = wv_[i].w; }
    LDS_WAIT(); asm volatile("" ::: "memory");
    const int c = lane & 7; const float sc = (float)(1 << pg8::F8_WSHIFT);
#pragma unroll
    for (int j = 0; j < 4; ++j) { const int n = (lane >> 3) + 8 * j; const LAS float* s = scr + (8 * c) * 33 + n;
        v2u o; o.x = pg8::pk4_fp8(s[0 * 33] * sc, s[1 * 33] * sc, s[2 * 33] * sc, s[3 * 33] * sc); o.y = pg8::pk4_fp8(s[4 * 33] * sc, s[5 * 33] * sc, s[6 * 33] * sc, s[7 * 33] * sc);
        *(GAS v2u*)(WT + (size_t)(row_off + n0 + n) * K + k0 + 8 * c) = o; }
    LDS_WAIT(); asm volatile("" ::: "memory");
}
__device__ __forceinline__ void conv_matrix8(const float* W, int K, int N, unsigned char* WT, int mode, LAS float* scr, int gw, int ngw, int lane) {
    const int nblk = N / 32, items = (K / 64) * nblk;
    for (int it = gw; it < items; it += ngw) { const int kb = it / nblk, nb = it - kb * nblk, n0 = 32 * nb;
        const int d0 = mode == 0 ? n0 : (256 * (n0 >> 7) + (n0 & 127) + (mode == 2 ? 128 : 0));
        transpose_item8(W, K, N, WT, d0 - n0, scr, 64 * kb, n0, lane); }
}
__device__ __forceinline__ void conv_flat8(const float* W, size_t wstride, int nmat, int K, int N, unsigned char* WT, size_t tstride, int mode, LAS unsigned char* ldsb, int wave, int gw, int ngw, int lane) {
    LAS float* const s = (LAS float*)(ldsb + wave * 17408);
    const int nblk = N / 32, ipm = (K / 128) * nblk, items = nmat * ipm; const float sc = (float)(1 << pg8::F8_WSHIFT);
    for (int it = gw; it < items; it += ngw) {
        const int e = it / ipm, idx = it - e * ipm, kb = idx / nblk, nb = idx - kb * nblk, n0 = 32 * nb, k0 = 128 * kb;
        const float* Wp = W + (size_t)e * wstride; unsigned char* Tp = WT + (size_t)e * tstride;
        f32x4 wv[16];
#pragma unroll
        for (int i = 0; i < 16; ++i) wv[i] = *(const GAS f32x4*)(Wp + (size_t)(k0 + 8 * i + (lane >> 3)) * N + n0 + 4 * (lane & 7));
#pragma unroll
        for (int i = 0; i < 16; ++i) { LAS float* d = s + (8 * i + (lane >> 3)) * 33 + 4 * (lane & 7); d[0] = wv[i].x; d[1] = wv[i].y; d[2] = wv[i].z; d[3] = wv[i].w; }
        LDS_WAIT(); asm volatile("" ::: "memory");
        const int d0 = mode == 0 ? n0 : (256 * (n0 >> 7) + (n0 & 127) + (mode == 2 ? 128 : 0)); const int n = lane & 31;
#pragma unroll
        for (int j = 0; j < 4; ++j) { const int c = (lane >> 5) + 2 * j; const LAS float* p = s + (16 * c) * 33 + n; v4u o;
            o.x = pg8::pk4_fp8(p[0 * 33] * sc, p[1 * 33] * sc, p[2 * 33] * sc, p[3 * 33] * sc); o.y = pg8::pk4_fp8(p[4 * 33] * sc, p[5 * 33] * sc, p[6 * 33] * sc, p[7 * 33] * sc);
            o.z = pg8::pk4_fp8(p[8 * 33] * sc, p[9 * 33] * sc, p[10 * 33] * sc, p[11 * 33] * sc); o.w = pg8::pk4_fp8(p[12 * 33] * sc, p[13 * 33] * sc, p[14 * 33] * sc, p[15 * 33] * sc);
            *(GAS v4u*)(Tp + (size_t)(d0 + n) * K + k0 + 16 * c) = o; }
        LDS_WAIT(); asm volatile("" ::: "memory");
    }
}
__device__ __forceinline__ void store_row_fp8(unsigned char* orow, const f32x4 (&v)[4], int lane) {
    GAS unsigned* o4 = (GAS unsigned*)orow + lane;
#pragma unroll
    for (int j = 0; j < 4; ++j) o4[64 * j] = pg8::pk4_fp8(v[j].x, v[j].y, v[j].z, v[j].w);
}
__device__ __forceinline__ void rms_row(const float* xrow, const f32x4 (&g)[4], f32x4 (&v)[4], int lane) {
    const GAS f32x4* xr = (const GAS f32x4*)xrow + lane; float s2 = 0.f;
#pragma unroll
    for (int j = 0; j < 4; ++j) { v[j] = xr[64 * j]; s2 += (v[j].x * v[j].x + v[j].y * v[j].y) + (v[j].z * v[j].z + v[j].w * v[j].w); }
    const float rstd = 1.f / sqrtf(wave_sum(s2) * (1.f / D) + EPS);
#pragma unroll
    for (int j = 0; j < 4; ++j) v[j] = v[j] * rstd * g[j];
}
__device__ __forceinline__ f32x4 bf4(const v2u w) { return (f32x4){bfl(w.x), bfh(w.x), bfl(w.y), bfh(w.y)}; }
__device__ __forceinline__ void rms_row(const bf16* xrow, const f32x4 (&g)[4], f32x4 (&v)[4], int lane) {
    const GAS v2u* xr = (const GAS v2u*)xrow + lane; float s2 = 0.f; v2u w[4];
#pragma unroll
    for (int j = 0; j < 4; ++j) w[j] = xr[64 * j];
#pragma unroll
    for (int j = 0; j < 4; ++j) { v[j] = bf4(w[j]); s2 += (v[j].x * v[j].x + v[j].y * v[j].y) + (v[j].z * v[j].z + v[j].w * v[j].w); }
    const float rstd = 1.f / sqrtf(wave_sum(s2) * (1.f / D) + EPS);
#pragma unroll
    for (int j = 0; j < 4; ++j) v[j] = v[j] * rstd * g[j];
}
__device__ __forceinline__ void rms_row2(const bf16* xa, const bf16* xb, const f32x4 (&g)[4], f32x4 (&va)[4], f32x4 (&vb)[4], int lane) {
    const GAS v2u* pa = (const GAS v2u*)xa + lane; const GAS v2u* pb = (const GAS v2u*)xb + lane; float sa = 0.f, sb = 0.f; v2u wa[4], wb[4];
#pragma unroll
    for (int j = 0; j < 4; ++j) { wa[j] = pa[64 * j]; wb[j] = pb[64 * j]; }
#pragma unroll
    for (int j = 0; j < 4; ++j) { va[j] = bf4(wa[j]); vb[j] = bf4(wb[j]); sa += (va[j].x * va[j].x + va[j].y * va[j].y) + (va[j].z * va[j].z + va[j].w * va[j].w); sb += (vb[j].x * vb[j].x + vb[j].y * vb[j].y) + (vb[j].z * vb[j].z + vb[j].w * vb[j].w); }
    const float ra = 1.f / sqrtf(wave_sum(sa) * (1.f / D) + EPS), rb = 1.f / sqrtf(wave_sum(sb) * (1.f / D) + EPS);
#pragma unroll
    for (int j = 0; j < 4; ++j) { va[j] = va[j] * ra * g[j]; vb[j] = vb[j] * rb * g[j]; }
}
__device__ __forceinline__ void rms_row2(const float* xa, const float* xb, const f32x4 (&g)[4], f32x4 (&va)[4], f32x4 (&vb)[4], int lane) {
    const GAS f32x4* pa = (const GAS f32x4*)xa + lane; const GAS f32x4* pb = (const GAS f32x4*)xb + lane; float sa = 0.f, sb = 0.f;
#pragma unroll
    for (int j = 0; j < 4; ++j) { va[j] = pa[64 * j]; vb[j] = pb[64 * j]; }
#pragma unroll
    for (int j = 0; j < 4; ++j) { sa += (va[j].x * va[j].x + va[j].y * va[j].y) + (va[j].z * va[j].z + va[j].w * va[j].w); sb += (vb[j].x * vb[j].x + vb[j].y * vb[j].y) + (vb[j].z * vb[j].z + vb[j].w * vb[j].w); }
    const float ra = 1.f / sqrtf(wave_sum(sa) * (1.f / D) + EPS), rb = 1.f / sqrtf(wave_sum(sb) * (1.f / D) + EPS);
#pragma unroll
    for (int j = 0; j < 4; ++j) { va[j] = va[j] * ra * g[j]; vb[j] = vb[j] * rb * g[j]; }
}
__device__ __forceinline__ void store_row_bf16(bf16* orow, const f32x4 (&v)[4], int lane) {
    GAS v2u* o8 = (GAS v2u*)orow + lane;
#pragma unroll
    for (int j = 0; j < 4; ++j) { v2u w; w.x = pk2(v[j].x, v[j].y); w.y = pk2(v[j].z, v[j].w); o8[64 * j] = w; }
}


enum { PH_PRO = 0, PH_L = 20, NPHASE = 1 + 2 * PH_L };
struct Args { const float* in[18]; float* out; unsigned char* ws; int ph_lo, ph_hi; };
static_assert(sizeof(Args) == 18 * 8 + 8 + 8 + 8, "Args has no padding");

__global__ void __launch_bounds__(NWAVES * 64, 2) mega_fwd(Args args) {
    extern __shared__ __attribute__((aligned(16))) unsigned char lds_raw[];
    LAS unsigned char* const lds = (LAS unsigned char*)lds_raw;
    volatile LAS unsigned* const MISC = (volatile LAS unsigned*)(lds + MISC_OFF);
    const int wave_k = __builtin_amdgcn_readfirstlane((int)threadIdx.x >> 6);
    const int G = gridDim.x, bx = blockIdx.x; const int vcu = (G % 8 == 0) ? (bx % 8) * (G / 8) + bx / 8 : bx;
    const int NGW = G * NWAVES;
    unsigned char* const ws = args.ws;
    gu32* const ctl = (gu32*)(ws + WS_CTL);
    for (int u = threadIdx.x; u < (LDS_BYTES - LDSCTL_OFF) / 4; u += NWAVES * 64) ((LAS unsigned*)(lds + LDSCTL_OFF))[u] = 0u;
    __syncthreads();
#if MK_N_LAUNCHES == 1
    XcdBarrier bar = xcd_barrier_post((unsigned*)(ctl + CW_BAR), MISC + 8);
#ifndef PROBE_AMP
#define PROBE_AMP 1
#endif
#ifdef PROBE_CAT
#define SEAM() do { xcd_barrier(bar); if (bx == 0 && threadIdx.x == 0) { const unsigned long long tn_ = __builtin_amdgcn_s_memrealtime(); volatile LAS unsigned* pa_ = (volatile LAS unsigned*)(lds + LDSCTL_OFF + 640); if (cat_ == PROBE_CAT) pa_[0] += (unsigned)(tn_ - *(volatile LAS unsigned long long*)(lds + LDSCTL_OFF + 704)); *(volatile LAS unsigned long long*)(lds + LDSCTL_OFF + 704) = tn_; } } while (0)
#else
#define SEAM() xcd_barrier(bar)
#endif
#else
#define SEAM() do { } while (0)
#endif
    const int lo = args.ph_lo, hi = args.ph_hi;
#ifdef PROBE_CAT
    int cat_ = 0; if (bx == 0 && threadIdx.x == 0) *(volatile LAS unsigned long long*)(lds + LDSCTL_OFF + 704) = __builtin_amdgcn_s_memrealtime();
#define CAT(c) cat_ = (c)
#define STAMP(c) do { if (bx == 0 && threadIdx.x == 0) { const unsigned long long tn_ = __builtin_amdgcn_s_memrealtime(); volatile LAS unsigned* pa_ = (volatile LAS unsigned*)(lds + LDSCTL_OFF + 640); if (cat_ == PROBE_CAT) pa_[0] += (unsigned)(tn_ - *(volatile LAS unsigned long long*)(lds + LDSCTL_OFF + 704)); *(volatile LAS unsigned long long*)(lds + LDSCTL_OFF + 704) = tn_; } cat_ = (c); } while (0)
#else
#define CAT(c) do { } while (0)
#define STAMP(c) do { } while (0)
#endif
#define IN(k) (lo <= (k) && (k) < hi)
#ifndef REPG
#define REPG 1
#endif
#ifndef REPA
#define REPA 1
#endif
#ifndef REPA_A
#define REPA_A REPA
#endif
#ifndef REPA_C
#define REPA_C REPA
#endif
#ifndef REPA_B
#define REPA_B REPA
#endif
#ifndef REPT
#define REPT 1
#endif
#define PHASE_IDS() unsigned z0_ = 0u; asm volatile("" : "+s"(z0_)); int tidp = wave_k * 64 + (int)__builtin_amdgcn_mbcnt_hi(~0u, __builtin_amdgcn_mbcnt_lo(~0u, z0_)); asm volatile("" : "+v"(tidp)); const int tid = tidp, lane = tidp & 63, wave = __builtin_amdgcn_readfirstlane(tidp >> 6); const int gw = vcu * NWAVES + wave; LAS float* const scr = (LAS float*)(lds + RING_OFF + wave * 16384); (void)tid; (void)lane; (void)gw; (void)scr
#define INP(i) ([&]() -> const float* { int i_ = (i); asm volatile("" : "+s"(i_)); return args.in[i_]; }())
#define WSP(T, OFF) ([&]() -> T* { size_t o_ = (size_t)(OFF); asm volatile("" : "+s"(o_)); return (T*)(ws + o_); }())
#define x_in INP(0)
#define norm_mix INP(1)
#define w_in INP(2)
#define diff_lambda INP(3)
#define diff_subln INP(4)
#define w_gate INP(5)
#define b_gate INP(6)
#define w_branch INP(7)
#define w_out INP(8)
#define norm_ffn INP(9)
#define w_dg INP(10)
#define w_du INP(11)
#define w_dd INP(12)
#define w_router INP(13)
#define w_mg INP(14)
#define w_mu INP(15)
#define w_md INP(16)
#define norm_final INP(17)
#define xout (args.out)
#define Win_t WSP(bf16, WS_WIN)
#define Wg_t WSP(bf16, WS_WG)
#define Wb_t WSP(bf16, WS_WB)
#define Wo_t WSP(bf16, WS_WO)
#define Wgu_t WSP(bf16, WS_WGU)
#define Wd_t WSP(bf16, WS_WD)
#define Hb WSP(bf16, WS_H)
#define PA WSP(bf16, WS_PA)
#define PB WSP(bf16, WS_PB)
#define PC WSP(bf16, WS_PC)
#define OUTP(T, OFF) ([&]() -> T* { size_t o_ = (size_t)(OFF); asm volatile("" : "+s"(o_)); return (T*)((unsigned char*)args.out + o_); }())
#define YA OUTP(bf16, OUT_YA)
#define YC OUTP(bf16, OUT_YC)
#define YB OUTP(bf16, OUT_YB)
#define XB WSP(bf16, WS_XB)
#define BP WSP(bf16, WS_BP)
#define BST WSP(float, WS_BST)
#define GATES WSP(unsigned char, WS_GATES)
#define ACT WSP(bf16, WS_ACT)
#define MWgu WSP(bf16, WS_MWGU)
#define MWd WSP(bf16, WS_MWD)
#define HS WSP(bf16, WS_HS)
#define MACT WSP(bf16, WS_MACT)
#define TOKE WSP(int, WS_TOKE)
#define TOKW WSP(float, WS_TOKW)
#define SLOT WSP(int, WS_SLOT)
#define SLW WSP(float, WS_SLW)
#define CNT WSP(int, WS_CNT)
#define MHDR WSP(int, WS_MHDR)
#define Hb8 WSP(unsigned char, WS_H)
#define H8 OUTP(unsigned char, OUT_H8)
#define Win8 WSP(unsigned char, WS_WIN)
#define Wg8 WSP(unsigned char, WS_WG)
#define Wgu8 WSP(unsigned char, WS_WGU)
#define Wd8 WSP(unsigned char, WS_WD)
#define ACT8 WSP(unsigned char, WS_ACT)
#define MWgu8 WSP(unsigned char, WS8_MWGU)
#define MWd8 WSP(unsigned char, WS8_MWD)
#define HS8 WSP(unsigned char, WS8_HS)
#define YS8 WSP(bf16, WS8_YS)
#define MACT8 OUTP(unsigned char, OUT_MACT8)
#define PART WSP(float, WS_PART)

    if (IN(PH_PRO)) { PHASE_IDS(); CAT(1);
        int rot = 0;
#define RGW() ((gw + rot) % NGW)
#define RADV(K_, N_) rot = (rot + ((K_) / 64) * ((N_) / 32)) % NGW
        for (int L = 0; L < 2; ++L) {
#if MIX_FP8 >= 2
            conv_matrix8(w_in + (size_t)L * D * NPROJ, D, NPROJ, Win8 + (size_t)L * NPROJ * D, 0, scr, gw, NGW, lane);
#else
            conv_matrix(w_in + (size_t)L * D * NPROJ, D, NPROJ, Win_t + (size_t)L * NPROJ * D, 0, scr, RGW(), NGW, lane); RADV(D, NPROJ);
#endif
            if (GATE_FP8(L)) conv_matrix8(w_gate + (size_t)L * D * NGATE, D, NGATE, Wg8 + (size_t)L * NGATE * D * 2, 0, scr, RGW(), NGW, lane);
            else conv_matrix(w_gate + (size_t)L * D * NGATE, D, NGATE, Wg_t + (size_t)L * NGATE * D, 0, scr, RGW(), NGW, lane);
            RADV(D, NGATE);
            for (int i = 0; i < 3; ++i) { conv_matrix(w_branch + (size_t)(L * 3 + i) * BW * D, BW, D, Wb_t + (size_t)(L * 3 + i) * D * BW, 0, scr, RGW(), NGW, lane); RADV(BW, D); }
            conv_matrix(w_out + (size_t)L * D * D, D, D, Wo_t + (size_t)L * D * D, 0, scr, RGW(), NGW, lane); RADV(D, D);
        }
#if DENSE_FP8
        conv_matrix8(w_dg, D, DFF, Wgu8, 1, scr, gw, NGW, lane);
        conv_matrix8(w_du, D, DFF, Wgu8, 2, scr, gw, NGW, lane);
        conv_matrix8(w_dd, DFF, D, Wd8, 0, scr, gw, NGW, lane);
#elif DENSE_DOWN_FP8
        conv_matrix(w_dg, D, DFF, Wgu_t, 1, scr, RGW(), NGW, lane); RADV(D, DFF);
        conv_matrix(w_du, D, DFF, Wgu_t, 2, scr, RGW(), NGW, lane); RADV(D, DFF);
        conv_matrix8(w_dd, DFF, D, Wd8, 0, scr, RGW(), NGW, lane);
#else
        conv_matrix(w_dg, D, DFF, Wgu_t, 1, scr, gw, NGW, lane);
        conv_matrix(w_du, D, DFF, Wgu_t, 2, scr, gw, NGW, lane);
        conv_matrix(w_dd, DFF, D, Wd_t, 0, scr, gw, NGW, lane);
#endif
#undef RGW
#undef RADV
        {

            f32x4 g[4];
#pragma unroll
            for (int j = 0; j < 4; ++j) g[j] = ((const GAS f32x4*)(norm_mix) + lane)[64 * j];
            for (int m = gw; m < M; m += 2 * NGW) { f32x4 v[4], w[4]; rms_row2(x_in + (size_t)m * D, x_in + (size_t)(m + NGW) * D, g, v, w, lane);
                store_row_bf16(Hb + (size_t)m * D, v, lane); store_row_bf16(Hb + (size_t)(m + NGW) * D, w, lane);
                if (GATE0_FP8) { store_row_fp8(H8 + (size_t)m * D, v, lane); store_row_fp8(H8 + (size_t)(m + NGW) * D, w, lane); } }
        }
        SEAM();
    }

    for (int L = 0; L < 2; ++L) {
        const int P = 1 + L * PH_L;
        if (L == 1 && IN(P + 0)) { PHASE_IDS(); CAT(2);
            f32x4 g[4];
#pragma unroll
            for (int j = 0; j < 4; ++j) g[j] = ((const GAS f32x4*)(norm_mix + L * D) + lane)[64 * j];
            for (int m = gw; m < M; m += 2 * NGW) { f32x4 v[4], w[4]; rms_row2(XB + (size_t)m * D, XB + (size_t)(m + NGW) * D, g, v, w, lane);
                store_row_bf16(Hb + (size_t)m * D, v, lane); store_row_bf16(Hb + (size_t)(m + NGW) * D, w, lane);
                if (MIX_FP8 >= 1 && L == 1) { store_row_fp8(H8 + (size_t)m * D, v, lane); store_row_fp8(H8 + (size_t)(m + NGW) * D, w, lane); } }
            SEAM();
        }
        if (IN(P + 1)) { PHASE_IDS(); CAT(3);
#if MIX_FP8 >= 2
            pg8::Gemm g{(const bf16*)H8, (const bf16*)(Win8 + (size_t)L * NPROJ * D), D / 2}; pg8::StaticOrder S; S.init(M, NPROJ, D / 2, G, bx);
            pg8::EpiProj E{PA, (size_t)(WS_PB - WS_PA) / 2, C2, pg8::F8_WINV};
            pg8::gemm_phase<pg8::EpiProj, pg8::StaticOrder, true, true, true>(lds + RING_OFF, g, S, E, tidp);
#else
            pg8::Gemm g{Hb, Win_t + (size_t)L * NPROJ * D, D}; pg8::StaticOrder S; S.init(M, NPROJ, D, G, bx);
            pg8::EpiProj E{PA, (size_t)(WS_PB - WS_PA) / 2, C2, 1.f};
            for (int rep_ = 0; rep_ < REPG; ++rep_) { int tq_ = tidp; asm volatile("" : "+v"(tq_)); pg8::gemm_phase<pg8::EpiProj, pg8::StaticOrder, true, true>(lds + RING_OFF, g, S, E, tq_); }
#endif

            SEAM();
        }
        if (IN(P + 2)) { PHASE_IDS(); CAT(40);
            const float lam_init = 0.8f - 0.6f * expf(-0.3f * (float)L);
            float lam;
            { const float* lv = diff_lambda + L * 256; float s01 = lv[lane] * lv[64 + lane], s23 = lv[128 + lane] * lv[192 + lane];
              s01 += att::swz_xor<1>(s01); s01 += att::swz_xor<2>(s01); s01 += att::swz_xor<4>(s01); s01 += att::swz_xor<8>(s01); s01 += att::swz_xor<16>(s01); s01 += att::xhalf(s01, lane >> 5);
              s23 += att::swz_xor<1>(s23); s23 += att::swz_xor<2>(s23); s23 += att::swz_xor<4>(s23); s23 += att::swz_xor<8>(s23); s23 += att::swz_xor<16>(s23); s23 += att::xhalf(s23, lane >> 5);
              lam = expf(s01) - expf(s23) + lam_init; }
            { LAS int* qs = (LAS int*)(lds + LDSCTL_OFF + 512); const int grp = bx & 7;
              gu32* km = ctl + CW_KM + (L * 8 + grp) * 64; gu32* kc = ctl + CW_KC + (L * 8 + grp) * 64;
              { const int r0 = grp * SEQ + (bx >> 3) * 128 + wave * 16; float mx = 0.f; v4u kw[16];
#pragma unroll
                for (int r = 0; r < 16; ++r) kw[r] = *(const GAS v4u*)(PA + (size_t)(r0 + r) * 1536 + 512 + lane * 8);
#pragma unroll
                for (int r = 0; r < 16; ++r) { const v4u w = kw[r];
                    float ss = bfl(w.x) * bfl(w.x) + bfh(w.x) * bfh(w.x) + bfl(w.y) * bfl(w.y) + bfh(w.y) * bfh(w.y) + bfl(w.z) * bfl(w.z) + bfh(w.z) * bfh(w.z) + bfl(w.w) * bfl(w.w) + bfh(w.w) * bfh(w.w);
                    ss += att::swz_xor<1>(ss); ss += att::swz_xor<2>(ss); ss += att::swz_xor<4>(ss); mx = fmaxf(mx, ss); }
                if ((lane & 7) == 0) __hip_atomic_fetch_max(km + (lane >> 3), __float_as_uint(mx), RLX_AGENT);
                VM_WAIT(); __syncthreads();
                if (tid == 0) __hip_atomic_fetch_add(kc, 1u, RLX_AGENT); }
              STAMP(41);
              gu32* ctrA = ctl + CW_Q + ((L * 2 + 0) * 8 + grp) * 64; gu32* ctrC = ctl + CW_Q + ((L * 2 + 1) * 8 + grp) * 64;
              LAS float* const knl = (LAS float*)(lds + RING_OFF + att::A_KN);
              { LAS float* sln = (LAS float*)(lds + RING_OFF + att::A_SLN);
                if (tid < 128) sln[tid] = (diff_subln + L * 128)[tid] * (1.f - lam_init);
                if (tid >= 128 && tid < 136) knl[tid - 128] = INFINITY;
                if (tid == 136) qs[3] = 0; }
              for (int rep_ = 0; rep_ < REPA_A; ++rep_) {
                  if (tid == 0) qs[0] = (int)__hip_atomic_fetch_add(ctrA + rep_ * 8192, 1u, RLX_AGENT);
                  __syncthreads();
                  int u = __builtin_amdgcn_readfirstlane(qs[0]);
                  att::bf16x8 qrA[4]; qrA[0] = att::bf16x8{}; qrA[1] = qrA[0]; qrA[2] = qrA[0]; qrA[3] = qrA[0]; bool prefA = false;
                  while (u < 128) {
                      if (qs[3] == 0 && wave == 2) {
                          const unsigned c_ = (unsigned)__builtin_amdgcn_readfirstlane((int)__hip_atomic_load(kc, RLX_AGENT));
                          if (c_ >= 32u) { int ln_ = lane; asm volatile("" : "+v"(ln_));
                              if (ln_ < 8) knl[ln_] = sqrtf(__uint_as_float(__hip_atomic_load(km + ln_, RLX_AGENT))); if (ln_ == 0) qs[3] = 1; } }
#ifdef PROBE_AMODE
                      if (rep_ != REPA_A - 1) att::diff_unit<PROBE_AMODE>(grp, 3 - (u >> 5), 31 - (u & 31), PA, YA, lam, knl, ctrA + rep_ * 8192, qs, qrA, prefA, (LAS char*)(lds + RING_OFF), tidp, 0); else
#endif
                      att::diff_unit<0>(grp, 3 - (u >> 5), 31 - (u & 31), PA, YA, lam, knl, ctrA + rep_ * 8192, qs, qrA, prefA, (LAS char*)(lds + RING_OFF), tidp);
                      prefA = true;
                      asm volatile("s_waitcnt lgkmcnt(0)\n\ts_barrier" ::: "memory");
                      u = __builtin_amdgcn_readfirstlane(qs[0]);
                  }
              }
              __syncthreads();
              STAMP(42);
              for (int rep_ = 0; rep_ < REPA_C; ++rep_) {
                  if (tid == 0) qs[1] = (int)__hip_atomic_fetch_add(ctrC + rep_ * 8192, 1u, RLX_AGENT);
                  __syncthreads();
                  int u = __builtin_amdgcn_readfirstlane(qs[1]);
                  while (u < 128) {
                      att::sb_unit(grp, u & 7, 15 - (u >> 3), PC, YC, ctrC + rep_ * 8192, qs + 1, (LAS char*)(lds + RING_OFF), tidp);
                      u = __builtin_amdgcn_readfirstlane(qs[1]);
                  }
              }
            }
            STAMP(43);
            SEAM();
        }
        if (IN(P + 3)) { PHASE_IDS(); CAT(5);
            int vcb = vcu; asm volatile("" : "+s"(vcb));
            att::dil_phase(vcb, PB, BP, BST, (LAS char*)(lds + RING_OFF), tidp);
            SEAM();
        }
        if (IN(P + 4)) { PHASE_IDS(); CAT(6);
            for (int m = gw; m < M; m += NGW) {
                const int hd = lane >> 3; f32x2 st[3]; float mx = -INFINITY;
#pragma unroll
                for (int p = 0; p < 3; ++p) { st[p] = *(const GAS f32x2*)(BST + ((size_t)p * M + m) * 16 + hd * 2); mx = fmaxf(mx, st[p].x); }
                float wgt[3], wsum = 0.f;
#pragma unroll
                for (int p = 0; p < 3; ++p) { wgt[p] = __builtin_amdgcn_exp2f(st[p].x - mx) * st[p].y; wsum += wgt[p]; }
                const float inv = 1.f / wsum; float acc[8];
#pragma unroll
                for (int k = 0; k < 8; ++k) acc[k] = 0.f;
#pragma unroll
                for (int p = 0; p < 3; ++p) { const v4u w = *(const GAS v4u*)(BP + ((size_t)p * M + m) * BW + lane * 8); const float f = wgt[p] * inv;
                    acc[0] += f * bfl(w.x); acc[1] += f * bfh(w.x); acc[2] += f * bfl(w.y); acc[3] += f * bfh(w.y); acc[4] += f * bfl(w.z); acc[5] += f * bfh(w.z); acc[6] += f * bfl(w.w); acc[7] += f * bfh(w.w); }
                v4u o; o.x = pk2(acc[0], acc[1]); o.y = pk2(acc[2], acc[3]); o.z = pk2(acc[4], acc[5]); o.w = pk2(acc[6], acc[7]);
                *(GAS v4u*)(YB + (size_t)m * BW + lane * 8) = o;
            }
            VM_WAIT(); __syncthreads();
            if (GATE_FP8(L)) {
                pg8::Gemm g{(const bf16*)H8, (const bf16*)(Wg8 + (size_t)L * NGATE * D * 2), D / 2}; pg8::StaticOrder S; S.init(M, NGATE, D / 2, G, bx);
                pg8::EpiGate E{GATES, NGATE, b_gate + L * NGATE, pg8::F8_WINV};
                pg8::gemm_phase<pg8::EpiGate, pg8::StaticOrder, true, true, true>(lds + RING_OFF, g, S, E, tidp);
            } else {
                pg8::Gemm g{Hb, Wg_t + (size_t)L * NGATE * D, D}; pg8::StaticOrder S; S.init(M, NGATE, D, G, bx);
                pg8::EpiGate E{GATES, NGATE, b_gate + L * NGATE, 1.f};
                for (int rep_ = 0; rep_ < REPG; ++rep_) { int tq_ = tidp; asm volatile("" : "+v"(tq_)); pg8::gemm_phase<pg8::EpiGate, pg8::StaticOrder, true, true>(lds + RING_OFF, g, S, E, tq_); }
            }

            SEAM();
        }
        if (IN(P + 5)) { PHASE_IDS(); CAT(7);
            pg8::Gemm g{YA, Wb_t + (size_t)L * 3 * D * BW, BW}; pg8::MergeOrder S; S.b.init(M, D, BW, G, bx);
            S.as = (long)(OUT_YB - OUT_YA); S.bs = (long)D * BW * 2;
            pg8::EpiMerge E{GATES, Hb};

 for (int rep_ = 0; rep_ < ((true) ? REPG : 1); ++rep_) { int tq_ = tidp; asm volatile("" : "+v"(tq_));  pg8::gemm_phase<pg8::EpiMerge, pg8::MergeOrder, true, true>(lds + RING_OFF, g, S, E, tq_); }

            SEAM();
        }
        if (IN(P + 6)) { PHASE_IDS(); CAT(8);
            pg8::Gemm g{Hb, Wo_t + (size_t)L * D * D, D}; pg8::StaticOrder S; S.init(M, D, D, G, bx);
            pg8::EpiResB E{(L == 0) ? (const void*)x_in : (const void*)XB, XB, 1.f, L == 0};

 for (int rep_ = 0; rep_ < ((L == 0) ? REPG : 1); ++rep_) { int tq_ = tidp; asm volatile("" : "+v"(tq_));  pg8::gemm_phase<pg8::EpiResB, pg8::StaticOrder, true, true>(lds + RING_OFF, g, S, E, tq_); }

            SEAM();
        }
        if (L == 0) {
            if (IN(P + 7)) { PHASE_IDS(); CAT(9);
                f32x4 g[4];
#pragma unroll
                for (int j = 0; j < 4; ++j) g[j] = ((const GAS f32x4*)(norm_ffn + L * D) + lane)[64 * j];
#if DENSE_FP8
                for (int m = gw; m < M; m += NGW) { f32x4 v[4]; rms_row(XB + (size_t)m * D, g, v, lane); store_row_fp8(Hb8 + (size_t)m * D, v, lane); }
#else
                for (int m = gw; m < M; m += 2 * NGW) { f32x4 v[4], w[4]; rms_row2(XB + (size_t)m * D, XB + (size_t)(m + NGW) * D, g, v, w, lane); store_row_bf16(Hb + (size_t)m * D, v, lane); store_row_bf16(Hb + (size_t)(m + NGW) * D, w, lane); }
#endif
                SEAM();
            }
            if (IN(P + 8)) { PHASE_IDS(); CAT(10);
#if DENSE_FP8
                pg8::Gemm g{(const bf16*)Hb8, (const bf16*)Wgu8, D / 2}; pg8::StaticOrder S; S.init(M, 2 * DFF, D / 2, G, bx);
                pg8::EpiSwigluF8 E{ACT8, DFF};
                for (int rep_ = 0; rep_ < REPG; ++rep_) { int tq_ = tidp; asm volatile("" : "+v"(tq_)); pg8::gemm_phase<pg8::EpiSwigluF8, pg8::StaticOrder, true, true, true>(lds + RING_OFF, g, S, E, tq_); }
#elif DENSE_DOWN_FP8
                pg8::Gemm g{Hb, Wgu_t, D}; pg8::StaticOrder S; S.init(M, 2 * DFF, D, G, bx);
                pg8::EpiSwigluF8 E{ACT8, DFF, 1.f};
                pg8::gemm_phase<pg8::EpiSwigluF8, pg8::StaticOrder, true, true>(lds + RING_OFF, g, S, E, tidp);
#else
                pg8::Gemm g{Hb, Wgu_t, D}; pg8::StaticOrder S; S.init(M, 2 * DFF, D, G, bx);
                pg8::EpiSwiglu E{ACT, DFF};
                for (int rep_ = 0; rep_ < REPG; ++rep_) { int tq_ = tidp; asm volatile("" : "+v"(tq_)); pg8::gemm_phase<pg8::EpiSwiglu, pg8::StaticOrder, true, true>(lds + RING_OFF, g, S, E, tq_); }
#endif

                SEAM();
            }
            if (IN(P + 9)) { PHASE_IDS(); CAT(11);
#if DENSE_FP8 || DENSE_DOWN_FP8
                pg8::EpiResB E{XB, XB, pg8::F8_WINV, 0};
                pg8::Gemm g{(const bf16*)ACT8, (const bf16*)Wd8, DFF / 2}; pg8::StaticOrder S; S.init(M, D, DFF / 2, G, bx);
                pg8::gemm_phase<pg8::EpiResB, pg8::StaticOrder, true, true, true>(lds + RING_OFF, g, S, E, tidp);
#else
                pg8::EpiResB E{XB, XB, 1.f, 0};
                pg8::Gemm g{ACT, Wd_t, DFF}; pg8::StaticOrder S; S.init(M, D, DFF, G, bx);
                pg8::gemm_phase<pg8::EpiResB, pg8::StaticOrder, true, true>(lds + RING_OFF, g, S, E, tidp);
#endif

                SEAM();
            }
        } else {
            if (IN(P + 7)) { PHASE_IDS(); CAT(12);
                LAS float* wr = (LAS float*)(lds + RING_OFF);
                LAS int* cl = (LAS int*)(lds + RING_OFF + 32768);
                for (int u = tid; u < D * NEXP; u += NWAVES * 64) wr[(u & 7) * D + (u >> 3)] = w_router[u];
                if (tid < NEXP) cl[tid] = 0;
                __syncthreads();
                f32x4 g[4];
#pragma unroll
                for (int j = 0; j < 4; ++j) g[j] = ((const GAS f32x4*)(norm_ffn + L * D) + lane)[64 * j];
                for (int k = 0; k < 16; ++k) { const int m = bx * 128 + wave + 8 * k;
                    f32x4 v[4]; rms_row(XB + (size_t)m * D, g, v, lane);
#if FFN_FP8
                    store_row_fp8(Hb8 + (size_t)m * D, v, lane);
#else
                    store_row_bf16(Hb + (size_t)m * D, v, lane);
#endif
                    float lg[NEXP];
#pragma unroll
                    for (int e = 0; e < NEXP; ++e) lg[e] = 0.f;
#pragma unroll
                    for (int j = 0; j < 4; ++j)
#pragma unroll
                        for (int e = 0; e < NEXP; ++e) { const f32x4 w4 = *(const LAS f32x4*)(wr + e * D + 4 * lane + 256 * j); lg[e] += (v[j].x * w4.x + v[j].y * w4.y) + (v[j].z * w4.z + v[j].w * w4.w); }
#pragma unroll
                    for (int e = 0; e < NEXP; ++e) lg[e] = wave_sum(lg[e]);
                    int e1 = 0; float v1 = lg[0];
#pragma unroll
                    for (int e = 1; e < NEXP; ++e) if (lg[e] > v1) { v1 = lg[e]; e1 = e; }
                    int e2 = -1; float v2 = -INFINITY;
#pragma unroll
                    for (int e = 0; e < NEXP; ++e) if (e != e1 && lg[e] > v2) { v2 = lg[e]; e2 = e; }
                    const float w1 = 1.f / (1.f + expf(v2 - v1));
                    if (lane == 0) { TOKE[m] = e1 | (e2 << 8); TOKW[2 * m] = w1; TOKW[2 * m + 1] = 1.f - w1; __hip_atomic_fetch_add(cl + e1, 1, __ATOMIC_RELAXED, __HIP_MEMORY_SCOPE_WORKGROUP); __hip_atomic_fetch_add(cl + e2, 1, __ATOMIC_RELAXED, __HIP_MEMORY_SCOPE_WORKGROUP); }
                }
                __syncthreads();
                if (tid < NEXP) CNT[bx * NEXP + tid] = cl[tid];
                __syncthreads();
#if FFN_FP8
                conv_flat8(w_mg, (size_t)D * DFX, NEXP, D, DFX, MWgu8, (size_t)2 * DFX * D, 1, lds + RING_OFF, wave, gw, NGW, lane);
                conv_flat8(w_mu, (size_t)D * DFX, NEXP, D, DFX, MWgu8, (size_t)2 * DFX * D, 2, lds + RING_OFF, wave, gw, NGW, lane);
                conv_flat8(w_md, (size_t)DFX * D, NEXP, DFX, D, MWd8, (size_t)D * DFX, 0, lds + RING_OFF, wave, gw, NGW, lane);
#endif
                for (int e = 0; e < (FFN_FP8 ? 0 : NEXP); ++e) {
#if FFN_FP8
#else
                    conv_matrix(w_mg + (size_t)e * D * DFX, D, DFX, MWgu + (size_t)e * 2 * DFX * D, 1, scr, gw, NGW, lane);
                    conv_matrix(w_mu + (size_t)e * D * DFX, D, DFX, MWgu + (size_t)e * 2 * DFX * D, 2, scr, gw, NGW, lane);
                    conv_matrix(w_md + (size_t)e * DFX * D, DFX, D, MWd + (size_t)e * D * DFX, 0, scr, gw, NGW, lane);
#endif
                }
                SEAM();
            }
            if (IN(P + 8)) { PHASE_IDS(); CAT(13);
                LAS int* C = (LAS int*)(lds + RING_OFF);
                LAS int* TB = (LAS int*)(lds + RING_OFF + 8192);
                LAS int* SL = (LAS int*)(lds + RING_OFF + 8192 + 256);
                for (int u = tid; u < 256 * NEXP; u += NWAVES * 64) C[u] = CNT[u];
                __syncthreads();
                { const int e = wave; int tot = 0, pre = 0;
#pragma unroll
                  for (int q = 0; q < 4; ++q) { const int i = 4 * lane + q; const int cv = C[i * NEXP + e]; tot += cv; pre += (i < bx) ? cv : 0; }
                  tot = wave_sum_i(tot); pre = wave_sum_i(pre);
                  if (lane == 0) { TB[e] = pre; TB[8 + e] = tot; } }
                __syncthreads();
                if (tid == 0) { int base = 0, cum = 0;
                    for (int e = 0; e < NEXP; ++e) { TB[16 + e] = base; const int nt = (TB[8 + e] + 255) >> 8; base += nt * 256; cum += nt; if (bx == 0) MHDR[1 + e] = cum; }
                    if (bx == 0) MHDR[0] = cum; }
                __syncthreads();
                if (wave == 0) {
                    const int t0 = bx * 128 + 2 * lane; const int ea = TOKE[t0], eb = TOKE[t0 + 1];
                    int pe[4] = {ea & 255, ea >> 8, eb & 255, eb >> 8}; int slot[4] = {0, 0, 0, 0};
#pragma unroll
                    for (int e = 0; e < NEXP; ++e) { int mine = 0;
#pragma unroll
                        for (int q = 0; q < 4; ++q) mine += (pe[q] == e) ? 1 : 0;
                        int inc = mine;
#pragma unroll
                        for (int o = 1; o < 64; o <<= 1) { const int t = __builtin_amdgcn_ds_bpermute(((lane - o) & 63) << 2, inc); if (lane >= o) inc += t; }
                        int run = TB[16 + e] + TB[e] + inc - mine;
#pragma unroll
                        for (int q = 0; q < 4; ++q) if (pe[q] == e) { slot[q] = run; ++run; } }
                    const f32x4 wv = *(const GAS f32x4*)(TOKW + 2 * t0);
                    SL[4 * lane + 0] = slot[0]; SL[4 * lane + 1] = slot[1]; SL[4 * lane + 2] = slot[2]; SL[4 * lane + 3] = slot[3];
                    { v4u sv; sv.x = (unsigned)slot[0]; sv.y = (unsigned)slot[1]; sv.z = (unsigned)slot[2]; sv.w = (unsigned)slot[3]; *(GAS v4u*)(SLOT + 2 * t0) = sv; }
                    SLW[slot[0]] = wv.x; SLW[slot[1]] = wv.y; SLW[slot[2]] = wv.z; SLW[slot[3]] = wv.w;
                }
                __syncthreads();
                for (int k = 0; k < 16; ++k) { const int tl = wave + 8 * k; const int m = bx * 128 + tl; const int s0 = SL[2 * tl], s1 = SL[2 * tl + 1];
#if FFN_FP8
                    const v4u a = ((const GAS v4u*)(Hb8 + (size_t)m * D))[lane];
                    ((GAS v4u*)(HS8 + (size_t)s0 * D))[lane] = a; ((GAS v4u*)(HS8 + (size_t)s1 * D))[lane] = a; }
#else
                    const GAS v4u* src = (const GAS v4u*)(Hb + (size_t)m * D) + lane; const v4u a = src[0], b = src[64];
                    GAS v4u* d0 = (GAS v4u*)(HS + (size_t)s0 * D) + lane; GAS v4u* d1 = (GAS v4u*)(HS + (size_t)s1 * D) + lane;
                    d0[0] = a; d0[64] = b; d1[0] = a; d1[64] = b; }
#endif
                SEAM();
            }
            {
                int nt_all = 0, c0 = 0, c1 = 0, c2 = 0, c3 = 0, c4 = 0, c5 = 0, c6 = 0;
                if (hi > P + 9 && lo < P + 19) { const int* hd = MHDR;
                    nt_all = __builtin_amdgcn_readfirstlane(hd[0]); c0 = __builtin_amdgcn_readfirstlane(hd[1]); c1 = __builtin_amdgcn_readfirstlane(hd[2]); c2 = __builtin_amdgcn_readfirstlane(hd[3]);
                    c3 = __builtin_amdgcn_readfirstlane(hd[4]); c4 = __builtin_amdgcn_readfirstlane(hd[5]); c5 = __builtin_amdgcn_readfirstlane(hd[6]); c6 = __builtin_amdgcn_readfirstlane(hd[7]); }
                if (nt_all > MOE_MAX_TILES) nt_all = MOE_MAX_TILES;
                for (int ch = 0; ch < MOE_MAX_CH; ++ch) {
                    const int t0 = ch * MOE_CH_TILES; int nt = nt_all - t0; if (nt > MOE_CH_TILES) nt = MOE_CH_TILES;
                    if (nt <= 0) break;
                    if (IN(P + 9 + 2 * ch)) { PHASE_IDS(); CAT(14);
#if FFN_FP8
                        pg8::Gemm g{(const bf16*)HS8, (const bf16*)MWgu8, D / 2}; pg8::MoeOrder S{t0, nt, 2 * DFX / 256, nt * (2 * DFX / 256), G, bx, (long)256 * D, (long)256 * D, (long)2 * DFX * D, c0, c1, c2, c3, c4, c5, c6, false, true};
                        pg8::EpiSwigluF8 E{MACT8, DFX};
                        pg8::gemm_phase<pg8::EpiSwigluF8, pg8::MoeOrder, true, true, true>(lds + RING_OFF, g, S, E, tidp);
#else
                        pg8::Gemm g{HS, MWgu, D}; pg8::MoeOrder S{t0, nt, 2 * DFX / 256, nt * (2 * DFX / 256), G, bx, (long)256 * D * 2, (long)256 * D * 2, (long)2 * DFX * D * 2, c0, c1, c2, c3, c4, c5, c6, false, true};
                        pg8::EpiSwiglu E{MACT, DFX};
                        pg8::gemm_phase<pg8::EpiSwiglu, pg8::MoeOrder, true, true>(lds + RING_OFF, g, S, E, tidp);
#endif

                        SEAM();
                    }
                    if (IN(P + 10 + 2 * ch)) { PHASE_IDS(); CAT(15);
#if FFN_FP8
                        if (ch == 2) {
                            pg8::Gemm g{(const bf16*)MACT8, (const bf16*)MWd8, DFX / 2, DFX / 128 / MOE_SK}; pg8::MoeOrderSK S{t0, nt, D / 256, MOE_SK, nt * (D / 256) * MOE_SK, G, bx, (long)256 * DFX, (long)256 * DFX, (long)D * DFX, (long)DFX / MOE_SK, c0, c1, c2, c3, c4, c5, c6};
                            pg8::EpiMoeDownPart E{PART, SLW, pg8::F8_WINV, t0 * 256, MOE_SK_ROWS};
                            pg8::gemm_phase<pg8::EpiMoeDownPart, pg8::MoeOrderSK, true, true, true>(lds + RING_OFF, g, S, E, tidp);
                        } else {
                        pg8::Gemm g{(const bf16*)MACT8, (const bf16*)MWd8, DFX / 2}; pg8::MoeOrder S{t0, nt, D / 256, nt * (D / 256), G, bx, (long)256 * DFX, (long)256 * DFX, (long)D * DFX, c0, c1, c2, c3, c4, c5, c6, true, false};
                        pg8::EpiMoeDown E{YS8, SLW, pg8::F8_WINV};
                        pg8::gemm_phase<pg8::EpiMoeDown, pg8::MoeOrder, true, true, true>(lds + RING_OFF, g, S, E, tidp);
                        }
#else
                        pg8::Gemm g{MACT, MWd, DFX}; pg8::MoeOrder S{t0, nt, D / 256, nt * (D / 256), G, bx, (long)256 * DFX * 2, (long)256 * DFX * 2, (long)D * DFX * 2, c0, c1, c2, c3, c4, c5, c6, true, false};
                        pg8::EpiMoeDown E{HS, SLW, 1.f};
                        pg8::gemm_phase<pg8::EpiMoeDown, pg8::MoeOrder, true, true>(lds + RING_OFF, g, S, E, tidp);
#endif

                        SEAM();
                    }
                }
            }
            if (IN(P + 19)) { PHASE_IDS();
                f32x4 g[4];
#pragma unroll
                for (int j = 0; j < 4; ++j) g[j] = ((const GAS f32x4*)norm_final + lane)[64 * j];
                unsigned bad = 0u;
#if MK_N_LAUNCHES == 1
                bad = __hip_atomic_load(ctl + CW_BAR + XB_TMO, RLX_AGENT);
#endif
#ifdef PROBE_CAT
                CAT(16);
#endif
#if FFN_FP8
                const bf16* const ysb = YS8;
#else
                const bf16* const ysb = HS;
#endif
                for (int m = gw; m < M; m += 2 * NGW) {
                    const int ma = m, mb = m + NGW;
                    const v4u sl = (v4u){(unsigned)SLOT[2 * ma], (unsigned)SLOT[2 * ma + 1], (unsigned)SLOT[2 * mb], (unsigned)SLOT[2 * mb + 1]};
                    const GAS v2u* xa = (const GAS v2u*)(XB + (size_t)ma * D) + lane; const GAS v2u* xb = (const GAS v2u*)(XB + (size_t)mb * D) + lane;
                    const GAS v2u* a0 = (const GAS v2u*)(ysb + (size_t)sl.x * D) + lane; const GAS v2u* a1 = (const GAS v2u*)(ysb + (size_t)sl.y * D) + lane;
                    const GAS v2u* b0 = (const GAS v2u*)(ysb + (size_t)sl.z * D) + lane; const GAS v2u* b1 = (const GAS v2u*)(ysb + (size_t)sl.w * D) + lane;
                    f32x4 va[4], vb[4]; v2u xa4[4], xb4[4], pa0[4], pa1[4], pb0[4], pb1[4];
#pragma unroll
                    for (int j = 0; j < 4; ++j) { xa4[j] = xa[64 * j]; xb4[j] = xb[64 * j]; pa0[j] = a0[64 * j]; pa1[j] = a1[64 * j]; pb0[j] = b0[64 * j]; pb1[j] = b1[64 * j]; }
                    f32x4 ca0[4], ca1[4], cb0[4], cb1[4];
#pragma unroll
                    for (int j = 0; j < 4; ++j) { ca0[j] = bf4(pa0[j]); ca1[j] = bf4(pa1[j]); cb0[j] = bf4(pb0[j]); cb1[j] = bf4(pb1[j]); }
#if FFN_FP8
#define TAIL_SLOT(S_, C_) if ((S_) >= (unsigned)(2 * MOE_CH_TILES * 256)) { const GAS f32x4* pp_ = (const GAS f32x4*)(PART + (size_t)((S_) - 2 * MOE_CH_TILES * 256) * D) + lane; \
                        _Pragma("unroll") for (int j = 0; j < 4; ++j) { f32x4 s_ = pp_[64 * j]; _Pragma("unroll") for (int q_ = 1; q_ < MOE_SK; ++q_) s_ += pp_[(size_t)q_ * MOE_SK_ROWS * (D / 4) + 64 * j]; C_[j] = s_; } }
                    TAIL_SLOT(sl.x, ca0) TAIL_SLOT(sl.y, ca1) TAIL_SLOT(sl.z, cb0) TAIL_SLOT(sl.w, cb1)
#undef TAIL_SLOT
#endif
                    float sa = 0.f, sb = 0.f;
#pragma unroll
                    for (int j = 0; j < 4; ++j) { va[j] = bf4(xa4[j]) + (ca0[j] + ca1[j]); vb[j] = bf4(xb4[j]) + (cb0[j] + cb1[j]);
                        sa += (va[j].x * va[j].x + va[j].y * va[j].y) + (va[j].z * va[j].z + va[j].w * va[j].w); sb += (vb[j].x * vb[j].x + vb[j].y * vb[j].y) + (vb[j].z * vb[j].z + vb[j].w * vb[j].w); }
                    const float ra = 1.f / sqrtf(wave_sum(sa) * (1.f / D) + EPS), rb = 1.f / sqrtf(wave_sum(sb) * (1.f / D) + EPS);
                    GAS f32x4* oa = (GAS f32x4*)(xout + (size_t)ma * D) + lane; GAS f32x4* ob = (GAS f32x4*)(xout + (size_t)mb * D) + lane;
                    const float q = __builtin_nanf("");
#pragma unroll
                    for (int j = 0; j < 4; ++j) { f32x4 o = va[j] * ra * g[j], p = vb[j] * rb * g[j]; if (bad) { o = (f32x4){q, q, q, q}; p = o; } oa[64 * j] = o; ob[64 * j] = p; }
                }
#ifdef PROBE_CAT
                if (bx == 0 && tid == 0) { { const unsigned long long tn_ = __builtin_amdgcn_s_memrealtime(); volatile LAS unsigned* pa_ = (volatile LAS unsigned*)(lds + LDSCTL_OFF + 640); if (cat_ == PROBE_CAT) pa_[0] += (unsigned)(tn_ - *(volatile LAS unsigned long long*)(lds + LDSCTL_OFF + 704)); } const unsigned ticks = *(volatile LAS unsigned*)(lds + LDSCTL_OFF + 640); const unsigned long long te_ = __builtin_amdgcn_s_memrealtime(); const unsigned long long tw_ = (unsigned long long)ticks * PROBE_AMP; while (__builtin_amdgcn_s_memrealtime() - te_ < (tw_ < 5000000ull ? tw_ : 5000000ull)) __builtin_amdgcn_s_sleep(8); }
#endif
            }
        }
    }
#undef IN
#undef SEAM
}

extern "C" void kernel_launch(void* const* d_in, const int* in_sizes, int n_in, void* d_out, int out_size, void* d_ws, size_t ws_size, hipStream_t stream) {
    static int grid = 0;
    if (grid == 0) {
        if (n_in != 18 || in_sizes[0] != M * D || out_size != M * D || ws_size < WS_END) { fprintf(stderr, "kernel_launch: unexpected shapes (n_in %d, in0 %d, out %d, ws %zu < %zu); nothing launched\n", n_in, n_in > 0 ? in_sizes[0] : -1, out_size, ws_size, (size_t)WS_END); grid = -1; return; }
        int dev = 0, cus = 0, per_cu = 0;
        if (hipGetDevice(&dev) != hipSuccess || hipDeviceGetAttribute(&cus, hipDeviceAttributeMultiprocessorCount, dev) != hipSuccess) { grid = -1; return; }
        if (hipFuncSetAttribute((const void*)mega_fwd, hipFuncAttributeMaxDynamicSharedMemorySize, LDS_BYTES) != hipSuccess) { fprintf(stderr, "kernel_launch: hipFuncSetAttribute failed\n"); grid = -1; return; }
        if (hipOccupancyMaxActiveBlocksPerMultiprocessor(&per_cu, (const void*)mega_fwd, NWAVES * 64, LDS_BYTES) != hipSuccess || per_cu < 1) fprintf(stderr, "kernel_launch: occupancy query reports %d workgroups per CU\n", per_cu);
        (void)hipGetLastError();
        grid = cus;
        if (grid != 256) { fprintf(stderr, "kernel_launch: built for 256 CUs, device has %d; nothing launched\n", cus); grid = -1; return; }
    }
    if (grid < 0) return;
    if (hipMemsetAsync((char*)d_ws + WS_CTL, 0, CTL_ZERO_BYTES, stream) != hipSuccess) return;
    Args a{};
    for (int i = 0; i < 18; ++i) a.in[i] = (const float*)d_in[i];
    a.out = (float*)d_out; a.ws = (unsigned char*)d_ws;
#if MK_N_LAUNCHES == 1
    a.ph_lo = 0; a.ph_hi = NPHASE;
    hipLaunchKernelGGL(mega_fwd, dim3(grid), dim3(NWAVES * 64), LDS_BYTES, stream, a);
#else
    for (int p = 0; p < NPHASE; ++p) {
        const int r = (p - 1) % PH_L, L = (p - 1) / PH_L;
        if (p > 0 && L == 0 && r >= 10) continue;
        a.ph_lo = p; a.ph_hi = p + 1;
        hipLaunchKernelGGL(mega_fwd, dim3(grid), dim3(NWAVES * 64), LDS_BYTES, stream, a);
    }
#endif
}
```
